# Optimizing an MI355X kernel written in HIP

```python
import jax, jax.numpy as jnp
from jax import lax
import numpy as np

D_MODEL = 2048
BATCH = 1
SEQ = 8192
DEPTH = 2

HEAD_DIM = 128
N_HEADS_A = 6
N_HEADS_B = 6
N_HEADS_C = 4
W_A = N_HEADS_A * HEAD_DIM
W_B = N_HEADS_B * HEAD_DIM
W_C = N_HEADS_C * HEAD_DIM
Q_RANK_A = 512
KV_RANK_A = 256
N_IDX_HEADS = 16
IDX_DIM = 64
TOPK_A_MAX = 256
MOBA_BLOCK = 256
MOBA_TOPK = 3
N_MEM = 256
N_ALIBI = N_HEADS_A + N_HEADS_B
N_GROUPS = 4
EXPERTS_PER_GROUP = 8
N_EXPERTS = N_GROUPS * EXPERTS_PER_GROUP
TOPK_IN_GROUP = 2
D_EXPERT = 512
Q_BLOCK = 128
ALPHA = (2 * DEPTH) ** 0.25
BETA = (8 * DEPTH) ** -0.25
NORM_EPS = 1e-5
NEG = -1e30

kernel_name = 'hybrid_dsa_moba_mem_hmoe_deepnorm'


def layer_norm(x, g, b):
    xf = x.astype(jnp.float32)
    mu = jnp.mean(xf, -1, keepdims=True)
    var = jnp.mean(jnp.square(xf - mu), -1, keepdims=True)
    return ((xf - mu) * lax.rsqrt(var + NORM_EPS) * g.astype(jnp.float32) + b.astype(jnp.float32)).astype(x.dtype)


def rms_norm(x, g):
    xf = x.astype(jnp.float32)
    return (xf * lax.rsqrt(jnp.mean(jnp.square(xf), -1, keepdims=True) + NORM_EPS) * g.astype(jnp.float32)).astype(x.dtype)


def split_cols(h):
    sizes = [Q_RANK_A, KV_RANK_A, IDX_DIM, N_IDX_HEADS, W_B, W_B, W_B, W_C]
    return jnp.split(h, np.cumsum(sizes)[:-1].tolist(), axis=-1)


def dsa_attention(q, k, v, q_idx, k_idx, w_idx, slopes):
    B, T = q.shape[:2]
    top_k = min(TOPK_A_MAX, T // 4)
    s_pos = jnp.arange(T)

    def one_block(i):
        t0 = i * Q_BLOCK
        t_pos = t0 + jnp.arange(Q_BLOCK)
        qi = lax.dynamic_slice_in_dim(q_idx, t0, Q_BLOCK, axis=1)
        wi = lax.dynamic_slice_in_dim(w_idx, t0, Q_BLOCK, axis=1)
        rel = jax.nn.relu(jnp.einsum('bqhd,bsd->bqhs', qi, k_idx))
        score = jnp.einsum('bqh,bqhs->bqs', wi, rel).astype(jnp.float32)
        score = jnp.where((s_pos[None, :] <= t_pos[:, None])[None], score, NEG)
        _, sel = lax.top_k(score, top_k)
        ks = jax.vmap(lambda kk, ii: kk[ii])(k, sel)
        vs = jax.vmap(lambda vv, ii: vv[ii])(v, sel)
        qb = lax.dynamic_slice_in_dim(q, t0, Q_BLOCK, axis=1)
        s = jnp.einsum('bqhd,bqkhd->bhqk', qb, ks).astype(jnp.float32) * HEAD_DIM ** -0.5
        dist = (t_pos[None, :, None] - sel).astype(jnp.float32)
        s = s - slopes[None, :, None, None] * dist[:, None]
        s = jnp.where((sel <= t_pos[None, :, None])[:, None], s, NEG)
        p = jax.nn.softmax(s, axis=-1).astype(v.dtype)
        return jnp.einsum('bhqk,bqkhd->bqhd', p, vs)

    o = lax.map(one_block, jnp.arange(T // Q_BLOCK))
    return jnp.moveaxis(o, 0, 1).reshape(B, T, -1)


def moba_attention(q, k, v, slopes):
    B, T, H, Dh = q.shape
    n_kb = -(-T // MOBA_BLOCK)
    t_pad = n_kb * MOBA_BLOCK
    top_b = min(MOBA_TOPK, n_kb)
    pad = ((0, 0), (0, t_pad - T), (0, 0), (0, 0))
    k_p, v_p = jnp.pad(k, pad), jnp.pad(v, pad)
    k_blk = k_p.reshape(B, n_kb, MOBA_BLOCK, H, Dh)
    k_mean = jnp.mean(k_blk, axis=2)
    k_bh = k_blk.transpose(0, 3, 1, 2, 4)
    v_bh = v_p.reshape(B, n_kb, MOBA_BLOCK, H, Dh).transpose(0, 3, 1, 2, 4)
    h_ix = jnp.arange(H)[None, :, None]
    off = jnp.arange(MOBA_BLOCK)
    scale = Dh ** -0.5

    def one_block(i):
        t0 = i * Q_BLOCK
        t_pos = t0 + jnp.arange(Q_BLOCK)
        c = t0 // MOBA_BLOCK
        qb = lax.dynamic_slice_in_dim(q, t0, Q_BLOCK, axis=1)
        gate = jnp.einsum('bqhd,bnhd->bqhn', qb, k_mean).astype(jnp.float32)
        gate = jnp.where(jnp.arange(n_kb) < c, gate, NEG)
        _, blk = lax.top_k(gate, top_b)
        ks = jax.vmap(lambda kk, ii: kk[h_ix, ii])(k_bh, blk)
        vs = jax.vmap(lambda vv, ii: vv[h_ix, ii])(v_bh, blk)
        s_sel = jnp.einsum('bqhd,bqhjkd->bqhjk', qb, ks).astype(jnp.float32) * scale
        pos_sel = blk[..., None] * MOBA_BLOCK + off
        dist_sel = (t_pos[None, :, None, None, None] - pos_sel).astype(jnp.float32)
        s_sel = s_sel - slopes[None, None, :, None, None] * dist_sel
        s_sel = jnp.where((blk < c)[..., None], s_sel, NEG)
        k_own = lax.dynamic_slice_in_dim(k_p, c * MOBA_BLOCK, MOBA_BLOCK, axis=1)
        v_own = lax.dynamic_slice_in_dim(v_p, c * MOBA_BLOCK, MOBA_BLOCK, axis=1)
        s_own = jnp.einsum('bqhd,bkhd->bqhk', qb, k_own).astype(jnp.float32) * scale
        dist_own = t_pos[:, None] - (c * MOBA_BLOCK + off)[None, :]
        s_own = s_own - slopes[None, None, :, None] * dist_own.astype(jnp.float32)[None, :, None, :]
        s_own = jnp.where((dist_own >= 0)[None, :, None, :], s_own, NEG)
        s = jnp.concatenate([s_sel.reshape(B, Q_BLOCK, H, top_b * MOBA_BLOCK), s_own], axis=-1)
        p = jax.nn.softmax(s, axis=-1).astype(v.dtype)
        p_sel = p[..., :top_b * MOBA_BLOCK].reshape(B, Q_BLOCK, H, top_b, MOBA_BLOCK)
        p_own = p[..., top_b * MOBA_BLOCK:]
        return (jnp.einsum('bqhjk,bqhjkd->bqhd', p_sel, vs)
                + jnp.einsum('bqhk,bkhd->bqhd', p_own, v_own))

    o = lax.map(one_block, jnp.arange(T // Q_BLOCK))
    return jnp.moveaxis(o, 0, 1).reshape(B, T, -1)


def memory_attention(q, mk, mv):
    B, T = q.shape[:2]
    s = jnp.einsum('bthd,bmhd->bhtm', q, mk).astype(jnp.float32) * HEAD_DIM ** -0.5
    p = jax.nn.softmax(s, axis=-1).astype(mv.dtype)
    return jnp.einsum('bhtm,bmhd->bthd', p, mv).reshape(B, T, -1)


def hier_moe(x, w_grp, b_grp, w_rt, b_rt, w1, w3, w2):
    B, T, D = x.shape
    xt = x.reshape(B * T, D)
    n = xt.shape[0]
    g_logit = (xt @ w_grp + b_grp).astype(jnp.float32)
    g_sel = jnp.argmax(g_logit, axis=-1)
    p_g = jnp.take_along_axis(jax.nn.softmax(g_logit, -1), g_sel[:, None], -1)
    e_logit = (xt @ w_rt + b_rt).astype(jnp.float32).reshape(n, N_GROUPS, EXPERTS_PER_GROUP)
    e_logit = jnp.take_along_axis(e_logit, g_sel[:, None, None], axis=1)[:, 0]
    p_e, e_sel = lax.top_k(jax.nn.softmax(e_logit, -1), TOPK_IN_GROUP)
    p_e = p_e / jnp.sum(p_e, -1, keepdims=True)
    wts = p_g * p_e
    gidx = g_sel[:, None] * EXPERTS_PER_GROUP + e_sel
    comb = jnp.einsum('nk,nke->ne', wts, jax.nn.one_hot(gidx, N_EXPERTS, dtype=jnp.float32)).astype(x.dtype)
    out = jnp.zeros_like(xt)
    for e in range(N_EXPERTS):
        hid = jax.nn.silu(xt @ w1[e]) * (xt @ w3[e])
        out = out + comb[:, e:e + 1] * (hid @ w2[e])
    return out.reshape(B, T, D)


def setup_inputs(seed: int = 0) -> dict:
    key = jax.random.key(seed)
    keys = iter(jax.random.split(key, 64))

    def nrm(shape, fan_in, scale=1.0):
        return jax.random.normal(next(keys), shape, jnp.float32) * (scale * fan_in ** -0.5)

    def gain(shape):
        return 1.0 + 0.05 * jax.random.normal(next(keys), shape, jnp.float32)

    def bias(shape):
        return 0.01 * jax.random.normal(next(keys), shape, jnp.float32)

    L, D = DEPTH, D_MODEL
    x = jax.random.normal(next(keys), (BATCH, SEQ, D), jnp.float32)
    mem = jax.random.normal(next(keys), (BATCH, N_MEM, D), jnp.float32)
    w_mem_kv = jnp.concatenate([nrm((D, W_C), D), nrm((D, W_C), D, BETA)], -1)
    w_in = jnp.concatenate([
        nrm((L, D, Q_RANK_A), D), nrm((L, D, KV_RANK_A), D), nrm((L, D, IDX_DIM), D),
        nrm((L, D, N_IDX_HEADS), D), nrm((L, D, W_B), D), nrm((L, D, W_B), D),
        nrm((L, D, W_B), D, BETA), nrm((L, D, W_C), D)], -1)
    return {
        'x': x,
        'mem': mem,
        'w_mem_kv': w_mem_kv,
        'w_in': w_in,
        'g_cq': gain((L, Q_RANK_A)),
        'g_ckv': gain((L, KV_RANK_A)),
        'g_kidx': gain((L, IDX_DIM)),
        'b_kidx': bias((L, IDX_DIM)),
        'w_uq': nrm((L, Q_RANK_A, W_A), Q_RANK_A),
        'w_uqi': nrm((L, Q_RANK_A, N_IDX_HEADS * IDX_DIM), Q_RANK_A),
        'w_ukv': jnp.concatenate([nrm((L, KV_RANK_A, W_A), KV_RANK_A), nrm((L, KV_RANK_A, W_A), KV_RANK_A, BETA)], -1),
        'w_up_a': nrm((L, W_A, D), W_A, BETA),
        'w_up_b': nrm((L, W_B, D), W_B, BETA),
        'w_up_c': nrm((L, W_C, D), W_C, BETA),
        'w_gate': nrm((L, D, 3 * D), D),
        'b_gate': bias((L, 3 * D)),
        'w_o': nrm((L, D, D), D, BETA),
        'ln1_g': gain((L, D)),
        'ln1_b': bias((L, D)),
        'w_grp': nrm((L, D, N_GROUPS), D),
        'b_grp': bias((L, N_GROUPS)),
        'w_rt': nrm((L, D, N_EXPERTS), D),
        'b_rt': bias((L, N_EXPERTS)),
        'w1': nrm((L, N_EXPERTS, D, D_EXPERT), D),
        'w3': nrm((L, N_EXPERTS, D, D_EXPERT), D),
        'w2': nrm((L, N_EXPERTS, D_EXPERT, D), D_EXPERT, BETA),
        'ln2_g': gain((L, D)),
        'ln2_b': bias((L, D)),
    }


def reference(x, mem, w_mem_kv, w_in, g_cq, g_ckv, g_kidx, b_kidx, w_uq, w_uqi, w_ukv,
              w_up_a, w_up_b, w_up_c, w_gate, b_gate, w_o, ln1_g, ln1_b,
              w_grp, b_grp, w_rt, b_rt, w1, w3, w2, ln2_g, ln2_b):
    B, T, _ = x.shape
    slopes = 2.0 ** (-8.0 * jnp.arange(1, N_ALIBI + 1, dtype=jnp.float32) / N_ALIBI)
    slopes_a, slopes_b = slopes[0::2], slopes[1::2]
    mk, mv = jnp.split(mem @ w_mem_kv, 2, axis=-1)
    mk = mk.reshape(B, N_MEM, N_HEADS_C, HEAD_DIM)
    mv = mv.reshape(B, N_MEM, N_HEADS_C, HEAD_DIM)
    for l in range(DEPTH):
        h = x
        c_q, c_kv, k_i, w_i, q_b, k_b, v_b, q_c = split_cols(h @ w_in[l])
        c_q = rms_norm(c_q, g_cq[l])
        c_kv = rms_norm(c_kv, g_ckv[l])
        q_a = (c_q @ w_uq[l]).reshape(B, T, N_HEADS_A, HEAD_DIM)
        q_i = (c_q @ w_uqi[l]).reshape(B, T, N_IDX_HEADS, IDX_DIM) * IDX_DIM ** -0.5
        k_a, v_a = jnp.split(c_kv @ w_ukv[l], 2, axis=-1)
        k_a = k_a.reshape(B, T, N_HEADS_A, HEAD_DIM)
        v_a = v_a.reshape(B, T, N_HEADS_A, HEAD_DIM)
        k_i = layer_norm(k_i, g_kidx[l], b_kidx[l])
        w_i = w_i * N_IDX_HEADS ** -0.5
        o_a = dsa_attention(q_a, k_a, v_a, q_i, k_i, w_i, slopes_a)
        o_b = moba_attention(q_b.reshape(B, T, N_HEADS_B, HEAD_DIM), k_b.reshape(B, T, N_HEADS_B, HEAD_DIM),
                             v_b.reshape(B, T, N_HEADS_B, HEAD_DIM), slopes_b)
        o_c = memory_attention(q_c.reshape(B, T, N_HEADS_C, HEAD_DIM), mk, mv)
        g_a, g_b, g_c = jnp.split(jax.nn.sigmoid(h @ w_gate[l] + b_gate[l]), 3, axis=-1)
        merged = g_a * (o_a @ w_up_a[l]) + g_b * (o_b @ w_up_b[l]) + g_c * (o_c @ w_up_c[l])
        x = layer_norm(ALPHA * x + merged @ w_o[l], ln1_g[l], ln1_b[l])
        y = hier_moe(x, w_grp[l], b_grp[l], w_rt[l], b_rt[l], w1[l], w3[l], w2[l])
        x = layer_norm(ALPHA * x + y, ln2_g[l], ln2_b[l])
    return x
```

```cpp
#define DBG_MIX_SCALE 1.0f
#define DBG_ZERO_BR 0
#define DBG_DOUBLE_MASK 0x10
#include <hip/hip_runtime.h>
#include <cstdio>
#include <cstdint>

#define GAS __attribute__((address_space(1)))
#define LAS __attribute__((address_space(3)))
typedef unsigned short bf16;
typedef unsigned v4u __attribute__((ext_vector_type(4)));
typedef unsigned v2u __attribute__((ext_vector_type(2)));
typedef float f32x4 __attribute__((ext_vector_type(4)));
typedef float f32x2 __attribute__((ext_vector_type(2)));
typedef float f32x16 __attribute__((ext_vector_type(16)));
typedef short bf16x8 __attribute__((ext_vector_type(8)));
typedef short s16x4 __attribute__((ext_vector_type(4)));
typedef GAS unsigned gu32;
#define RLX_AGENT __ATOMIC_RELAXED, __HIP_MEMORY_SCOPE_AGENT
#define LDS_WAIT() asm volatile("s_waitcnt lgkmcnt(0)" ::: "memory")
#define VM_WAIT() asm volatile("s_waitcnt vmcnt(0)" ::: "memory")
#define SBAR() __builtin_amdgcn_sched_barrier(0)

__device__ __forceinline__ unsigned f2bf(float f) { unsigned u = __builtin_bit_cast(unsigned, f); return (u + 0x7fffu + ((u >> 16) & 1u)) >> 16; }
__device__ __forceinline__ unsigned pk2(float lo, float hi) { return f2bf(lo) | (f2bf(hi) << 16); }
__device__ __forceinline__ float bf2f(unsigned b) { return __builtin_bit_cast(float, b << 16); }
__device__ __forceinline__ float bflo(unsigned w) { return __builtin_bit_cast(float, w << 16); }
__device__ __forceinline__ float bfhi(unsigned w) { return __builtin_bit_cast(float, w & 0xffff0000u); }
typedef __bf16 bf16x2_t __attribute__((ext_vector_type(2)));
__device__ __forceinline__ unsigned cvtpk(float lo, float hi) { f32x2 v = {lo, hi}; bf16x2_t b = __builtin_convertvector(v, bf16x2_t); return __builtin_bit_cast(unsigned, b); }
__device__ __forceinline__ float wave_sum(float v) {
#pragma unroll
    for (int o = 1; o < 64; o <<= 1) v += __shfl_xor(v, o);
    return v;
}

constexpr int T = 8192, DM = 2048, NLAYER = 2;
constexpr int NA = 9984;
constexpr int NPROJ = 3840, NGATE = 6144;
constexpr int PJ_QB = 1024, PJ_KB = 1792, PJ_VB = 2560, PJ_QC = 3328;
constexpr int NQAI = 1792;
constexpr int NKVA = 1536;
constexpr int NEXP = 32, DEXP = 512;
constexpr int MPAD = 24576;
constexpr float LN_EPS = 1e-5f;
constexpr float ALPHA = 1.4142135623730951f;
constexpr float SM_SCALE = 0.088388347648318440f;
constexpr float LOG2E = 1.4426950408889634f;
namespace pg8 {
#define PG8_LAS __attribute__((address_space(3)))
typedef unsigned short bf16_t;
typedef short bf16x8 __attribute__((ext_vector_type(8)));
typedef float f32x4 __attribute__((ext_vector_type(4)));
typedef unsigned u32x4 __attribute__((ext_vector_type(4)));
constexpr int BM = 256, BK = 64, HALF = 128, HTB = HALF * BK * 2  , STAGE_BYTES = 8 * HTB, NXCD = 8, WGM = 8;

__host__ __device__ __forceinline__ int lds_byte(int r, int c) { const int st = (r >> 4) * 2 + (c >> 5), rr = r & 15, cc = c & 31, ob = rr * 64 + cc * 2; return st * 1024 + (ob ^ (((ob >> 9) & 1) << 5)); }
__host__ __device__ __forceinline__ void stage_rc(int b, int& R, int& C) { const int st = b / 1024, sb = b % 1024, swz = sb ^ (((sb >> 9) & 1) << 5); R = (st >> 1) * 16 + swz / 64; C = (st & 1) * 32 + (swz % 64) / 2; }
__host__ __device__ __forceinline__ int perm32(int rho) { const int n = rho >> 4, i = rho & 15; return 8 * (i >> 2) + 4 * n + (i & 3); }

struct Unit { int pm, pn; };
struct Gemm { const bf16_t* A; const bf16_t* Bt; int M, N, K, ld; };

struct StaticOrder {
    int nM, nN, nwg, G, c;
    __host__ __device__ void init(int M, int N, int G_, int c_) { nM = M / BM; nN = N / BM; nwg = nM * nN; G = G_; c = c_; }
    __host__ __device__ bool next(int i, Unit& u) const {
        const long L = (long)i * G + c; if (L >= nwg) return false;
        int wgid = (int)L; { const int q = nwg / NXCD, r = nwg % NXCD, xcd = wgid % NXCD, off = wgid / NXCD; wgid = (xcd < r ? xcd * (q + 1) : r * (q + 1) + (xcd - r) * q) + off; }
        const int nig = WGM * nN, gid = wgid / nig, fm = gid * WGM, gsz = (nM - fm) < WGM ? (nM - fm) : WGM;
        u.pm = fm + ((wgid % nig) % gsz); u.pn = (wgid % nig) / gsz; return true;
    }
    __device__ __forceinline__ void a_ready(const Unit&) const {}
    __device__ __forceinline__ void done(const Unit&) const {}
};


__device__ __forceinline__ unsigned cvt_pk_bf16(float lo, float hi) { return ::cvtpk(lo, hi); }
__device__ __forceinline__ float sigmoidf_(float v) { return __builtin_amdgcn_rcpf(1.0f + __builtin_amdgcn_exp2f(-1.4426950408889634f * v)); }
__device__ __forceinline__ u32x4 pack8(const f32x4 v0, const f32x4 v1) { u32x4 w; w.x = cvt_pk_bf16(v0[0], v0[1]); w.y = cvt_pk_bf16(v0[2], v0[3]); w.z = cvt_pk_bf16(v1[0], v1[1]); w.w = cvt_pk_bf16(v1[2], v1[3]); return w; }
__device__ __forceinline__ void unpack8(const u32x4 w, f32x4& a, f32x4& b) {
    a[0] = __builtin_bit_cast(float, w.x << 16); a[1] = __builtin_bit_cast(float, w.x & 0xffff0000u); a[2] = __builtin_bit_cast(float, w.y << 16); a[3] = __builtin_bit_cast(float, w.y & 0xffff0000u);
    b[0] = __builtin_bit_cast(float, w.z << 16); b[1] = __builtin_bit_cast(float, w.z & 0xffff0000u); b[2] = __builtin_bit_cast(float, w.w << 16); b[3] = __builtin_bit_cast(float, w.w & 0xffff0000u); }
struct EpiBase { static constexpr bool PERM = true, AFTER_DRAIN = false; };

struct EpiA : EpiBase {
    bf16_t* proj; bf16_t* gate; const float* bgate; float qs;
    __device__ __forceinline__ void operator()(const f32x4 (&acc)[2][2][4][2], const Unit& u, int wr, int wc, int fr, int fq) const {
        const int row0 = u.pm * BM + wr * 64 + fr; const int colt = u.pn * BM + wc * 32 + 8 * fq;
        if (u.pn < 15) {
            const float s = ((u.pn >= 4 && u.pn < 7) || u.pn >= 13) ? qs : 1.0f;
#pragma unroll
            for (int ai = 0; ai < 2; ++ai)
#pragma unroll
                for (int m = 0; m < 4; ++m) { bf16_t* rowp = proj + (size_t)(row0 + ai * HALF + m * 16) * 3840 + colt;
#pragma unroll
                    for (int bj = 0; bj < 2; ++bj) *(u32x4*)(rowp + bj * HALF) = pack8(acc[ai][bj][m][0] * s, acc[ai][bj][m][1] * s); }
        } else {
            const int gc = colt - 3840;
            f32x4 bv[2][2];
#pragma unroll
            for (int bj = 0; bj < 2; ++bj)
#pragma unroll
                for (int n = 0; n < 2; ++n) bv[bj][n] = *(const f32x4*)(bgate + gc + bj * HALF + 4 * n);
#pragma unroll
            for (int ai = 0; ai < 2; ++ai)
#pragma unroll
                for (int m = 0; m < 4; ++m) { bf16_t* rowp = gate + (size_t)(row0 + ai * HALF + m * 16) * 6144 + gc;
#pragma unroll
                    for (int bj = 0; bj < 2; ++bj) { f32x4 v0 = acc[ai][bj][m][0] + bv[bj][0], v1 = acc[ai][bj][m][1] + bv[bj][1];
#pragma unroll
                        for (int j = 0; j < 4; ++j) { v0[j] = sigmoidf_(v0[j]); v1[j] = sigmoidf_(v1[j]); }
                        *(u32x4*)(rowp + bj * HALF) = pack8(v0, v1); } }
        }
    }
};
struct EpiScale : EpiBase {
    bf16_t* O; int ldc; int pn_a; float sa, sb;
    __device__ __forceinline__ void operator()(const f32x4 (&acc)[2][2][4][2], const Unit& u, int wr, int wc, int fr, int fq) const {
        const int row0 = u.pm * BM + wr * 64 + fr; const int colt = u.pn * BM + wc * 32 + 8 * fq; const float s = (u.pn < pn_a) ? sa : sb;
#pragma unroll
        for (int ai = 0; ai < 2; ++ai)
#pragma unroll
            for (int m = 0; m < 4; ++m) { bf16_t* rowp = O + (size_t)(row0 + ai * HALF + m * 16) * ldc + colt;
#pragma unroll
                for (int bj = 0; bj < 2; ++bj) *(u32x4*)(rowp + bj * HALF) = pack8(acc[ai][bj][m][0] * s, acc[ai][bj][m][1] * s); }
    }
};
template <int STEP> struct EpiUp : EpiBase {
    const bf16_t* gate; bf16_t* O;
    __device__ __forceinline__ void operator()(const f32x4 (&acc)[2][2][4][2], const Unit& u, int wr, int wc, int fr, int fq) const {
        const int row0 = u.pm * BM + wr * 64 + fr; const int colt = u.pn * BM + wc * 32 + 8 * fq;
#pragma unroll
        for (int ai = 0; ai < 2; ++ai)
#pragma unroll
            for (int m = 0; m < 4; ++m) { const size_t r = (size_t)(row0 + ai * HALF + m * 16);
#pragma unroll
                for (int bj = 0; bj < 2; ++bj) { const u32x4 wg = *(const u32x4*)(gate + r * 6144 + STEP * 2048 + colt + bj * HALF); f32x4 g0, g1; unpack8(wg, g0, g1);
                    f32x4 v0 = acc[ai][bj][m][0] * g0, v1 = acc[ai][bj][m][1] * g1;
                    if constexpr (STEP > 0) { const u32x4 wp = __builtin_nontemporal_load((const u32x4*)(O + r * 2048 + colt + bj * HALF)); f32x4 p0, p1; unpack8(wp, p0, p1); v0 += p0; v1 += p1; }
                    *(u32x4*)(O + r * 2048 + colt + bj * HALF) = pack8(v0, v1); } }
    }
};
struct EpiPre : EpiBase {
    const float* x; float* pre; float alpha;
    __device__ __forceinline__ void operator()(const f32x4 (&acc)[2][2][4][2], const Unit& u, int wr, int wc, int fr, int fq) const {
        const int row0 = u.pm * BM + wr * 64 + fr; const int colt = u.pn * BM + wc * 32 + 8 * fq;
#pragma unroll
        for (int ai = 0; ai < 2; ++ai)
#pragma unroll
            for (int m = 0; m < 4; ++m) { const size_t off = (size_t)(row0 + ai * HALF + m * 16) * 2048 + colt;
#pragma unroll
                for (int bj = 0; bj < 2; ++bj)
#pragma unroll
                    for (int n = 0; n < 2; ++n) { const f32x4 xv = *(const f32x4*)(x + off + bj * HALF + 4 * n); *(f32x4*)(pre + off + bj * HALF + 4 * n) = xv * alpha + acc[ai][bj][m][n]; } }
    }
};
struct EpiMoeA : EpiBase {
    bf16_t* hid;
    __device__ __forceinline__ void operator()(const f32x4 (&acc)[2][2][4][2], const Unit& u, int wr, int wc, int fr, int fq) const {
        const int row0 = u.pm * BM + wr * 64 + fr; const int hc = (u.pn & 3) * 128 + wc * 32 + 8 * fq;
#pragma unroll
        for (int ai = 0; ai < 2; ++ai)
#pragma unroll
            for (int m = 0; m < 4; ++m) { f32x4 h0, h1;
#pragma unroll
                for (int j = 0; j < 4; ++j) { const float a0 = acc[ai][0][m][0][j], a1 = acc[ai][0][m][1][j]; h0[j] = a0 * sigmoidf_(a0) * acc[ai][1][m][0][j]; h1[j] = a1 * sigmoidf_(a1) * acc[ai][1][m][1][j]; }
                *(u32x4*)(hid + (size_t)(row0 + ai * HALF + m * 16) * 512 + hc) = pack8(h0, h1); }
    }
};
struct EpiMoeB : EpiBase {
    bf16_t* Y; const int* rowmap; const float* roww;
    __device__ __forceinline__ void operator()(const f32x4 (&acc)[2][2][4][2], const Unit& u, int wr, int wc, int fr, int fq) const {
        const int row0 = u.pm * BM + wr * 64 + fr; const int colt = (u.pn & 7) * BM + wc * 32 + 8 * fq;
#pragma unroll
        for (int ai = 0; ai < 2; ++ai)
#pragma unroll
            for (int m = 0; m < 4; ++m) { const int rg = row0 + ai * HALF + m * 16; const int dst = rowmap[rg]; const float w = roww[rg];
                if (dst >= 0) {
#pragma unroll
                    for (int bj = 0; bj < 2; ++bj) *(u32x4*)(Y + (size_t)dst * 2048 + colt + bj * HALF) = pack8(acc[ai][bj][m][0] * w, acc[ai][bj][m][1] * w); } }
    }
};
struct MoeOrder {
    const int* tile_e; int ntile, nN, G, c;
    __device__ __forceinline__ bool next(int i, Unit& u) const {
        const int L = i * G + c; if (L >= ntile * nN) return false;
        const int mt = L / nN, nl = L - mt * nN; u.pm = mt; u.pn = tile_e[mt] * nN + nl; return true; }
    __device__ __forceinline__ void a_ready(const Unit&) const {}
    __device__ __forceinline__ void done(const Unit&) const {}
};

template <class Epi, class Sched, bool ALIGN_EPI = false, bool SP2 = false>
__device__ __forceinline__ void gemm_phase(PG8_LAS unsigned char* lds, const Gemm g, const Sched& S, const Epi& E, const int tid) {
    const int wid = __builtin_amdgcn_readfirstlane(tid >> 6), lane = tid & 63, wr = wid >> 2, wc = wid & 3, fr = lane & 15, fq = lane >> 4;
    const int K = g.ld, nt = g.K / BK;
    unsigned voffA[2], voffB[2];
#pragma unroll
    for (int i = 0; i < 2; ++i) { int R, C; stage_rc(tid * 16 + i * 8192, R, C); const int Rb = Epi::PERM ? ((R & ~31) + perm32(R & 31)) : R;
        voffA[i] = (unsigned)(R * K + C) * 2u; voffB[i] = (unsigned)(Rb * K + C) * 2u; }
    const size_t kstep = (size_t)(BK * 2);
    const size_t hstep = (size_t)HALF * K * 2;
    const size_t tstep = 2 * hstep;
    const unsigned ldsw = (unsigned)wid * 1024u;
    const int aoff = lds_byte(wr * 64 + fr, fq * 8), boff = lds_byte(wc * 32 + fr, fq * 8);
#define PG8_SA(b, h) (((b) * 2 + (h)) * HTB)
#define PG8_SB(b, h) ((4 + (b) * 2 + (h)) * HTB)
#define PG8_STAGE(bufoff, gbase, voff) do { _Pragma("unroll") for (int _i = 0; _i < 2; ++_i) \
        __builtin_amdgcn_global_load_lds((const unsigned*)((const char*)(gbase) + (voff)[_i]), (PG8_LAS unsigned*)(lds + (bufoff) + ldsw + _i * 8192), 16, 0, 0); } while (0)
#define PG8_LDA(dst, b, h) do { _Pragma("unroll") for (int m = 0; m < 4; ++m) _Pragma("unroll") for (int k = 0; k < 2; ++k) dst[m][k] = *(const PG8_LAS bf16x8*)(lds + PG8_SA(b, h) + aoff + m * 2048 + k * 1024); } while (0)
#define PG8_LDB(dst, b, h) do { _Pragma("unroll") for (int n = 0; n < 2; ++n) _Pragma("unroll") for (int k = 0; k < 2; ++k) dst[n][k] = *(const PG8_LAS bf16x8*)(lds + PG8_SB(b, h) + boff + n * 2048 + k * 1024); } while (0)
#define PG8_MMA(ai, bj, At, Bt) do { __builtin_amdgcn_s_setprio(1); _Pragma("unroll") for (int m = 0; m < 4; ++m) _Pragma("unroll") for (int n = 0; n < 2; ++n) _Pragma("unroll") for (int k = 0; k < 2; ++k) \
        acc[ai][bj][m][n] = __builtin_amdgcn_mfma_f32_16x16x32_bf16(Bt[n][k], At[m][k], acc[ai][bj][m][n], 0, 0, 0); __builtin_amdgcn_s_setprio(0); } while (0)
#define PG8_WAIT_V(n) asm volatile("s_waitcnt vmcnt(" #n ")" ::: "memory")
#define PG8_WAIT_L(n) asm volatile("s_waitcnt lgkmcnt(" #n ")" ::: "memory")
#define PG8_BAR __builtin_amdgcn_s_barrier()
#define PG8_SCHED __builtin_amdgcn_sched_barrier(0)
    Unit cur, nxt; int ui = 0;
    if (!S.next(0, cur)) return;
    f32x4 acc[2][2][4][2];
#pragma unroll
    for (int a = 0; a < 2; ++a)
#pragma unroll
        for (int b = 0; b < 2; ++b)
#pragma unroll
            for (int m = 0; m < 4; ++m)
#pragma unroll
                for (int n = 0; n < 2; ++n) acc[a][b][m][n] = (f32x4){0.f, 0.f, 0.f, 0.f};
    bf16x8 At[4][2], B0[2][2], B1[2][2];
    const char* cA = (const char*)g.A + (size_t)cur.pm * tstep; const char* cB = (const char*)g.Bt + (size_t)cur.pn * tstep;
    S.a_ready(cur);
    if constexpr (SP2) {
        PG8_STAGE(PG8_SB(0, 0), cB, voffB); PG8_STAGE(PG8_SB(0, 1), cB + hstep, voffB); PG8_STAGE(PG8_SA(0, 0), cA, voffA); PG8_STAGE(PG8_SA(0, 1), cA + hstep, voffA);
        if (wr == 1) PG8_BAR;
        PG8_WAIT_V(2); PG8_BAR;
        PG8_STAGE(PG8_SB(1, 0), cB + kstep, voffB); PG8_STAGE(PG8_SA(1, 0), cA + kstep, voffA); PG8_STAGE(PG8_SB(1, 1), cB + hstep + kstep, voffB);
        PG8_WAIT_V(6); PG8_BAR;
    } else {
        PG8_STAGE(PG8_SB(0, 0), cB, voffB); PG8_STAGE(PG8_SA(0, 0), cA, voffA); PG8_STAGE(PG8_SB(0, 1), cB + hstep, voffB); PG8_STAGE(PG8_SA(0, 1), cA + hstep, voffA);
        if (wr == 1) PG8_BAR;
        PG8_WAIT_V(4); PG8_BAR;
        PG8_STAGE(PG8_SB(1, 0), cB + kstep, voffB); PG8_STAGE(PG8_SA(1, 0), cA + kstep, voffA); PG8_STAGE(PG8_SB(1, 1), cB + hstep + kstep, voffB);
        PG8_WAIT_V(6); PG8_BAR;
    }
    for (;;) {
        const bool has_next = S.next(ui + 1, nxt);
        const char* nA = has_next ? (const char*)g.A + (size_t)nxt.pm * tstep : cA; const char* nB = has_next ? (const char*)g.Bt + (size_t)nxt.pn * tstep : cB;
        for (int t = 0; t < nt; t += 2) {
            const bool last = (t == nt - 2);
            const char* a1 = cA + (size_t)(t + 1) * kstep;
            const char* a2 = last ? nA : cA + (size_t)(t + 2) * kstep; const char* b2 = last ? nB : cB + (size_t)(t + 2) * kstep;
            const char* a3 = a2 + kstep; const char* b3 = b2 + kstep;
            if (last && has_next) S.a_ready(nxt);
            if constexpr (SP2) {
            PG8_LDB(B0, 0, 0); PG8_LDB(B1, 0, 1); PG8_SCHED; PG8_LDA(At, 0, 0); PG8_STAGE(PG8_SA(1, 1), a1 + hstep, voffA);
            PG8_WAIT_V(8); PG8_WAIT_L(0); PG8_BAR; PG8_MMA(0, 0, At, B0); PG8_MMA(0, 1, At, B1); PG8_BAR; PG8_SCHED;
            PG8_LDA(At, 0, 1); PG8_STAGE(PG8_SB(0, 0), b2, voffB); PG8_STAGE(PG8_SB(0, 1), b2 + hstep, voffB); PG8_STAGE(PG8_SA(0, 0), a2, voffA);
            PG8_WAIT_V(8); PG8_WAIT_L(0); PG8_BAR; PG8_MMA(1, 0, At, B0); PG8_MMA(1, 1, At, B1); PG8_BAR; PG8_SCHED;
            PG8_LDB(B0, 1, 0); PG8_LDB(B1, 1, 1); PG8_SCHED; PG8_LDA(At, 1, 0); PG8_STAGE(PG8_SA(0, 1), a2 + hstep, voffA);
            PG8_WAIT_V(8); PG8_WAIT_L(0); PG8_BAR; PG8_MMA(0, 0, At, B0); PG8_MMA(0, 1, At, B1); PG8_BAR; PG8_SCHED;
            PG8_LDA(At, 1, 1); PG8_STAGE(PG8_SB(1, 0), b3, voffB); PG8_STAGE(PG8_SB(1, 1), b3 + hstep, voffB); PG8_STAGE(PG8_SA(1, 0), a3, voffA);
            PG8_WAIT_V(8); PG8_WAIT_L(0); PG8_BAR; PG8_MMA(1, 0, At, B0); PG8_MMA(1, 1, At, B1); PG8_BAR; PG8_SCHED;
            } else {
            PG8_LDB(B0, 0, 0); PG8_SCHED; PG8_LDA(At, 0, 0); PG8_STAGE(PG8_SA(1, 1), a1 + hstep, voffA);
            PG8_WAIT_L(8); PG8_BAR; PG8_WAIT_L(0); PG8_MMA(0, 0, At, B0); PG8_BAR; PG8_SCHED;
            PG8_LDB(B1, 0, 1); PG8_STAGE(PG8_SB(0, 0), b2, voffB);
            PG8_BAR; PG8_WAIT_L(0); PG8_MMA(0, 1, At, B1); PG8_BAR;
            PG8_LDA(At, 0, 1); PG8_STAGE(PG8_SA(0, 0), a2, voffA);
            PG8_BAR; PG8_WAIT_L(0); PG8_MMA(1, 0, At, B0); PG8_BAR; PG8_SCHED;
            PG8_STAGE(PG8_SB(0, 1), b2 + hstep, voffB);
            PG8_WAIT_V(6); PG8_BAR; PG8_MMA(1, 1, At, B1); PG8_BAR;
            PG8_LDB(B0, 1, 0); PG8_SCHED; PG8_LDA(At, 1, 0); PG8_STAGE(PG8_SA(0, 1), a2 + hstep, voffA);
            PG8_WAIT_L(8); PG8_BAR; PG8_WAIT_L(0); PG8_MMA(0, 0, At, B0); PG8_BAR; PG8_SCHED;
            PG8_LDB(B1, 1, 1); PG8_STAGE(PG8_SB(1, 0), b3, voffB);
            PG8_BAR; PG8_WAIT_L(0); PG8_MMA(0, 1, At, B1); PG8_BAR;
            PG8_LDA(At, 1, 1); PG8_STAGE(PG8_SA(1, 0), a3, voffA);
            PG8_BAR; PG8_WAIT_L(0); PG8_MMA(1, 0, At, B0); PG8_BAR; PG8_SCHED;
            PG8_STAGE(PG8_SB(1, 1), b3 + hstep, voffB);
            PG8_WAIT_V(6); PG8_BAR; PG8_MMA(1, 1, At, B1); PG8_BAR;
            }
        }
        if constexpr (ALIGN_EPI) { if (wr == 0) PG8_BAR; }
        if constexpr (!Epi::AFTER_DRAIN) { E(acc, cur, wr, wc, fr, fq); S.done(cur); }
        if (!has_next) break;
#pragma unroll
        for (int a = 0; a < 2; ++a)
#pragma unroll
            for (int b = 0; b < 2; ++b)
#pragma unroll
                for (int m = 0; m < 4; ++m)
#pragma unroll
                    for (int n = 0; n < 2; ++n) acc[a][b][m][n] = (f32x4){0.f, 0.f, 0.f, 0.f};
        cur = nxt; cA = nA; cB = nB; ++ui;
        if constexpr (ALIGN_EPI) { if (wr == 1) PG8_BAR; }
    }
    PG8_WAIT_V(0);
    if constexpr (!ALIGN_EPI) { if (wr == 0) PG8_BAR; }
    PG8_BAR;
    if constexpr (Epi::AFTER_DRAIN) { E.fused(acc, cur, wr, wc, fr, fq, lds, wid, lane); S.done(cur); }
#undef PG8_SA
#undef PG8_SB
#undef PG8_STAGE
#undef PG8_LDA
#undef PG8_LDB
#undef PG8_MMA
#undef PG8_WAIT_V
#undef PG8_WAIT_L
#undef PG8_BAR
#undef PG8_SCHED
}
}

namespace att {
constexpr int D = 128, NW = 8, QBLK = 32, KVBLK = 64;
constexpr int SDEPTH = 1;
constexpr float THR2 = 8.f * 1.4426950408889634f;
constexpr size_t SHM_V = KVBLK * D * 2, SHM_K = KVBLK * D * 2, SHM_ATTN = 2 * SHM_V + 2 * SHM_K + NW * 64 * 4;
#define KSWZ(row, colB) ((row) * 256 + ((colB) ^ (((row) & 7) << 4)))
__device__ __forceinline__ int crow(int r, int hi) { return (r & 3) + 8 * (r >> 2) + 4 * hi; }
constexpr int ccol(int r) { return (r & 3) + 8 * (r >> 2); }

template <int MODE>
__device__ __forceinline__ void partialSM(f32x16& p0, f32x16& p1, float& m_reg, float& alpha, float& sub1_out, int j, int NT, float slope2, float lanec, int lanet, int hi, v2u mw, unsigned bmw) {
  const float NEGINF = -__builtin_inff();
  float base0 = 0.f, base1 = 0.f;
  if constexpr (MODE != 0) {
    base0 = fmaf(slope2 * 64.f, (float)j, lanec); base1 = base0 + 32.f * slope2;
#pragma unroll
    for (int r = 0; r < 16; ++r) { p0[r] = fmaf(slope2, (float)ccol(r), p0[r]); p1[r] = fmaf(slope2, (float)ccol(r), p1[r]); }
  }
  if constexpr (MODE == 1) {
    const unsigned w0 = mw.x >> (4 * hi), w1 = mw.y >> (4 * hi);
#pragma unroll
    for (int r = 0; r < 16; ++r) {
      const int m0 = __builtin_amdgcn_sbfe(w0, ccol(r), 1), m1 = __builtin_amdgcn_sbfe(w1, ccol(r), 1);
      p0[r] = __uint_as_float((__float_as_uint(p0[r]) & (unsigned)m0) | (0xff800000u & ~(unsigned)m0));
      p1[r] = __uint_as_float((__float_as_uint(p1[r]) & (unsigned)m1) | (0xff800000u & ~(unsigned)m1));
    }
  }
  if constexpr (MODE == 2) {
    const bool sel = (bmw >> (j >> 2)) & 1u; if (!sel) { base0 = NEGINF; base1 = NEGINF; }
    if (j >= NT - 4) { const int thr0 = lanet - 64 * j, thr1 = thr0 - 32;
#pragma unroll
      for (int r = 0; r < 16; ++r) { p0[r] = (ccol(r) <= thr0) ? p0[r] : NEGINF; p1[r] = (ccol(r) <= thr1) ? p1[r] : NEGINF; }
    }
  }
  float mx0 = p0[0], mx1 = p1[0];
#pragma unroll
  for (int r = 1; r < 16; ++r) { mx0 = fmaxf(mx0, p0[r]); mx1 = fmaxf(mx1, p1[r]); }
  float pmax;
  if constexpr (MODE == 0) pmax = fmaxf(mx0, mx1); else pmax = fmaxf(mx0 + base0, mx1 + base1);
  { auto rr = __builtin_amdgcn_permlane32_swap(__float_as_uint(pmax), __float_as_uint(pmax), false, false);
    pmax = fmaxf(__uint_as_float(rr[0]), __uint_as_float(rr[1])); }
  float mn;
  if (__builtin_expect(__all(pmax - m_reg <= THR2), 1)) { mn = m_reg; alpha = 1.f; }
  else { mn = fmaxf(m_reg, pmax); alpha = __builtin_amdgcn_exp2f(m_reg - mn); m_reg = mn; }
  float sub0, sub1;
  if constexpr (MODE == 0) { sub0 = mn; sub1 = mn; } else { sub0 = mn - base0; sub1 = mn - base1; }
#pragma unroll
  for (int r = 0; r < 16; ++r) p0[r] = __builtin_amdgcn_exp2f(p0[r] - sub0);
  sub1_out = sub1;
}
__device__ __forceinline__ void finishSM(f32x16& p0, f32x16& p1, float sub1, float alpha, float& l_reg, bf16x8& pa0, bf16x8& pa1, bf16x8& pa2, bf16x8& pa3) {
#pragma unroll
  for (int r = 0; r < 16; ++r) p1[r] = __builtin_amdgcn_exp2f(p1[r] - sub1);
  float ps = 0;
#pragma unroll
  for (int r = 0; r < 16; ++r) ps += p0[r];
#pragma unroll
  for (int r = 0; r < 16; ++r) ps += p1[r];
  { auto rr = __builtin_amdgcn_permlane32_swap(__float_as_uint(ps), __float_as_uint(ps), false, false);
    ps = __uint_as_float(rr[0]) + __uint_as_float(rr[1]); }
  l_reg = l_reg * alpha + ps;
#define PK4(P, BASE, OUT) do { unsigned a0 = cvtpk(P[BASE + 0], P[BASE + 1]), a1 = cvtpk(P[BASE + 2], P[BASE + 3]);   \
    unsigned b0 = cvtpk(P[BASE + 4], P[BASE + 5]), b1 = cvtpk(P[BASE + 6], P[BASE + 7]);                              \
    auto r0 = __builtin_amdgcn_permlane32_swap(a0, b0, false, false); auto r1 = __builtin_amdgcn_permlane32_swap(a1, b1, false, false); \
    v4u w = {r0[0], r1[0], r0[1], r1[1]}; OUT = *reinterpret_cast<bf16x8*>(&w); } while (0)
  PK4(p0, 0, pa0); PK4(p0, 8, pa1); PK4(p1, 0, pa2); PK4(p1, 8, pa3);
#undef PK4
}
__device__ __forceinline__ void qkt(f32x16& p0, f32x16& p1, const LAS char* Ks, const LAS bf16x8* qs, int r32, int hi) {
  p0 = f32x16{}; p1 = f32x16{};
#pragma unroll
  for (int d0 = 0; d0 < 8; ++d0) { int cb = (d0 * 16 + hi * 8) * 2;
    bf16x8 b0 = *reinterpret_cast<const LAS bf16x8*>(Ks + KSWZ(r32, cb));
    bf16x8 b1 = *reinterpret_cast<const LAS bf16x8*>(Ks + KSWZ(32 + r32, cb));
    const bf16x8 q = qs[d0 * 64];
    p0 = __builtin_amdgcn_mfma_f32_32x32x16_bf16(b0, q, p0, 0, 0, 0);
    p1 = __builtin_amdgcn_mfma_f32_32x32x16_bf16(b1, q, p1, 0, 0, 0); }
}
__device__ __forceinline__ int v_st(int k, int c) { const int kk = (k & ~0xC) | ((k & 4) << 1) | ((k & 8) >> 1); return ((kk >> 3) * 4 + (c >> 5)) * 512 + ((kk & 7) * 32 + (c & 31)) * 2; }
__device__ __forceinline__ int v_rd_base(int lane) { return ((lane & 3) << 3) | (((lane >> 2) & 3) << 6) | (((lane >> 4) & 1) << 5) | (((lane >> 5) & 1) << 8); }
constexpr int v_rd_off(int d0, int ks, int half) { return d0 * 512 + ks * 4096 + half * 2048; }
template <int OFF> __device__ __forceinline__ s16x4 tr_read(int vb) {
  s16x4 r; asm volatile("ds_read_b64_tr_b16 %0, %1 offset:%2" : "=&v"(r) : "v"(vb), "i"(OFF) : "memory"); return r;
}
template <int D0> __device__ __forceinline__ void pv_one(f32x16& od, int vb, bf16x8 pa0, bf16x8 pa1, bf16x8 pa2, bf16x8 pa3) {
  const s16x4 l0 = tr_read<v_rd_off(D0, 0, 0)>(vb), h0 = tr_read<v_rd_off(D0, 0, 1)>(vb), l1 = tr_read<v_rd_off(D0, 1, 0)>(vb), h1 = tr_read<v_rd_off(D0, 1, 1)>(vb);
  const s16x4 l2 = tr_read<v_rd_off(D0, 2, 0)>(vb), h2 = tr_read<v_rd_off(D0, 2, 1)>(vb), l3 = tr_read<v_rd_off(D0, 3, 0)>(vb), h3 = tr_read<v_rd_off(D0, 3, 1)>(vb);
  asm volatile("s_waitcnt lgkmcnt(0)" ::: "memory"); SBAR();
#define PK(L, H) (bf16x8){L[0], L[1], L[2], L[3], H[0], H[1], H[2], H[3]}
  od = __builtin_amdgcn_mfma_f32_32x32x16_bf16(pa0, PK(l0, h0), od, 0, 0, 0);
  od = __builtin_amdgcn_mfma_f32_32x32x16_bf16(pa1, PK(l1, h1), od, 0, 0, 0);
  od = __builtin_amdgcn_mfma_f32_32x32x16_bf16(pa2, PK(l2, h2), od, 0, 0, 0);
  od = __builtin_amdgcn_mfma_f32_32x32x16_bf16(pa3, PK(l3, h3), od, 0, 0, 0);
#undef PK
}
__device__ __forceinline__ void pv_d0(f32x16* o, int vb, bf16x8 pa0, bf16x8 pa1, bf16x8 pa2, bf16x8 pa3) {
  pv_one<0>(o[0], vb, pa0, pa1, pa2, pa3); pv_one<1>(o[1], vb, pa0, pa1, pa2, pa3); pv_one<2>(o[2], vb, pa0, pa1, pa2, pa3); pv_one<3>(o[3], vb, pa0, pa1, pa2, pa3);
}

template <int MODE>
__device__ __forceinline__ void attn_unit(const GAS bf16* __restrict__ Qb, int ldq, const GAS bf16* __restrict__ Kh, const GAS bf16* __restrict__ Vh, int ldk, GAS bf16* __restrict__ Ob, int ldo,
                                          int NT, int qpos0, float slope2, const GAS unsigned* __restrict__ maskA, const GAS unsigned* __restrict__ blkm, LAS char* lds, const int tid) {
  const int wid = tid >> 6, lane = tid & 63, r32 = lane & 31, hi = lane >> 5;
  LAS char* V_lds = lds; LAS char* K_lds = lds + 2 * SHM_V;
  LAS float* ws = (LAS float*)(lds + 2 * SHM_V + 2 * SHM_K) + wid * 64; LAS float* li_l = ws; LAS float* al_l = ws + 32;
  float m_reg = -1e30f, l_reg = 0; f32x16 o[4] = {};
  LAS bf16x8* qr = (LAS bf16x8*)(lds + SHM_ATTN + wid * 8192) + lane;
  const int qrow = wid * QBLK + r32, qpos = qpos0 + qrow;
  unsigned bmw = 0; if constexpr (MODE == 2) { bmw = blkm[(unsigned)qrow * 6u]; asm volatile("" : "+v"(bmw)); }
  const GAS bf16* Qw = Qb + (unsigned)(qrow * ldq + hi * 8);
#pragma unroll
  for (int d0 = 0; d0 < 8; ++d0) qr[64 * d0] = *reinterpret_cast<const GAS bf16x8*>(Qw + d0 * 16);
  slope2 = __uint_as_float(__builtin_amdgcn_readfirstlane(__float_as_uint(slope2)));
  const float lanec = slope2 * (float)(4 * hi - qpos); const int lanet = qpos - 4 * hi;
  unsigned moff = 0; if constexpr (MODE == 1) moff = (unsigned)qpos * 1024u;
  const int sr = tid >> 4, sc = (tid & 15) * 8, vst0 = v_st(sr, sc), vst1 = v_st(32 + sr, sc);
  const int vb0 = (int)(uintptr_t)V_lds + v_rd_base(lane);
  struct { bf16x8 vs0, vs1, ks0, ks1; } sr_[SDEPTH];
  const unsigned so0 = (unsigned)(sr * ldk + sc) * 2u, so1 = so0 + (unsigned)(32 * ldk) * 2u, tstep_ = (unsigned)(64 * ldk) * 2u;
#define SLOAD(i, k0) do { const unsigned tb_ = (unsigned)((k0) >> 6) * tstep_; \
    sr_[i].vs0 = *reinterpret_cast<const GAS bf16x8*>((const GAS char*)Vh + (tb_ + so0)); sr_[i].vs1 = *reinterpret_cast<const GAS bf16x8*>((const GAS char*)Vh + (tb_ + so1)); \
    sr_[i].ks0 = *reinterpret_cast<const GAS bf16x8*>((const GAS char*)Kh + (tb_ + so0)); sr_[i].ks1 = *reinterpret_cast<const GAS bf16x8*>((const GAS char*)Kh + (tb_ + so1)); } while (0)
#define SWRITE(b, i) do { *(LAS bf16x8*)(V_lds + (b) * SHM_V + vst0) = sr_[i].vs0;          \
    *(LAS bf16x8*)(V_lds + (b) * SHM_V + vst1) = sr_[i].vs1; int kc = sc * 2;               \
    *(LAS bf16x8*)(K_lds + (b) * SHM_K + KSWZ(sr, kc)) = sr_[i].ks0;                       \
    *(LAS bf16x8*)(K_lds + (b) * SHM_K + KSWZ(32 + sr, kc)) = sr_[i].ks1; } while (0)
#define SWAIT() do { if constexpr (SDEPTH == 2) asm volatile("s_waitcnt vmcnt(4)" ::: "memory"); else asm volatile("s_waitcnt vmcnt(0)" ::: "memory"); } while (0)
#define RESC(a) do { if (__any((a) < 1.f)) { if (hi == 0) al_l[r32] = (a); asm volatile("s_waitcnt lgkmcnt(0)" ::: "memory"); \
    _Pragma("unroll") for (int d = 0; d < 4; ++d) _Pragma("unroll") for (int r = 0; r < 16; ++r) o[d][r] *= al_l[crow(r, hi)]; } } while (0)
  v2u mwA = {0u, 0u}, mwB = {0u, 0u};
#define MLOAD(dst, j) do { if constexpr (MODE == 1) dst = *reinterpret_cast<const GAS v2u*>((const GAS char*)maskA + (moff + 8u * (unsigned)(j))); } while (0)
#define PSM(P0, P1, AL, S1, J, MW) partialSM<MODE>(P0, P1, m_reg, AL, S1, J, NT, slope2, lanec, lanet, hi, MW, bmw)
  f32x16 pA0, pA1, pB0, pB1; float alA, alB, s1A, s1B; bf16x8 pa0, pa1, pa2, pa3;
  constexpr int SE = 0, SO = SDEPTH - 1;
  MLOAD(mwA, 0); MLOAD(mwB, 1);
  SLOAD(SE, 0); asm volatile("s_waitcnt vmcnt(0)" ::: "memory"); SWRITE(0, SE); __syncthreads();
  qkt(pA0, pA1, K_lds, qr, r32, hi); PSM(pA0, pA1, alA, s1A, 0, mwA);
  SLOAD(SO, KVBLK); if constexpr (SDEPTH == 2) { if (2 < NT) SLOAD(SE, 2 * KVBLK); }
  SWAIT(); SWRITE(1, SO); __syncthreads();
  for (int j = 1; j + 1 < NT; j += 2) {
    SBAR(); qkt(pB0, pB1, K_lds + SHM_K, qr, r32, hi);
    finishSM(pA0, pA1, s1A, alA, l_reg, pa0, pa1, pa2, pa3); SBAR();
    MLOAD(mwA, j + 1);
    SLOAD(SO, (j + SDEPTH) * KVBLK); SBAR();
    pv_d0(o, vb0, pa0, pa1, pa2, pa3); PSM(pB0, pB1, alB, s1B, j, mwB);
    __syncthreads(); SWAIT(); SWRITE(0, SE);
    RESC(alB); __syncthreads();
    SBAR(); qkt(pA0, pA1, K_lds, qr, r32, hi);
    finishSM(pB0, pB1, s1B, alB, l_reg, pa0, pa1, pa2, pa3); SBAR();
    if (j + 2 < NT) MLOAD(mwB, j + 2);
    if (SDEPTH == 1 || j + 3 < NT) SLOAD(SE, (j + 1 + SDEPTH) * KVBLK); SBAR();
    pv_d0(o, vb0 + (int)SHM_V, pa0, pa1, pa2, pa3); PSM(pA0, pA1, alA, s1A, j + 1, mwA);
    __syncthreads(); SWAIT(); SWRITE(1, SO);
    RESC(alA); __syncthreads();
  }
  SBAR(); qkt(pB0, pB1, K_lds + SHM_K, qr, r32, hi);
  finishSM(pA0, pA1, s1A, alA, l_reg, pa0, pa1, pa2, pa3); SBAR();
  pv_d0(o, vb0, pa0, pa1, pa2, pa3); PSM(pB0, pB1, alB, s1B, NT - 1, mwB);
  __syncthreads(); RESC(alB);
  finishSM(pB0, pB1, s1B, alB, l_reg, pa0, pa1, pa2, pa3); SBAR();
  pv_d0(o, vb0 + (int)SHM_V, pa0, pa1, pa2, pa3);
  if (hi == 0) li_l[r32] = l_reg; asm volatile("s_waitcnt lgkmcnt(0)" ::: "memory");
  float rli[16];
#pragma unroll
  for (int r = 0; r < 16; ++r) rli[r] = __builtin_amdgcn_rcpf(li_l[crow(r, hi)]);
  GAS bf16* Ow = Ob + (unsigned)(wid * QBLK * ldo);
#pragma unroll
  for (int r = 0; r < 16; ++r) { int orow = crow(r, hi);
#pragma unroll
    for (int d0 = 0; d0 < 4; ++d0) Ow[(unsigned)(orow * ldo + d0 * 32 + r32)] = (bf16)f2bf(o[d0][r] * rli[r] * ((DBG_ZERO_BR >> MODE) & 1 ? 0.f : 1.f)); }
  __syncthreads();
#undef SLOAD
#undef SWRITE
#undef SWAIT
#undef RESC
#undef MLOAD
#undef PSM
}
}

constexpr size_t MiB = 1u << 20;
constexpr size_t WS_CTL = 0, CTL_ZERO_BYTES = 1 * MiB;
constexpr size_t WS_INFO = 1 * MiB;
constexpr size_t WS_WA = 2 * MiB, WS_WC1 = 41 * MiB, WS_WC2 = 43 * MiB, WS_WUP = 44 * MiB, WS_WO = 52 * MiB, WS_W13 = 60 * MiB, WS_W2 = 188 * MiB, WS_WMEM = 252 * MiB, WS_WR = 256 * MiB;
constexpr size_t WS_MEMB = 257 * MiB, WS_MKV = 258 * MiB, WS_HB = 259 * MiB, WS_PROJ = 291 * MiB, WS_GATE = 351 * MiB, WS_XG = WS_GATE;
constexpr size_t WS_CQN = 447 * MiB, WS_CKVN = 455 * MiB, WS_KIDX = 459 * MiB, WS_WIDX = 460 * MiB, WS_KMEAN = 461 * MiB, WS_QAI = 462 * MiB, WS_KVA = 490 * MiB;
constexpr size_t WS_MASKA = 514 * MiB, WS_BLKM = 522 * MiB, WS_OATT = 523 * MiB, WS_MERGED = 555 * MiB, WS_PRE = 587 * MiB, WS_Y = WS_PRE, WS_X1 = 651 * MiB, WS_X1B = 715 * MiB;
constexpr size_t WS_ROUTE = 747 * MiB, WS_ROWMAP = 748 * MiB, WS_ROWW = 749 * MiB, WS_HID = 750 * MiB, WS_XF = 774 * MiB, WS_SC = 838 * MiB, WS_END = 968 * MiB;
constexpr int CW_TMO = 0;
constexpr int CW_BAR = 4096;
constexpr int CW_ECNT = 16384;
constexpr int CW_AQ = 20480;
constexpr int LDS_BYTES = 163840;
constexpr int MISC_OFF = LDS_BYTES - 256;

#define XB_TMO      128
#define XB_XCNT(j)  (256  + 64 * (j))
#define XB_XSUB(j)  (1280 + 64 * (j))
#define XB_XGEN(j)  (2304 + 64 * (j))
#define XB_TOP      3328
#define XB_TOPGEN   3392
#define XCD_BAR_WORDS 3456
#define XB_SPIN_CAP (1u << 22)
__device__ __forceinline__ unsigned xb_ld(unsigned* p)              { return __hip_atomic_load(p, __ATOMIC_RELAXED, __HIP_MEMORY_SCOPE_AGENT); }
__device__ __forceinline__ unsigned xb_add(unsigned* p, unsigned v) { return __hip_atomic_fetch_add(p, v, __ATOMIC_RELAXED, __HIP_MEMORY_SCOPE_AGENT); }
__device__ __forceinline__ unsigned xb_xcc_id() { return (unsigned)__builtin_amdgcn_s_getreg((3 << 11) | 20) & 0xFu; }
#define XB_SPIN(cond, bar) do { unsigned _sp = 0; while (cond) { __builtin_amdgcn_s_sleep(1); \
    if ((++_sp & 255u) == 0u) { if (xb_ld(&(bar)[XB_TMO])) break; if (_sp > XB_SPIN_CAP) { atomicAdd(&(bar)[XB_TMO], 1u); break; } } } } while (0)
__device__ __forceinline__ int lane_id() { int l; asm volatile("v_mbcnt_lo_u32_b32 %0, -1, 0\n\tv_mbcnt_hi_u32_b32 %0, -1, %0" : "=v"(l)); return l; }
struct XcdBarrier { unsigned* bar; unsigned x; volatile LAS unsigned* st; unsigned w0; };
__device__ __forceinline__ XcdBarrier xcd_barrier_post(unsigned* bar, volatile LAS unsigned* st, unsigned w0) {
    XcdBarrier b; b.bar = bar; b.x = xb_xcc_id(); b.st = st; b.w0 = w0;
    if (w0 && lane_id() == 0) (void)xb_add(&bar[XB_XCNT(b.x)], 1u);
    return b;
}
__device__ __forceinline__ void xcd_barrier_complete(unsigned* bar, unsigned x, unsigned& nloc, unsigned& nx) {
    const unsigned G = gridDim.x * gridDim.y * gridDim.z;
    unsigned sum, cnt, mine, sp = 0u;
    for (;;) {
        sum = 0u; cnt = 0u; mine = 0u;
#pragma unroll
        for (unsigned j = 0; j < 16; ++j) { const unsigned c = xb_ld(&bar[XB_XCNT(j)]); sum += c; cnt += (c > 0u) ? 1u : 0u; mine = (j == x) ? c : mine; }
        if (sum == G) break;
        __builtin_amdgcn_s_sleep(1);
        if ((++sp & 255u) == 0u) { if (xb_ld(&bar[XB_TMO])) break; if (sp > XB_SPIN_CAP) { atomicAdd(&bar[XB_TMO], 1u); break; } }
    }
    nloc = mine > 0u ? mine : 1u; nx = cnt > 0u ? cnt : 1u;
}
__device__ __forceinline__ void xcd_barrier(const XcdBarrier& b) {
    asm volatile("s_waitcnt vmcnt(0)" ::: "memory");
    __syncthreads();
    if (b.w0 && lane_id() == 0) {
        unsigned* bar = b.bar;
        __builtin_amdgcn_s_waitcnt(0);
        unsigned nloc = b.st[0], nx = b.st[1];
        if (nloc == 0u) { xcd_barrier_complete(bar, b.x, nloc, nx); b.st[0] = nloc; b.st[1] = nx; }
        const unsigned old = xb_add(&bar[XB_XSUB(b.x)], 1u);
        const unsigned gen = old / nloc;
        if (old + 1u == (gen + 1u) * nloc) {
            __builtin_amdgcn_fence(__ATOMIC_RELEASE, "agent");
            asm volatile("s_waitcnt vmcnt(0)" ::: "memory");
            const unsigned og = xb_add(&bar[XB_TOP], 1u);
            const unsigned tg = og / nx;
            if (og + 1u == (tg + 1u) * nx) xb_add(&bar[XB_TOPGEN], 1u);
            else XB_SPIN(xb_ld(&bar[XB_TOPGEN]) == tg, bar);
            __builtin_amdgcn_fence(__ATOMIC_ACQUIRE, "agent");
            xb_add(&bar[XB_XGEN(b.x)], 1u);
            asm volatile("s_waitcnt vmcnt(0)" ::: "memory");
        } else {
            XB_SPIN(xb_ld(&bar[XB_XGEN(b.x)]) == gen, bar);
            __builtin_amdgcn_fence(__ATOMIC_ACQUIRE, "agent");
            asm volatile("s_waitcnt vmcnt(0)" ::: "memory");
        }
    }
    __syncthreads();
}

struct Args { const float* in[28]; float* out; unsigned char* ws; int ph_lo, ph_hi; };
struct Frame {
    LAS unsigned char* lds; volatile LAS unsigned* MISC; gu32* ctl; int* info;
    int tid, lane, wave, G, bid;
    unsigned char* ws; size_t z;
};
enum { I_X = 0, I_MEM, I_WMEMKV, I_WIN, I_GCQ, I_GCKV, I_GKIDX, I_BKIDX, I_WUQ, I_WUQI, I_WUKV, I_WUPA, I_WUPB, I_WUPC, I_WGATE, I_BGATE, I_WO, I_LN1G, I_LN1B,
       I_WGRP, I_BGRP, I_WRT, I_BRT, I_W1, I_W3, I_W2, I_LN2G, I_LN2B };
#define WSP(T_, off) ((T_*)(F.ws + (off)))

template <int NWD>
__device__ __forceinline__ void transpose_item(const float* src, int ldw, bf16* dst, int ldk, LAS float* scr, int lane) {
    constexpr int ST = NWD + 1, KPI = 64 / NWD;
#pragma unroll 8
    for (int i = 0; i < NWD; ++i) { const int kk = KPI * i + lane / NWD; scr[kk * ST + (lane % NWD)] = src[(size_t)kk * ldw + (lane % NWD)]; }
    LDS_WAIT(); asm volatile("" ::: "memory");
    const int c = lane & 7;
#pragma unroll
    for (int j = 0; j < NWD / 8; ++j) { const int n = (lane >> 3) + 8 * j; const LAS float* s = scr + (8 * c) * ST + n;
        v4u o; o.x = pk2(s[0 * ST], s[1 * ST]); o.y = pk2(s[2 * ST], s[3 * ST]); o.z = pk2(s[4 * ST], s[5 * ST]); o.w = pk2(s[6 * ST], s[7 * ST]);
        *(GAS v4u*)(dst + (size_t)n * ldk + 8 * c) = o; }
    LDS_WAIT(); asm volatile("" ::: "memory");
}
__device__ __forceinline__ void conv_layer(Frame& F, const Args& a, int l) {
    LAS float* scr = (LAS float*)(F.lds + F.wave * 16384);
    const int gw = F.bid * 8 + F.wave, NGW = F.G * 8, lane = F.lane;
    bf16* WA = WSP(bf16, WS_WA); bf16* WC1 = WSP(bf16, WS_WC1); bf16* WC2 = WSP(bf16, WS_WC2); bf16* WUP = WSP(bf16, WS_WUP); bf16* WO = WSP(bf16, WS_WO);
    bf16* W13 = WSP(bf16, WS_W13); bf16* W2T = WSP(bf16, WS_W2); float* WR = WSP(float, WS_WR);
    const float* w_in = (a.in[I_WIN] + F.z) + (size_t)l * 2048 * 3664; const float* w_gate = (a.in[I_WGATE] + F.z) + (size_t)l * 2048 * 6144;
    const float* w_uq = (a.in[I_WUQ] + F.z) + (size_t)l * 512 * 768; const float* w_uqi = (a.in[I_WUQI] + F.z) + (size_t)l * 512 * 1024; const float* w_ukv = (a.in[I_WUKV] + F.z) + (size_t)l * 256 * 1536;
    const float* w_upa = (a.in[I_WUPA] + F.z) + (size_t)l * 768 * 2048; const float* w_upb = (a.in[I_WUPB] + F.z) + (size_t)l * 768 * 2048; const float* w_upc = (a.in[I_WUPC] + F.z) + (size_t)l * 512 * 2048;
    const float* w_o = (a.in[I_WO] + F.z) + (size_t)l * 2048 * 2048;
    const float* w1 = (a.in[I_W1] + F.z) + (size_t)l * 32 * 2048 * 512; const float* w3 = (a.in[I_W3] + F.z) + (size_t)l * 32 * 2048 * 512; const float* w2 = (a.in[I_W2] + F.z) + (size_t)l * 32 * 512 * 2048;
    const float* w_grp = (a.in[I_WGRP] + F.z) + (size_t)l * 2048 * 4; const float* w_rt = (a.in[I_WRT] + F.z) + (size_t)l * 2048 * 32;
    constexpr int N_IN = 32 * 229, N_PAD = 176, N_GATE = 32 * 192, N_UQ = 8 * 24, N_UQI = 8 * 32, N_UKV = 4 * 48, N_UPA = 12 * 64, N_UPC = 8 * 64, N_O = 32 * 64, N_E = 32 * 512, N_R = 1536;
    constexpr int TOTAL = N_IN + N_PAD + N_GATE + N_UQ + N_UQI + N_UKV + 2 * N_UPA + N_UPC + N_O + 3 * N_E + N_R;
    for (int it = gw; it < TOTAL; it += NGW) {
        int r = it;
        if (r < N_IN) { const int kb = r / 229, nb = r % 229, n0 = 16 * nb, k0 = 64 * kb, dr = n0 < 848 ? n0 : n0 + 176;
            transpose_item<16>(w_in + (size_t)k0 * 3664 + n0, 3664, WA + (size_t)dr * 2048 + k0, 2048, scr, lane); continue; } r -= N_IN;
        if (r < N_PAD) { GAS v4u* p = (GAS v4u*)(WA + (size_t)(848 + r) * 2048) + lane * 4; const v4u z = {0u, 0u, 0u, 0u}; p[0] = z; p[1] = z; p[2] = z; p[3] = z; continue; } r -= N_PAD;
        if (r < N_GATE) { const int kb = r / 192, nb = r % 192, n0 = 32 * nb, k0 = 64 * kb;
            transpose_item<32>(w_gate + (size_t)k0 * 6144 + n0, 6144, WA + (size_t)(3840 + n0) * 2048 + k0, 2048, scr, lane); continue; } r -= N_GATE;
        if (r < N_UQ) { const int kb = r / 24, nb = r % 24, n0 = 32 * nb, k0 = 64 * kb;
            transpose_item<32>(w_uq + (size_t)k0 * 768 + n0, 768, WC1 + (size_t)n0 * 512 + k0, 512, scr, lane); continue; } r -= N_UQ;
        if (r < N_UQI) { const int kb = r / 32, nb = r % 32, n0 = 32 * nb, k0 = 64 * kb;
            transpose_item<32>(w_uqi + (size_t)k0 * 1024 + n0, 1024, WC1 + (size_t)(768 + n0) * 512 + k0, 512, scr, lane); continue; } r -= N_UQI;
        if (r < N_UKV) { const int kb = r / 48, nb = r % 48, n0 = 32 * nb, k0 = 64 * kb;
            transpose_item<32>(w_ukv + (size_t)k0 * 1536 + n0, 1536, WC2 + (size_t)n0 * 256 + k0, 256, scr, lane); continue; } r -= N_UKV;
        if (r < N_UPA) { const int kb = r / 64, nb = r % 64, n0 = 32 * nb, k0 = 64 * kb;
            transpose_item<32>(w_upa + (size_t)k0 * 2048 + n0, 2048, WUP + (size_t)n0 * 2048 + k0, 2048, scr, lane); continue; } r -= N_UPA;
        if (r < N_UPA) { const int kb = r / 64, nb = r % 64, n0 = 32 * nb, k0 = 64 * kb;
            transpose_item<32>(w_upb + (size_t)k0 * 2048 + n0, 2048, WUP + (size_t)n0 * 2048 + 768 + k0, 2048, scr, lane); continue; } r -= N_UPA;
        if (r < N_UPC) { const int kb = r / 64, nb = r % 64, n0 = 32 * nb, k0 = 64 * kb;
            transpose_item<32>(w_upc + (size_t)k0 * 2048 + n0, 2048, WUP + (size_t)n0 * 2048 + 1536 + k0, 2048, scr, lane); continue; } r -= N_UPC;
        if (r < N_O) { const int kb = r / 64, nb = r % 64, n0 = 32 * nb, k0 = 64 * kb;
            transpose_item<32>(w_o + (size_t)k0 * 2048 + n0, 2048, WO + (size_t)n0 * 2048 + k0, 2048, scr, lane); continue; } r -= N_O;
        if (r < 2 * N_E) { const int which = r / N_E; r -= which * N_E; const int e = r / 512, q = r % 512, kb = q / 16, nb = q % 16, n0 = 32 * nb, k0 = 64 * kb;
            const float* src = (which ? w3 : w1) + (size_t)e * 2048 * 512 + (size_t)k0 * 512 + n0;
            const int dr = e * 1024 + (n0 >> 7) * 256 + (n0 & 127) + which * 128;
            transpose_item<32>(src, 512, W13 + (size_t)dr * 2048 + k0, 2048, scr, lane); continue; } r -= 2 * N_E;
        if (r < N_E) { const int e = r / 512, q = r % 512, kb = q / 64, nb = q % 64, n0 = 32 * nb, k0 = 64 * kb;
            transpose_item<32>(w2 + (size_t)e * 512 * 2048 + (size_t)k0 * 2048 + n0, 2048, W2T + (size_t)(e * 2048 + n0) * 512 + k0, 512, scr, lane); continue; } r -= N_E;
        { const int idx = r * 64 + lane, k = idx / 48, c = idx % 48; WR[idx] = c < 32 ? w_rt[k * 32 + c] : (c < 36 ? w_grp[k * 4 + (c - 32)] : 0.f); }
    }
}
__device__ __forceinline__ void prologue(Frame& F, const Args& a) {
    LAS float* scr = (LAS float*)(F.lds + F.wave * 16384);
    const int gw = F.bid * 8 + F.wave, NGW = F.G * 8, lane = F.lane;
    bf16* HB = WSP(bf16, WS_HB); bf16* MEMB = WSP(bf16, WS_MEMB); bf16* WMEM = WSP(bf16, WS_WMEM);
    const float* x = (a.in[I_X] + F.z); const float* mem = (a.in[I_MEM] + F.z); const float* wm = (a.in[I_WMEMKV] + F.z);
    const long NX8 = (long)T * DM / 8, NM8 = 256L * DM / 8;
    for (long i = (long)gw * 64 + lane; i < NX8 + NM8; i += (long)NGW * 64) {
        const bool inx = i < NX8; const long j = inx ? i : i - NX8; const float* s = (inx ? x : mem) + j * 8;
        f32x4 v0 = *(const GAS f32x4*)s, v1 = *(const GAS f32x4*)(s + 4);
#ifdef DBG_NOISE
        if (inx) {
#pragma unroll
            for (int q = 0; q < 4; ++q) { unsigned hh = (unsigned)(j * 8 + q) * 2654435761u; hh ^= hh >> 15; hh *= 2246822519u; hh ^= hh >> 13;
                v0[q] *= 1.f + DBG_NOISE * ((float)(hh & 0xffff) * (1.f / 65536.f) - 0.5f); v1[q] *= 1.f + DBG_NOISE * ((float)(hh >> 16) * (1.f / 65536.f) - 0.5f); } }
#endif
        v4u o; o.x = pk2(v0[0], v0[1]); o.y = pk2(v0[2], v0[3]); o.z = pk2(v1[0], v1[1]); o.w = pk2(v1[2], v1[3]);
        *(GAS v4u*)((inx ? HB : MEMB) + j * 8) = o;
    }
    for (int it = gw; it < 32 * 32; it += NGW) { const int kb = it / 32, nb = it % 32, n0 = 32 * nb, k0 = 64 * kb;
        transpose_item<32>(wm + (size_t)k0 * 1024 + n0, 1024, WMEM + (size_t)n0 * 2048 + k0, 2048, scr, lane); }
}

__device__ __forceinline__ void phase_norms(Frame& F, const Args& a, int l) {
    const int gw = F.bid * 8 + F.wave, NGW = F.G * 8, lane = F.lane;
    const bf16* PROJ = WSP(bf16, WS_PROJ); bf16* CQN = WSP(bf16, WS_CQN); bf16* CKVN = WSP(bf16, WS_CKVN); bf16* KIDX = WSP(bf16, WS_KIDX); float* WIDX = WSP(float, WS_WIDX); float* KMEAN = WSP(float, WS_KMEAN);
    const float* gcq = (a.in[I_GCQ] + F.z) + l * 512; const float* gckv = (a.in[I_GCKV] + F.z) + l * 256; const float* gk = (a.in[I_GKIDX] + F.z) + l * 64; const float* bk = (a.in[I_BKIDX] + F.z) + l * 64;
    for (int t = gw; t < T; t += NGW) {
        const bf16* row = PROJ + (size_t)t * NPROJ;
        { const v4u w = *(const GAS v4u*)(row + 8 * lane); float v[8] = {bflo(w.x), bfhi(w.x), bflo(w.y), bfhi(w.y), bflo(w.z), bfhi(w.z), bflo(w.w), bfhi(w.w)};
          float ss = 0.f;
#pragma unroll
          for (int j = 0; j < 8; ++j) ss += v[j] * v[j];
          const float rs = 1.0f / sqrtf(wave_sum(ss) * (1.f / 512.f) + LN_EPS);
          const f32x4 g0 = *(const GAS f32x4*)(gcq + 8 * lane), g1 = *(const GAS f32x4*)(gcq + 8 * lane + 4);
          v4u o; o.x = pk2(v[0] * rs * g0[0], v[1] * rs * g0[1]); o.y = pk2(v[2] * rs * g0[2], v[3] * rs * g0[3]); o.z = pk2(v[4] * rs * g1[0], v[5] * rs * g1[1]); o.w = pk2(v[6] * rs * g1[2], v[7] * rs * g1[3]);
          *(GAS v4u*)(CQN + (size_t)t * 512 + 8 * lane) = o; }
        { const v2u w = *(const GAS v2u*)(row + 512 + 4 * lane); float v[4] = {bflo(w.x), bfhi(w.x), bflo(w.y), bfhi(w.y)};
          float ss = (v[0] * v[0] + v[1] * v[1]) + (v[2] * v[2] + v[3] * v[3]);
          const float rs = 1.0f / sqrtf(wave_sum(ss) * (1.f / 256.f) + LN_EPS);
          const f32x4 g0 = *(const GAS f32x4*)(gckv + 4 * lane);
          v2u o; o.x = pk2(v[0] * rs * g0[0], v[1] * rs * g0[1]); o.y = pk2(v[2] * rs * g0[2], v[3] * rs * g0[3]);
          *(GAS v2u*)(CKVN + (size_t)t * 256 + 4 * lane) = o; }
        { const float v = bf2f(row[768 + lane]); const float mu = wave_sum(v) * (1.f / 64.f); const float d = v - mu; const float var = wave_sum(d * d) * (1.f / 64.f);
          KIDX[(size_t)t * 64 + lane] = (bf16)f2bf(d * (1.0f / sqrtf(var + LN_EPS)) * gk[lane] + bk[lane]); }
        if (lane < 16) WIDX[(size_t)t * 16 + lane] = bf2f(row[832 + lane]) * 0.25f;
    }
    for (int task = gw; task < 32 * 6; task += NGW) {
        const int n = task / 6, g = task % 6, rsub = lane >> 4, co = lane & 15;
        float s[8] = {0, 0, 0, 0, 0, 0, 0, 0};
#pragma unroll 16
        for (int i = 0; i < 64; ++i) { const v4u w = *(const GAS v4u*)(PROJ + (size_t)(n * 256 + 4 * i + rsub) * NPROJ + PJ_KB + g * 128 + 8 * co);
            s[0] += bflo(w.x); s[1] += bfhi(w.x); s[2] += bflo(w.y); s[3] += bfhi(w.y); s[4] += bflo(w.z); s[5] += bfhi(w.z); s[6] += bflo(w.w); s[7] += bfhi(w.w); }
#pragma unroll
        for (int j = 0; j < 8; ++j) { s[j] += __shfl_xor(s[j], 16); s[j] += __shfl_xor(s[j], 32); }
        if (rsub == 0) {
#pragma unroll
            for (int j = 0; j < 8; ++j) KMEAN[(size_t)n * 768 + g * 128 + 8 * co + j] = s[j] * (1.f / 256.f); }
    }
}

__device__ __forceinline__ void indexer_item(Frame& F, int item) {
    int tid = F.tid; asm volatile("" : "+v"(tid));
    const int lane = tid & 63, w = F.wave, hi = lane >> 5, kl = lane & 31;
    const bf16* QAI = WSP(bf16, WS_QAI); const bf16* KIDX = WSP(bf16, WS_KIDX); const float* WIDX = WSP(float, WS_WIDX); unsigned* MASKA = WSP(unsigned, WS_MASKA);
    const int t0 = item * 16, myq = t0 + 2 * w + hi;
    const GAS char* SCb = (const GAS char*)WSP(float, WS_SC); unsigned scoff; { const unsigned b_ = myq >> 6, r_ = myq & 63; scoff = (2048u * b_ * (b_ + 1u) + 64u * r_ * (b_ + 1u)) * 4u; }
    LAS unsigned char* reg = F.lds + (2 * w) * 8192;
    LAS unsigned char* myreg = reg + hi * 8192;
    LAS unsigned char* KST = F.lds + 131072;
    bf16x8 af[4];
    { const int rho = kl, qsel = (rho >> 2) & 1, head = (rho & 3) + 4 * (rho >> 3);
      const bf16* src = QAI + (size_t)(t0 + 2 * w + qsel) * NQAI + 768 + head * 64 + 8 * hi;
#pragma unroll
      for (int c = 0; c < 4; ++c) af[c] = *(const GAS bf16x8*)(src + 16 * c); }
    float wv[16];
    { const GAS f32x4* wp = (const GAS f32x4*)(WIDX + (size_t)myq * 16);
#pragma unroll
      for (int j = 0; j < 4; ++j) { const f32x4 v = wp[j]; wv[4 * j] = v[0]; wv[4 * j + 1] = v[1]; wv[4 * j + 2] = v[2]; wv[4 * j + 3] = v[3]; } }
    const int nch = (t0 + 16 + 63) >> 6;
    const int skey = tid >> 3, sch = tid & 7;
    const int sdst = skey * 128 + ((sch ^ ((skey >> 1) & 7)) << 4);
    int bstar = 0, nab = 0; bool allq = false;
#ifndef DBG_IDX_DUMMY
#define DBG_IDX_DUMMY 0
#endif
    {
        { const v4u z = {0u, 0u, 0u, 0u};
#pragma unroll
          for (int i = 0; i < 16; ++i) *(LAS v4u*)(reg + (i * 64 + lane) * 16) = z; }
        const GAS char* kgb = (const GAS char*)KIDX; const unsigned kgo = (unsigned)(skey * 64 + sch * 8) * 2u;
#define KG(c) (*(const GAS v4u*)(kgb + (kgo + (unsigned)(c) * 8192u)))
        v4u R0 = {0u, 0u, 0u, 0u}, R1 = R0;
        { const v4u k0 = KG(0); R1 = KG(1 < nch ? 1 : nch - 1); R0 = KG(2 < nch ? 2 : nch - 1); *(LAS v4u*)(KST + sdst) = k0; }
        __syncthreads();
        int fo[4];
#pragma unroll
        for (int c = 0; c < 4; ++c) fo[c] = kl * 128 + (((2 * c + hi) ^ ((kl >> 1) & 7)) << 4);
#define IDX_STEP(J, RW) do { const int mm_ = m + (J); if (mm_ < nch) { \
            const LAS unsigned char* kb_ = KST + (mm_ & 1) * 8192; bf16x8 FR[2][4]; \
            _Pragma("unroll") for (int tile = 0; tile < 2; ++tile) _Pragma("unroll") for (int c = 0; c < 4; ++c) FR[tile][c] = *(const LAS bf16x8*)(kb_ + fo[c] + tile * 4096); \
            asm volatile("s_waitcnt lgkmcnt(0)" ::: "memory"); SBAR(); \
            f32x16 AC[2] = {{}, {}}; \
            _Pragma("unroll") for (int c = 0; c < 4; ++c) { AC[0] = __builtin_amdgcn_mfma_f32_32x32x16_bf16(af[c], FR[0][c], AC[0], 0, 0, 0); AC[1] = __builtin_amdgcn_mfma_f32_32x32x16_bf16(af[c], FR[1][c], AC[1], 0, 0, 0); } \
            _Pragma("unroll") for (int tile = 0; tile < 2; ++tile) { float ps[4] = {0.f, 0.f, 0.f, 0.f}; \
                _Pragma("unroll") for (int r = 0; r < 16; ++r) { const float av = AC[tile][r]; const int xi = __float_as_int(av); const float rl = __int_as_float(xi > 0 ? xi : 0); \
                    ps[r & 3] = fmaf(rl, wv[r], ps[r & 3]); } \
                const float score = (ps[0] + ps[1]) + (ps[2] + ps[3]); \
                const int row = 32 * tile + kl; const int key = 64 * mm_ + row; const bool valid = key <= myq; \
                const unsigned bits = __float_as_uint(score); const unsigned u = bits ^ ((unsigned)((int)bits >> 31) | 0x80000000u); const int bin = (int)(u >> 20); \
                *(GAS float*)(SCb + (scoff + 4u * (unsigned)key)) = score; \
                if (valid) __hip_atomic_fetch_add((LAS unsigned*)(myreg + ((bin >> 1) << 2)), 1u << ((bin & 1) << 4), __ATOMIC_RELAXED, __HIP_MEMORY_SCOPE_WORKGROUP); \
} \
            if (mm_ + 1 < nch) *(LAS v4u*)(KST + ((mm_ + 1) & 1) * 8192 + sdst) = RW; \
            RW = KG(mm_ + 3 < nch ? mm_ + 3 : nch - 1); \
            __syncthreads(); } } while (0)
        for (int m = 0; m < nch; m += 2) { IDX_STEP(0, R1); IDX_STEP(1, R0); }
#undef IDX_STEP
#undef KG
        {
            int bsq[2], nbq[2]; bool alq[2];
#pragma unroll
            for (int q = 0; q < 2; ++q) {
                const LAS unsigned* hw = (const LAS unsigned*)(reg + q * 8192) + 32 * lane;
                unsigned wd[32]; unsigned s = 0;
#pragma unroll
                for (int i = 0; i < 8; ++i) { const v4u v = *(const LAS v4u*)(hw + 4 * i); wd[4 * i] = v.x; wd[4 * i + 1] = v.y; wd[4 * i + 2] = v.z; wd[4 * i + 3] = v.w; }
#pragma unroll
                for (int i = 0; i < 32; ++i) s += (wd[i] & 0xffffu) + (wd[i] >> 16);
                unsigned v = s;
#pragma unroll
                for (int off = 1; off < 64; off <<= 1) { const unsigned tt = __shfl_down(v, off); if (lane + off < 64) v += tt; }
                const unsigned sufx = v - s; const unsigned total = __builtin_amdgcn_readfirstlane(v);
                int nbel = 0; int fn = (int)sufx; int cum = (int)sufx;
#pragma unroll
                for (int i = 31; i >= 0; --i) {
                    cum += (int)(wd[i] >> 16);     { const int mk = (cum - 256) >> 31; nbel -= mk; const int cm = cum & mk; fn = cm > fn ? cm : fn; }
                    cum += (int)(wd[i] & 0xffffu); { const int mk = (cum - 256) >> 31; nbel -= mk; const int cm = cum & mk; fn = cm > fn ? cm : fn; }
                }
                const int fb = 64 * lane + 63 - nbel;
                const unsigned long long bm = __ballot(sufx < 256u && v >= 256u);
                const int lstar = bm ? (int)__builtin_ctzll(bm) : 0;
                bsq[q] = __builtin_amdgcn_readlane(fb, lstar); nbq[q] = __builtin_amdgcn_readlane(fn, lstar); alq[q] = total <= 256u;
            }
            bstar = hi ? bsq[1] : bsq[0]; nab = hi ? nbq[1] : nbq[0]; allq = hi ? alq[1] : alq[0];
        }
        { const v4u z = {0u, 0u, 0u, 0u};
#pragma unroll
          for (int i = 0; i < 16; ++i) *(LAS v4u*)(reg + (i * 64 + lane) * 16) = z; }
        asm volatile("s_waitcnt vmcnt(0)" ::: "memory");
        { const int ntile = 2 * nch;
          for (int t8 = 0; t8 < ntile; t8 += 8) {
              float sv[8];
#pragma unroll
              for (int j = 0; j < 8; ++j) sv[j] = __builtin_nontemporal_load((const GAS float*)(SCb + (scoff + 4u * (unsigned)(32 * (t8 + j < ntile ? t8 + j : ntile - 1) + kl))));
#pragma unroll
              for (int j = 0; j < 8; ++j) if (t8 + j < ntile) {
                  const int key = 32 * (t8 + j) + kl; const bool valid = key <= myq; const float score = sv[j];
                  const unsigned bits = __float_as_uint(score); const unsigned u = bits ^ ((unsigned)((int)bits >> 31) | 0x80000000u); const int bin = (int)(u >> 20);
                  const bool above = valid && (allq || bin > bstar), cand = valid && !allq && bin == bstar;
                  const unsigned long long bal = __ballot(above);
                  if (kl == 0) *(LAS unsigned*)(myreg + 6144 + (t8 + j) * 4) = hi ? (unsigned)(bal >> 32) : (unsigned)bal;
                  if (__any(cand)) { if (cand) { const unsigned slot = __hip_atomic_fetch_add((LAS unsigned*)(myreg + 7168), 1u, __ATOMIC_RELAXED, __HIP_MEMORY_SCOPE_WORKGROUP);
                      if (slot < 768u) { v2u e; e.x = u; e.y = (unsigned)key; *(LAS v2u*)(myreg + slot * 8) = e; } } }
              } } }
        {
#pragma unroll
            for (int q = 0; q < 2; ++q) {
                LAS unsigned char* rq = reg + q * 8192;
                const int nbq_ = __builtin_amdgcn_readlane(nab, q * 32); const bool alq_ = __builtin_amdgcn_readlane((int)allq, q * 32) != 0;
                unsigned nc = *(LAS unsigned*)(rq + 7168); nc = nc > 768u ? 768u : nc; nc = __builtin_amdgcn_readfirstlane(nc);
                const int need = 256 - nbq_;
                if (!alq_ && nc > 0u) {
                    for (unsigned i0 = 0; i0 < nc; i0 += 64) { const unsigned i = i0 + lane; const bool act = i < nc;
                        v2u me = {0u, 0u}; if (act) me = *(LAS v2u*)(rq + i * 8);
                        int rank = 0;
                        unsigned j = 0;
                        for (; j + 4 <= nc; j += 4) { const v2u o0 = *(LAS v2u*)(rq + j * 8), o1 = *(LAS v2u*)(rq + j * 8 + 8), o2 = *(LAS v2u*)(rq + j * 8 + 16), o3 = *(LAS v2u*)(rq + j * 8 + 24);
                            rank += ((o0.x > me.x || (o0.x == me.x && o0.y < me.y)) ? 1 : 0) + ((o1.x > me.x || (o1.x == me.x && o1.y < me.y)) ? 1 : 0)
                                  + ((o2.x > me.x || (o2.x == me.x && o2.y < me.y)) ? 1 : 0) + ((o3.x > me.x || (o3.x == me.x && o3.y < me.y)) ? 1 : 0); }
                        for (; j < nc; ++j) { const v2u o = *(LAS v2u*)(rq + j * 8); rank += (o.x > me.x || (o.x == me.x && o.y < me.y)) ? 1 : 0; }
                        if (act && rank < need) __hip_atomic_fetch_or((LAS unsigned*)(rq + 6144 + ((me.y >> 5) << 2)), 1u << (me.y & 31u), __ATOMIC_RELAXED, __HIP_MEMORY_SCOPE_WORKGROUP);
                    }
                }
                LDS_WAIT();
                const v4u mrow = *(LAS v4u*)(rq + 6144 + lane * 16);
                *(GAS v4u*)(MASKA + (size_t)(t0 + 2 * w + q) * 256 + 4 * lane) = mrow;
            }
        }
    }
    __syncthreads();
}
__device__ __forceinline__ void phase_indexer(Frame& F) {
    for (int p = F.bid; p < 256; p += F.G) { indexer_item(F, 511 - p); indexer_item(F, p); }
}

__device__ __forceinline__ void phase_moba_gate(Frame& F) {
    const int gw = F.bid * 8 + F.wave, NGW = F.G * 8, lane = F.lane, n = lane & 31, half = lane >> 5;
    const bf16* PROJ = WSP(bf16, WS_PROJ); const float* KMEAN = WSP(float, WS_KMEAN); unsigned* BLKM = WSP(unsigned, WS_BLKM);
    for (int t = gw; t < T; t += NGW) {
        const int c = t >> 8;
        for (int h = 0; h < 6; ++h) {
            unsigned mask = 1u << c;
            if (c > 0) {
                const bf16* q = PROJ + (size_t)t * NPROJ + PJ_QB + h * 128 + 64 * half; const float* km = KMEAN + (size_t)n * 768 + h * 128 + 64 * half;
                float g = 0.f;
#pragma unroll
                for (int i = 0; i < 8; ++i) { const v4u qw = *(const GAS v4u*)(q + 8 * i); const f32x4 k0 = *(const GAS f32x4*)(km + 8 * i), k1 = *(const GAS f32x4*)(km + 8 * i + 4);
                    g += bflo(qw.x) * k0[0] + bfhi(qw.x) * k0[1] + bflo(qw.y) * k0[2] + bfhi(qw.y) * k0[3] + bflo(qw.z) * k1[0] + bfhi(qw.z) * k1[1] + bflo(qw.w) * k1[2] + bfhi(qw.w) * k1[3]; }
                g += __shfl_xor(g, 32);
                float val = (n < c) ? g : -__builtin_inff();
                for (int rnd = 0; rnd < 3; ++rnd) {
                    float mx = val;
#pragma unroll
                    for (int o = 1; o < 32; o <<= 1) mx = fmaxf(mx, __shfl_xor(mx, o));
                    if (!(mx > -__builtin_inff())) break;
                    const unsigned long long bm = __ballot(val == mx) & 0xffffffffull;
                    const int idx = (int)__builtin_ctzll(bm);
                    mask |= 1u << idx; if (n == idx) val = -__builtin_inff();
                }
            }
            if (lane == 0) BLKM[(size_t)t * 6 + h] = mask;
        }
    }
}

__device__ __forceinline__ void phase_attention(Frame& F, int l, int rep) {
    const GAS bf16* PROJ = (const GAS bf16*)WSP(bf16, WS_PROJ); const GAS bf16* QAI = (const GAS bf16*)WSP(bf16, WS_QAI); const GAS bf16* KVA = (const GAS bf16*)WSP(bf16, WS_KVA); const GAS bf16* MKV = (const GAS bf16*)WSP(bf16, WS_MKV);
    GAS bf16* OATT = (GAS bf16*)WSP(bf16, WS_OATT); const GAS unsigned* MASKA = (const GAS unsigned*)WSP(unsigned, WS_MASKA); const GAS unsigned* BLKM = (const GAS unsigned*)WSP(unsigned, WS_BLKM);
    gu32* head = F.ctl + CW_AQ + 64 * l + 32 * rep;
    for (;;) {
        if (F.tid == 0) F.MISC[16] = __hip_atomic_fetch_add(head, 1u, RLX_AGENT);
        __syncthreads();
        const int i = __builtin_amdgcn_readfirstlane((int)F.MISC[16]);
        __syncthreads();
        if (i >= 512) break;
        int mode, h, qb;
        if (i < 384) { qb = 31 - i / 12; const int k = i % 12; mode = k < 6 ? 1 : 2; h = k < 6 ? k : k - 6; } else { const int m = i - 384; mode = 0; h = m & 3; qb = m >> 2; }
        const int qpos0 = qb * 256;
        int tl = F.tid; asm volatile("" : "+v"(tl));
#ifndef ATT_MODES
#define ATT_MODES 7
#endif
        if ((ATT_MODES & 2) && mode == 1) { const float sl = exp2f(-8.f * (float)(2 * h + 1) / 12.f) * LOG2E;
            att::attn_unit<1>(QAI + (size_t)qpos0 * NQAI + h * 128, NQAI, KVA + h * 128, KVA + 768 + h * 128, NKVA, OATT + (size_t)qpos0 * 2048 + h * 128, 2048, 4 * (qb + 1), qpos0, sl, MASKA, nullptr, (LAS char*)F.lds, tl); }
        else if ((ATT_MODES & 4) && mode == 2) { const float sl = exp2f(-8.f * (float)(2 * h + 2) / 12.f) * LOG2E;
            att::attn_unit<2>(PROJ + (size_t)qpos0 * NPROJ + PJ_QB + h * 128, NPROJ, PROJ + PJ_KB + h * 128, PROJ + PJ_VB + h * 128, NPROJ, OATT + (size_t)qpos0 * 2048 + 768 + h * 128, 2048, 4 * (qb + 1), qpos0, sl, nullptr, BLKM + (size_t)qpos0 * 6 + h, (LAS char*)F.lds, tl); }
        else if (ATT_MODES & 1) { att::attn_unit<0>(PROJ + (size_t)qpos0 * NPROJ + PJ_QC + h * 128, NPROJ, MKV + h * 128, MKV + 512 + h * 128, 1024, OATT + (size_t)qpos0 * 2048 + 1536 + h * 128, 2048, 4, qpos0, 0.f, nullptr, nullptr, (LAS char*)F.lds, tl); }
    }
}

__device__ __forceinline__ void phase_ln1_router(Frame& F, const Args& a, int l, int rep) {
    const int lane = F.lane, w = F.wave, tid = F.tid;
    const float* PRE = WSP(float, WS_PRE); float* X1 = WSP(float, WS_X1); bf16* X1B = WSP(bf16, WS_X1B); const float* WR = WSP(float, WS_WR); int* ROUTE = WSP(int, WS_ROUTE);
    const float* g1 = (a.in[I_LN1G] + F.z) + l * 2048; const float* b1 = (a.in[I_LN1B] + F.z) + l * 2048; const float* bgrp = (a.in[I_BGRP] + F.z) + l * 4; const float* brt = (a.in[I_BRT] + F.z) + l * 32;
    gu32* ecnt = F.ctl + CW_ECNT + 64 * l;
    constexpr int XS = 2052;
    LAS float* xt = (LAS float*)F.lds; LAS float* part = (LAS float*)(F.lds + 16 * XS * 4); LAS float* lg = part + 8 * 16 * 48;
    for (int it = F.bid; it < T / 16; it += F.G) {
        const int t0 = it * 16;
#pragma unroll
        for (int i = 0; i < 2; ++i) {
            const int rl = 2 * w + i, t = t0 + rl;
            const GAS f32x4* xr = (const GAS f32x4*)(PRE + (size_t)t * 2048) + lane;
            f32x4 v[8]; float s = 0.f;
#pragma unroll
            for (int j = 0; j < 8; ++j) { v[j] = xr[64 * j]; s += (v[j].x + v[j].y) + (v[j].z + v[j].w); }
            const float mean = wave_sum(s) * (1.f / 2048.f); float s2 = 0.f;
#pragma unroll
            for (int j = 0; j < 8; ++j) { v[j] = v[j] - mean; s2 += (v[j].x * v[j].x + v[j].y * v[j].y) + (v[j].z * v[j].z + v[j].w * v[j].w); }
            const float rstd = 1.f / sqrtf(wave_sum(s2) * (1.f / 2048.f) + LN_EPS);
#pragma unroll
            for (int j = 0; j < 8; ++j) { const int col = 4 * lane + 256 * j; const f32x4 g = *(const GAS f32x4*)(g1 + col), b = *(const GAS f32x4*)(b1 + col);
                const f32x4 o = v[j] * rstd * g + b;
                *(GAS f32x4*)(X1 + (size_t)t * 2048 + col) = o; v2u ob; ob.x = pk2(o[0], o[1]); ob.y = pk2(o[2], o[3]); *(GAS v2u*)(X1B + (size_t)t * 2048 + col) = ob;
                *(LAS f32x4*)(xt + rl * XS + col) = o; }
        }
        __syncthreads();
        { f32x4 acc[3] = {{0, 0, 0, 0}, {0, 0, 0, 0}, {0, 0, 0, 0}};
          const int ar = lane & 15, kq = lane >> 4;
#pragma unroll 16
          for (int s = 0; s < 64; ++s) { const int k = 256 * w + 4 * s + kq; const float av = xt[ar * XS + k]; const float* wr = WR + (size_t)k * 48 + ar;
#pragma unroll
              for (int c = 0; c < 3; ++c) acc[c] = __builtin_amdgcn_mfma_f32_16x16x4f32(av, wr[16 * c], acc[c], 0, 0, 0); }
#pragma unroll
          for (int c = 0; c < 3; ++c)
#pragma unroll
              for (int r = 0; r < 4; ++r) part[(w * 16 + 4 * kq + r) * 48 + 16 * c + ar] = acc[c][r]; }
        __syncthreads();
        for (int e = tid; e < 16 * 48; e += 512) { float s = 0.f;
#pragma unroll
            for (int ww = 0; ww < 8; ++ww) s += part[ww * 16 * 48 + e]; lg[e] = s; }
        __syncthreads();
        if (tid < 16 && rep == 0) {
            const int t = t0 + tid; const LAS float* L = lg + tid * 48;
            float gl[4]; int gs = 0;
#pragma unroll
            for (int j = 0; j < 4; ++j) gl[j] = L[32 + j] + bgrp[j];
#pragma unroll
            for (int j = 1; j < 4; ++j) if (gl[j] > gl[gs]) gs = j;
            float den = 0.f;
#pragma unroll
            for (int j = 0; j < 4; ++j) den += expf(gl[j] - gl[gs]);
            const float pg = 1.f / den;
            float el[8];
#pragma unroll
            for (int j = 0; j < 8; ++j) el[j] = L[8 * gs + j] + brt[8 * gs + j];
            int i0 = 0;
#pragma unroll
            for (int j = 1; j < 8; ++j) if (el[j] > el[i0]) i0 = j;
            int i1 = (i0 == 0) ? 1 : 0;
#pragma unroll
            for (int j = 0; j < 8; ++j) if (j != i0 && el[j] > el[i1]) i1 = j;
            const float e1 = expf(el[i1] - el[i0]); const float w0 = pg / (1.f + e1), w1 = pg * e1 / (1.f + e1);
            const int x0 = 8 * gs + i0, x1 = 8 * gs + i1;
            const int p0 = (int)__hip_atomic_fetch_add(ecnt + x0, 1u, RLX_AGENT), p1 = (int)__hip_atomic_fetch_add(ecnt + x1, 1u, RLX_AGENT);
            int* R = ROUTE + (size_t)t * 8; R[0] = x0; R[1] = x1; R[2] = (int)__float_as_uint(w0); R[3] = (int)__float_as_uint(w1); R[4] = p0; R[5] = p1;
        }
        __syncthreads();
    }
}

__device__ __forceinline__ void phase_gather(Frame& F, int l) {
    const int lane = F.lane, tid = F.tid;
    gu32* ecnt = F.ctl + CW_ECNT + 64 * l; int* info = F.info + l * 256;
    const bf16* X1B = WSP(bf16, WS_X1B); bf16* XG = WSP(bf16, WS_XG); const int* ROUTE = WSP(int, WS_ROUTE); int* ROWMAP = WSP(int, WS_ROWMAP); float* ROWW = WSP(float, WS_ROWW);
    LAS int* off = (LAS int*)F.lds;
    if (tid == 0) { int o = 0;
#pragma nounroll
        for (int e = 0; e < 32; ++e) { off[e] = o; const int c = (int)__hip_atomic_load(ecnt + e, RLX_AGENT); const int nt = (c + 255) >> 8;
            if (F.bid == 0) {
#pragma nounroll
                for (int j = 0; j < nt; ++j) __hip_atomic_store(info + (o >> 8) + j, e, RLX_AGENT); }
            o += nt << 8; } off[32] = o; if (F.bid == 0) info[128] = o >> 8; }
    __syncthreads();
    for (int e = F.bid; e < 32; e += F.G) { const int c = (int)__hip_atomic_load(ecnt + e, RLX_AGENT); for (int r = off[e] + c + tid; r < off[e + 1]; r += 512) { ROWMAP[r] = -1; ROWW[r] = 0.f; } }
    const int gw = F.bid * 8 + F.wave, NGW = F.G * 8;
    for (int t = gw; t < T; t += NGW) {
        const int* R = ROUTE + (size_t)t * 8; const int e0 = R[0], e1 = R[1], p0 = R[4], p1 = R[5];
        const int d0 = off[e0] + p0, d1 = off[e1] + p1;
        const GAS v4u* src = (const GAS v4u*)(X1B + (size_t)t * 2048) + lane; GAS v4u* o0 = (GAS v4u*)(XG + (size_t)d0 * 2048) + lane; GAS v4u* o1 = (GAS v4u*)(XG + (size_t)d1 * 2048) + lane;
#pragma unroll
        for (int j = 0; j < 4; ++j) { const v4u v = src[64 * j]; o0[64 * j] = v; o1[64 * j] = v; }
        if (lane == 0) { ROWMAP[d0] = 2 * t; ROWMAP[d1] = 2 * t + 1; ROWW[d0] = __uint_as_float((unsigned)R[2]); ROWW[d1] = __uint_as_float((unsigned)R[3]); }
    }
    __syncthreads();
}

__device__ __forceinline__ void phase_ln2(Frame& F, const Args& a, int l, float* xout) {
    const int gw = F.bid * 8 + F.wave, NGW = F.G * 8, lane = F.lane;
    const float* X1 = WSP(float, WS_X1); const bf16* Y = WSP(bf16, WS_Y); bf16* HB = WSP(bf16, WS_HB);
    const float* g2 = (a.in[I_LN2G] + F.z) + l * 2048; const float* b2 = (a.in[I_LN2B] + F.z) + l * 2048;
    for (int t = gw; t < T; t += NGW) {
        const GAS f32x4* xr = (const GAS f32x4*)(X1 + (size_t)t * 2048) + lane; const GAS v2u* y0 = (const GAS v2u*)(Y + (size_t)(2 * t) * 2048) + lane; const GAS v2u* y1 = (const GAS v2u*)(Y + (size_t)(2 * t + 1) * 2048) + lane;
        f32x4 v[8]; float s = 0.f;
#pragma unroll
        for (int j = 0; j < 8; ++j) { const f32x4 xv = xr[64 * j]; const v2u a0 = y0[64 * j], a1 = y1[64 * j];
            v[j][0] = ALPHA * xv[0] + (bflo(a0.x) + bflo(a1.x)); v[j][1] = ALPHA * xv[1] + (bfhi(a0.x) + bfhi(a1.x)); v[j][2] = ALPHA * xv[2] + (bflo(a0.y) + bflo(a1.y)); v[j][3] = ALPHA * xv[3] + (bfhi(a0.y) + bfhi(a1.y));
            s += (v[j].x + v[j].y) + (v[j].z + v[j].w); }
        const float mean = wave_sum(s) * (1.f / 2048.f); float s2 = 0.f;
#pragma unroll
        for (int j = 0; j < 8; ++j) { v[j] = v[j] - mean; s2 += (v[j].x * v[j].x + v[j].y * v[j].y) + (v[j].z * v[j].z + v[j].w * v[j].w); }
        const float rstd = 1.f / sqrtf(wave_sum(s2) * (1.f / 2048.f) + LN_EPS);
#pragma unroll
        for (int j = 0; j < 8; ++j) { const int col = 4 * lane + 256 * j; const f32x4 g = *(const GAS f32x4*)(g2 + col), b = *(const GAS f32x4*)(b2 + col);
            const f32x4 o = v[j] * rstd * g + b;
            *(GAS f32x4*)(xout + (size_t)t * 2048 + col) = o; v2u ob; ob.x = pk2(o[0], o[1]); ob.y = pk2(o[2], o[3]); *(GAS v2u*)(HB + (size_t)t * 2048 + col) = ob; }
    }
}

#ifndef MK_PER_PHASE
#define MK_PER_PHASE 0
#endif
constexpr int NPHASE = 1 + 14 * NLAYER;
#ifndef PH_MASK
#define PH_MASK 0xFFFF
#endif
constexpr bool EN(int k) { return (PH_MASK >> k) & 1; }
#ifndef DBG_DOUBLE_MASK
#define DBG_DOUBLE_MASK 0
#endif
constexpr int REP(int k) { return ((DBG_DOUBLE_MASK >> k) & 1) ? 2 : 1; }
__global__ void __launch_bounds__(512, 2) fwd(Args a) {
    extern __shared__ __attribute__((aligned(16))) unsigned char lds_raw[];
    Frame F;
    F.lds = (LAS unsigned char*)lds_raw; F.MISC = (volatile LAS unsigned*)(F.lds + MISC_OFF);
    F.wave = __builtin_amdgcn_readfirstlane((int)threadIdx.x >> 6); F.lane = lane_id(); F.tid = F.wave * 64 + F.lane; F.G = gridDim.x; F.bid = blockIdx.x;
    F.z = 0; F.ws = a.ws; F.ctl = (gu32*)(F.ws + WS_CTL); F.info = (int*)(F.ws + WS_INFO);
    if (F.tid < 64) F.MISC[F.tid] = 0u;
    __syncthreads();
    XcdBarrier bar = xcd_barrier_post((unsigned*)(F.ctl + CW_BAR), F.MISC + 8, F.wave == 0 ? 1u : 0u);
    const int lo = a.ph_lo, hi = a.ph_hi;
#define ENTER() do { size_t z_ = 0; asm volatile("" : "+s"(z_)); F.z = z_; unsigned char* w_ = a.ws + z_; F.ws = w_; F.ctl = (gu32*)(w_ + WS_CTL); F.info = (int*)(w_ + WS_INFO); int wv_ = F.wave; asm volatile("" : "+s"(wv_)); int t_ = wv_ * 64 + lane_id(); asm volatile("" : "+v"(t_)); F.tid = t_; F.lane = t_ & 63; F.wave = wv_; } while (0)
#define IN(k) (lo <= (k) && (k) < hi)
#define SEAM(k) do { if (lo <= (k) && (k) + 1 < hi) xcd_barrier(bar); } while (0)
    if constexpr (EN(0)) if (IN(0)) for (int rep = 0; rep < REP(0); ++rep) { ENTER(); prologue(F, a); conv_layer(F, a, 0); } SEAM(0);
#pragma unroll
    for (int l = 0; l < NLAYER; ++l) {
        const int pb = 1 + 14 * l;

        if constexpr (EN(0)) if (IN(pb + 0)) for (int rep = 0; rep < REP(0); ++rep) { ENTER(); if (l > 0) conv_layer(F, a, l); } if (l > 0) SEAM(pb + 0);
        if constexpr (EN(1)) if (IN(pb + 1)) for (int rep = 0; rep < REP(1); ++rep) { ENTER();
            pg8::Gemm g{WSP(bf16, WS_HB), WSP(bf16, WS_WA), T, NA, DM, DM}; pg8::StaticOrder S; S.init(T, NA, F.G, F.bid);
            pg8::EpiA E; E.proj = WSP(bf16, WS_PROJ); E.gate = WSP(bf16, WS_GATE); E.bgate = (a.in[I_BGATE] + F.z) + l * 6144; E.qs = SM_SCALE * LOG2E;
            pg8::gemm_phase<pg8::EpiA, pg8::StaticOrder, true, true>(F.lds, g, S, E, F.tid);
            if (l == 0) { pg8::Gemm g2{WSP(bf16, WS_MEMB), WSP(bf16, WS_WMEM), 256, 1024, DM, DM}; pg8::StaticOrder S2; S2.init(256, 1024, F.G, F.G - 1 - F.bid);
                pg8::EpiScale E2; E2.O = WSP(bf16, WS_MKV); E2.ldc = 1024; E2.pn_a = 0; E2.sa = 1.f; E2.sb = 1.f;
                pg8::gemm_phase<pg8::EpiScale, pg8::StaticOrder, true, true>(F.lds, g2, S2, E2, F.tid); }
        } SEAM(pb + 1);
        if constexpr (EN(2)) if (IN(pb + 2)) for (int rep = 0; rep < REP(2); ++rep) { ENTER(); phase_norms(F, a, l); } SEAM(pb + 2);
        if constexpr (EN(3)) if (IN(pb + 3)) for (int rep = 0; rep < REP(3); ++rep) { ENTER();
            { pg8::Gemm g{WSP(bf16, WS_CQN), WSP(bf16, WS_WC1), T, NQAI, 512, 512}; pg8::StaticOrder S; S.init(T, NQAI, F.G, F.bid);
              pg8::EpiScale E; E.O = WSP(bf16, WS_QAI); E.ldc = NQAI; E.pn_a = 3; E.sa = SM_SCALE * LOG2E; E.sb = 0.125f;
              pg8::gemm_phase<pg8::EpiScale, pg8::StaticOrder, true, true>(F.lds, g, S, E, F.tid); }
            { pg8::Gemm g{WSP(bf16, WS_CKVN), WSP(bf16, WS_WC2), T, NKVA, 256, 256}; pg8::StaticOrder S; S.init(T, NKVA, F.G, F.G - 1 - F.bid);
              pg8::EpiScale E; E.O = WSP(bf16, WS_KVA); E.ldc = NKVA; E.pn_a = 0; E.sa = 1.f; E.sb = 1.f;
              pg8::gemm_phase<pg8::EpiScale, pg8::StaticOrder, true, true>(F.lds, g, S, E, F.tid); }
        } SEAM(pb + 3);
        if constexpr (EN(4)) if (IN(pb + 4)) for (int rep = 0; rep < REP(4); ++rep) { ENTER(); if (rep == 0) phase_moba_gate(F); phase_indexer(F); } SEAM(pb + 4);
        if constexpr (EN(6)) if (IN(pb + 6)) for (int rep = 0; rep < REP(6); ++rep) { ENTER(); phase_attention(F, l, rep); } SEAM(pb + 6);
        if constexpr (EN(7)) if (IN(pb + 7)) for (int rep = 0; rep < REP(7); ++rep) { ENTER();
#ifdef DBG_UPTEST
            { pg8::Gemm g{WSP(bf16, WS_OATT), WSP(bf16, WS_WUP), T, DM, DM, DM}; pg8::StaticOrder S; S.init(T, DM, F.G, F.bid);
              pg8::EpiUp<0> E; E.gate = WSP(bf16, WS_GATE); E.O = WSP(bf16, WS_MERGED);
              pg8::gemm_phase<pg8::EpiUp<0>, pg8::StaticOrder, true, true>(F.lds, g, S, E, F.tid); }
#else
            { pg8::Gemm g{WSP(bf16, WS_OATT), WSP(bf16, WS_WUP), T, DM, 768, DM}; pg8::StaticOrder S; S.init(T, DM, F.G, F.bid);
              pg8::EpiUp<0> E; E.gate = WSP(bf16, WS_GATE); E.O = WSP(bf16, WS_MERGED);
              pg8::gemm_phase<pg8::EpiUp<0>, pg8::StaticOrder, true, true>(F.lds, g, S, E, F.tid); }
            { pg8::Gemm g{WSP(bf16, WS_OATT) + 768, WSP(bf16, WS_WUP) + 768, T, DM, 768, DM}; pg8::StaticOrder S; S.init(T, DM, F.G, F.bid);
              pg8::EpiUp<1> E; E.gate = WSP(bf16, WS_GATE); E.O = WSP(bf16, WS_MERGED);
              pg8::gemm_phase<pg8::EpiUp<1>, pg8::StaticOrder, true, true>(F.lds, g, S, E, F.tid); }
            { pg8::Gemm g{WSP(bf16, WS_OATT) + 1536, WSP(bf16, WS_WUP) + 1536, T, DM, 512, DM}; pg8::StaticOrder S; S.init(T, DM, F.G, F.bid);
              pg8::EpiUp<2> E; E.gate = WSP(bf16, WS_GATE); E.O = WSP(bf16, WS_MERGED);
              pg8::gemm_phase<pg8::EpiUp<2>, pg8::StaticOrder, true, true>(F.lds, g, S, E, F.tid); }
#endif
        } SEAM(pb + 7);
        if constexpr (EN(8)) if (IN(pb + 8)) for (int rep = 0; rep < REP(8); ++rep) { ENTER();
            pg8::Gemm g{WSP(bf16, WS_MERGED), WSP(bf16, WS_WO), T, DM, DM, DM}; pg8::StaticOrder S; S.init(T, DM, F.G, F.bid);
            pg8::EpiPre E; E.x = (l == 0) ? (a.in[I_X] + F.z) : WSP(float, WS_XF); E.pre = WSP(float, WS_PRE); E.alpha = ALPHA;
            pg8::gemm_phase<pg8::EpiPre, pg8::StaticOrder, true, true>(F.lds, g, S, E, F.tid);
        } SEAM(pb + 8);
        if constexpr (EN(9)) if (IN(pb + 9)) for (int rep = 0; rep < REP(9); ++rep) { ENTER(); phase_ln1_router(F, a, l, rep); } SEAM(pb + 9);
        if constexpr (EN(10)) if (IN(pb + 10)) for (int rep = 0; rep < REP(10); ++rep) { ENTER(); phase_gather(F, l); } SEAM(pb + 10);
        if constexpr (EN(11)) if (IN(pb + 11)) for (int rep = 0; rep < REP(11); ++rep) { ENTER();
            const int* info = F.info + l * 256; const int ntile = __builtin_amdgcn_readfirstlane(info[128]);
            pg8::Gemm g{WSP(bf16, WS_XG), WSP(bf16, WS_W13), MPAD, 32 * 1024, DM, DM}; pg8::MoeOrder S; S.tile_e = info; S.ntile = ntile; S.nN = 4; S.G = F.G; S.c = F.bid;
            pg8::EpiMoeA E; E.hid = WSP(bf16, WS_HID);
            pg8::gemm_phase<pg8::EpiMoeA, pg8::MoeOrder, true, true>(F.lds, g, S, E, F.tid);
        } SEAM(pb + 11);
        if constexpr (EN(12)) if (IN(pb + 12)) for (int rep = 0; rep < REP(12); ++rep) { ENTER();
            const int* info = F.info + l * 256; const int ntile = __builtin_amdgcn_readfirstlane(info[128]);
            pg8::Gemm g{WSP(bf16, WS_HID), WSP(bf16, WS_W2), MPAD, 32 * 2048, DEXP, DEXP}; pg8::MoeOrder S; S.tile_e = info; S.ntile = ntile; S.nN = 8; S.G = F.G; S.c = F.bid;
            pg8::EpiMoeB E; E.Y = WSP(bf16, WS_Y); E.rowmap = WSP(int, WS_ROWMAP); E.roww = WSP(float, WS_ROWW);
            pg8::gemm_phase<pg8::EpiMoeB, pg8::MoeOrder, true, true>(F.lds, g, S, E, F.tid);
        } SEAM(pb + 12);
        if constexpr (EN(13)) if (IN(pb + 13)) for (int rep = 0; rep < REP(13); ++rep) { ENTER(); phase_ln2(F, a, l, (l == NLAYER - 1) ? (a.out + F.z) : WSP(float, WS_XF)); } if (l + 1 < NLAYER) SEAM(pb + 13);
    }
#ifdef DBG_EXTRA_BARRIERS
    for (int i = 0; i < DBG_EXTRA_BARRIERS; ++i) xcd_barrier(bar);
#endif
#undef IN
#undef SEAM
}


#ifdef DBG_STOP_PHASE
__global__ void dbg_dump(const unsigned char* ws, size_t off, int kind, long n, float* out, long nout) {
    for (long i = blockIdx.x * 256L + threadIdx.x; i < nout; i += gridDim.x * 256L) { const long j = i % n; float v;
        if (kind == 0) v = __builtin_bit_cast(float, (unsigned)((const unsigned short*)(ws + off))[j] << 16);
        else if (kind == 1) v = ((const float*)(ws + off))[j];
        else v = (float)(((const unsigned*)(ws + off))[j] & 0xffffu);
        out[i] = v; }
}
#endif
extern "C" void kernel_launch(void* const* d_in, const int* in_sizes, int n_in, void* d_out, int out_size, void* d_ws, size_t ws_size, hipStream_t stream) {
    static int grid = 0;
    if (grid == 0) {
        if (n_in != 28 || out_size != T * DM || ws_size < WS_END) { fprintf(stderr, "kernel_launch: unexpected shapes (n_in %d out %d ws %zu)\n", n_in, out_size, ws_size); grid = -1; return; }
        int dev = 0, cus = 0;
        if (hipGetDevice(&dev) != hipSuccess || hipDeviceGetAttribute(&cus, hipDeviceAttributeMultiprocessorCount, dev) != hipSuccess) { grid = -1; return; }
        if (hipFuncSetAttribute((const void*)fwd, hipFuncAttributeMaxDynamicSharedMemorySize, LDS_BYTES) != hipSuccess) { fprintf(stderr, "kernel_launch: hipFuncSetAttribute failed\n"); grid = -1; return; }
        int per_cu = 0;
        if (hipOccupancyMaxActiveBlocksPerMultiprocessor(&per_cu, (const void*)fwd, 512, LDS_BYTES) != hipSuccess || per_cu < 1) fprintf(stderr, "kernel_launch: occupancy query says %d\n", per_cu);
        (void)hipGetLastError();
        grid = cus;
    }
    if (grid < 0) return;
    if (hipMemsetAsync((char*)d_ws + WS_CTL, 0, CTL_ZERO_BYTES, stream) != hipSuccess) return;
    Args a{};
    for (int i = 0; i < 28; ++i) a.in[i] = (const float*)d_in[i];
    a.out = (float*)d_out; a.ws = (unsigned char*)d_ws;
#if defined(DBG_STOP_PHASE)
    for (int k = 0; k <= DBG_STOP_PHASE; ++k) { a.ph_lo = k; a.ph_hi = k + 1; hipLaunchKernelGGL(fwd, dim3(grid), dim3(512), LDS_BYTES, stream, a); }
    hipLaunchKernelGGL(dbg_dump, dim3(2048), dim3(256), 0, stream, (const unsigned char*)d_ws, (size_t)DBG_DUMP_OFF, DBG_DUMP_KIND, (long)DBG_DUMP_N, (float*)d_out, (long)out_size);
#elif MK_PER_PHASE
    for (int k = 0; k < NPHASE; ++k) { a.ph_lo = k; a.ph_hi = k + 1; hipLaunchKernelGGL(fwd, dim3(grid), dim3(512), LDS_BYTES, stream, a); }
#else
    a.ph_lo = 0; a.ph_hi = NPHASE;
    hipLaunchKernelGGL(fwd, dim3(grid), dim3(512), LDS_BYTES, stream, a);
#endif
    const hipError_t le = hipPeekAtLastError();
    if (le != hipSuccess) fprintf(stderr, "kernel_launch: launch failed: %s\n", hipGetErrorName(le));
}
```

```cpp
#define DBG_MIX_SCALE 1.0f
#define DBG_ZERO_BR 0
#define DBG_DOUBLE_MASK 0
#include <hip/hip_runtime.h>
#include <cstdio>
#include <cstdint>

#define GAS __attribute__((address_space(1)))
#define LAS __attribute__((address_space(3)))
typedef unsigned short bf16;
typedef unsigned v4u __attribute__((ext_vector_type(4)));
typedef unsigned v2u __attribute__((ext_vector_type(2)));
typedef float f32x4 __attribute__((ext_vector_type(4)));
typedef float f32x2 __attribute__((ext_vector_type(2)));
typedef float f32x16 __attribute__((ext_vector_type(16)));
typedef short bf16x8 __attribute__((ext_vector_type(8)));
typedef short s16x4 __attribute__((ext_vector_type(4)));
typedef GAS unsigned gu32;
#define RLX_AGENT __ATOMIC_RELAXED, __HIP_MEMORY_SCOPE_AGENT
#define LDS_WAIT() asm volatile("s_waitcnt lgkmcnt(0)" ::: "memory")
#define VM_WAIT() asm volatile("s_waitcnt vmcnt(0)" ::: "memory")
#define SBAR() __builtin_amdgcn_sched_barrier(0)

__device__ __forceinline__ unsigned f2bf(float f) { unsigned u = __builtin_bit_cast(unsigned, f); return (u + 0x7fffu + ((u >> 16) & 1u)) >> 16; }
__device__ __forceinline__ unsigned pk2(float lo, float hi) { return f2bf(lo) | (f2bf(hi) << 16); }
__device__ __forceinline__ float bf2f(unsigned b) { return __builtin_bit_cast(float, b << 16); }
__device__ __forceinline__ float bflo(unsigned w) { return __builtin_bit_cast(float, w << 16); }
__device__ __forceinline__ float bfhi(unsigned w) { return __builtin_bit_cast(float, w & 0xffff0000u); }
typedef __bf16 bf16x2_t __attribute__((ext_vector_type(2)));
__device__ __forceinline__ unsigned cvtpk(float lo, float hi) { f32x2 v = {lo, hi}; bf16x2_t b = __builtin_convertvector(v, bf16x2_t); return __builtin_bit_cast(unsigned, b); }
__device__ __forceinline__ float wave_sum(float v) {
#pragma unroll
    for (int o = 1; o < 64; o <<= 1) v += __shfl_xor(v, o);
    return v;
}

constexpr int T = 8192, DM = 2048, NLAYER = 2;
constexpr int NA = 9984;
constexpr int NPROJ = 3840, NGATE = 6144;
constexpr int PJ_QB = 1024, PJ_KB = 1792, PJ_VB = 2560, PJ_QC = 3328;
constexpr int NQAI = 1792;
constexpr int NKVA = 1536;
constexpr int NEXP = 32, DEXP = 512;
constexpr int MPAD = 24576;
constexpr float LN_EPS = 1e-5f;
constexpr float ALPHA = 1.4142135623730951f;
constexpr float SM_SCALE = 0.088388347648318440f;
constexpr float LOG2E = 1.4426950408889634f;
namespace pg8 {
#define PG8_LAS __attribute__((address_space(3)))
typedef unsigned short bf16_t;
typedef short bf16x8 __attribute__((ext_vector_type(8)));
typedef float f32x4 __attribute__((ext_vector_type(4)));
typedef unsigned u32x4 __attribute__((ext_vector_type(4)));
constexpr int BM = 256, BK = 64, HALF = 128, HTB = HALF * BK * 2  , STAGE_BYTES = 8 * HTB, NXCD = 8, WGM = 8;

__host__ __device__ __forceinline__ int lds_byte(int r, int c) { const int st = (r >> 4) * 2 + (c >> 5), rr = r & 15, cc = c & 31, ob = rr * 64 + cc * 2; return st * 1024 + (ob ^ (((ob >> 9) & 1) << 5)); }
__host__ __device__ __forceinline__ void stage_rc(int b, int& R, int& C) { const int st = b / 1024, sb = b % 1024, swz = sb ^ (((sb >> 9) & 1) << 5); R = (st >> 1) * 16 + swz / 64; C = (st & 1) * 32 + (swz % 64) / 2; }
__host__ __device__ __forceinline__ int perm32(int rho) { const int n = rho >> 4, i = rho & 15; return 8 * (i >> 2) + 4 * n + (i & 3); }

struct Unit { int pm, pn; };
struct Gemm { const bf16_t* A; const bf16_t* Bt; int M, N, K, ld; };

struct StaticOrder {
    int nM, nN, nwg, G, c;
    __host__ __device__ void init(int M, int N, int G_, int c_) { nM = M / BM; nN = N / BM; nwg = nM * nN; G = G_; c = c_; }
    __host__ __device__ bool next(int i, Unit& u) const {
        const long L = (long)i * G + c; if (L >= nwg) return false;
        int wgid = (int)L; { const int q = nwg / NXCD, r = nwg % NXCD, xcd = wgid % NXCD, off = wgid / NXCD; wgid = (xcd < r ? xcd * (q + 1) : r * (q + 1) + (xcd - r) * q) + off; }
        const int nig = WGM * nN, gid = wgid / nig, fm = gid * WGM, gsz = (nM - fm) < WGM ? (nM - fm) : WGM;
        u.pm = fm + ((wgid % nig) % gsz); u.pn = (wgid % nig) / gsz; return true;
    }
    __device__ __forceinline__ void a_ready(const Unit&) const {}
    __device__ __forceinline__ void done(const Unit&) const {}
};


__device__ __forceinline__ unsigned cvt_pk_bf16(float lo, float hi) { return ::cvtpk(lo, hi); }
__device__ __forceinline__ float sigmoidf_(float v) { return __builtin_amdgcn_rcpf(1.0f + __builtin_amdgcn_exp2f(-1.4426950408889634f * v)); }
__device__ __forceinline__ u32x4 pack8(const f32x4 v0, const f32x4 v1) { u32x4 w; w.x = cvt_pk_bf16(v0[0], v0[1]); w.y = cvt_pk_bf16(v0[2], v0[3]); w.z = cvt_pk_bf16(v1[0], v1[1]); w.w = cvt_pk_bf16(v1[2], v1[3]); return w; }
__device__ __forceinline__ void unpack8(const u32x4 w, f32x4& a, f32x4& b) {
    a[0] = __builtin_bit_cast(float, w.x << 16); a[1] = __builtin_bit_cast(float, w.x & 0xffff0000u); a[2] = __builtin_bit_cast(float, w.y << 16); a[3] = __builtin_bit_cast(float, w.y & 0xffff0000u);
    b[0] = __builtin_bit_cast(float, w.z << 16); b[1] = __builtin_bit_cast(float, w.z & 0xffff0000u); b[2] = __builtin_bit_cast(float, w.w << 16); b[3] = __builtin_bit_cast(float, w.w & 0xffff0000u); }
struct EpiBase { static constexpr bool PERM = true, AFTER_DRAIN = false; };

struct EpiA : EpiBase {
    bf16_t* proj; bf16_t* gate; const float* bgate; float qs;
    __device__ __forceinline__ void operator()(const f32x4 (&acc)[2][2][4][2], const Unit& u, int wr, int wc, int fr, int fq) const {
        const int row0 = u.pm * BM + wr * 64 + fr; const int colt = u.pn * BM + wc * 32 + 8 * fq;
        if (u.pn < 15) {
            const float s = ((u.pn >= 4 && u.pn < 7) || u.pn >= 13) ? qs : 1.0f;
#pragma unroll
            for (int ai = 0; ai < 2; ++ai)
#pragma unroll
                for (int m = 0; m < 4; ++m) { bf16_t* rowp = proj + (size_t)(row0 + ai * HALF + m * 16) * 3840 + colt;
#pragma unroll
                    for (int bj = 0; bj < 2; ++bj) *(u32x4*)(rowp + bj * HALF) = pack8(acc[ai][bj][m][0] * s, acc[ai][bj][m][1] * s); }
        } else {
            const int gc = colt - 3840;
            f32x4 bv[2][2];
#pragma unroll
            for (int bj = 0; bj < 2; ++bj)
#pragma unroll
                for (int n = 0; n < 2; ++n) bv[bj][n] = *(const f32x4*)(bgate + gc + bj * HALF + 4 * n);
#pragma unroll
            for (int ai = 0; ai < 2; ++ai)
#pragma unroll
                for (int m = 0; m < 4; ++m) { bf16_t* rowp = gate + (size_t)(row0 + ai * HALF + m * 16) * 6144 + gc;
#pragma unroll
                    for (int bj = 0; bj < 2; ++bj) { f32x4 v0 = acc[ai][bj][m][0] + bv[bj][0], v1 = acc[ai][bj][m][1] + bv[bj][1];
#pragma unroll
                        for (int j = 0; j < 4; ++j) { v0[j] = sigmoidf_(v0[j]); v1[j] = sigmoidf_(v1[j]); }
                        *(u32x4*)(rowp + bj * HALF) = pack8(v0, v1); } }
        }
    }
};
struct EpiScale : EpiBase {
    bf16_t* O; int ldc; int pn_a; float sa, sb;
    __device__ __forceinline__ void operator()(const f32x4 (&acc)[2][2][4][2], const Unit& u, int wr, int wc, int fr, int fq) const {
        const int row0 = u.pm * BM + wr * 64 + fr; const int colt = u.pn * BM + wc * 32 + 8 * fq; const float s = (u.pn < pn_a) ? sa : sb;
#pragma unroll
        for (int ai = 0; ai < 2; ++ai)
#pragma unroll
            for (int m = 0; m < 4; ++m) { bf16_t* rowp = O + (size_t)(row0 + ai * HALF + m * 16) * ldc + colt;
#pragma unroll
                for (int bj = 0; bj < 2; ++bj) *(u32x4*)(rowp + bj * HALF) = pack8(acc[ai][bj][m][0] * s, acc[ai][bj][m][1] * s); }
    }
};
template <int STEP> struct EpiUp : EpiBase {
    const bf16_t* gate; bf16_t* O;
    __device__ __forceinline__ void operator()(const f32x4 (&acc)[2][2][4][2], const Unit& u, int wr, int wc, int fr, int fq) const {
        const int row0 = u.pm * BM + wr * 64 + fr; const int colt = u.pn * BM + wc * 32 + 8 * fq;
#pragma unroll
        for (int ai = 0; ai < 2; ++ai)
#pragma unroll
            for (int m = 0; m < 4; ++m) { const size_t r = (size_t)(row0 + ai * HALF + m * 16);
#pragma unroll
                for (int bj = 0; bj < 2; ++bj) { const u32x4 wg = *(const u32x4*)(gate + r * 6144 + STEP * 2048 + colt + bj * HALF); f32x4 g0, g1; unpack8(wg, g0, g1);
                    f32x4 v0 = acc[ai][bj][m][0] * g0, v1 = acc[ai][bj][m][1] * g1;
                    if constexpr (STEP > 0) { const u32x4 wp = __builtin_nontemporal_load((const u32x4*)(O + r * 2048 + colt + bj * HALF)); f32x4 p0, p1; unpack8(wp, p0, p1); v0 += p0; v1 += p1; }
                    *(u32x4*)(O + r * 2048 + colt + bj * HALF) = pack8(v0, v1); } }
    }
};
struct EpiPre : EpiBase {
    const float* x; float* pre; float alpha;
    __device__ __forceinline__ void operator()(const f32x4 (&acc)[2][2][4][2], const Unit& u, int wr, int wc, int fr, int fq) const {
        const int row0 = u.pm * BM + wr * 64 + fr; const int colt = u.pn * BM + wc * 32 + 8 * fq;
#pragma unroll
        for (int ai = 0; ai < 2; ++ai)
#pragma unroll
            for (int m = 0; m < 4; ++m) { const size_t off = (size_t)(row0 + ai * HALF + m * 16) * 2048 + colt;
#pragma unroll
                for (int bj = 0; bj < 2; ++bj)
#pragma unroll
                    for (int n = 0; n < 2; ++n) { const f32x4 xv = *(const f32x4*)(x + off + bj * HALF + 4 * n); *(f32x4*)(pre + off + bj * HALF + 4 * n) = xv * alpha + acc[ai][bj][m][n]; } }
    }
};
struct EpiMoeA : EpiBase {
    bf16_t* hid;
    __device__ __forceinline__ void operator()(const f32x4 (&acc)[2][2][4][2], const Unit& u, int wr, int wc, int fr, int fq) const {
        const int row0 = u.pm * BM + wr * 64 + fr; const int hc = (u.pn & 3) * 128 + wc * 32 + 8 * fq;
#pragma unroll
        for (int ai = 0; ai < 2; ++ai)
#pragma unroll
            for (int m = 0; m < 4; ++m) { f32x4 h0, h1;
#pragma unroll
                for (int j = 0; j < 4; ++j) { const float a0 = acc[ai][0][m][0][j], a1 = acc[ai][0][m][1][j]; h0[j] = a0 * sigmoidf_(a0) * acc[ai][1][m][0][j]; h1[j] = a1 * sigmoidf_(a1) * acc[ai][1][m][1][j]; }
                *(u32x4*)(hid + (size_t)(row0 + ai * HALF + m * 16) * 512 + hc) = pack8(h0, h1); }
    }
};
struct EpiMoeB : EpiBase {
    bf16_t* Y; const int* rowmap; const float* roww;
    __device__ __forceinline__ void operator()(const f32x4 (&acc)[2][2][4][2], const Unit& u, int wr, int wc, int fr, int fq) const {
        const int row0 = u.pm * BM + wr * 64 + fr; const int colt = (u.pn & 7) * BM + wc * 32 + 8 * fq;
#pragma unroll
        for (int ai = 0; ai < 2; ++ai)
#pragma unroll
            for (int m = 0; m < 4; ++m) { const int rg = row0 + ai * HALF + m * 16; const int dst = rowmap[rg]; const float w = roww[rg];
                if (dst >= 0) {
#pragma unroll
                    for (int bj = 0; bj < 2; ++bj) *(u32x4*)(Y + (size_t)dst * 2048 + colt + bj * HALF) = pack8(acc[ai][bj][m][0] * w, acc[ai][bj][m][1] * w); } }
    }
};
struct MoeOrder {
    const int* tile_e; int ntile, nN, G, c;
    __device__ __forceinline__ bool next(int i, Unit& u) const {
        const int L = i * G + c; if (L >= ntile * nN) return false;
        const int mt = L / nN, nl = L - mt * nN; u.pm = mt; u.pn = tile_e[mt] * nN + nl; return true; }
    __device__ __forceinline__ void a_ready(const Unit&) const {}
    __device__ __forceinline__ void done(const Unit&) const {}
};

template <class Epi, class Sched, bool ALIGN_EPI = false, bool SP2 = false>
__device__ __forceinline__ void gemm_phase(PG8_LAS unsigned char* lds, const Gemm g, const Sched& S, const Epi& E, const int tid) {
    const int wid = __builtin_amdgcn_readfirstlane(tid >> 6), lane = tid & 63, wr = wid >> 2, wc = wid & 3, fr = lane & 15, fq = lane >> 4;
    const int K = g.ld, nt = g.K / BK;
    unsigned voffA[2], voffB[2];
#pragma unroll
    for (int i = 0; i < 2; ++i) { int R, C; stage_rc(tid * 16 + i * 8192, R, C); const int Rb = Epi::PERM ? ((R & ~31) + perm32(R & 31)) : R;
        voffA[i] = (unsigned)(R * K + C) * 2u; voffB[i] = (unsigned)(Rb * K + C) * 2u; }
    const size_t kstep = (size_t)(BK * 2);
    const size_t hstep = (size_t)HALF * K * 2;
    const size_t tstep = 2 * hstep;
    const unsigned ldsw = (unsigned)wid * 1024u;
    const int aoff = lds_byte(wr * 64 + fr, fq * 8), boff = lds_byte(wc * 32 + fr, fq * 8);
#define PG8_SA(b, h) (((b) * 2 + (h)) * HTB)
#define PG8_SB(b, h) ((4 + (b) * 2 + (h)) * HTB)
#define PG8_STAGE(bufoff, gbase, voff) do { _Pragma("unroll") for (int _i = 0; _i < 2; ++_i) \
        __builtin_amdgcn_global_load_lds((const unsigned*)((const char*)(gbase) + (voff)[_i]), (PG8_LAS unsigned*)(lds + (bufoff) + ldsw + _i * 8192), 16, 0, 0); } while (0)
#define PG8_LDA(dst, b, h) do { _Pragma("unroll") for (int m = 0; m < 4; ++m) _Pragma("unroll") for (int k = 0; k < 2; ++k) dst[m][k] = *(const PG8_LAS bf16x8*)(lds + PG8_SA(b, h) + aoff + m * 2048 + k * 1024); } while (0)
#define PG8_LDB(dst, b, h) do { _Pragma("unroll") for (int n = 0; n < 2; ++n) _Pragma("unroll") for (int k = 0; k < 2; ++k) dst[n][k] = *(const PG8_LAS bf16x8*)(lds + PG8_SB(b, h) + boff + n * 2048 + k * 1024); } while (0)
#define PG8_MMA(ai, bj, At, Bt) do { __builtin_amdgcn_s_setprio(1); _Pragma("unroll") for (int m = 0; m < 4; ++m) _Pragma("unroll") for (int n = 0; n < 2; ++n) _Pragma("unroll") for (int k = 0; k < 2; ++k) \
        acc[ai][bj][m][n] = __builtin_amdgcn_mfma_f32_16x16x32_bf16(Bt[n][k], At[m][k], acc[ai][bj][m][n], 0, 0, 0); __builtin_amdgcn_s_setprio(0); } while (0)
#define PG8_WAIT_V(n) asm volatile("s_waitcnt vmcnt(" #n ")" ::: "memory")
#define PG8_WAIT_L(n) asm volatile("s_waitcnt lgkmcnt(" #n ")" ::: "memory")
#define PG8_BAR __builtin_amdgcn_s_barrier()
#define PG8_SCHED __builtin_amdgcn_sched_barrier(0)
    Unit cur, nxt; int ui = 0;
    if (!S.next(0, cur)) return;
    f32x4 acc[2][2][4][2];
#pragma unroll
    for (int a = 0; a < 2; ++a)
#pragma unroll
        for (int b = 0; b < 2; ++b)
#pragma unroll
            for (int m = 0; m < 4; ++m)
#pragma unroll
                for (int n = 0; n < 2; ++n) acc[a][b][m][n] = (f32x4){0.f, 0.f, 0.f, 0.f};
    bf16x8 At[4][2], B0[2][2], B1[2][2];
    const char* cA = (const char*)g.A + (size_t)cur.pm * tstep; const char* cB = (const char*)g.Bt + (size_t)cur.pn * tstep;
    S.a_ready(cur);
    if constexpr (SP2) {
        PG8_STAGE(PG8_SB(0, 0), cB, voffB); PG8_STAGE(PG8_SB(0, 1), cB + hstep, voffB); PG8_STAGE(PG8_SA(0, 0), cA, voffA); PG8_STAGE(PG8_SA(0, 1), cA + hstep, voffA);
        if (wr == 1) PG8_BAR;
        PG8_WAIT_V(2); PG8_BAR;
        PG8_STAGE(PG8_SB(1, 0), cB + kstep, voffB); PG8_STAGE(PG8_SA(1, 0), cA + kstep, voffA); PG8_STAGE(PG8_SB(1, 1), cB + hstep + kstep, voffB);
        PG8_WAIT_V(6); PG8_BAR;
    } else {
        PG8_STAGE(PG8_SB(0, 0), cB, voffB); PG8_STAGE(PG8_SA(0, 0), cA, voffA); PG8_STAGE(PG8_SB(0, 1), cB + hstep, voffB); PG8_STAGE(PG8_SA(0, 1), cA + hstep, voffA);
        if (wr == 1) PG8_BAR;
        PG8_WAIT_V(4); PG8_BAR;
        PG8_STAGE(PG8_SB(1, 0), cB + kstep, voffB); PG8_STAGE(PG8_SA(1, 0), cA + kstep, voffA); PG8_STAGE(PG8_SB(1, 1), cB + hstep + kstep, voffB);
        PG8_WAIT_V(6); PG8_BAR;
    }
    for (;;) {
        const bool has_next = S.next(ui + 1, nxt);
        const char* nA = has_next ? (const char*)g.A + (size_t)nxt.pm * tstep : cA; const char* nB = has_next ? (const char*)g.Bt + (size_t)nxt.pn * tstep : cB;
        for (int t = 0; t < nt; t += 2) {
            const bool last = (t == nt - 2);
            const char* a1 = cA + (size_t)(t + 1) * kstep;
            const char* a2 = last ? nA : cA + (size_t)(t + 2) * kstep; const char* b2 = last ? nB : cB + (size_t)(t + 2) * kstep;
            const char* a3 = a2 + kstep; const char* b3 = b2 + kstep;
            if (last && has_next) S.a_ready(nxt);
            if constexpr (SP2) {
            PG8_LDB(B0, 0, 0); PG8_LDB(B1, 0, 1); PG8_SCHED; PG8_LDA(At, 0, 0); PG8_STAGE(PG8_SA(1, 1), a1 + hstep, voffA);
            PG8_WAIT_V(8); PG8_WAIT_L(0); PG8_BAR; PG8_MMA(0, 0, At, B0); PG8_MMA(0, 1, At, B1); PG8_BAR; PG8_SCHED;
            PG8_LDA(At, 0, 1); PG8_STAGE(PG8_SB(0, 0), b2, voffB); PG8_STAGE(PG8_SB(0, 1), b2 + hstep, voffB); PG8_STAGE(PG8_SA(0, 0), a2, voffA);
            PG8_WAIT_V(8); PG8_WAIT_L(0); PG8_BAR; PG8_MMA(1, 0, At, B0); PG8_MMA(1, 1, At, B1); PG8_BAR; PG8_SCHED;
            PG8_LDB(B0, 1, 0); PG8_LDB(B1, 1, 1); PG8_SCHED; PG8_LDA(At, 1, 0); PG8_STAGE(PG8_SA(0, 1), a2 + hstep, voffA);
            PG8_WAIT_V(8); PG8_WAIT_L(0); PG8_BAR; PG8_MMA(0, 0, At, B0); PG8_MMA(0, 1, At, B1); PG8_BAR; PG8_SCHED;
            PG8_LDA(At, 1, 1); PG8_STAGE(PG8_SB(1, 0), b3, voffB); PG8_STAGE(PG8_SB(1, 1), b3 + hstep, voffB); PG8_STAGE(PG8_SA(1, 0), a3, voffA);
            PG8_WAIT_V(8); PG8_WAIT_L(0); PG8_BAR; PG8_MMA(1, 0, At, B0); PG8_MMA(1, 1, At, B1); PG8_BAR; PG8_SCHED;
            } else {
            PG8_LDB(B0, 0, 0); PG8_SCHED; PG8_LDA(At, 0, 0); PG8_STAGE(PG8_SA(1, 1), a1 + hstep, voffA);
            PG8_WAIT_L(8); PG8_BAR; PG8_WAIT_L(0); PG8_MMA(0, 0, At, B0); PG8_BAR; PG8_SCHED;
            PG8_LDB(B1, 0, 1); PG8_STAGE(PG8_SB(0, 0), b2, voffB);
            PG8_BAR; PG8_WAIT_L(0); PG8_MMA(0, 1, At, B1); PG8_BAR;
            PG8_LDA(At, 0, 1); PG8_STAGE(PG8_SA(0, 0), a2, voffA);
            PG8_BAR; PG8_WAIT_L(0); PG8_MMA(1, 0, At, B0); PG8_BAR; PG8_SCHED;
            PG8_STAGE(PG8_SB(0, 1), b2 + hstep, voffB);
            PG8_WAIT_V(6); PG8_BAR; PG8_MMA(1, 1, At, B1); PG8_BAR;
            PG8_LDB(B0, 1, 0); PG8_SCHED; PG8_LDA(At, 1, 0); PG8_STAGE(PG8_SA(0, 1), a2 + hstep, voffA);
            PG8_WAIT_L(8); PG8_BAR; PG8_WAIT_L(0); PG8_MMA(0, 0, At, B0); PG8_BAR; PG8_SCHED;
            PG8_LDB(B1, 1, 1); PG8_STAGE(PG8_SB(1, 0), b3, voffB);
            PG8_BAR; PG8_WAIT_L(0); PG8_MMA(0, 1, At, B1); PG8_BAR;
            PG8_LDA(At, 1, 1); PG8_STAGE(PG8_SA(1, 0), a3, voffA);
            PG8_BAR; PG8_WAIT_L(0); PG8_MMA(1, 0, At, B0); PG8_BAR; PG8_SCHED;
            PG8_STAGE(PG8_SB(1, 1), b3 + hstep, voffB);
            PG8_WAIT_V(6); PG8_BAR; PG8_MMA(1, 1, At, B1); PG8_BAR;
            }
        }
        if constexpr (ALIGN_EPI) { if (wr == 0) PG8_BAR; }
        if constexpr (!Epi::AFTER_DRAIN) { E(acc, cur, wr, wc, fr, fq); S.done(cur); }
        if (!has_next) break;
#pragma unroll
        for (int a = 0; a < 2; ++a)
#pragma unroll
            for (int b = 0; b < 2; ++b)
#pragma unroll
                for (int m = 0; m < 4; ++m)
#pragma unroll
                    for (int n = 0; n < 2; ++n) acc[a][b][m][n] = (f32x4){0.f, 0.f, 0.f, 0.f};
        cur = nxt; cA = nA; cB = nB; ++ui;
        if constexpr (ALIGN_EPI) { if (wr == 1) PG8_BAR; }
    }
    PG8_WAIT_V(0);
    if constexpr (!ALIGN_EPI) { if (wr == 0) PG8_BAR; }
    PG8_BAR;
    if constexpr (Epi::AFTER_DRAIN) { E.fused(acc, cur, wr, wc, fr, fq, lds, wid, lane); S.done(cur); }
#undef PG8_SA
#undef PG8_SB
#undef PG8_STAGE
#undef PG8_LDA
#undef PG8_LDB
#undef PG8_MMA
#undef PG8_WAIT_V
#undef PG8_WAIT_L
#undef PG8_BAR
#undef PG8_SCHED
}
}

namespace att {
constexpr int D = 128, NW = 8, QBLK = 32, KVBLK = 64;
constexpr int SDEPTH = 1;
constexpr float THR2 = 8.f * 1.4426950408889634f;
constexpr size_t SHM_V = KVBLK * D * 2, SHM_K = KVBLK * D * 2, SHM_ATTN = 2 * SHM_V + 2 * SHM_K + NW * 64 * 4;
#define KSWZ(row, colB) ((row) * 256 + ((colB) ^ (((row) & 7) << 4)))
__device__ __forceinline__ int crow(int r, int hi) { return (r & 3) + 8 * (r >> 2) + 4 * hi; }
constexpr int ccol(int r) { return (r & 3) + 8 * (r >> 2); }

template <int MODE>
__device__ __forceinline__ void partialSM(f32x16& p0, f32x16& p1, float& m_reg, float& alpha, float& sub1_out, int j, int NT, float slope2, float lanec, int lanet, int hi, v2u mw, unsigned bmw) {
  const float NEGINF = -__builtin_inff();
  float base0 = 0.f, base1 = 0.f;
  if constexpr (MODE != 0) {
    base0 = fmaf(slope2 * 64.f, (float)j, lanec); base1 = base0 + 32.f * slope2;
#pragma unroll
    for (int r = 0; r < 16; ++r) { p0[r] = fmaf(slope2, (float)ccol(r), p0[r]); p1[r] = fmaf(slope2, (float)ccol(r), p1[r]); }
  }
  if constexpr (MODE == 1) {
    const unsigned w0 = mw.x >> (4 * hi), w1 = mw.y >> (4 * hi);
#pragma unroll
    for (int r = 0; r < 16; ++r) {
      const int m0 = __builtin_amdgcn_sbfe(w0, ccol(r), 1), m1 = __builtin_amdgcn_sbfe(w1, ccol(r), 1);
      p0[r] = __uint_as_float((__float_as_uint(p0[r]) & (unsigned)m0) | (0xff800000u & ~(unsigned)m0));
      p1[r] = __uint_as_float((__float_as_uint(p1[r]) & (unsigned)m1) | (0xff800000u & ~(unsigned)m1));
    }
  }
  if constexpr (MODE == 2) {
    const bool sel = (bmw >> (j >> 2)) & 1u; if (!sel) { base0 = NEGINF; base1 = NEGINF; }
    if (j >= NT - 4) { const int thr0 = lanet - 64 * j, thr1 = thr0 - 32;
#pragma unroll
      for (int r = 0; r < 16; ++r) { p0[r] = (ccol(r) <= thr0) ? p0[r] : NEGINF; p1[r] = (ccol(r) <= thr1) ? p1[r] : NEGINF; }
    }
  }
  float mx0 = p0[0], mx1 = p1[0];
#pragma unroll
  for (int r = 1; r < 16; ++r) { mx0 = fmaxf(mx0, p0[r]); mx1 = fmaxf(mx1, p1[r]); }
  float pmax;
  if constexpr (MODE == 0) pmax = fmaxf(mx0, mx1); else pmax = fmaxf(mx0 + base0, mx1 + base1);
  { auto rr = __builtin_amdgcn_permlane32_swap(__float_as_uint(pmax), __float_as_uint(pmax), false, false);
    pmax = fmaxf(__uint_as_float(rr[0]), __uint_as_float(rr[1])); }
  float mn;
  if (__builtin_expect(__all(pmax - m_reg <= THR2), 1)) { mn = m_reg; alpha = 1.f; }
  else { mn = fmaxf(m_reg, pmax); alpha = __builtin_amdgcn_exp2f(m_reg - mn); m_reg = mn; }
  float sub0, sub1;
  if constexpr (MODE == 0) { sub0 = mn; sub1 = mn; } else { sub0 = mn - base0; sub1 = mn - base1; }
#pragma unroll
  for (int r = 0; r < 16; ++r) p0[r] = __builtin_amdgcn_exp2f(p0[r] - sub0);
  sub1_out = sub1;
}
__device__ __forceinline__ void finishSM(f32x16& p0, f32x16& p1, float sub1, float alpha, float& l_reg, bf16x8& pa0, bf16x8& pa1, bf16x8& pa2, bf16x8& pa3) {
#pragma unroll
  for (int r = 0; r < 16; ++r) p1[r] = __builtin_amdgcn_exp2f(p1[r] - sub1);
  float ps = 0;
#pragma unroll
  for (int r = 0; r < 16; ++r) ps += p0[r];
#pragma unroll
  for (int r = 0; r < 16; ++r) ps += p1[r];
  { auto rr = __builtin_amdgcn_permlane32_swap(__float_as_uint(ps), __float_as_uint(ps), false, false);
    ps = __uint_as_float(rr[0]) + __uint_as_float(rr[1]); }
  l_reg = l_reg * alpha + ps;
#define PK4(P, BASE, OUT) do { unsigned a0 = cvtpk(P[BASE + 0], P[BASE + 1]), a1 = cvtpk(P[BASE + 2], P[BASE + 3]);   \
    unsigned b0 = cvtpk(P[BASE + 4], P[BASE + 5]), b1 = cvtpk(P[BASE + 6], P[BASE + 7]);                              \
    auto r0 = __builtin_amdgcn_permlane32_swap(a0, b0, false, false); auto r1 = __builtin_amdgcn_permlane32_swap(a1, b1, false, false); \
    v4u w = {r0[0], r1[0], r0[1], r1[1]}; OUT = *reinterpret_cast<bf16x8*>(&w); } while (0)
  PK4(p0, 0, pa0); PK4(p0, 8, pa1); PK4(p1, 0, pa2); PK4(p1, 8, pa3);
#undef PK4
}
__device__ __forceinline__ void qkt(f32x16& p0, f32x16& p1, const LAS char* Ks, const LAS bf16x8* qs, int r32, int hi) {
  p0 = f32x16{}; p1 = f32x16{};
#pragma unroll
  for (int d0 = 0; d0 < 8; ++d0) { int cb = (d0 * 16 + hi * 8) * 2;
    bf16x8 b0 = *reinterpret_cast<const LAS bf16x8*>(Ks + KSWZ(r32, cb));
    bf16x8 b1 = *reinterpret_cast<const LAS bf16x8*>(Ks + KSWZ(32 + r32, cb));
    const bf16x8 q = qs[d0 * 64];
    p0 = __builtin_amdgcn_mfma_f32_32x32x16_bf16(b0, q, p0, 0, 0, 0);
    p1 = __builtin_amdgcn_mfma_f32_32x32x16_bf16(b1, q, p1, 0, 0, 0); }
}
__device__ __forceinline__ int v_st(int k, int c) { const int kk = (k & ~0xC) | ((k & 4) << 1) | ((k & 8) >> 1); return ((kk >> 3) * 4 + (c >> 5)) * 512 + ((kk & 7) * 32 + (c & 31)) * 2; }
__device__ __forceinline__ int v_rd_base(int lane) { return ((lane & 3) << 3) | (((lane >> 2) & 3) << 6) | (((lane >> 4) & 1) << 5) | (((lane >> 5) & 1) << 8); }
constexpr int v_rd_off(int d0, int ks, int half) { return d0 * 512 + ks * 4096 + half * 2048; }
template <int OFF> __device__ __forceinline__ s16x4 tr_read(int vb) {
  s16x4 r; asm volatile("ds_read_b64_tr_b16 %0, %1 offset:%2" : "=&v"(r) : "v"(vb), "i"(OFF) : "memory"); return r;
}
template <int D0> __device__ __forceinline__ void pv_one(f32x16& od, int vb, bf16x8 pa0, bf16x8 pa1, bf16x8 pa2, bf16x8 pa3) {
  const s16x4 l0 = tr_read<v_rd_off(D0, 0, 0)>(vb), h0 = tr_read<v_rd_off(D0, 0, 1)>(vb), l1 = tr_read<v_rd_off(D0, 1, 0)>(vb), h1 = tr_read<v_rd_off(D0, 1, 1)>(vb);
  const s16x4 l2 = tr_read<v_rd_off(D0, 2, 0)>(vb), h2 = tr_read<v_rd_off(D0, 2, 1)>(vb), l3 = tr_read<v_rd_off(D0, 3, 0)>(vb), h3 = tr_read<v_rd_off(D0, 3, 1)>(vb);
  asm volatile("s_waitcnt lgkmcnt(0)" ::: "memory"); SBAR();
#define PK(L, H) (bf16x8){L[0], L[1], L[2], L[3], H[0], H[1], H[2], H[3]}
  od = __builtin_amdgcn_mfma_f32_32x32x16_bf16(pa0, PK(l0, h0), od, 0, 0, 0);
  od = __builtin_amdgcn_mfma_f32_32x32x16_bf16(pa1, PK(l1, h1), od, 0, 0, 0);
  od = __builtin_amdgcn_mfma_f32_32x32x16_bf16(pa2, PK(l2, h2), od, 0, 0, 0);
  od = __builtin_amdgcn_mfma_f32_32x32x16_bf16(pa3, PK(l3, h3), od, 0, 0, 0);
#undef PK
}
__device__ __forceinline__ void pv_d0(f32x16* o, int vb, bf16x8 pa0, bf16x8 pa1, bf16x8 pa2, bf16x8 pa3) {
  pv_one<0>(o[0], vb, pa0, pa1, pa2, pa3); pv_one<1>(o[1], vb, pa0, pa1, pa2, pa3); pv_one<2>(o[2], vb, pa0, pa1, pa2, pa3); pv_one<3>(o[3], vb, pa0, pa1, pa2, pa3);
}

template <int MODE>
__device__ __forceinline__ void attn_unit(const GAS bf16* __restrict__ Qb, int ldq, const GAS bf16* __restrict__ Kh, const GAS bf16* __restrict__ Vh, int ldk, GAS bf16* __restrict__ Ob, int ldo,
                                          int NT, int qpos0, float slope2, const GAS unsigned* __restrict__ maskA, const GAS unsigned* __restrict__ blkm, LAS char* lds, const int tid) {
  const int wid = tid >> 6, lane = tid & 63, r32 = lane & 31, hi = lane >> 5;
  LAS char* V_lds = lds; LAS char* K_lds = lds + 2 * SHM_V;
  LAS float* ws = (LAS float*)(lds + 2 * SHM_V + 2 * SHM_K) + wid * 64; LAS float* li_l = ws; LAS float* al_l = ws + 32;
  float m_reg = -1e30f, l_reg = 0; f32x16 o[4] = {};
  LAS bf16x8* qr = (LAS bf16x8*)(lds + SHM_ATTN + wid * 8192) + lane;
  const int qrow = wid * QBLK + r32, qpos = qpos0 + qrow;
  unsigned bmw = 0; if constexpr (MODE == 2) { bmw = blkm[(unsigned)qrow * 6u]; asm volatile("" : "+v"(bmw)); }
  const GAS bf16* Qw = Qb + (unsigned)(qrow * ldq + hi * 8);
#pragma unroll
  for (int d0 = 0; d0 < 8; ++d0) qr[64 * d0] = *reinterpret_cast<const GAS bf16x8*>(Qw + d0 * 16);
  slope2 = __uint_as_float(__builtin_amdgcn_readfirstlane(__float_as_uint(slope2)));
  const float lanec = slope2 * (float)(4 * hi - qpos); const int lanet = qpos - 4 * hi;
  unsigned moff = 0; if constexpr (MODE == 1) moff = (unsigned)qpos * 1024u;
  const int sr = tid >> 4, sc = (tid & 15) * 8, vst0 = v_st(sr, sc), vst1 = v_st(32 + sr, sc);
  const int vb0 = (int)(uintptr_t)V_lds + v_rd_base(lane);
  struct { bf16x8 vs0, vs1, ks0, ks1; } sr_[SDEPTH];
  const unsigned so0 = (unsigned)(sr * ldk + sc) * 2u, so1 = so0 + (unsigned)(32 * ldk) * 2u, tstep_ = (unsigned)(64 * ldk) * 2u;
#define SLOAD(i, k0) do { const unsigned tb_ = (unsigned)((k0) >> 6) * tstep_; \
    sr_[i].vs0 = *reinterpret_cast<const GAS bf16x8*>((const GAS char*)Vh + (tb_ + so0)); sr_[i].vs1 = *reinterpret_cast<const GAS bf16x8*>((const GAS char*)Vh + (tb_ + so1)); \
    sr_[i].ks0 = *reinterpret_cast<const GAS bf16x8*>((const GAS char*)Kh + (tb_ + so0)); sr_[i].ks1 = *reinterpret_cast<const GAS bf16x8*>((const GAS char*)Kh + (tb_ + so1)); } while (0)
#define SWRITE(b, i) do { *(LAS bf16x8*)(V_lds + (b) * SHM_V + vst0) = sr_[i].vs0;          \
    *(LAS bf16x8*)(V_lds + (b) * SHM_V + vst1) = sr_[i].vs1; int kc = sc * 2;               \
    *(LAS bf16x8*)(K_lds + (b) * SHM_K + KSWZ(sr, kc)) = sr_[i].ks0;                       \
    *(LAS bf16x8*)(K_lds + (b) * SHM_K + KSWZ(32 + sr, kc)) = sr_[i].ks1; } while (0)
#define SWAIT() do { if constexpr (SDEPTH == 2) asm volatile("s_waitcnt vmcnt(4)" ::: "memory"); else asm volatile("s_waitcnt vmcnt(0)" ::: "memory"); } while (0)
#define RESC(a) do { if (__any((a) < 1.f)) { if (hi == 0) al_l[r32] = (a); asm volatile("s_waitcnt lgkmcnt(0)" ::: "memory"); \
    _Pragma("unroll") for (int d = 0; d < 4; ++d) _Pragma("unroll") for (int r = 0; r < 16; ++r) o[d][r] *= al_l[crow(r, hi)]; } } while (0)
  v2u mwA = {0u, 0u}, mwB = {0u, 0u};
#define MLOAD(dst, j) do { if constexpr (MODE == 1) dst = *reinterpret_cast<const GAS v2u*>((const GAS char*)maskA + (moff + 8u * (unsigned)(j))); } while (0)
#define PSM(P0, P1, AL, S1, J, MW) partialSM<MODE>(P0, P1, m_reg, AL, S1, J, NT, slope2, lanec, lanet, hi, MW, bmw)
  f32x16 pA0, pA1, pB0, pB1; float alA, alB, s1A, s1B; bf16x8 pa0, pa1, pa2, pa3;
  constexpr int SE = 0, SO = SDEPTH - 1;
  MLOAD(mwA, 0); MLOAD(mwB, 1);
  SLOAD(SE, 0); asm volatile("s_waitcnt vmcnt(0)" ::: "memory"); SWRITE(0, SE); __syncthreads();
  qkt(pA0, pA1, K_lds, qr, r32, hi); PSM(pA0, pA1, alA, s1A, 0, mwA);
  SLOAD(SO, KVBLK); if constexpr (SDEPTH == 2) { if (2 < NT) SLOAD(SE, 2 * KVBLK); }
  SWAIT(); SWRITE(1, SO); __syncthreads();
  for (int j = 1; j + 1 < NT; j += 2) {
    SBAR(); qkt(pB0, pB1, K_lds + SHM_K, qr, r32, hi);
    finishSM(pA0, pA1, s1A, alA, l_reg, pa0, pa1, pa2, pa3); SBAR();
    MLOAD(mwA, j + 1);
    SLOAD(SO, (j + SDEPTH) * KVBLK); SBAR();
    pv_d0(o, vb0, pa0, pa1, pa2, pa3); PSM(pB0, pB1, alB, s1B, j, mwB);
    __syncthreads(); SWAIT(); SWRITE(0, SE);
    RESC(alB); __syncthreads();
    SBAR(); qkt(pA0, pA1, K_lds, qr, r32, hi);
    finishSM(pB0, pB1, s1B, alB, l_reg, pa0, pa1, pa2, pa3); SBAR();
    if (j + 2 < NT) MLOAD(mwB, j + 2);
    if (SDEPTH == 1 || j + 3 < NT) SLOAD(SE, (j + 1 + SDEPTH) * KVBLK); SBAR();
    pv_d0(o, vb0 + (int)SHM_V, pa0, pa1, pa2, pa3); PSM(pA0, pA1, alA, s1A, j + 1, mwA);
    __syncthreads(); SWAIT(); SWRITE(1, SO);
    RESC(alA); __syncthreads();
  }
  SBAR(); qkt(pB0, pB1, K_lds + SHM_K, qr, r32, hi);
  finishSM(pA0, pA1, s1A, alA, l_reg, pa0, pa1, pa2, pa3); SBAR();
  pv_d0(o, vb0, pa0, pa1, pa2, pa3); PSM(pB0, pB1, alB, s1B, NT - 1, mwB);
  __syncthreads(); RESC(alB);
  finishSM(pB0, pB1, s1B, alB, l_reg, pa0, pa1, pa2, pa3); SBAR();
  pv_d0(o, vb0 + (int)SHM_V, pa0, pa1, pa2, pa3);
  if (hi == 0) li_l[r32] = l_reg; asm volatile("s_waitcnt lgkmcnt(0)" ::: "memory");
  float rli[16];
#pragma unroll
  for (int r = 0; r < 16; ++r) rli[r] = __builtin_amdgcn_rcpf(li_l[crow(r, hi)]);
  GAS bf16* Ow = Ob + (unsigned)(wid * QBLK * ldo);
#pragma unroll
  for (int r = 0; r < 16; ++r) { int orow = crow(r, hi);
#pragma unroll
    for (int d0 = 0; d0 < 4; ++d0) Ow[(unsigned)(orow * ldo + d0 * 32 + r32)] = (bf16)f2bf(o[d0][r] * rli[r] * ((DBG_ZERO_BR >> MODE) & 1 ? 0.f : 1.f)); }
  __syncthreads();
#undef SLOAD
#undef SWRITE
#undef SWAIT
#undef RESC
#undef MLOAD
#undef PSM
}
}

constexpr size_t MiB = 1u << 20;
constexpr size_t WS_CTL = 0, CTL_ZERO_BYTES = 1 * MiB;
constexpr size_t WS_INFO = 1 * MiB;
constexpr size_t WS_WA = 2 * MiB, WS_WC1 = 41 * MiB, WS_WC2 = 43 * MiB, WS_WUP = 44 * MiB, WS_WO = 52 * MiB, WS_W13 = 60 * MiB, WS_W2 = 188 * MiB, WS_WMEM = 252 * MiB, WS_WR = 256 * MiB;
constexpr size_t WS_MEMB = 257 * MiB, WS_MKV = 258 * MiB, WS_HB = 259 * MiB, WS_PROJ = 291 * MiB, WS_GATE = 351 * MiB, WS_XG = WS_GATE;
constexpr size_t WS_CQN = 447 * MiB, WS_CKVN = 455 * MiB, WS_KIDX = 459 * MiB, WS_WIDX = 460 * MiB, WS_KMEAN = 461 * MiB, WS_QAI = 462 * MiB, WS_KVA = 490 * MiB;
constexpr size_t WS_MASKA = 514 * MiB, WS_BLKM = 522 * MiB, WS_OATT = 523 * MiB, WS_MERGED = 555 * MiB, WS_PRE = 587 * MiB, WS_Y = WS_PRE, WS_X1 = 651 * MiB, WS_X1B = 715 * MiB;
constexpr size_t WS_ROUTE = 747 * MiB, WS_ROWMAP = 748 * MiB, WS_ROWW = 749 * MiB, WS_HID = 750 * MiB, WS_XF = 774 * MiB, WS_SC = 838 * MiB, WS_END = 968 * MiB;
constexpr int CW_TMO = 0;
constexpr int CW_BAR = 4096;
constexpr int CW_ECNT = 16384;
constexpr int CW_AQ = 20480;
constexpr int LDS_BYTES = 163840;
constexpr int MISC_OFF = LDS_BYTES - 256;

#define XB_TMO      128
#define XB_XCNT(j)  (256  + 64 * (j))
#define XB_XSUB(j)  (1280 + 64 * (j))
#define XB_XGEN(j)  (2304 + 64 * (j))
#define XB_TOP      3328
#define XB_TOPGEN   3392
#define XCD_BAR_WORDS 3456
#define XB_SPIN_CAP (1u << 22)
__device__ __forceinline__ unsigned xb_ld(unsigned* p)              { return __hip_atomic_load(p, __ATOMIC_RELAXED, __HIP_MEMORY_SCOPE_AGENT); }
__device__ __forceinline__ unsigned xb_add(unsigned* p, unsigned v) { return __hip_atomic_fetch_add(p, v, __ATOMIC_RELAXED, __HIP_MEMORY_SCOPE_AGENT); }
__device__ __forceinline__ unsigned xb_xcc_id() { return (unsigned)__builtin_amdgcn_s_getreg((3 << 11) | 20) & 0xFu; }
#define XB_SPIN(cond, bar) do { unsigned _sp = 0; while (cond) { __builtin_amdgcn_s_sleep(1); \
    if ((++_sp & 255u) == 0u) { if (xb_ld(&(bar)[XB_TMO])) break; if (_sp > XB_SPIN_CAP) { atomicAdd(&(bar)[XB_TMO], 1u); break; } } } } while (0)
__device__ __forceinline__ int lane_id() { int l; asm volatile("v_mbcnt_lo_u32_b32 %0, -1, 0\n\tv_mbcnt_hi_u32_b32 %0, -1, %0" : "=v"(l)); return l; }
struct XcdBarrier { unsigned* bar; unsigned x; volatile LAS unsigned* st; unsigned w0; };
__device__ __forceinline__ XcdBarrier xcd_barrier_post(unsigned* bar, volatile LAS unsigned* st, unsigned w0) {
    XcdBarrier b; b.bar = bar; b.x = xb_xcc_id(); b.st = st; b.w0 = w0;
    if (w0 && lane_id() == 0) (void)xb_add(&bar[XB_XCNT(b.x)], 1u);
    return b;
}
__device__ __forceinline__ void xcd_barrier_complete(unsigned* bar, unsigned x, unsigned& nloc, unsigned& nx) {
    const unsigned G = gridDim.x * gridDim.y * gridDim.z;
    unsigned sum, cnt, mine, sp = 0u;
    for (;;) {
        sum = 0u; cnt = 0u; mine = 0u;
#pragma unroll
        for (unsigned j = 0; j < 16; ++j) { const unsigned c = xb_ld(&bar[XB_XCNT(j)]); sum += c; cnt += (c > 0u) ? 1u : 0u; mine = (j == x) ? c : mine; }
        if (sum == G) break;
        __builtin_amdgcn_s_sleep(1);
        if ((++sp & 255u) == 0u) { if (xb_ld(&bar[XB_TMO])) break; if (sp > XB_SPIN_CAP) { atomicAdd(&bar[XB_TMO], 1u); break; } }
    }
    nloc = mine > 0u ? mine : 1u; nx = cnt > 0u ? cnt : 1u;
}
__device__ __forceinline__ void xcd_barrier(const XcdBarrier& b) {
    asm volatile("s_waitcnt vmcnt(0)" ::: "memory");
    __syncthreads();
    if (b.w0 && lane_id() == 0) {
        unsigned* bar = b.bar;
        __builtin_amdgcn_s_waitcnt(0);
        unsigned nloc = b.st[0], nx = b.st[1];
        if (nloc == 0u) { xcd_barrier_complete(bar, b.x, nloc, nx); b.st[0] = nloc; b.st[1] = nx; }
        const unsigned old = xb_add(&bar[XB_XSUB(b.x)], 1u);
        const unsigned gen = old / nloc;
        if (old + 1u == (gen + 1u) * nloc) {
            __builtin_amdgcn_fence(__ATOMIC_RELEASE, "agent");
            asm volatile("s_waitcnt vmcnt(0)" ::: "memory");
            const unsigned og = xb_add(&bar[XB_TOP], 1u);
            const unsigned tg = og / nx;
            if (og + 1u == (tg + 1u) * nx) xb_add(&bar[XB_TOPGEN], 1u);
            else XB_SPIN(xb_ld(&bar[XB_TOPGEN]) == tg, bar);
            __builtin_amdgcn_fence(__ATOMIC_ACQUIRE, "agent");
            xb_add(&bar[XB_XGEN(b.x)], 1u);
            asm volatile("s_waitcnt vmcnt(0)" ::: "memory");
        } else {
            XB_SPIN(xb_ld(&bar[XB_XGEN(b.x)]) == gen, bar);
            __builtin_amdgcn_fence(__ATOMIC_ACQUIRE, "agent");
            asm volatile("s_waitcnt vmcnt(0)" ::: "memory");
        }
    }
    __syncthreads();
}

struct Args { const float* in[28]; float* out; unsigned char* ws; int ph_lo, ph_hi; };
struct Frame {
    LAS unsigned char* lds; volatile LAS unsigned* MISC; gu32* ctl; int* info;
    int tid, lane, wave, G, bid;
    unsigned char* ws; size_t z;
};
enum { I_X = 0, I_MEM, I_WMEMKV, I_WIN, I_GCQ, I_GCKV, I_GKIDX, I_BKIDX, I_WUQ, I_WUQI, I_WUKV, I_WUPA, I_WUPB, I_WUPC, I_WGATE, I_BGATE, I_WO, I_LN1G, I_LN1B,
       I_WGRP, I_BGRP, I_WRT, I_BRT, I_W1, I_W3, I_W2, I_LN2G, I_LN2B };
#define WSP(T_, off) ((T_*)(F.ws + (off)))

template <int NWD>
__device__ __forceinline__ void transpose_item(const float* src, int ldw, bf16* dst, int ldk, LAS float* scr, int lane) {
    constexpr int ST = NWD + 1, KPI = 64 / NWD;
#pragma unroll 8
    for (int i = 0; i < NWD; ++i) { const int kk = KPI * i + lane / NWD; scr[kk * ST + (lane % NWD)] = src[(size_t)kk * ldw + (lane % NWD)]; }
    LDS_WAIT(); asm volatile("" ::: "memory");
    const int c = lane & 7;
#pragma unroll
    for (int j = 0; j < NWD / 8; ++j) { const int n = (lane >> 3) + 8 * j; const LAS float* s = scr + (8 * c) * ST + n;
        v4u o; o.x = pk2(s[0 * ST], s[1 * ST]); o.y = pk2(s[2 * ST], s[3 * ST]); o.z = pk2(s[4 * ST], s[5 * ST]); o.w = pk2(s[6 * ST], s[7 * ST]);
        *(GAS v4u*)(dst + (size_t)n * ldk + 8 * c) = o; }
    LDS_WAIT(); asm volatile("" ::: "memory");
}
__device__ __forceinline__ void conv_layer(Frame& F, const Args& a, int l) {
    LAS float* scr = (LAS float*)(F.lds + F.wave * 16384);
    const int gw = F.bid * 8 + F.wave, NGW = F.G * 8, lane = F.lane;
    bf16* WA = WSP(bf16, WS_WA); bf16* WC1 = WSP(bf16, WS_WC1); bf16* WC2 = WSP(bf16, WS_WC2); bf16* WUP = WSP(bf16, WS_WUP); bf16* WO = WSP(bf16, WS_WO);
    bf16* W13 = WSP(bf16, WS_W13); bf16* W2T = WSP(bf16, WS_W2); float* WR = WSP(float, WS_WR);
    const float* w_in = (a.in[I_WIN] + F.z) + (size_t)l * 2048 * 3664; const float* w_gate = (a.in[I_WGATE] + F.z) + (size_t)l * 2048 * 6144;
    const float* w_uq = (a.in[I_WUQ] + F.z) + (size_t)l * 512 * 768; const float* w_uqi = (a.in[I_WUQI] + F.z) + (size_t)l * 512 * 1024; const float* w_ukv = (a.in[I_WUKV] + F.z) + (size_t)l * 256 * 1536;
    const float* w_upa = (a.in[I_WUPA] + F.z) + (size_t)l * 768 * 2048; const float* w_upb = (a.in[I_WUPB] + F.z) + (size_t)l * 768 * 2048; const float* w_upc = (a.in[I_WUPC] + F.z) + (size_t)l * 512 * 2048;
    const float* w_o = (a.in[I_WO] + F.z) + (size_t)l * 2048 * 2048;
    const float* w1 = (a.in[I_W1] + F.z) + (size_t)l * 32 * 2048 * 512; const float* w3 = (a.in[I_W3] + F.z) + (size_t)l * 32 * 2048 * 512; const float* w2 = (a.in[I_W2] + F.z) + (size_t)l * 32 * 512 * 2048;
    const float* w_grp = (a.in[I_WGRP] + F.z) + (size_t)l * 2048 * 4; const float* w_rt = (a.in[I_WRT] + F.z) + (size_t)l * 2048 * 32;
    constexpr int N_IN = 32 * 229, N_PAD = 176, N_GATE = 32 * 192, N_UQ = 8 * 24, N_UQI = 8 * 32, N_UKV = 4 * 48, N_UPA = 12 * 64, N_UPC = 8 * 64, N_O = 32 * 64, N_E = 32 * 512, N_R = 1536;
    constexpr int TOTAL = N_IN + N_PAD + N_GATE + N_UQ + N_UQI + N_UKV + 2 * N_UPA + N_UPC + N_O + 3 * N_E + N_R;
    for (int it = gw; it < TOTAL; it += NGW) {
        int r = it;
        if (r < N_IN) { const int kb = r / 229, nb = r % 229, n0 = 16 * nb, k0 = 64 * kb, dr = n0 < 848 ? n0 : n0 + 176;
            transpose_item<16>(w_in + (size_t)k0 * 3664 + n0, 3664, WA + (size_t)dr * 2048 + k0, 2048, scr, lane); continue; } r -= N_IN;
        if (r < N_PAD) { GAS v4u* p = (GAS v4u*)(WA + (size_t)(848 + r) * 2048) + lane * 4; const v4u z = {0u, 0u, 0u, 0u}; p[0] = z; p[1] = z; p[2] = z; p[3] = z; continue; } r -= N_PAD;
        if (r < N_GATE) { const int kb = r / 192, nb = r % 192, n0 = 32 * nb, k0 = 64 * kb;
            transpose_item<32>(w_gate + (size_t)k0 * 6144 + n0, 6144, WA + (size_t)(3840 + n0) * 2048 + k0, 2048, scr, lane); continue; } r -= N_GATE;
        if (r < N_UQ) { const int kb = r / 24, nb = r % 24, n0 = 32 * nb, k0 = 64 * kb;
            transpose_item<32>(w_uq + (size_t)k0 * 768 + n0, 768, WC1 + (size_t)n0 * 512 + k0, 512, scr, lane); continue; } r -= N_UQ;
        if (r < N_UQI) { const int kb = r / 32, nb = r % 32, n0 = 32 * nb, k0 = 64 * kb;
            transpose_item<32>(w_uqi + (size_t)k0 * 1024 + n0, 1024, WC1 + (size_t)(768 + n0) * 512 + k0, 512, scr, lane); continue; } r -= N_UQI;
        if (r < N_UKV) { const int kb = r / 48, nb = r % 48, n0 = 32 * nb, k0 = 64 * kb;
            transpose_item<32>(w_ukv + (size_t)k0 * 1536 + n0, 1536, WC2 + (size_t)n0 * 256 + k0, 256, scr, lane); continue; } r -= N_UKV;
        if (r < N_UPA) { const int kb = r / 64, nb = r % 64, n0 = 32 * nb, k0 = 64 * kb;
            transpose_item<32>(w_upa + (size_t)k0 * 2048 + n0, 2048, WUP + (size_t)n0 * 2048 + k0, 2048, scr, lane); continue; } r -= N_UPA;
        if (r < N_UPA) { const int kb = r / 64, nb = r % 64, n0 = 32 * nb, k0 = 64 * kb;
            transpose_item<32>(w_upb + (size_t)k0 * 2048 + n0, 2048, WUP + (size_t)n0 * 2048 + 768 + k0, 2048, scr, lane); continue; } r -= N_UPA;
        if (r < N_UPC) { const int kb = r / 64, nb = r % 64, n0 = 32 * nb, k0 = 64 * kb;
            transpose_item<32>(w_upc + (size_t)k0 * 2048 + n0, 2048, WUP + (size_t)n0 * 2048 + 1536 + k0, 2048, scr, lane); continue; } r -= N_UPC;
        if (r < N_O) { const int kb = r / 64, nb = r % 64, n0 = 32 * nb, k0 = 64 * kb;
            transpose_item<32>(w_o + (size_t)k0 * 2048 + n0, 2048, WO + (size_t)n0 * 2048 + k0, 2048, scr, lane); continue; } r -= N_O;
        if (r < 2 * N_E) { const int which = r / N_E; r -= which * N_E; const int e = r / 512, q = r % 512, kb = q / 16, nb = q % 16, n0 = 32 * nb, k0 = 64 * kb;
            const float* src = (which ? w3 : w1) + (size_t)e * 2048 * 512 + (size_t)k0 * 512 + n0;
            const int dr = e * 1024 + (n0 >> 7) * 256 + (n0 & 127) + which * 128;
            transpose_item<32>(src, 512, W13 + (size_t)dr * 2048 + k0, 2048, scr, lane); continue; } r -= 2 * N_E;
        if (r < N_E) { const int e = r / 512, q = r % 512, kb = q / 64, nb = q % 64, n0 = 32 * nb, k0 = 64 * kb;
            transpose_item<32>(w2 + (size_t)e * 512 * 2048 + (size_t)k0 * 2048 + n0, 2048, W2T + (size_t)(e * 2048 + n0) * 512 + k0, 512, scr, lane); continue; } r -= N_E;
        { const int idx = r * 64 + lane, k = idx / 48, c = idx % 48; WR[idx] = c < 32 ? w_rt[k * 32 + c] : (c < 36 ? w_grp[k * 4 + (c - 32)] : 0.f); }
    }
}
__device__ __forceinline__ void prologue(Frame& F, const Args& a) {
    LAS float* scr = (LAS float*)(F.lds + F.wave * 16384);
    const int gw = F.bid * 8 + F.wave, NGW = F.G * 8, lane = F.lane;
    bf16* HB = WSP(bf16, WS_HB); bf16* MEMB = WSP(bf16, WS_MEMB); bf16* WMEM = WSP(bf16, WS_WMEM);
    const float* x = (a.in[I_X] + F.z); const float* mem = (a.in[I_MEM] + F.z); const float* wm = (a.in[I_WMEMKV] + F.z);
    const long NX8 = (long)T * DM / 8, NM8 = 256L * DM / 8;
    for (long i = (long)gw * 64 + lane; i < NX8 + NM8; i += (long)NGW * 64) {
        const bool inx = i < NX8; const long j = inx ? i : i - NX8; const float* s = (inx ? x : mem) + j * 8;
        f32x4 v0 = *(const GAS f32x4*)s, v1 = *(const GAS f32x4*)(s + 4);
#ifdef DBG_NOISE
        if (inx) {
#pragma unroll
            for (int q = 0; q < 4; ++q) { unsigned hh = (unsigned)(j * 8 + q) * 2654435761u; hh ^= hh >> 15; hh *= 2246822519u; hh ^= hh >> 13;
                v0[q] *= 1.f + DBG_NOISE * ((float)(hh & 0xffff) * (1.f / 65536.f) - 0.5f); v1[q] *= 1.f + DBG_NOISE * ((float)(hh >> 16) * (1.f / 65536.f) - 0.5f); } }
#endif
        v4u o; o.x = pk2(v0[0], v0[1]); o.y = pk2(v0[2], v0[3]); o.z = pk2(v1[0], v1[1]); o.w = pk2(v1[2], v1[3]);
        *(GAS v4u*)((inx ? HB : MEMB) + j * 8) = o;
    }
    for (int it = gw; it < 32 * 32; it += NGW) { const int kb = it / 32, nb = it % 32, n0 = 32 * nb, k0 = 64 * kb;
        transpose_item<32>(wm + (size_t)k0 * 1024 + n0, 1024, WMEM + (size_t)n0 * 2048 + k0, 2048, scr, lane); }
}

__device__ __forceinline__ void phase_norms(Frame& F, const Args& a, int l) {
    const int gw = F.bid * 8 + F.wave, NGW = F.G * 8, lane = F.lane;
    const bf16* PROJ = WSP(bf16, WS_PROJ); bf16* CQN = WSP(bf16, WS_CQN); bf16* CKVN = WSP(bf16, WS_CKVN); bf16* KIDX = WSP(bf16, WS_KIDX); float* WIDX = WSP(float, WS_WIDX); float* KMEAN = WSP(float, WS_KMEAN);
    const float* gcq = (a.in[I_GCQ] + F.z) + l * 512; const float* gckv = (a.in[I_GCKV] + F.z) + l * 256; const float* gk = (a.in[I_GKIDX] + F.z) + l * 64; const float* bk = (a.in[I_BKIDX] + F.z) + l * 64;
    for (int t = gw; t < T; t += NGW) {
        const bf16* row = PROJ + (size_t)t * NPROJ;
        { const v4u w = *(const GAS v4u*)(row + 8 * lane); float v[8] = {bflo(w.x), bfhi(w.x), bflo(w.y), bfhi(w.y), bflo(w.z), bfhi(w.z), bflo(w.w), bfhi(w.w)};
          float ss = 0.f;
#pragma unroll
          for (int j = 0; j < 8; ++j) ss += v[j] * v[j];
          const float rs = 1.0f / sqrtf(wave_sum(ss) * (1.f / 512.f) + LN_EPS);
          const f32x4 g0 = *(const GAS f32x4*)(gcq + 8 * lane), g1 = *(const GAS f32x4*)(gcq + 8 * lane + 4);
          v4u o; o.x = pk2(v[0] * rs * g0[0], v[1] * rs * g0[1]); o.y = pk2(v[2] * rs * g0[2], v[3] * rs * g0[3]); o.z = pk2(v[4] * rs * g1[0], v[5] * rs * g1[1]); o.w = pk2(v[6] * rs * g1[2], v[7] * rs * g1[3]);
          *(GAS v4u*)(CQN + (size_t)t * 512 + 8 * lane) = o; }
        { const v2u w = *(const GAS v2u*)(row + 512 + 4 * lane); float v[4] = {bflo(w.x), bfhi(w.x), bflo(w.y), bfhi(w.y)};
          float ss = (v[0] * v[0] + v[1] * v[1]) + (v[2] * v[2] + v[3] * v[3]);
          const float rs = 1.0f / sqrtf(wave_sum(ss) * (1.f / 256.f) + LN_EPS);
          const f32x4 g0 = *(const GAS f32x4*)(gckv + 4 * lane);
          v2u o; o.x = pk2(v[0] * rs * g0[0], v[1] * rs * g0[1]); o.y = pk2(v[2] * rs * g0[2], v[3] * rs * g0[3]);
          *(GAS v2u*)(CKVN + (size_t)t * 256 + 4 * lane) = o; }
        { const float v = bf2f(row[768 + lane]); const float mu = wave_sum(v) * (1.f / 64.f); const float d = v - mu; const float var = wave_sum(d * d) * (1.f / 64.f);
          KIDX[(size_t)t * 64 + lane] = (bf16)f2bf(d * (1.0f / sqrtf(var + LN_EPS)) * gk[lane] + bk[lane]); }
        if (lane < 16) WIDX[(size_t)t * 16 + lane] = bf2f(row[832 + lane]) * 0.25f;
    }
    for (int task = gw; task < 32 * 6; task += NGW) {
        const int n = task / 6, g = task % 6, rsub = lane >> 4, co = lane & 15;
        float s[8] = {0, 0, 0, 0, 0, 0, 0, 0};
#pragma unroll 16
        for (int i = 0; i < 64; ++i) { const v4u w = *(const GAS v4u*)(PROJ + (size_t)(n * 256 + 4 * i + rsub) * NPROJ + PJ_KB + g * 128 + 8 * co);
            s[0] += bflo(w.x); s[1] += bfhi(w.x); s[2] += bflo(w.y); s[3] += bfhi(w.y); s[4] += bflo(w.z); s[5] += bfhi(w.z); s[6] += bflo(w.w); s[7] += bfhi(w.w); }
#pragma unroll
        for (int j = 0; j < 8; ++j) { s[j] += __shfl_xor(s[j], 16); s[j] += __shfl_xor(s[j], 32); }
        if (rsub == 0) {
#pragma unroll
            for (int j = 0; j < 8; ++j) KMEAN[(size_t)n * 768 + g * 128 + 8 * co + j] = s[j] * (1.f / 256.f); }
    }
}

__device__ __forceinline__ void indexer_item(Frame& F, int item) {
    int tid = F.tid; asm volatile("" : "+v"(tid));
    const int lane = tid & 63, w = F.wave, hi = lane >> 5, kl = lane & 31;
    const bf16* QAI = WSP(bf16, WS_QAI); const bf16* KIDX = WSP(bf16, WS_KIDX); const float* WIDX = WSP(float, WS_WIDX); unsigned* MASKA = WSP(unsigned, WS_MASKA);
    const int t0 = item * 16, myq = t0 + 2 * w + hi;
    const GAS char* SCb = (const GAS char*)WSP(float, WS_SC); unsigned scoff; { const unsigned b_ = myq >> 6, r_ = myq & 63; scoff = (2048u * b_ * (b_ + 1u) + 64u * r_ * (b_ + 1u)) * 4u; }
    LAS unsigned char* reg = F.lds + (2 * w) * 8192;
    LAS unsigned char* myreg = reg + hi * 8192;
    LAS unsigned char* KST = F.lds + 131072;
    bf16x8 af[4];
    { const int rho = kl, qsel = (rho >> 2) & 1, head = (rho & 3) + 4 * (rho >> 3);
      const bf16* src = QAI + (size_t)(t0 + 2 * w + qsel) * NQAI + 768 + head * 64 + 8 * hi;
#pragma unroll
      for (int c = 0; c < 4; ++c) af[c] = *(const GAS bf16x8*)(src + 16 * c); }
    float wv[16];
    { const GAS f32x4* wp = (const GAS f32x4*)(WIDX + (size_t)myq * 16);
#pragma unroll
      for (int j = 0; j < 4; ++j) { const f32x4 v = wp[j]; wv[4 * j] = v[0]; wv[4 * j + 1] = v[1]; wv[4 * j + 2] = v[2]; wv[4 * j + 3] = v[3]; } }
    const int nch = (t0 + 16 + 63) >> 6;
    const int skey = tid >> 3, sch = tid & 7;
    const int sdst = skey * 128 + ((sch ^ ((skey >> 1) & 7)) << 4);
    int bstar = 0, nab = 0; bool allq = false;
#ifndef DBG_IDX_DUMMY
#define DBG_IDX_DUMMY 0
#endif
    {
        { const v4u z = {0u, 0u, 0u, 0u};
#pragma unroll
          for (int i = 0; i < 16; ++i) *(LAS v4u*)(reg + (i * 64 + lane) * 16) = z; }
        const GAS char* kgb = (const GAS char*)KIDX; const unsigned kgo = (unsigned)(skey * 64 + sch * 8) * 2u;
#define KG(c) (*(const GAS v4u*)(kgb + (kgo + (unsigned)(c) * 8192u)))
        v4u R0 = {0u, 0u, 0u, 0u}, R1 = R0;
        { const v4u k0 = KG(0); R1 = KG(1 < nch ? 1 : nch - 1); R0 = KG(2 < nch ? 2 : nch - 1); *(LAS v4u*)(KST + sdst) = k0; }
        __syncthreads();
        int fo[4];
#pragma unroll
        for (int c = 0; c < 4; ++c) fo[c] = kl * 128 + (((2 * c + hi) ^ ((kl >> 1) & 7)) << 4);
        f32x16 AC[2][2];
#define IDX_POST(P, MM) do { \
            _Pragma("unroll") for (int tile = 0; tile < 2; ++tile) { float ps[4] = {0.f, 0.f, 0.f, 0.f}; \
                _Pragma("unroll") for (int r = 0; r < 16; ++r) { const float av = AC[P][tile][r]; const int xi = __float_as_int(av); const float rl = __int_as_float(xi > 0 ? xi : 0); \
                    ps[r & 3] = fmaf(rl, wv[r], ps[r & 3]); } \
                const float score = (ps[0] + ps[1]) + (ps[2] + ps[3]); \
                const int row = 32 * tile + kl; const int key = 64 * (MM) + row; const bool valid = key <= myq; \
                const unsigned bits = __float_as_uint(score); const unsigned u = bits ^ ((unsigned)((int)bits >> 31) | 0x80000000u); const int bin = (int)(u >> 20); \
                *(GAS float*)(SCb + (scoff + 4u * (unsigned)key)) = score; \
                if (valid) __hip_atomic_fetch_add((LAS unsigned*)(myreg + ((bin >> 1) << 2)), 1u << ((bin & 1) << 4), __ATOMIC_RELAXED, __HIP_MEMORY_SCOPE_WORKGROUP); \
            } } while (0)
#define IDX_STEP(J, RW) do { const int mm_ = m + (J); if (mm_ < nch) { \
            const LAS unsigned char* kb_ = KST + ((J) & 1) * 8192; bf16x8 FR[2][4]; \
            _Pragma("unroll") for (int tile = 0; tile < 2; ++tile) _Pragma("unroll") for (int c = 0; c < 4; ++c) FR[tile][c] = *(const LAS bf16x8*)(kb_ + fo[c] + tile * 4096); \
            asm volatile("s_waitcnt lgkmcnt(0)" ::: "memory"); SBAR(); \
            AC[(J) & 1][0] = __builtin_amdgcn_mfma_f32_32x32x16_bf16(af[0], FR[0][0], f32x16{}, 0, 0, 0); AC[(J) & 1][1] = __builtin_amdgcn_mfma_f32_32x32x16_bf16(af[0], FR[1][0], f32x16{}, 0, 0, 0); \
            _Pragma("unroll") for (int c = 1; c < 4; ++c) { AC[(J) & 1][0] = __builtin_amdgcn_mfma_f32_32x32x16_bf16(af[c], FR[0][c], AC[(J) & 1][0], 0, 0, 0); \
                AC[(J) & 1][1] = __builtin_amdgcn_mfma_f32_32x32x16_bf16(af[c], FR[1][c], AC[(J) & 1][1], 0, 0, 0); } \
            SBAR(); \
            if (mm_ >= 1) IDX_POST(((J) + 1) & 1, mm_ - 1); \
            if (mm_ + 1 < nch) *(LAS v4u*)(KST + (((J) + 1) & 1) * 8192 + sdst) = RW; \
            RW = KG(mm_ + 3 < nch ? mm_ + 3 : nch - 1); \
            __syncthreads(); } } while (0)
        for (int m = 0; m < nch; m += 2) { IDX_STEP(0, R1); IDX_STEP(1, R0); }
        if ((nch - 1) & 1) IDX_POST(1, nch - 1); else IDX_POST(0, nch - 1);
#undef IDX_POST
#undef IDX_STEP
#undef KG
        {
            int bsq[2], nbq[2]; bool alq[2];
#pragma unroll
            for (int q = 0; q < 2; ++q) {
                const LAS unsigned* hw = (const LAS unsigned*)(reg + q * 8192) + 32 * lane;
                unsigned wd[32]; unsigned s = 0;
#pragma unroll
                for (int i = 0; i < 8; ++i) { const v4u v = *(const LAS v4u*)(hw + 4 * i); wd[4 * i] = v.x; wd[4 * i + 1] = v.y; wd[4 * i + 2] = v.z; wd[4 * i + 3] = v.w; }
#pragma unroll
                for (int i = 0; i < 32; ++i) s += (wd[i] & 0xffffu) + (wd[i] >> 16);
                unsigned v = s;
#pragma unroll
                for (int off = 1; off < 64; off <<= 1) { const unsigned tt = __shfl_down(v, off); if (lane + off < 64) v += tt; }
                const unsigned sufx = v - s; const unsigned total = __builtin_amdgcn_readfirstlane(v);
                int nbel = 0; int fn = (int)sufx; int cum = (int)sufx;
#pragma unroll
                for (int i = 31; i >= 0; --i) {
                    cum += (int)(wd[i] >> 16);     { const int mk = (cum - 256) >> 31; nbel -= mk; const int cm = cum & mk; fn = cm > fn ? cm : fn; }
                    cum += (int)(wd[i] & 0xffffu); { const int mk = (cum - 256) >> 31; nbel -= mk; const int cm = cum & mk; fn = cm > fn ? cm : fn; }
                }
                const int fb = 64 * lane + 63 - nbel;
                const unsigned long long bm = __ballot(sufx < 256u && v >= 256u);
                const int lstar = bm ? (int)__builtin_ctzll(bm) : 0;
                bsq[q] = __builtin_amdgcn_readlane(fb, lstar); nbq[q] = __builtin_amdgcn_readlane(fn, lstar); alq[q] = total <= 256u;
            }
            bstar = hi ? bsq[1] : bsq[0]; nab = hi ? nbq[1] : nbq[0]; allq = hi ? alq[1] : alq[0];
        }
        { const v4u z = {0u, 0u, 0u, 0u};
#pragma unroll
          for (int i = 0; i < 16; ++i) *(LAS v4u*)(reg + (i * 64 + lane) * 16) = z; }
        asm volatile("s_waitcnt vmcnt(0)" ::: "memory");
        { const int ntile = 2 * nch;
          for (int t8 = 0; t8 < ntile; t8 += 8) {
              float sv[8];
#pragma unroll
              for (int j = 0; j < 8; ++j) sv[j] = __builtin_nontemporal_load((const GAS float*)(SCb + (scoff + 4u * (unsigned)(32 * (t8 + j < ntile ? t8 + j : ntile - 1) + kl))));
#pragma unroll
              for (int j = 0; j < 8; ++j) if (t8 + j < ntile) {
                  const int key = 32 * (t8 + j) + kl; const bool valid = key <= myq; const float score = sv[j];
                  const unsigned bits = __float_as_uint(score); const unsigned u = bits ^ ((unsigned)((int)bits >> 31) | 0x80000000u); const int bin = (int)(u >> 20);
                  const bool above = valid && (allq || bin > bstar), cand = valid && !allq && bin == bstar;
                  const unsigned long long bal = __ballot(above);
                  if (kl == 0) *(LAS unsigned*)(myreg + 6144 + (t8 + j) * 4) = hi ? (unsigned)(bal >> 32) : (unsigned)bal;
                  if (__any(cand)) { if (cand) { const unsigned slot = __hip_atomic_fetch_add((LAS unsigned*)(myreg + 7168), 1u, __ATOMIC_RELAXED, __HIP_MEMORY_SCOPE_WORKGROUP);
                      if (slot < 768u) { v2u e; e.x = u; e.y = (unsigned)key; *(LAS v2u*)(myreg + slot * 8) = e; } } }
              } } }
        {
#pragma unroll
            for (int q = 0; q < 2; ++q) {
                LAS unsigned char* rq = reg + q * 8192;
                const int nbq_ = __builtin_amdgcn_readlane(nab, q * 32); const bool alq_ = __builtin_amdgcn_readlane((int)allq, q * 32) != 0;
                unsigned nc = *(LAS unsigned*)(rq + 7168); nc = nc > 768u ? 768u : nc; nc = __builtin_amdgcn_readfirstlane(nc);
                const int need = 256 - nbq_;
                if (!alq_ && nc > 0u) {
                    for (unsigned i0 = 0; i0 < nc; i0 += 64) { const unsigned i = i0 + lane; const bool act = i < nc;
                        v2u me = {0u, 0u}; if (act) me = *(LAS v2u*)(rq + i * 8);
                        int rank = 0;
                        unsigned j = 0;
                        for (; j + 4 <= nc; j += 4) { const v2u o0 = *(LAS v2u*)(rq + j * 8), o1 = *(LAS v2u*)(rq + j * 8 + 8), o2 = *(LAS v2u*)(rq + j * 8 + 16), o3 = *(LAS v2u*)(rq + j * 8 + 24);
                            rank += ((o0.x > me.x || (o0.x == me.x && o0.y < me.y)) ? 1 : 0) + ((o1.x > me.x || (o1.x == me.x && o1.y < me.y)) ? 1 : 0)
                                  + ((o2.x > me.x || (o2.x == me.x && o2.y < me.y)) ? 1 : 0) + ((o3.x > me.x || (o3.x == me.x && o3.y < me.y)) ? 1 : 0); }
                        for (; j < nc; ++j) { const v2u o = *(LAS v2u*)(rq + j * 8); rank += (o.x > me.x || (o.x == me.x && o.y < me.y)) ? 1 : 0; }
                        if (act && rank < need) __hip_atomic_fetch_or((LAS unsigned*)(rq + 6144 + ((me.y >> 5) << 2)), 1u << (me.y & 31u), __ATOMIC_RELAXED, __HIP_MEMORY_SCOPE_WORKGROUP);
                    }
                }
                LDS_WAIT();
                const v4u mrow = *(LAS v4u*)(rq + 6144 + lane * 16);
                *(GAS v4u*)(MASKA + (size_t)(t0 + 2 * w + q) * 256 + 4 * lane) = mrow;
            }
        }
    }
    __syncthreads();
}
__device__ __forceinline__ void phase_indexer(Frame& F) {
    for (int p = F.bid; p < 256; p += F.G) { indexer_item(F, 511 - p); indexer_item(F, p); }
}

__device__ __forceinline__ void phase_moba_gate(Frame& F) {
    const int gw = F.bid * 8 + F.wave, NGW = F.G * 8, lane = F.lane, n = lane & 31, half = lane >> 5;
    const bf16* PROJ = WSP(bf16, WS_PROJ); const float* KMEAN = WSP(float, WS_KMEAN); unsigned* BLKM = WSP(unsigned, WS_BLKM);
    for (int t = gw; t < T; t += NGW) {
        const int c = t >> 8;
        for (int h = 0; h < 6; ++h) {
            unsigned mask = 1u << c;
            if (c > 0) {
                const bf16* q = PROJ + (size_t)t * NPROJ + PJ_QB + h * 128 + 64 * half; const float* km = KMEAN + (size_t)n * 768 + h * 128 + 64 * half;
                float g = 0.f;
#pragma unroll
                for (int i = 0; i < 8; ++i) { const v4u qw = *(const GAS v4u*)(q + 8 * i); const f32x4 k0 = *(const GAS f32x4*)(km + 8 * i), k1 = *(const GAS f32x4*)(km + 8 * i + 4);
                    g += bflo(qw.x) * k0[0] + bfhi(qw.x) * k0[1] + bflo(qw.y) * k0[2] + bfhi(qw.y) * k0[3] + bflo(qw.z) * k1[0] + bfhi(qw.z) * k1[1] + bflo(qw.w) * k1[2] + bfhi(qw.w) * k1[3]; }
                g += __shfl_xor(g, 32);
                float val = (n < c) ? g : -__builtin_inff();
                for (int rnd = 0; rnd < 3; ++rnd) {
                    float mx = val;
#pragma unroll
                    for (int o = 1; o < 32; o <<= 1) mx = fmaxf(mx, __shfl_xor(mx, o));
                    if (!(mx > -__builtin_inff())) break;
                    const unsigned long long bm = __ballot(val == mx) & 0xffffffffull;
                    const int idx = (int)__builtin_ctzll(bm);
                    mask |= 1u << idx; if (n == idx) val = -__builtin_inff();
                }
            }
            if (lane == 0) BLKM[(size_t)t * 6 + h] = mask;
        }
    }
}

__device__ __forceinline__ void phase_attention(Frame& F, int l, int rep) {
    const GAS bf16* PROJ = (const GAS bf16*)WSP(bf16, WS_PROJ); const GAS bf16* QAI = (const GAS bf16*)WSP(bf16, WS_QAI); const GAS bf16* KVA = (const GAS bf16*)WSP(bf16, WS_KVA); const GAS bf16* MKV = (const GAS bf16*)WSP(bf16, WS_MKV);
    GAS bf16* OATT = (GAS bf16*)WSP(bf16, WS_OATT); const GAS unsigned* MASKA = (const GAS unsigned*)WSP(unsigned, WS_MASKA); const GAS unsigned* BLKM = (const GAS unsigned*)WSP(unsigned, WS_BLKM);
    gu32* head = F.ctl + CW_AQ + 64 * l + 32 * rep;
    for (;;) {
        if (F.tid == 0) F.MISC[16] = __hip_atomic_fetch_add(head, 1u, RLX_AGENT);
        __syncthreads();
        const int i = __builtin_amdgcn_readfirstlane((int)F.MISC[16]);
        __syncthreads();
        if (i >= 512) break;
        int mode, h, qb;
        if (i < 384) { qb = 31 - i / 12; const int k = i % 12; mode = k < 6 ? 1 : 2; h = k < 6 ? k : k - 6; } else { const int m = i - 384; mode = 0; h = m & 3; qb = m >> 2; }
        const int qpos0 = qb * 256;
        int tl = F.tid; asm volatile("" : "+v"(tl));
#ifndef ATT_MODES
#define ATT_MODES 7
#endif
        if ((ATT_MODES & 2) && mode == 1) { const float sl = exp2f(-8.f * (float)(2 * h + 1) / 12.f) * LOG2E;
            att::attn_unit<1>(QAI + (size_t)qpos0 * NQAI + h * 128, NQAI, KVA + h * 128, KVA + 768 + h * 128, NKVA, OATT + (size_t)qpos0 * 2048 + h * 128, 2048, 4 * (qb + 1), qpos0, sl, MASKA, nullptr, (LAS char*)F.lds, tl); }
        else if ((ATT_MODES & 4) && mode == 2) { const float sl = exp2f(-8.f * (float)(2 * h + 2) / 12.f) * LOG2E;
            att::attn_unit<2>(PROJ + (size_t)qpos0 * NPROJ + PJ_QB + h * 128, NPROJ, PROJ + PJ_KB + h * 128, PROJ + PJ_VB + h * 128, NPROJ, OATT + (size_t)qpos0 * 2048 + 768 + h * 128, 2048, 4 * (qb + 1), qpos0, sl, nullptr, BLKM + (size_t)qpos0 * 6 + h, (LAS char*)F.lds, tl); }
        else if (ATT_MODES & 1) { att::attn_unit<0>(PROJ + (size_t)qpos0 * NPROJ + PJ_QC + h * 128, NPROJ, MKV + h * 128, MKV + 512 + h * 128, 1024, OATT + (size_t)qpos0 * 2048 + 1536 + h * 128, 2048, 4, qpos0, 0.f, nullptr, nullptr, (LAS char*)F.lds, tl); }
    }
}

__device__ __forceinline__ void phase_ln1_router(Frame& F, const Args& a, int l, int rep) {
    const int lane = F.lane, w = F.wave, tid = F.tid;
    const float* PRE = WSP(float, WS_PRE); float* X1 = WSP(float, WS_X1); bf16* X1B = WSP(bf16, WS_X1B); const float* WR = WSP(float, WS_WR); int* ROUTE = WSP(int, WS_ROUTE);
    const float* g1 = (a.in[I_LN1G] + F.z) + l * 2048; const float* b1 = (a.in[I_LN1B] + F.z) + l * 2048; const float* bgrp = (a.in[I_BGRP] + F.z) + l * 4; const float* brt = (a.in[I_BRT] + F.z) + l * 32;
    gu32* ecnt = F.ctl + CW_ECNT + 64 * l;
    constexpr int XS = 2052;
    LAS float* xt = (LAS float*)F.lds; LAS float* part = (LAS float*)(F.lds + 16 * XS * 4); LAS float* lg = part + 8 * 16 * 48;
    for (int it = F.bid; it < T / 16; it += F.G) {
        const int t0 = it * 16;
#pragma unroll
        for (int i = 0; i < 2; ++i) {
            const int rl = 2 * w + i, t = t0 + rl;
            const GAS f32x4* xr = (const GAS f32x4*)(PRE + (size_t)t * 2048) + lane;
            f32x4 v[8]; float s = 0.f;
#pragma unroll
            for (int j = 0; j < 8; ++j) { v[j] = xr[64 * j]; s += (v[j].x + v[j].y) + (v[j].z + v[j].w); }
            const float mean = wave_sum(s) * (1.f / 2048.f); float s2 = 0.f;
#pragma unroll
            for (int j = 0; j < 8; ++j) { v[j] = v[j] - mean; s2 += (v[j].x * v[j].x + v[j].y * v[j].y) + (v[j].z * v[j].z + v[j].w * v[j].w); }
            const float rstd = 1.f / sqrtf(wave_sum(s2) * (1.f / 2048.f) + LN_EPS);
#pragma unroll
            for (int j = 0; j < 8; ++j) { const int col = 4 * lane + 256 * j; const f32x4 g = *(const GAS f32x4*)(g1 + col), b = *(const GAS f32x4*)(b1 + col);
                const f32x4 o = v[j] * rstd * g + b;
                *(GAS f32x4*)(X1 + (size_t)t * 2048 + col) = o; v2u ob; ob.x = pk2(o[0], o[1]); ob.y = pk2(o[2], o[3]); *(GAS v2u*)(X1B + (size_t)t * 2048 + col) = ob;
                *(LAS f32x4*)(xt + rl * XS + col) = o; }
        }
        __syncthreads();
        { f32x4 acc[3] = {{0, 0, 0, 0}, {0, 0, 0, 0}, {0, 0, 0, 0}};
          const int ar = lane & 15, kq = lane >> 4;
#pragma unroll 16
          for (int s = 0; s < 64; ++s) { const int k = 256 * w + 4 * s + kq; const float av = xt[ar * XS + k]; const float* wr = WR + (size_t)k * 48 + ar;
#pragma unroll
              for (int c = 0; c < 3; ++c) acc[c] = __builtin_amdgcn_mfma_f32_16x16x4f32(av, wr[16 * c], acc[c], 0, 0, 0); }
#pragma unroll
          for (int c = 0; c < 3; ++c)
#pragma unroll
              for (int r = 0; r < 4; ++r) part[(w * 16 + 4 * kq + r) * 48 + 16 * c + ar] = acc[c][r]; }
        __syncthreads();
        for (int e = tid; e < 16 * 48; e += 512) { float s = 0.f;
#pragma unroll
            for (int ww = 0; ww < 8; ++ww) s += part[ww * 16 * 48 + e]; lg[e] = s; }
        __syncthreads();
        if (tid < 16 && rep == 0) {
            const int t = t0 + tid; const LAS float* L = lg + tid * 48;
            float gl[4]; int gs = 0;
#pragma unroll
            for (int j = 0; j < 4; ++j) gl[j] = L[32 + j] + bgrp[j];
#pragma unroll
            for (int j = 1; j < 4; ++j) if (gl[j] > gl[gs]) gs = j;
            float den = 0.f;
#pragma unroll
            for (int j = 0; j < 4; ++j) den += expf(gl[j] - gl[gs]);
            const float pg = 1.f / den;
            float el[8];
#pragma unroll
            for (int j = 0; j < 8; ++j) el[j] = L[8 * gs + j] + brt[8 * gs + j];
            int i0 = 0;
#pragma unroll
            for (int j = 1; j < 8; ++j) if (el[j] > el[i0]) i0 = j;
            int i1 = (i0 == 0) ? 1 : 0;
#pragma unroll
            for (int j = 0; j < 8; ++j) if (j != i0 && el[j] > el[i1]) i1 = j;
            const float e1 = expf(el[i1] - el[i0]); const float w0 = pg / (1.f + e1), w1 = pg * e1 / (1.f + e1);
            const int x0 = 8 * gs + i0, x1 = 8 * gs + i1;
            const int p0 = (int)__hip_atomic_fetch_add(ecnt + x0, 1u, RLX_AGENT), p1 = (int)__hip_atomic_fetch_add(ecnt + x1, 1u, RLX_AGENT);
            int* R = ROUTE + (size_t)t * 8; R[0] = x0; R[1] = x1; R[2] = (int)__float_as_uint(w0); R[3] = (int)__float_as_uint(w1); R[4] = p0; R[5] = p1;
        }
        __syncthreads();
    }
}

__device__ __forceinline__ void phase_gather(Frame& F, int l) {
    const int lane = F.lane, tid = F.tid;
    gu32* ecnt = F.ctl + CW_ECNT + 64 * l; int* info = F.info + l * 256;
    const bf16* X1B = WSP(bf16, WS_X1B); bf16* XG = WSP(bf16, WS_XG); const int* ROUTE = WSP(int, WS_ROUTE); int* ROWMAP = WSP(int, WS_ROWMAP); float* ROWW = WSP(float, WS_ROWW);
    LAS int* off = (LAS int*)F.lds;
    if (tid == 0) { int o = 0;
#pragma nounroll
        for (int e = 0; e < 32; ++e) { off[e] = o; const int c = (int)__hip_atomic_load(ecnt + e, RLX_AGENT); const int nt = (c + 255) >> 8;
            if (F.bid == 0) {
#pragma nounroll
                for (int j = 0; j < nt; ++j) __hip_atomic_store(info + (o >> 8) + j, e, RLX_AGENT); }
            o += nt << 8; } off[32] = o; if (F.bid == 0) info[128] = o >> 8; }
    __syncthreads();
    for (int e = F.bid; e < 32; e += F.G) { const int c = (int)__hip_atomic_load(ecnt + e, RLX_AGENT); for (int r = off[e] + c + tid; r < off[e + 1]; r += 512) { ROWMAP[r] = -1; ROWW[r] = 0.f; } }
    const int gw = F.bid * 8 + F.wave, NGW = F.G * 8;
    for (int t = gw; t < T; t += NGW) {
        const int* R = ROUTE + (size_t)t * 8; const int e0 = R[0], e1 = R[1], p0 = R[4], p1 = R[5];
        const int d0 = off[e0] + p0, d1 = off[e1] + p1;
        const GAS v4u* src = (const GAS v4u*)(X1B + (size_t)t * 2048) + lane; GAS v4u* o0 = (GAS v4u*)(XG + (size_t)d0 * 2048) + lane; GAS v4u* o1 = (GAS v4u*)(XG + (size_t)d1 * 2048) + lane;
#pragma unroll
        for (int j = 0; j < 4; ++j) { const v4u v = src[64 * j]; o0[64 * j] = v; o1[64 * j] = v; }
        if (lane == 0) { ROWMAP[d0] = 2 * t; ROWMAP[d1] = 2 * t + 1; ROWW[d0] = __uint_as_float((unsigned)R[2]); ROWW[d1] = __uint_as_float((unsigned)R[3]); }
    }
    __syncthreads();
}

__device__ __forceinline__ void phase_ln2(Frame& F, const Args& a, int l, float* xout) {
    const int gw = F.bid * 8 + F.wave, NGW = F.G * 8, lane = F.lane;
    const float* X1 = WSP(float, WS_X1); const bf16* Y = WSP(bf16, WS_Y); bf16* HB = WSP(bf16, WS_HB);
    const float* g2 = (a.in[I_LN2G] + F.z) + l * 2048; const float* b2 = (a.in[I_LN2B] + F.z) + l * 2048;
    for (int t = gw; t < T; t += NGW) {
        const GAS f32x4* xr = (const GAS f32x4*)(X1 + (size_t)t * 2048) + lane; const GAS v2u* y0 = (const GAS v2u*)(Y + (size_t)(2 * t) * 2048) + lane; const GAS v2u* y1 = (const GAS v2u*)(Y + (size_t)(2 * t + 1) * 2048) + lane;
        f32x4 v[8]; float s = 0.f;
#pragma unroll
        for (int j = 0; j < 8; ++j) { const f32x4 xv = xr[64 * j]; const v2u a0 = y0[64 * j], a1 = y1[64 * j];
            v[j][0] = ALPHA * xv[0] + (bflo(a0.x) + bflo(a1.x)); v[j][1] = ALPHA * xv[1] + (bfhi(a0.x) + bfhi(a1.x)); v[j][2] = ALPHA * xv[2] + (bflo(a0.y) + bflo(a1.y)); v[j][3] = ALPHA * xv[3] + (bfhi(a0.y) + bfhi(a1.y));
            s += (v[j].x + v[j].y) + (v[j].z + v[j].w); }
        const float mean = wave_sum(s) * (1.f / 2048.f); float s2 = 0.f;
#pragma unroll
        for (int j = 0; j < 8; ++j) { v[j] = v[j] - mean; s2 += (v[j].x * v[j].x + v[j].y * v[j].y) + (v[j].z * v[j].z + v[j].w * v[j].w); }
        const float rstd = 1.f / sqrtf(wave_sum(s2) * (1.f / 2048.f) + LN_EPS);
#pragma unroll
        for (int j = 0; j < 8; ++j) { const int col = 4 * lane + 256 * j; const f32x4 g = *(const GAS f32x4*)(g2 + col), b = *(const GAS f32x4*)(b2 + col);
            const f32x4 o = v[j] * rstd * g + b;
            *(GAS f32x4*)(xout + (size_t)t * 2048 + col) = o; v2u ob; ob.x = pk2(o[0], o[1]); ob.y = pk2(o[2], o[3]); *(GAS v2u*)(HB + (size_t)t * 2048 + col) = ob; }
    }
}

#ifndef MK_PER_PHASE
#define MK_PER_PHASE 0
#endif
constexpr int NPHASE = 1 + 14 * NLAYER;
#ifndef PH_MASK
#define PH_MASK 0xFFFF
#endif
constexpr bool EN(int k) { return (PH_MASK >> k) & 1; }
#ifndef DBG_DOUBLE_MASK
#define DBG_DOUBLE_MASK 0
#endif
constexpr int REP(int k) { return ((DBG_DOUBLE_MASK >> k) & 1) ? 2 : 1; }
__global__ void __launch_bounds__(512, 2) fwd(Args a) {
    extern __shared__ __attribute__((aligned(16))) unsigned char lds_raw[];
    Frame F;
    F.lds = (LAS unsigned char*)lds_raw; F.MISC = (volatile LAS unsigned*)(F.lds + MISC_OFF);
    F.wave = __builtin_amdgcn_readfirstlane((int)threadIdx.x >> 6); F.lane = lane_id(); F.tid = F.wave * 64 + F.lane; F.G = gridDim.x; F.bid = blockIdx.x;
    F.z = 0; F.ws = a.ws; F.ctl = (gu32*)(F.ws + WS_CTL); F.info = (int*)(F.ws + WS_INFO);
    if (F.tid < 64) F.MISC[F.tid] = 0u;
    __syncthreads();
    XcdBarrier bar = xcd_barrier_post((unsigned*)(F.ctl + CW_BAR), F.MISC + 8, F.wave == 0 ? 1u : 0u);
    const int lo = a.ph_lo, hi = a.ph_hi;
#define ENTER() do { size_t z_ = 0; asm volatile("" : "+s"(z_)); F.z = z_; unsigned char* w_ = a.ws + z_; F.ws = w_; F.ctl = (gu32*)(w_ + WS_CTL); F.info = (int*)(w_ + WS_INFO); int wv_ = F.wave; asm volatile("" : "+s"(wv_)); int t_ = wv_ * 64 + lane_id(); asm volatile("" : "+v"(t_)); F.tid = t_; F.lane = t_ & 63; F.wave = wv_; } while (0)
#define IN(k) (lo <= (k) && (k) < hi)
#define SEAM(k) do { if (lo <= (k) && (k) + 1 < hi) xcd_barrier(bar); } while (0)
    if constexpr (EN(0)) if (IN(0)) for (int rep = 0; rep < REP(0); ++rep) { ENTER(); prologue(F, a); conv_layer(F, a, 0); } SEAM(0);
#pragma unroll
    for (int l = 0; l < NLAYER; ++l) {
        const int pb = 1 + 14 * l;

        if constexpr (EN(0)) if (IN(pb + 0)) for (int rep = 0; rep < REP(0); ++rep) { ENTER(); if (l > 0) conv_layer(F, a, l); } if (l > 0) SEAM(pb + 0);
        if constexpr (EN(1)) if (IN(pb + 1)) for (int rep = 0; rep < REP(1); ++rep) { ENTER();
            pg8::Gemm g{WSP(bf16, WS_HB), WSP(bf16, WS_WA), T, NA, DM, DM}; pg8::StaticOrder S; S.init(T, NA, F.G, F.bid);
            pg8::EpiA E; E.proj = WSP(bf16, WS_PROJ); E.gate = WSP(bf16, WS_GATE); E.bgate = (a.in[I_BGATE] + F.z) + l * 6144; E.qs = SM_SCALE * LOG2E;
            pg8::gemm_phase<pg8::EpiA, pg8::StaticOrder, true, true>(F.lds, g, S, E, F.tid);
            if (l == 0) { pg8::Gemm g2{WSP(bf16, WS_MEMB), WSP(bf16, WS_WMEM), 256, 1024, DM, DM}; pg8::StaticOrder S2; S2.init(256, 1024, F.G, F.G - 1 - F.bid);
                pg8::EpiScale E2; E2.O = WSP(bf16, WS_MKV); E2.ldc = 1024; E2.pn_a = 0; E2.sa = 1.f; E2.sb = 1.f;
                pg8::gemm_phase<pg8::EpiScale, pg8::StaticOrder, true, true>(F.lds, g2, S2, E2, F.tid); }
        } SEAM(pb + 1);
        if constexpr (EN(2)) if (IN(pb + 2)) for (int rep = 0; rep < REP(2); ++rep) { ENTER(); phase_norms(F, a, l); } SEAM(pb + 2);
        if constexpr (EN(3)) if (IN(pb + 3)) for (int rep = 0; rep < REP(3); ++rep) { ENTER();
            { pg8::Gemm g{WSP(bf16, WS_CQN), WSP(bf16, WS_WC1), T, NQAI, 512, 512}; pg8::StaticOrder S; S.init(T, NQAI, F.G, F.bid);
              pg8::EpiScale E; E.O = WSP(bf16, WS_QAI); E.ldc = NQAI; E.pn_a = 3; E.sa = SM_SCALE * LOG2E; E.sb = 0.125f;
              pg8::gemm_phase<pg8::EpiScale, pg8::StaticOrder, true, true>(F.lds, g, S, E, F.tid); }
            { pg8::Gemm g{WSP(bf16, WS_CKVN), WSP(bf16, WS_WC2), T, NKVA, 256, 256}; pg8::StaticOrder S; S.init(T, NKVA, F.G, F.G - 1 - F.bid);
              pg8::EpiScale E; E.O = WSP(bf16, WS_KVA); E.ldc = NKVA; E.pn_a = 0; E.sa = 1.f; E.sb = 1.f;
              pg8::gemm_phase<pg8::EpiScale, pg8::StaticOrder, true, true>(F.lds, g, S, E, F.tid); }
        } SEAM(pb + 3);
        if constexpr (EN(4)) if (IN(pb + 4)) for (int rep = 0; rep < REP(4); ++rep) { ENTER(); if (rep == 0) phase_moba_gate(F); phase_indexer(F); } SEAM(pb + 4);
        if constexpr (EN(6)) if (IN(pb + 6)) for (int rep = 0; rep < REP(6); ++rep) { ENTER(); phase_attention(F, l, rep); } SEAM(pb + 6);
        if constexpr (EN(7)) if (IN(pb + 7)) for (int rep = 0; rep < REP(7); ++rep) { ENTER();
#ifdef DBG_UPTEST
            { pg8::Gemm g{WSP(bf16, WS_OATT), WSP(bf16, WS_WUP), T, DM, DM, DM}; pg8::StaticOrder S; S.init(T, DM, F.G, F.bid);
              pg8::EpiUp<0> E; E.gate = WSP(bf16, WS_GATE); E.O = WSP(bf16, WS_MERGED);
              pg8::gemm_phase<pg8::EpiUp<0>, pg8::StaticOrder, true, true>(F.lds, g, S, E, F.tid); }
#else
            { pg8::Gemm g{WSP(bf16, WS_OATT), WSP(bf16, WS_WUP), T, DM, 768, DM}; pg8::StaticOrder S; S.init(T, DM, F.G, F.bid);
              pg8::EpiUp<0> E; E.gate = WSP(bf16, WS_GATE); E.O = WSP(bf16, WS_MERGED);
              pg8::gemm_phase<pg8::EpiUp<0>, pg8::StaticOrder, true, true>(F.lds, g, S, E, F.tid); }
            { pg8::Gemm g{WSP(bf16, WS_OATT) + 768, WSP(bf16, WS_WUP) + 768, T, DM, 768, DM}; pg8::StaticOrder S; S.init(T, DM, F.G, F.bid);
              pg8::EpiUp<1> E; E.gate = WSP(bf16, WS_GATE); E.O = WSP(bf16, WS_MERGED);
              pg8::gemm_phase<pg8::EpiUp<1>, pg8::StaticOrder, true, true>(F.lds, g, S, E, F.tid); }
            { pg8::Gemm g{WSP(bf16, WS_OATT) + 1536, WSP(bf16, WS_WUP) + 1536, T, DM, 512, DM}; pg8::StaticOrder S; S.init(T, DM, F.G, F.bid);
              pg8::EpiUp<2> E; E.gate = WSP(bf16, WS_GATE); E.O = WSP(bf16, WS_MERGED);
              pg8::gemm_phase<pg8::EpiUp<2>, pg8::StaticOrder, true, true>(F.lds, g, S, E, F.tid); }
#endif
        } SEAM(pb + 7);
        if constexpr (EN(8)) if (IN(pb + 8)) for (int rep = 0; rep < REP(8); ++rep) { ENTER();
            pg8::Gemm g{WSP(bf16, WS_MERGED), WSP(bf16, WS_WO), T, DM, DM, DM}; pg8::StaticOrder S; S.init(T, DM, F.G, F.bid);
            pg8::EpiPre E; E.x = (l == 0) ? (a.in[I_X] + F.z) : WSP(float, WS_XF); E.pre = WSP(float, WS_PRE); E.alpha = ALPHA;
            pg8::gemm_phase<pg8::EpiPre, pg8::StaticOrder, true, true>(F.lds, g, S, E, F.tid);
        } SEAM(pb + 8);
        if constexpr (EN(9)) if (IN(pb + 9)) for (int rep = 0; rep < REP(9); ++rep) { ENTER(); phase_ln1_router(F, a, l, rep); } SEAM(pb + 9);
        if constexpr (EN(10)) if (IN(pb + 10)) for (int rep = 0; rep < REP(10); ++rep) { ENTER(); phase_gather(F, l); } SEAM(pb + 10);
        if constexpr (EN(11)) if (IN(pb + 11)) for (int rep = 0; rep < REP(11); ++rep) { ENTER();
            const int* info = F.info + l * 256; const int ntile = __builtin_amdgcn_readfirstlane(info[128]);
            pg8::Gemm g{WSP(bf16, WS_XG), WSP(bf16, WS_W13), MPAD, 32 * 1024, DM, DM}; pg8::MoeOrder S; S.tile_e = info; S.ntile = ntile; S.nN = 4; S.G = F.G; S.c = F.bid;
            pg8::EpiMoeA E; E.hid = WSP(bf16, WS_HID);
            pg8::gemm_phase<pg8::EpiMoeA, pg8::MoeOrder, true, true>(F.lds, g, S, E, F.tid);
        } SEAM(pb + 11);
        if constexpr (EN(12)) if (IN(pb + 12)) for (int rep = 0; rep < REP(12); ++rep) { ENTER();
            const int* info = F.info + l * 256; const int ntile = __builtin_amdgcn_readfirstlane(info[128]);
            pg8::Gemm g{WSP(bf16, WS_HID), WSP(bf16, WS_W2), MPAD, 32 * 2048, DEXP, DEXP}; pg8::MoeOrder S; S.tile_e = info; S.ntile = ntile; S.nN = 8; S.G = F.G; S.c = F.bid;
            pg8::EpiMoeB E; E.Y = WSP(bf16, WS_Y); E.rowmap = WSP(int, WS_ROWMAP); E.roww = WSP(float, WS_ROWW);
            pg8::gemm_phase<pg8::EpiMoeB, pg8::MoeOrder, true, true>(F.lds, g, S, E, F.tid);
        } SEAM(pb + 12);
        if constexpr (EN(13)) if (IN(pb + 13)) for (int rep = 0; rep < REP(13); ++rep) { ENTER(); phase_ln2(F, a, l, (l == NLAYER - 1) ? (a.out + F.z) : WSP(float, WS_XF)); } if (l + 1 < NLAYER) SEAM(pb + 13);
    }
#ifdef DBG_EXTRA_BARRIERS
    for (int i = 0; i < DBG_EXTRA_BARRIERS; ++i) xcd_barrier(bar);
#endif
#undef IN
#undef SEAM
}


#ifdef DBG_STOP_PHASE
__global__ void dbg_dump(const unsigned char* ws, size_t off, int kind, long n, float* out, long nout) {
    for (long i = blockIdx.x * 256L + threadIdx.x; i < nout; i += gridDim.x * 256L) { const long j = i % n; float v;
        if (kind == 0) v = __builtin_bit_cast(float, (unsigned)((const unsigned short*)(ws + off))[j] << 16);
        else if (kind == 1) v = ((const float*)(ws + off))[j];
        else v = (float)(((const unsigned*)(ws + off))[j] & 0xffffu);
        out[i] = v; }
}
#endif
extern "C" void kernel_launch(void* const* d_in, const int* in_sizes, int n_in, void* d_out, int out_size, void* d_ws, size_t ws_size, hipStream_t stream) {
    static int grid = 0;
    if (grid == 0) {
        if (n_in != 28 || out_size != T * DM || ws_size < WS_END) { fprintf(stderr, "kernel_launch: unexpected shapes (n_in %d out %d ws %zu)\n", n_in, out_size, ws_size); grid = -1; return; }
        int dev = 0, cus = 0;
        if (hipGetDevice(&dev) != hipSuccess || hipDeviceGetAttribute(&cus, hipDeviceAttributeMultiprocessorCount, dev) != hipSuccess) { grid = -1; return; }
        if (hipFuncSetAttribute((const void*)fwd, hipFuncAttributeMaxDynamicSharedMemorySize, LDS_BYTES) != hipSuccess) { fprintf(stderr, "kernel_launch: hipFuncSetAttribute failed\n"); grid = -1; return; }
        int per_cu = 0;
        if (hipOccupancyMaxActiveBlocksPerMultiprocessor(&per_cu, (const void*)fwd, 512, LDS_BYTES) != hipSuccess || per_cu < 1) fprintf(stderr, "kernel_launch: occupancy query says %d\n", per_cu);
        (void)hipGetLastError();
        grid = cus;
    }
    if (grid < 0) return;
    if (hipMemsetAsync((char*)d_ws + WS_CTL, 0, CTL_ZERO_BYTES, stream) != hipSuccess) return;
    Args a{};
    for (int i = 0; i < 28; ++i) a.in[i] = (const float*)d_in[i];
    a.out = (float*)d_out; a.ws = (unsigned char*)d_ws;
#if defined(DBG_STOP_PHASE)
    for (int k = 0; k <= DBG_STOP_PHASE; ++k) { a.ph_lo = k; a.ph_hi = k + 1; hipLaunchKernelGGL(fwd, dim3(grid), dim3(512), LDS_BYTES, stream, a); }
    hipLaunchKernelGGL(dbg_dump, dim3(2048), dim3(256), 0, stream, (const unsigned char*)d_ws, (size_t)DBG_DUMP_OFF, DBG_DUMP_KIND, (long)DBG_DUMP_N, (float*)d_out, (long)out_size);
#elif MK_PER_PHASE
    for (int k = 0; k < NPHASE; ++k) { a.ph_lo = k; a.ph_hi = k + 1; hipLaunchKernelGGL(fwd, dim3(grid), dim3(512), LDS_BYTES, stream, a); }
#else
    a.ph_lo = 0; a.ph_hi = NPHASE;
    hipLaunchKernelGGL(fwd, dim3(grid), dim3(512), LDS_BYTES, stream, a);
#endif
    const hipError_t le = hipPeekAtLastError();
    if (le != hipSuccess) fprintf(stderr, "kernel_launch: launch failed: %s\n", hipGetErrorName(le));
}
```

```cpp
#define DBG_MIX_SCALE 1.0f
#define DBG_ZERO_BR 0
#define DBG_DOUBLE_MASK 0
#include <hip/hip_runtime.h>
#include <cstdio>
#include <cstdint>

#define GAS __attribute__((address_space(1)))
#define LAS __attribute__((address_space(3)))
typedef unsigned short bf16;
typedef unsigned v4u __attribute__((ext_vector_type(4)));
typedef unsigned v2u __attribute__((ext_vector_type(2)));
typedef float f32x4 __attribute__((ext_vector_type(4)));
typedef float f32x2 __attribute__((ext_vector_type(2)));
typedef float f32x16 __attribute__((ext_vector_type(16)));
typedef short bf16x8 __attribute__((ext_vector_type(8)));
typedef short s16x4 __attribute__((ext_vector_type(4)));
typedef GAS unsigned gu32;
#define RLX_AGENT __ATOMIC_RELAXED, __HIP_MEMORY_SCOPE_AGENT
#define LDS_WAIT() asm volatile("s_waitcnt lgkmcnt(0)" ::: "memory")
#define VM_WAIT() asm volatile("s_waitcnt vmcnt(0)" ::: "memory")
#define SBAR() __builtin_amdgcn_sched_barrier(0)

__device__ __forceinline__ unsigned f2bf(float f) { unsigned u = __builtin_bit_cast(unsigned, f); return (u + 0x7fffu + ((u >> 16) & 1u)) >> 16; }
__device__ __forceinline__ unsigned pk2(float lo, float hi) { return f2bf(lo) | (f2bf(hi) << 16); }
__device__ __forceinline__ float bf2f(unsigned b) { return __builtin_bit_cast(float, b << 16); }
__device__ __forceinline__ float bflo(unsigned w) { return __builtin_bit_cast(float, w << 16); }
__device__ __forceinline__ float bfhi(unsigned w) { return __builtin_bit_cast(float, w & 0xffff0000u); }
typedef __bf16 bf16x2_t __attribute__((ext_vector_type(2)));
__device__ __forceinline__ unsigned cvtpk(float lo, float hi) { f32x2 v = {lo, hi}; bf16x2_t b = __builtin_convertvector(v, bf16x2_t); return __builtin_bit_cast(unsigned, b); }
__device__ __forceinline__ float wave_sum(float v) {
#pragma unroll
    for (int o = 1; o < 64; o <<= 1) v += __shfl_xor(v, o);
    return v;
}

constexpr int T = 8192, DM = 2048, NLAYER = 2;
constexpr int NA = 9984;
constexpr int NPROJ = 3840, NGATE = 6144;
constexpr int PJ_QB = 1024, PJ_KB = 1792, PJ_VB = 2560, PJ_QC = 3328;
constexpr int NQAI = 1792;
constexpr int NKVA = 1536;
constexpr int NEXP = 32, DEXP = 512;
constexpr int MPAD = 24576;
constexpr float LN_EPS = 1e-5f;
constexpr float ALPHA = 1.4142135623730951f;
constexpr float SM_SCALE = 0.088388347648318440f;
constexpr float LOG2E = 1.4426950408889634f;
namespace pg8 {
#define PG8_LAS __attribute__((address_space(3)))
typedef unsigned short bf16_t;
typedef short bf16x8 __attribute__((ext_vector_type(8)));
typedef float f32x4 __attribute__((ext_vector_type(4)));
typedef unsigned u32x4 __attribute__((ext_vector_type(4)));
constexpr int BM = 256, BK = 64, HALF = 128, HTB = HALF * BK * 2  , STAGE_BYTES = 8 * HTB, NXCD = 8, WGM = 8;

__host__ __device__ __forceinline__ int lds_byte(int r, int c) { const int st = (r >> 4) * 2 + (c >> 5), rr = r & 15, cc = c & 31, ob = rr * 64 + cc * 2; return st * 1024 + (ob ^ (((ob >> 9) & 1) << 5)); }
__host__ __device__ __forceinline__ void stage_rc(int b, int& R, int& C) { const int st = b / 1024, sb = b % 1024, swz = sb ^ (((sb >> 9) & 1) << 5); R = (st >> 1) * 16 + swz / 64; C = (st & 1) * 32 + (swz % 64) / 2; }
__host__ __device__ __forceinline__ int perm32(int rho) { const int n = rho >> 4, i = rho & 15; return 8 * (i >> 2) + 4 * n + (i & 3); }

struct Unit { int pm, pn; };
struct Gemm { const bf16_t* A; const bf16_t* Bt; int M, N, K, ld; };

struct StaticOrder {
    int nM, nN, nwg, G, c;
    __host__ __device__ void init(int M, int N, int G_, int c_) { nM = M / BM; nN = N / BM; nwg = nM * nN; G = G_; c = c_; }
    __host__ __device__ bool next(int i, Unit& u) const {
        const long L = (long)i * G + c; if (L >= nwg) return false;
        int wgid = (int)L; { const int q = nwg / NXCD, r = nwg % NXCD, xcd = wgid % NXCD, off = wgid / NXCD; wgid = (xcd < r ? xcd * (q + 1) : r * (q + 1) + (xcd - r) * q) + off; }
        const int nig = WGM * nN, gid = wgid / nig, fm = gid * WGM, gsz = (nM - fm) < WGM ? (nM - fm) : WGM;
        u.pm = fm + ((wgid % nig) % gsz); u.pn = (wgid % nig) / gsz; return true;
    }
    __device__ __forceinline__ void a_ready(const Unit&) const {}
    __device__ __forceinline__ void done(const Unit&) const {}
};


__device__ __forceinline__ unsigned cvt_pk_bf16(float lo, float hi) { return ::cvtpk(lo, hi); }
__device__ __forceinline__ float sigmoidf_(float v) { return __builtin_amdgcn_rcpf(1.0f + __builtin_amdgcn_exp2f(-1.4426950408889634f * v)); }
__device__ __forceinline__ u32x4 pack8(const f32x4 v0, const f32x4 v1) { u32x4 w; w.x = cvt_pk_bf16(v0[0], v0[1]); w.y = cvt_pk_bf16(v0[2], v0[3]); w.z = cvt_pk_bf16(v1[0], v1[1]); w.w = cvt_pk_bf16(v1[2], v1[3]); return w; }
__device__ __forceinline__ void unpack8(const u32x4 w, f32x4& a, f32x4& b) {
    a[0] = __builtin_bit_cast(float, w.x << 16); a[1] = __builtin_bit_cast(float, w.x & 0xffff0000u); a[2] = __builtin_bit_cast(float, w.y << 16); a[3] = __builtin_bit_cast(float, w.y & 0xffff0000u);
    b[0] = __builtin_bit_cast(float, w.z << 16); b[1] = __builtin_bit_cast(float, w.z & 0xffff0000u); b[2] = __builtin_bit_cast(float, w.w << 16); b[3] = __builtin_bit_cast(float, w.w & 0xffff0000u); }
struct EpiBase { static constexpr bool PERM = true, AFTER_DRAIN = false; };

struct EpiA : EpiBase {
    bf16_t* proj; bf16_t* gate; const float* bgate; float qs;
    __device__ __forceinline__ void operator()(const f32x4 (&acc)[2][2][4][2], const Unit& u, int wr, int wc, int fr, int fq) const {
        const int row0 = u.pm * BM + wr * 64 + fr; const int colt = u.pn * BM + wc * 32 + 8 * fq;
        if (u.pn < 15) {
            const float s = ((u.pn >= 4 && u.pn < 7) || u.pn >= 13) ? qs : 1.0f;
#pragma unroll
            for (int ai = 0; ai < 2; ++ai)
#pragma unroll
                for (int m = 0; m < 4; ++m) { bf16_t* rowp = proj + (size_t)(row0 + ai * HALF + m * 16) * 3840 + colt;
#pragma unroll
                    for (int bj = 0; bj < 2; ++bj) *(u32x4*)(rowp + bj * HALF) = pack8(acc[ai][bj][m][0] * s, acc[ai][bj][m][1] * s); }
        } else {
            const int gc = colt - 3840;
            f32x4 bv[2][2];
#pragma unroll
            for (int bj = 0; bj < 2; ++bj)
#pragma unroll
                for (int n = 0; n < 2; ++n) bv[bj][n] = *(const f32x4*)(bgate + gc + bj * HALF + 4 * n);
#pragma unroll
            for (int ai = 0; ai < 2; ++ai)
#pragma unroll
                for (int m = 0; m < 4; ++m) { bf16_t* rowp = gate + (size_t)(row0 + ai * HALF + m * 16) * 6144 + gc;
#pragma unroll
                    for (int bj = 0; bj < 2; ++bj) { f32x4 v0 = acc[ai][bj][m][0] + bv[bj][0], v1 = acc[ai][bj][m][1] + bv[bj][1];
#pragma unroll
                        for (int j = 0; j < 4; ++j) { v0[j] = sigmoidf_(v0[j]); v1[j] = sigmoidf_(v1[j]); }
                        *(u32x4*)(rowp + bj * HALF) = pack8(v0, v1); } }
        }
    }
};
struct EpiScale : EpiBase {
    bf16_t* O; int ldc; int pn_a; float sa, sb;
    __device__ __forceinline__ void operator()(const f32x4 (&acc)[2][2][4][2], const Unit& u, int wr, int wc, int fr, int fq) const {
        const int row0 = u.pm * BM + wr * 64 + fr; const int colt = u.pn * BM + wc * 32 + 8 * fq; const float s = (u.pn < pn_a) ? sa : sb;
#pragma unroll
        for (int ai = 0; ai < 2; ++ai)
#pragma unroll
            for (int m = 0; m < 4; ++m) { bf16_t* rowp = O + (size_t)(row0 + ai * HALF + m * 16) * ldc + colt;
#pragma unroll
                for (int bj = 0; bj < 2; ++bj) *(u32x4*)(rowp + bj * HALF) = pack8(acc[ai][bj][m][0] * s, acc[ai][bj][m][1] * s); }
    }
};
template <int STEP> struct EpiUp : EpiBase {
    const bf16_t* gate; bf16_t* O;
    __device__ __forceinline__ void operator()(const f32x4 (&acc)[2][2][4][2], const Unit& u, int wr, int wc, int fr, int fq) const {
        const int row0 = u.pm * BM + wr * 64 + fr; const int colt = u.pn * BM + wc * 32 + 8 * fq;
#pragma unroll
        for (int ai = 0; ai < 2; ++ai)
#pragma unroll
            for (int m = 0; m < 4; ++m) { const size_t r = (size_t)(row0 + ai * HALF + m * 16);
#pragma unroll
                for (int bj = 0; bj < 2; ++bj) { const u32x4 wg = *(const u32x4*)(gate + r * 6144 + STEP * 2048 + colt + bj * HALF); f32x4 g0, g1; unpack8(wg, g0, g1);
                    f32x4 v0 = acc[ai][bj][m][0] * g0, v1 = acc[ai][bj][m][1] * g1;
                    if constexpr (STEP > 0) { const u32x4 wp = __builtin_nontemporal_load((const u32x4*)(O + r * 2048 + colt + bj * HALF)); f32x4 p0, p1; unpack8(wp, p0, p1); v0 += p0; v1 += p1; }
                    *(u32x4*)(O + r * 2048 + colt + bj * HALF) = pack8(v0, v1); } }
    }
};
struct EpiPre : EpiBase {
    const float* x; float* pre; float alpha;
    __device__ __forceinline__ void operator()(const f32x4 (&acc)[2][2][4][2], const Unit& u, int wr, int wc, int fr, int fq) const {
        const int row0 = u.pm * BM + wr * 64 + fr; const int colt = u.pn * BM + wc * 32 + 8 * fq;
#pragma unroll
        for (int ai = 0; ai < 2; ++ai)
#pragma unroll
            for (int m = 0; m < 4; ++m) { const size_t off = (size_t)(row0 + ai * HALF + m * 16) * 2048 + colt;
#pragma unroll
                for (int bj = 0; bj < 2; ++bj)
#pragma unroll
                    for (int n = 0; n < 2; ++n) { const f32x4 xv = *(const f32x4*)(x + off + bj * HALF + 4 * n); *(f32x4*)(pre + off + bj * HALF + 4 * n) = xv * alpha + acc[ai][bj][m][n]; } }
    }
};
struct EpiMoeA : EpiBase {
    bf16_t* hid;
    __device__ __forceinline__ void operator()(const f32x4 (&acc)[2][2][4][2], const Unit& u, int wr, int wc, int fr, int fq) const {
        const int row0 = u.pm * BM + wr * 64 + fr; const int hc = (u.pn & 3) * 128 + wc * 32 + 8 * fq;
#pragma unroll
        for (int ai = 0; ai < 2; ++ai)
#pragma unroll
            for (int m = 0; m < 4; ++m) { f32x4 h0, h1;
#pragma unroll
                for (int j = 0; j < 4; ++j) { const float a0 = acc[ai][0][m][0][j], a1 = acc[ai][0][m][1][j]; h0[j] = a0 * sigmoidf_(a0) * acc[ai][1][m][0][j]; h1[j] = a1 * sigmoidf_(a1) * acc[ai][1][m][1][j]; }
                *(u32x4*)(hid + (size_t)(row0 + ai * HALF + m * 16) * 512 + hc) = pack8(h0, h1); }
    }
};
struct EpiMoeB : EpiBase {
    bf16_t* Y; const int* rowmap; const float* roww;
    __device__ __forceinline__ void operator()(const f32x4 (&acc)[2][2][4][2], const Unit& u, int wr, int wc, int fr, int fq) const {
        const int row0 = u.pm * BM + wr * 64 + fr; const int colt = (u.pn & 7) * BM + wc * 32 + 8 * fq;
#pragma unroll
        for (int ai = 0; ai < 2; ++ai)
#pragma unroll
            for (int m = 0; m < 4; ++m) { const int rg = row0 + ai * HALF + m * 16; const int dst = rowmap[rg]; const float w = roww[rg];
                if (dst >= 0) {
#pragma unroll
                    for (int bj = 0; bj < 2; ++bj) *(u32x4*)(Y + (size_t)dst * 2048 + colt + bj * HALF) = pack8(acc[ai][bj][m][0] * w, acc[ai][bj][m][1] * w); } }
    }
};
struct MoeOrder {
    const int* tile_e; int ntile, nN, G, c;
    __device__ __forceinline__ bool next(int i, Unit& u) const {
        const int L = i * G + c; if (L >= ntile * nN) return false;
        const int mt = L / nN, nl = L - mt * nN; u.pm = mt; u.pn = tile_e[mt] * nN + nl; return true; }
    __device__ __forceinline__ void a_ready(const Unit&) const {}
    __device__ __forceinline__ void done(const Unit&) const {}
};

template <class Epi, class Sched, bool ALIGN_EPI = false, bool SP2 = false>
__device__ __forceinline__ void gemm_phase(PG8_LAS unsigned char* lds, const Gemm g, const Sched& S, const Epi& E, const int tid) {
    const int wid = __builtin_amdgcn_readfirstlane(tid >> 6), lane = tid & 63, wr = wid >> 2, wc = wid & 3, fr = lane & 15, fq = lane >> 4;
    const int K = g.ld, nt = g.K / BK;
    unsigned voffA[2], voffB[2];
#pragma unroll
    for (int i = 0; i < 2; ++i) { int R, C; stage_rc(tid * 16 + i * 8192, R, C); const int Rb = Epi::PERM ? ((R & ~31) + perm32(R & 31)) : R;
        voffA[i] = (unsigned)(R * K + C) * 2u; voffB[i] = (unsigned)(Rb * K + C) * 2u; }
    const size_t kstep = (size_t)(BK * 2);
    const size_t hstep = (size_t)HALF * K * 2;
    const size_t tstep = 2 * hstep;
    const unsigned ldsw = (unsigned)wid * 1024u;
    const int aoff = lds_byte(wr * 64 + fr, fq * 8), boff = lds_byte(wc * 32 + fr, fq * 8);
#define PG8_SA(b, h) (((b) * 2 + (h)) * HTB)
#define PG8_SB(b, h) ((4 + (b) * 2 + (h)) * HTB)
#define PG8_STAGE(bufoff, gbase, voff) do { _Pragma("unroll") for (int _i = 0; _i < 2; ++_i) \
        __builtin_amdgcn_global_load_lds((const unsigned*)((const char*)(gbase) + (voff)[_i]), (PG8_LAS unsigned*)(lds + (bufoff) + ldsw + _i * 8192), 16, 0, 0); } while (0)
#define PG8_LDA(dst, b, h) do { _Pragma("unroll") for (int m = 0; m < 4; ++m) _Pragma("unroll") for (int k = 0; k < 2; ++k) dst[m][k] = *(const PG8_LAS bf16x8*)(lds + PG8_SA(b, h) + aoff + m * 2048 + k * 1024); } while (0)
#define PG8_LDB(dst, b, h) do { _Pragma("unroll") for (int n = 0; n < 2; ++n) _Pragma("unroll") for (int k = 0; k < 2; ++k) dst[n][k] = *(const PG8_LAS bf16x8*)(lds + PG8_SB(b, h) + boff + n * 2048 + k * 1024); } while (0)
#define PG8_MMA(ai, bj, At, Bt) do { __builtin_amdgcn_s_setprio(1); _Pragma("unroll") for (int m = 0; m < 4; ++m) _Pragma("unroll") for (int n = 0; n < 2; ++n) _Pragma("unroll") for (int k = 0; k < 2; ++k) \
        acc[ai][bj][m][n] = __builtin_amdgcn_mfma_f32_16x16x32_bf16(Bt[n][k], At[m][k], acc[ai][bj][m][n], 0, 0, 0); __builtin_amdgcn_s_setprio(0); } while (0)
#define PG8_WAIT_V(n) asm volatile("s_waitcnt vmcnt(" #n ")" ::: "memory")
#define PG8_WAIT_L(n) asm volatile("s_waitcnt lgkmcnt(" #n ")" ::: "memory")
#define PG8_BAR __builtin_amdgcn_s_barrier()
#define PG8_SCHED __builtin_amdgcn_sched_barrier(0)
    Unit cur, nxt; int ui = 0;
    if (!S.next(0, cur)) return;
    f32x4 acc[2][2][4][2];
#pragma unroll
    for (int a = 0; a < 2; ++a)
#pragma unroll
        for (int b = 0; b < 2; ++b)
#pragma unroll
            for (int m = 0; m < 4; ++m)
#pragma unroll
                for (int n = 0; n < 2; ++n) acc[a][b][m][n] = (f32x4){0.f, 0.f, 0.f, 0.f};
    bf16x8 At[4][2], B0[2][2], B1[2][2];
    const char* cA = (const char*)g.A + (size_t)cur.pm * tstep; const char* cB = (const char*)g.Bt + (size_t)cur.pn * tstep;
    S.a_ready(cur);
    if constexpr (SP2) {
        PG8_STAGE(PG8_SB(0, 0), cB, voffB); PG8_STAGE(PG8_SB(0, 1), cB + hstep, voffB); PG8_STAGE(PG8_SA(0, 0), cA, voffA); PG8_STAGE(PG8_SA(0, 1), cA + hstep, voffA);
        if (wr == 1) PG8_BAR;
        PG8_WAIT_V(2); PG8_BAR;
        PG8_STAGE(PG8_SB(1, 0), cB + kstep, voffB); PG8_STAGE(PG8_SA(1, 0), cA + kstep, voffA); PG8_STAGE(PG8_SB(1, 1), cB + hstep + kstep, voffB);
        PG8_WAIT_V(6); PG8_BAR;
    } else {
        PG8_STAGE(PG8_SB(0, 0), cB, voffB); PG8_STAGE(PG8_SA(0, 0), cA, voffA); PG8_STAGE(PG8_SB(0, 1), cB + hstep, voffB); PG8_STAGE(PG8_SA(0, 1), cA + hstep, voffA);
        if (wr == 1) PG8_BAR;
        PG8_WAIT_V(4); PG8_BAR;
        PG8_STAGE(PG8_SB(1, 0), cB + kstep, voffB); PG8_STAGE(PG8_SA(1, 0), cA + kstep, voffA); PG8_STAGE(PG8_SB(1, 1), cB + hstep + kstep, voffB);
        PG8_WAIT_V(6); PG8_BAR;
    }
    for (;;) {
        const bool has_next = S.next(ui + 1, nxt);
        const char* nA = has_next ? (const char*)g.A + (size_t)nxt.pm * tstep : cA; const char* nB = has_next ? (const char*)g.Bt + (size_t)nxt.pn * tstep : cB;
        for (int t = 0; t < nt; t += 2) {
            const bool last = (t == nt - 2);
            const char* a1 = cA + (size_t)(t + 1) * kstep;
            const char* a2 = last ? nA : cA + (size_t)(t + 2) * kstep; const char* b2 = last ? nB : cB + (size_t)(t + 2) * kstep;
            const char* a3 = a2 + kstep; const char* b3 = b2 + kstep;
            if (last && has_next) S.a_ready(nxt);
            if constexpr (SP2) {
            PG8_LDB(B0, 0, 0); PG8_LDB(B1, 0, 1); PG8_SCHED; PG8_LDA(At, 0, 0); PG8_STAGE(PG8_SA(1, 1), a1 + hstep, voffA);
            PG8_WAIT_V(8); PG8_WAIT_L(0); PG8_BAR; PG8_MMA(0, 0, At, B0); PG8_MMA(0, 1, At, B1); PG8_BAR; PG8_SCHED;
            PG8_LDA(At, 0, 1); PG8_STAGE(PG8_SB(0, 0), b2, voffB); PG8_STAGE(PG8_SB(0, 1), b2 + hstep, voffB); PG8_STAGE(PG8_SA(0, 0), a2, voffA);
            PG8_WAIT_V(8); PG8_WAIT_L(0); PG8_BAR; PG8_MMA(1, 0, At, B0); PG8_MMA(1, 1, At, B1); PG8_BAR; PG8_SCHED;
            PG8_LDB(B0, 1, 0); PG8_LDB(B1, 1, 1); PG8_SCHED; PG8_LDA(At, 1, 0); PG8_STAGE(PG8_SA(0, 1), a2 + hstep, voffA);
            PG8_WAIT_V(8); PG8_WAIT_L(0); PG8_BAR; PG8_MMA(0, 0, At, B0); PG8_MMA(0, 1, At, B1); PG8_BAR; PG8_SCHED;
            PG8_LDA(At, 1, 1); PG8_STAGE(PG8_SB(1, 0), b3, voffB); PG8_STAGE(PG8_SB(1, 1), b3 + hstep, voffB); PG8_STAGE(PG8_SA(1, 0), a3, voffA);
            PG8_WAIT_V(8); PG8_WAIT_L(0); PG8_BAR; PG8_MMA(1, 0, At, B0); PG8_MMA(1, 1, At, B1); PG8_BAR; PG8_SCHED;
            } else {
            PG8_LDB(B0, 0, 0); PG8_SCHED; PG8_LDA(At, 0, 0); PG8_STAGE(PG8_SA(1, 1), a1 + hstep, voffA);
            PG8_WAIT_L(8); PG8_BAR; PG8_WAIT_L(0); PG8_MMA(0, 0, At, B0); PG8_BAR; PG8_SCHED;
            PG8_LDB(B1, 0, 1); PG8_STAGE(PG8_SB(0, 0), b2, voffB);
            PG8_BAR; PG8_WAIT_L(0); PG8_MMA(0, 1, At, B1); PG8_BAR;
            PG8_LDA(At, 0, 1); PG8_STAGE(PG8_SA(0, 0), a2, voffA);
            PG8_BAR; PG8_WAIT_L(0); PG8_MMA(1, 0, At, B0); PG8_BAR; PG8_SCHED;
            PG8_STAGE(PG8_SB(0, 1), b2 + hstep, voffB);
            PG8_WAIT_V(6); PG8_BAR; PG8_MMA(1, 1, At, B1); PG8_BAR;
            PG8_LDB(B0, 1, 0); PG8_SCHED; PG8_LDA(At, 1, 0); PG8_STAGE(PG8_SA(0, 1), a2 + hstep, voffA);
            PG8_WAIT_L(8); PG8_BAR; PG8_WAIT_L(0); PG8_MMA(0, 0, At, B0); PG8_BAR; PG8_SCHED;
            PG8_LDB(B1, 1, 1); PG8_STAGE(PG8_SB(1, 0), b3, voffB);
            PG8_BAR; PG8_WAIT_L(0); PG8_MMA(0, 1, At, B1); PG8_BAR;
            PG8_LDA(At, 1, 1); PG8_STAGE(PG8_SA(1, 0), a3, voffA);
            PG8_BAR; PG8_WAIT_L(0); PG8_MMA(1, 0, At, B0); PG8_BAR; PG8_SCHED;
            PG8_STAGE(PG8_SB(1, 1), b3 + hstep, voffB);
            PG8_WAIT_V(6); PG8_BAR; PG8_MMA(1, 1, At, B1); PG8_BAR;
            }
        }
        if constexpr (ALIGN_EPI) { if (wr == 0) PG8_BAR; }
        if constexpr (!Epi::AFTER_DRAIN) { E(acc, cur, wr, wc, fr, fq); S.done(cur); }
        if (!has_next) break;
#pragma unroll
        for (int a = 0; a < 2; ++a)
#pragma unroll
            for (int b = 0; b < 2; ++b)
#pragma unroll
                for (int m = 0; m < 4; ++m)
#pragma unroll
                    for (int n = 0; n < 2; ++n) acc[a][b][m][n] = (f32x4){0.f, 0.f, 0.f, 0.f};
        cur = nxt; cA = nA; cB = nB; ++ui;
        if constexpr (ALIGN_EPI) { if (wr == 1) PG8_BAR; }
    }
    PG8_WAIT_V(0);
    if constexpr (!ALIGN_EPI) { if (wr == 0) PG8_BAR; }
    PG8_BAR;
    if constexpr (Epi::AFTER_DRAIN) { E.fused(acc, cur, wr, wc, fr, fq, lds, wid, lane); S.done(cur); }
#undef PG8_SA
#undef PG8_SB
#undef PG8_STAGE
#undef PG8_LDA
#undef PG8_LDB
#undef PG8_MMA
#undef PG8_WAIT_V
#undef PG8_WAIT_L
#undef PG8_BAR
#undef PG8_SCHED
}
}

namespace att {
constexpr int D = 128, NW = 8, QBLK = 32, KVBLK = 64;
constexpr int SDEPTH = 1;
constexpr float THR2 = 8.f * 1.4426950408889634f;
constexpr size_t SHM_V = KVBLK * D * 2, SHM_K = KVBLK * D * 2, SHM_ATTN = 2 * SHM_V + 2 * SHM_K + NW * 64 * 4;
#define KSWZ(row, colB) ((row) * 256 + ((colB) ^ (((row) & 7) << 4)))
__device__ __forceinline__ int crow(int r, int hi) { return (r & 3) + 8 * (r >> 2) + 4 * hi; }
constexpr int ccol(int r) { return (r & 3) + 8 * (r >> 2); }

template <int MODE>
__device__ __forceinline__ void partialSM(f32x16& p0, f32x16& p1, float& m_reg, float& alpha, float& sub1_out, int j, int NT, float slope2, float lanec, int lanet, int hi, v2u mw, unsigned bmw) {
  const float NEGINF = -__builtin_inff();
  float base0 = 0.f, base1 = 0.f;
  if constexpr (MODE != 0) {
    base0 = fmaf(slope2 * 64.f, (float)j, lanec); base1 = base0 + 32.f * slope2;
#pragma unroll
    for (int r = 0; r < 16; ++r) { p0[r] = fmaf(slope2, (float)ccol(r), p0[r]); p1[r] = fmaf(slope2, (float)ccol(r), p1[r]); }
  }
  if constexpr (MODE == 1) {
    const unsigned w0 = mw.x >> (4 * hi), w1 = mw.y >> (4 * hi);
#pragma unroll
    for (int r = 0; r < 16; ++r) {
      const int m0 = __builtin_amdgcn_sbfe(w0, ccol(r), 1), m1 = __builtin_amdgcn_sbfe(w1, ccol(r), 1);
      p0[r] = __uint_as_float((__float_as_uint(p0[r]) & (unsigned)m0) | (0xff800000u & ~(unsigned)m0));
      p1[r] = __uint_as_float((__float_as_uint(p1[r]) & (unsigned)m1) | (0xff800000u & ~(unsigned)m1));
    }
  }
  if constexpr (MODE == 2) {
    const bool sel = (bmw >> (j >> 2)) & 1u; if (!sel) { base0 = NEGINF; base1 = NEGINF; }
    if (j >= NT - 4) { const int thr0 = lanet - 64 * j, thr1 = thr0 - 32;
#pragma unroll
      for (int r = 0; r < 16; ++r) { p0[r] = (ccol(r) <= thr0) ? p0[r] : NEGINF; p1[r] = (ccol(r) <= thr1) ? p1[r] : NEGINF; }
    }
  }
  float mx0 = p0[0], mx1 = p1[0];
#pragma unroll
  for (int r = 1; r < 16; ++r) { mx0 = fmaxf(mx0, p0[r]); mx1 = fmaxf(mx1, p1[r]); }
  float pmax;
  if constexpr (MODE == 0) pmax = fmaxf(mx0, mx1); else pmax = fmaxf(mx0 + base0, mx1 + base1);
  { auto rr = __builtin_amdgcn_permlane32_swap(__float_as_uint(pmax), __float_as_uint(pmax), false, false);
    pmax = fmaxf(__uint_as_float(rr[0]), __uint_as_float(rr[1])); }
  float mn;
  if (__builtin_expect(__all(pmax - m_reg <= THR2), 1)) { mn = m_reg; alpha = 1.f; }
  else { mn = fmaxf(m_reg, pmax); alpha = __builtin_amdgcn_exp2f(m_reg - mn); m_reg = mn; }
  float sub0, sub1;
  if constexpr (MODE == 0) { sub0 = mn; sub1 = mn; } else { sub0 = mn - base0; sub1 = mn - base1; }
#pragma unroll
  for (int r = 0; r < 16; ++r) p0[r] = __builtin_amdgcn_exp2f(p0[r] - sub0);
  sub1_out = sub1;
}
__device__ __forceinline__ void finishSM(f32x16& p0, f32x16& p1, float sub1, float alpha, float& l_reg, bf16x8& pa0, bf16x8& pa1, bf16x8& pa2, bf16x8& pa3) {
#pragma unroll
  for (int r = 0; r < 16; ++r) p1[r] = __builtin_amdgcn_exp2f(p1[r] - sub1);
  float ps = 0;
#pragma unroll
  for (int r = 0; r < 16; ++r) ps += p0[r];
#pragma unroll
  for (int r = 0; r < 16; ++r) ps += p1[r];
  { auto rr = __builtin_amdgcn_permlane32_swap(__float_as_uint(ps), __float_as_uint(ps), false, false);
    ps = __uint_as_float(rr[0]) + __uint_as_float(rr[1]); }
  l_reg = l_reg * alpha + ps;
#define PK4(P, BASE, OUT) do { unsigned a0 = cvtpk(P[BASE + 0], P[BASE + 1]), a1 = cvtpk(P[BASE + 2], P[BASE + 3]);   \
    unsigned b0 = cvtpk(P[BASE + 4], P[BASE + 5]), b1 = cvtpk(P[BASE + 6], P[BASE + 7]);                              \
    auto r0 = __builtin_amdgcn_permlane32_swap(a0, b0, false, false); auto r1 = __builtin_amdgcn_permlane32_swap(a1, b1, false, false); \
    v4u w = {r0[0], r1[0], r0[1], r1[1]}; OUT = *reinterpret_cast<bf16x8*>(&w); } while (0)
  PK4(p0, 0, pa0); PK4(p0, 8, pa1); PK4(p1, 0, pa2); PK4(p1, 8, pa3);
#undef PK4
}
__device__ __forceinline__ void qkt(f32x16& p0, f32x16& p1, const LAS char* Ks, const LAS bf16x8* qs, int r32, int hi) {
  p0 = f32x16{}; p1 = f32x16{};
#pragma unroll
  for (int d0 = 0; d0 < 8; ++d0) { int cb = (d0 * 16 + hi * 8) * 2;
    bf16x8 b0 = *reinterpret_cast<const LAS bf16x8*>(Ks + KSWZ(r32, cb));
    bf16x8 b1 = *reinterpret_cast<const LAS bf16x8*>(Ks + KSWZ(32 + r32, cb));
    const bf16x8 q = qs[d0 * 64];
    p0 = __builtin_amdgcn_mfma_f32_32x32x16_bf16(b0, q, p0, 0, 0, 0);
    p1 = __builtin_amdgcn_mfma_f32_32x32x16_bf16(b1, q, p1, 0, 0, 0); }
}
__device__ __forceinline__ int v_st(int k, int c) { const int kk = (k & ~0xC) | ((k & 4) << 1) | ((k & 8) >> 1); return ((kk >> 3) * 4 + (c >> 5)) * 512 + ((kk & 7) * 32 + (c & 31)) * 2; }
__device__ __forceinline__ int v_rd_base(int lane) { return ((lane & 3) << 3) | (((lane >> 2) & 3) << 6) | (((lane >> 4) & 1) << 5) | (((lane >> 5) & 1) << 8); }
constexpr int v_rd_off(int d0, int ks, int half) { return d0 * 512 + ks * 4096 + half * 2048; }
template <int OFF> __device__ __forceinline__ s16x4 tr_read(int vb) {
  s16x4 r; asm volatile("ds_read_b64_tr_b16 %0, %1 offset:%2" : "=&v"(r) : "v"(vb), "i"(OFF) : "memory"); return r;
}
template <int D0> __device__ __forceinline__ void pv_one(f32x16& od, int vb, bf16x8 pa0, bf16x8 pa1, bf16x8 pa2, bf16x8 pa3) {
  const s16x4 l0 = tr_read<v_rd_off(D0, 0, 0)>(vb), h0 = tr_read<v_rd_off(D0, 0, 1)>(vb), l1 = tr_read<v_rd_off(D0, 1, 0)>(vb), h1 = tr_read<v_rd_off(D0, 1, 1)>(vb);
  const s16x4 l2 = tr_read<v_rd_off(D0, 2, 0)>(vb), h2 = tr_read<v_rd_off(D0, 2, 1)>(vb), l3 = tr_read<v_rd_off(D0, 3, 0)>(vb), h3 = tr_read<v_rd_off(D0, 3, 1)>(vb);
  asm volatile("s_waitcnt lgkmcnt(0)" ::: "memory"); SBAR();
#define PK(L, H) (bf16x8){L[0], L[1], L[2], L[3], H[0], H[1], H[2], H[3]}
  od = __builtin_amdgcn_mfma_f32_32x32x16_bf16(pa0, PK(l0, h0), od, 0, 0, 0);
  od = __builtin_amdgcn_mfma_f32_32x32x16_bf16(pa1, PK(l1, h1), od, 0, 0, 0);
  od = __builtin_amdgcn_mfma_f32_32x32x16_bf16(pa2, PK(l2, h2), od, 0, 0, 0);
  od = __builtin_amdgcn_mfma_f32_32x32x16_bf16(pa3, PK(l3, h3), od, 0, 0, 0);
#undef PK
}
__device__ __forceinline__ void pv_d0(f32x16* o, int vb, bf16x8 pa0, bf16x8 pa1, bf16x8 pa2, bf16x8 pa3) {
  pv_one<0>(o[0], vb, pa0, pa1, pa2, pa3); pv_one<1>(o[1], vb, pa0, pa1, pa2, pa3); pv_one<2>(o[2], vb, pa0, pa1, pa2, pa3); pv_one<3>(o[3], vb, pa0, pa1, pa2, pa3);
}

template <int MODE>
__device__ __forceinline__ void attn_unit(const GAS bf16* __restrict__ Qb, int ldq, const GAS bf16* __restrict__ Kh, const GAS bf16* __restrict__ Vh, int ldk, GAS bf16* __restrict__ Ob, int ldo,
                                          int NT, int qpos0, float slope2, const GAS unsigned* __restrict__ maskA, const GAS unsigned* __restrict__ blkm, LAS char* lds, const int tid) {
  const int wid = tid >> 6, lane = tid & 63, r32 = lane & 31, hi = lane >> 5;
  LAS char* V_lds = lds; LAS char* K_lds = lds + 2 * SHM_V;
  LAS float* ws = (LAS float*)(lds + 2 * SHM_V + 2 * SHM_K) + wid * 64; LAS float* li_l = ws; LAS float* al_l = ws + 32;
  float m_reg = -1e30f, l_reg = 0; f32x16 o[4] = {};
  LAS bf16x8* qr = (LAS bf16x8*)(lds + SHM_ATTN + wid * 8192) + lane;
  const int qrow = wid * QBLK + r32, qpos = qpos0 + qrow;
  unsigned bmw = 0; if constexpr (MODE == 2) { bmw = blkm[(unsigned)qrow * 6u]; asm volatile("" : "+v"(bmw)); }
  const GAS bf16* Qw = Qb + (unsigned)(qrow * ldq + hi * 8);
#pragma unroll
  for (int d0 = 0; d0 < 8; ++d0) qr[64 * d0] = *reinterpret_cast<const GAS bf16x8*>(Qw + d0 * 16);
  slope2 = __uint_as_float(__builtin_amdgcn_readfirstlane(__float_as_uint(slope2)));
  const float lanec = slope2 * (float)(4 * hi - qpos); const int lanet = qpos - 4 * hi;
  unsigned moff = 0; if constexpr (MODE == 1) moff = (unsigned)qpos * 1024u;
  const int sr = tid >> 4, sc = (tid & 15) * 8, vst0 = v_st(sr, sc), vst1 = v_st(32 + sr, sc);
  const int vb0 = (int)(uintptr_t)V_lds + v_rd_base(lane);
  struct { bf16x8 vs0, vs1, ks0, ks1; } sr_[SDEPTH];
  const unsigned so0 = (unsigned)(sr * ldk + sc) * 2u, so1 = so0 + (unsigned)(32 * ldk) * 2u, tstep_ = (unsigned)(64 * ldk) * 2u;
#define SLOAD(i, k0) do { const unsigned tb_ = (unsigned)((k0) >> 6) * tstep_; \
    sr_[i].vs0 = *reinterpret_cast<const GAS bf16x8*>((const GAS char*)Vh + (tb_ + so0)); sr_[i].vs1 = *reinterpret_cast<const GAS bf16x8*>((const GAS char*)Vh + (tb_ + so1)); \
    sr_[i].ks0 = *reinterpret_cast<const GAS bf16x8*>((const GAS char*)Kh + (tb_ + so0)); sr_[i].ks1 = *reinterpret_cast<const GAS bf16x8*>((const GAS char*)Kh + (tb_ + so1)); } while (0)
#define SWRITE(b, i) do { *(LAS bf16x8*)(V_lds + (b) * SHM_V + vst0) = sr_[i].vs0;          \
    *(LAS bf16x8*)(V_lds + (b) * SHM_V + vst1) = sr_[i].vs1; int kc = sc * 2;               \
    *(LAS bf16x8*)(K_lds + (b) * SHM_K + KSWZ(sr, kc)) = sr_[i].ks0;                       \
    *(LAS bf16x8*)(K_lds + (b) * SHM_K + KSWZ(32 + sr, kc)) = sr_[i].ks1; } while (0)
#define SWAIT() do { if constexpr (SDEPTH == 2) asm volatile("s_waitcnt vmcnt(4)" ::: "memory"); else asm volatile("s_waitcnt vmcnt(0)" ::: "memory"); } while (0)
#define RESC(a) do { if (__any((a) < 1.f)) { if (hi == 0) al_l[r32] = (a); asm volatile("s_waitcnt lgkmcnt(0)" ::: "memory"); \
    _Pragma("unroll") for (int d = 0; d < 4; ++d) _Pragma("unroll") for (int r = 0; r < 16; ++r) o[d][r] *= al_l[crow(r, hi)]; } } while (0)
  v2u mwA = {0u, 0u}, mwB = {0u, 0u};
#define MLOAD(dst, j) do { if constexpr (MODE == 1) dst = *reinterpret_cast<const GAS v2u*>((const GAS char*)maskA + (moff + 8u * (unsigned)(j))); } while (0)
#define PSM(P0, P1, AL, S1, J, MW) partialSM<MODE>(P0, P1, m_reg, AL, S1, J, NT, slope2, lanec, lanet, hi, MW, bmw)
  f32x16 pA0, pA1, pB0, pB1; float alA, alB, s1A, s1B; bf16x8 pa0, pa1, pa2, pa3;
  constexpr int SE = 0, SO = SDEPTH - 1;
  MLOAD(mwA, 0); MLOAD(mwB, 1);
  SLOAD(SE, 0); asm volatile("s_waitcnt vmcnt(0)" ::: "memory"); SWRITE(0, SE); __syncthreads();
  qkt(pA0, pA1, K_lds, qr, r32, hi); PSM(pA0, pA1, alA, s1A, 0, mwA);
  SLOAD(SO, KVBLK); if constexpr (SDEPTH == 2) { if (2 < NT) SLOAD(SE, 2 * KVBLK); }
  SWAIT(); SWRITE(1, SO); __syncthreads();
  for (int j = 1; j + 1 < NT; j += 2) {
    SBAR(); qkt(pB0, pB1, K_lds + SHM_K, qr, r32, hi);
    finishSM(pA0, pA1, s1A, alA, l_reg, pa0, pa1, pa2, pa3); SBAR();
    MLOAD(mwA, j + 1);
    SLOAD(SO, (j + SDEPTH) * KVBLK); SBAR();
    pv_d0(o, vb0, pa0, pa1, pa2, pa3); PSM(pB0, pB1, alB, s1B, j, mwB);
    __syncthreads(); SWAIT(); SWRITE(0, SE);
    RESC(alB); __syncthreads();
    SBAR(); qkt(pA0, pA1, K_lds, qr, r32, hi);
    finishSM(pB0, pB1, s1B, alB, l_reg, pa0, pa1, pa2, pa3); SBAR();
    if (j + 2 < NT) MLOAD(mwB, j + 2);
    if (SDEPTH == 1 || j + 3 < NT) SLOAD(SE, (j + 1 + SDEPTH) * KVBLK); SBAR();
    pv_d0(o, vb0 + (int)SHM_V, pa0, pa1, pa2, pa3); PSM(pA0, pA1, alA, s1A, j + 1, mwA);
    __syncthreads(); SWAIT(); SWRITE(1, SO);
    RESC(alA); __syncthreads();
  }
  SBAR(); qkt(pB0, pB1, K_lds + SHM_K, qr, r32, hi);
  finishSM(pA0, pA1, s1A, alA, l_reg, pa0, pa1, pa2, pa3); SBAR();
  pv_d0(o, vb0, pa0, pa1, pa2, pa3); PSM(pB0, pB1, alB, s1B, NT - 1, mwB);
  __syncthreads(); RESC(alB);
  finishSM(pB0, pB1, s1B, alB, l_reg, pa0, pa1, pa2, pa3); SBAR();
  pv_d0(o, vb0 + (int)SHM_V, pa0, pa1, pa2, pa3);
  if (hi == 0) li_l[r32] = l_reg; asm volatile("s_waitcnt lgkmcnt(0)" ::: "memory");
  float rli[16];
#pragma unroll
  for (int r = 0; r < 16; ++r) rli[r] = __builtin_amdgcn_rcpf(li_l[crow(r, hi)]);
  GAS bf16* Ow = Ob + (unsigned)(wid * QBLK * ldo);
#pragma unroll
  for (int r = 0; r < 16; ++r) { int orow = crow(r, hi);
#pragma unroll
    for (int d0 = 0; d0 < 4; ++d0) Ow[(unsigned)(orow * ldo + d0 * 32 + r32)] = (bf16)f2bf(o[d0][r] * rli[r] * ((DBG_ZERO_BR >> MODE) & 1 ? 0.f : 1.f)); }
  __syncthreads();
#undef SLOAD
#undef SWRITE
#undef SWAIT
#undef RESC
#undef MLOAD
#undef PSM
}
}

constexpr size_t MiB = 1u << 20;
constexpr size_t WS_CTL = 0, CTL_ZERO_BYTES = 1 * MiB;
constexpr size_t WS_INFO = 1 * MiB;
constexpr size_t WS_WA = 2 * MiB, WS_WC1 = 41 * MiB, WS_WC2 = 43 * MiB, WS_WUP = 44 * MiB, WS_WO = 52 * MiB, WS_W13 = 60 * MiB, WS_W2 = 188 * MiB, WS_WMEM = 252 * MiB, WS_WR = 256 * MiB;
constexpr size_t WS_MEMB = 257 * MiB, WS_MKV = 258 * MiB, WS_HB = 259 * MiB, WS_PROJ = 291 * MiB, WS_GATE = 351 * MiB, WS_XG = WS_GATE;
constexpr size_t WS_CQN = 447 * MiB, WS_CKVN = 455 * MiB, WS_KIDX = 459 * MiB, WS_WIDX = 460 * MiB, WS_KMEAN = 461 * MiB, WS_QAI = 462 * MiB, WS_KVA = 490 * MiB;
constexpr size_t WS_MASKA = 514 * MiB, WS_BLKM = 522 * MiB, WS_OATT = 523 * MiB, WS_MERGED = 555 * MiB, WS_PRE = 587 * MiB, WS_Y = WS_PRE, WS_X1 = 651 * MiB, WS_X1B = 715 * MiB;
constexpr size_t WS_ROUTE = 747 * MiB, WS_ROWMAP = 748 * MiB, WS_ROWW = 749 * MiB, WS_HID = 750 * MiB;
constexpr size_t WS_SC = WS_PRE;
constexpr size_t WDELTA = 772 * MiB;
constexpr size_t WS_END = 1024 * MiB;
__host__ __device__ constexpr size_t WD(int l) { return l ? WDELTA : 0; }
__host__ __device__ constexpr size_t WDR(int l) { return l ? 512 * 1024 : 0; }
constexpr int CW_TMO = 0;
constexpr int CW_BAR = 4096;
constexpr int CW_ECNT = 16384;
constexpr int CW_AQ = 20480;
constexpr int LDS_BYTES = 163840;
constexpr int MISC_OFF = LDS_BYTES - 256;

#define XB_TMO      128
#define XB_XCNT(j)  (256  + 64 * (j))
#define XB_XSUB(j)  (1280 + 64 * (j))
#define XB_XGEN(j)  (2304 + 64 * (j))
#define XB_TOP      3328
#define XB_TOPGEN   3392
#define XCD_BAR_WORDS 3456
#define XB_SPIN_CAP (1u << 22)
__device__ __forceinline__ unsigned xb_ld(unsigned* p)              { return __hip_atomic_load(p, __ATOMIC_RELAXED, __HIP_MEMORY_SCOPE_AGENT); }
__device__ __forceinline__ unsigned xb_add(unsigned* p, unsigned v) { return __hip_atomic_fetch_add(p, v, __ATOMIC_RELAXED, __HIP_MEMORY_SCOPE_AGENT); }
__device__ __forceinline__ unsigned xb_xcc_id() { return (unsigned)__builtin_amdgcn_s_getreg((3 << 11) | 20) & 0xFu; }
#define XB_SPIN(cond, bar) do { unsigned _sp = 0; while (cond) { __builtin_amdgcn_s_sleep(1); \
    if ((++_sp & 255u) == 0u) { if (xb_ld(&(bar)[XB_TMO])) break; if (_sp > XB_SPIN_CAP) { atomicAdd(&(bar)[XB_TMO], 1u); break; } } } } while (0)
__device__ __forceinline__ int lane_id() { int l; asm volatile("v_mbcnt_lo_u32_b32 %0, -1, 0\n\tv_mbcnt_hi_u32_b32 %0, -1, %0" : "=v"(l)); return l; }
struct XcdBarrier { unsigned* bar; unsigned x; volatile LAS unsigned* st; unsigned w0; };
__device__ __forceinline__ XcdBarrier xcd_barrier_post(unsigned* bar, volatile LAS unsigned* st, unsigned w0) {
    XcdBarrier b; b.bar = bar; b.x = xb_xcc_id(); b.st = st; b.w0 = w0;
    if (w0 && lane_id() == 0) (void)xb_add(&bar[XB_XCNT(b.x)], 1u);
    return b;
}
__device__ __forceinline__ void xcd_barrier_complete(unsigned* bar, unsigned x, unsigned& nloc, unsigned& nx) {
    const unsigned G = gridDim.x * gridDim.y * gridDim.z;
    unsigned sum, cnt, mine, sp = 0u;
    for (;;) {
        sum = 0u; cnt = 0u; mine = 0u;
#pragma unroll
        for (unsigned j = 0; j < 16; ++j) { const unsigned c = xb_ld(&bar[XB_XCNT(j)]); sum += c; cnt += (c > 0u) ? 1u : 0u; mine = (j == x) ? c : mine; }
        if (sum == G) break;
        __builtin_amdgcn_s_sleep(1);
        if ((++sp & 255u) == 0u) { if (xb_ld(&bar[XB_TMO])) break; if (sp > XB_SPIN_CAP) { atomicAdd(&bar[XB_TMO], 1u); break; } }
    }
    nloc = mine > 0u ? mine : 1u; nx = cnt > 0u ? cnt : 1u;
}
__device__ __forceinline__ void xcd_barrier(const XcdBarrier& b) {
    asm volatile("s_waitcnt vmcnt(0)" ::: "memory");
    __syncthreads();
    if (b.w0 && lane_id() == 0) {
        unsigned* bar = b.bar;
        __builtin_amdgcn_s_waitcnt(0);
        unsigned nloc = b.st[0], nx = b.st[1];
        if (nloc == 0u) { xcd_barrier_complete(bar, b.x, nloc, nx); b.st[0] = nloc; b.st[1] = nx; }
        const unsigned old = xb_add(&bar[XB_XSUB(b.x)], 1u);
        const unsigned gen = old / nloc;
        if (old + 1u == (gen + 1u) * nloc) {
            __builtin_amdgcn_fence(__ATOMIC_RELEASE, "agent");
            asm volatile("s_waitcnt vmcnt(0)" ::: "memory");
            const unsigned og = xb_add(&bar[XB_TOP], 1u);
            const unsigned tg = og / nx;
            if (og + 1u == (tg + 1u) * nx) xb_add(&bar[XB_TOPGEN], 1u);
            else XB_SPIN(xb_ld(&bar[XB_TOPGEN]) == tg, bar);
            __builtin_amdgcn_fence(__ATOMIC_ACQUIRE, "agent");
            xb_add(&bar[XB_XGEN(b.x)], 1u);
            asm volatile("s_waitcnt vmcnt(0)" ::: "memory");
        } else {
            XB_SPIN(xb_ld(&bar[XB_XGEN(b.x)]) == gen, bar);
            __builtin_amdgcn_fence(__ATOMIC_ACQUIRE, "agent");
            asm volatile("s_waitcnt vmcnt(0)" ::: "memory");
        }
    }
    __syncthreads();
}

struct Args { const float* in[28]; float* out; unsigned char* ws; int ph_lo, ph_hi; };
struct Frame {
    LAS unsigned char* lds; volatile LAS unsigned* MISC; gu32* ctl; int* info;
    int tid, lane, wave, G, bid;
    unsigned char* ws; size_t z;
};
enum { I_X = 0, I_MEM, I_WMEMKV, I_WIN, I_GCQ, I_GCKV, I_GKIDX, I_BKIDX, I_WUQ, I_WUQI, I_WUKV, I_WUPA, I_WUPB, I_WUPC, I_WGATE, I_BGATE, I_WO, I_LN1G, I_LN1B,
       I_WGRP, I_BGRP, I_WRT, I_BRT, I_W1, I_W3, I_W2, I_LN2G, I_LN2B };
#define WSP(T_, off) ((T_*)(F.ws + (off)))

template <int NWD>
__device__ __forceinline__ void transpose_item(const float* src, int ldw, bf16* dst, int ldk, LAS float* scr, int lane) {
    constexpr int ST = NWD + 1, KPI = 64 / NWD;
    float tv[NWD];
#pragma unroll
    for (int i = 0; i < NWD; ++i) { const int kk = KPI * i + lane / NWD; tv[i] = src[(size_t)kk * ldw + (lane % NWD)]; }
#pragma unroll
    for (int i = 0; i < NWD; ++i) { const int kk = KPI * i + lane / NWD; scr[kk * ST + (lane % NWD)] = tv[i]; }
    LDS_WAIT(); asm volatile("" ::: "memory");
    const int c = lane & 7;
#pragma unroll
    for (int j = 0; j < NWD / 8; ++j) { const int n = (lane >> 3) + 8 * j; const LAS float* s = scr + (8 * c) * ST + n;
        v4u o; o.x = pk2(s[0 * ST], s[1 * ST]); o.y = pk2(s[2 * ST], s[3 * ST]); o.z = pk2(s[4 * ST], s[5 * ST]); o.w = pk2(s[6 * ST], s[7 * ST]);
        *(GAS v4u*)(dst + (size_t)n * ldk + 8 * c) = o; }
    LDS_WAIT(); asm volatile("" ::: "memory");
}
constexpr int CONV_TOTAL = 32 * 229 + 176 + 32 * 192 + 8 * 24 + 8 * 32 + 4 * 48 + 2 * 12 * 64 + 8 * 64 + 32 * 64 + 3 * 32 * 512 + 1536;
__device__ __forceinline__ void conv_items(Frame& F, const Args& a, int l, int it_begin, int it_stride, int it_end) {
    LAS float* scr = (LAS float*)(F.lds + F.wave * 16384);
    const int lane = F.lane; const size_t wd = WD(l);
    bf16* WA = WSP(bf16, WS_WA + wd); bf16* WC1 = WSP(bf16, WS_WC1 + wd); bf16* WC2 = WSP(bf16, WS_WC2 + wd); bf16* WUP = WSP(bf16, WS_WUP + wd); bf16* WO = WSP(bf16, WS_WO + wd);
    bf16* W13 = WSP(bf16, WS_W13 + wd); bf16* W2T = WSP(bf16, WS_W2 + wd); float* WR = WSP(float, WS_WR + WDR(l));
    const float* w_in = (a.in[I_WIN] + F.z) + (size_t)l * 2048 * 3664; const float* w_gate = (a.in[I_WGATE] + F.z) + (size_t)l * 2048 * 6144;
    const float* w_uq = (a.in[I_WUQ] + F.z) + (size_t)l * 512 * 768; const float* w_uqi = (a.in[I_WUQI] + F.z) + (size_t)l * 512 * 1024; const float* w_ukv = (a.in[I_WUKV] + F.z) + (size_t)l * 256 * 1536;
    const float* w_upa = (a.in[I_WUPA] + F.z) + (size_t)l * 768 * 2048; const float* w_upb = (a.in[I_WUPB] + F.z) + (size_t)l * 768 * 2048; const float* w_upc = (a.in[I_WUPC] + F.z) + (size_t)l * 512 * 2048;
    const float* w_o = (a.in[I_WO] + F.z) + (size_t)l * 2048 * 2048;
    const float* w1 = (a.in[I_W1] + F.z) + (size_t)l * 32 * 2048 * 512; const float* w3 = (a.in[I_W3] + F.z) + (size_t)l * 32 * 2048 * 512; const float* w2 = (a.in[I_W2] + F.z) + (size_t)l * 32 * 512 * 2048;
    const float* w_grp = (a.in[I_WGRP] + F.z) + (size_t)l * 2048 * 4; const float* w_rt = (a.in[I_WRT] + F.z) + (size_t)l * 2048 * 32;
    constexpr int N_IN = 32 * 229, N_PAD = 176, N_GATE = 32 * 192, N_UQ = 8 * 24, N_UQI = 8 * 32, N_UKV = 4 * 48, N_UPA = 12 * 64, N_UPC = 8 * 64, N_O = 32 * 64, N_E = 32 * 512, N_R = 1536;
    constexpr int TOTAL = N_IN + N_PAD + N_GATE + N_UQ + N_UQI + N_UKV + 2 * N_UPA + N_UPC + N_O + 3 * N_E + N_R;
    static_assert(TOTAL == CONV_TOTAL, "conv item count");
    for (int it = it_begin; it < it_end; it += it_stride) {
        int r = it;
        const float* src = nullptr; bf16* dst = nullptr; int ldw = 0, ldk = 0, kind = 0;
        if (r < N_IN) { const int kb = r / 229, nb = r % 229, n0 = 16 * nb, k0 = 64 * kb, dr = n0 < 848 ? n0 : n0 + 176;
            src = w_in + (size_t)k0 * 3664 + n0; ldw = 3664; dst = WA + (size_t)dr * 2048 + k0; ldk = 2048; kind = 1; }
        else if ((r -= N_IN) < N_PAD) { kind = 2; }
        else if ((r -= N_PAD) < N_GATE) { const int kb = r / 192, nb = r % 192, n0 = 32 * nb, k0 = 64 * kb; src = w_gate + (size_t)k0 * 6144 + n0; ldw = 6144; dst = WA + (size_t)(3840 + n0) * 2048 + k0; ldk = 2048; }
        else if ((r -= N_GATE) < N_UQ) { const int kb = r / 24, nb = r % 24, n0 = 32 * nb, k0 = 64 * kb; src = w_uq + (size_t)k0 * 768 + n0; ldw = 768; dst = WC1 + (size_t)n0 * 512 + k0; ldk = 512; }
        else if ((r -= N_UQ) < N_UQI) { const int kb = r / 32, nb = r % 32, n0 = 32 * nb, k0 = 64 * kb; src = w_uqi + (size_t)k0 * 1024 + n0; ldw = 1024; dst = WC1 + (size_t)(768 + n0) * 512 + k0; ldk = 512; }
        else if ((r -= N_UQI) < N_UKV) { const int kb = r / 48, nb = r % 48, n0 = 32 * nb, k0 = 64 * kb; src = w_ukv + (size_t)k0 * 1536 + n0; ldw = 1536; dst = WC2 + (size_t)n0 * 256 + k0; ldk = 256; }
        else if ((r -= N_UKV) < N_UPA) { const int kb = r / 64, nb = r % 64, n0 = 32 * nb, k0 = 64 * kb; src = w_upa + (size_t)k0 * 2048 + n0; ldw = 2048; dst = WUP + (size_t)n0 * 2048 + k0; ldk = 2048; }
        else if ((r -= N_UPA) < N_UPA) { const int kb = r / 64, nb = r % 64, n0 = 32 * nb, k0 = 64 * kb; src = w_upb + (size_t)k0 * 2048 + n0; ldw = 2048; dst = WUP + (size_t)n0 * 2048 + 768 + k0; ldk = 2048; }
        else if ((r -= N_UPA) < N_UPC) { const int kb = r / 64, nb = r % 64, n0 = 32 * nb, k0 = 64 * kb; src = w_upc + (size_t)k0 * 2048 + n0; ldw = 2048; dst = WUP + (size_t)n0 * 2048 + 1536 + k0; ldk = 2048; }
        else if ((r -= N_UPC) < N_O) { const int kb = r / 64, nb = r % 64, n0 = 32 * nb, k0 = 64 * kb; src = w_o + (size_t)k0 * 2048 + n0; ldw = 2048; dst = WO + (size_t)n0 * 2048 + k0; ldk = 2048; }
        else if ((r -= N_O) < 2 * N_E) { const int which = r / N_E; r -= which * N_E; const int e = r / 512, q = r % 512, kb = q / 16, nb = q % 16, n0 = 32 * nb, k0 = 64 * kb;
            src = (which ? w3 : w1) + (size_t)e * 2048 * 512 + (size_t)k0 * 512 + n0; ldw = 512;
            const int dr = e * 1024 + (n0 >> 7) * 256 + (n0 & 127) + which * 128; dst = W13 + (size_t)dr * 2048 + k0; ldk = 2048; }
        else if ((r -= 2 * N_E) < N_E) { const int e = r / 512, q = r % 512, kb = q / 64, nb = q % 64, n0 = 32 * nb, k0 = 64 * kb;
            src = w2 + (size_t)e * 512 * 2048 + (size_t)k0 * 2048 + n0; ldw = 2048; dst = W2T + (size_t)(e * 2048 + n0) * 512 + k0; ldk = 512; }
        else { r -= N_E; kind = 3; }
        if (kind == 0) transpose_item<32>(src, ldw, dst, ldk, scr, lane);
        else if (kind == 1) transpose_item<16>(src, ldw, dst, ldk, scr, lane);
        else if (kind == 2) { GAS v4u* p = (GAS v4u*)(WA + (size_t)(848 + r) * 2048) + lane * 4; const v4u z = {0u, 0u, 0u, 0u}; p[0] = z; p[1] = z; p[2] = z; p[3] = z; }
        else { const int idx = r * 64 + lane, k = idx / 48, c = idx % 48; WR[idx] = c < 32 ? w_rt[k * 32 + c] : (c < 36 ? w_grp[k * 4 + (c - 32)] : 0.f); }
    }
}
__device__ __forceinline__ void conv_layer(Frame& F, const Args& a, int l) { conv_items(F, a, l, F.bid * 8 + F.wave, F.G * 8, CONV_TOTAL); }
__device__ __forceinline__ void prologue(Frame& F, const Args& a) {
    LAS float* scr = (LAS float*)(F.lds + F.wave * 16384);
    const int gw = F.bid * 8 + F.wave, NGW = F.G * 8, lane = F.lane;
    bf16* HB = WSP(bf16, WS_HB); bf16* MEMB = WSP(bf16, WS_MEMB); bf16* WMEM = WSP(bf16, WS_WMEM);
    const float* x = (a.in[I_X] + F.z); const float* mem = (a.in[I_MEM] + F.z); const float* wm = (a.in[I_WMEMKV] + F.z);
    const long NX8 = (long)T * DM / 8, NM8 = 256L * DM / 8;
    for (long i = (long)gw * 64 + lane; i < NX8 + NM8; i += (long)NGW * 64) {
        const bool inx = i < NX8; const long j = inx ? i : i - NX8; const float* s = (inx ? x : mem) + j * 8;
        f32x4 v0 = *(const GAS f32x4*)s, v1 = *(const GAS f32x4*)(s + 4);
#ifdef DBG_NOISE
        if (inx) {
#pragma unroll
            for (int q = 0; q < 4; ++q) { unsigned hh = (unsigned)(j * 8 + q) * 2654435761u; hh ^= hh >> 15; hh *= 2246822519u; hh ^= hh >> 13;
                v0[q] *= 1.f + DBG_NOISE * ((float)(hh & 0xffff) * (1.f / 65536.f) - 0.5f); v1[q] *= 1.f + DBG_NOISE * ((float)(hh >> 16) * (1.f / 65536.f) - 0.5f); } }
#endif
        v4u o; o.x = pk2(v0[0], v0[1]); o.y = pk2(v0[2], v0[3]); o.z = pk2(v1[0], v1[1]); o.w = pk2(v1[2], v1[3]);
        *(GAS v4u*)((inx ? HB : MEMB) + j * 8) = o;
    }
    for (int it = gw; it < 32 * 32; it += NGW) { const int kb = it / 32, nb = it % 32, n0 = 32 * nb, k0 = 64 * kb;
        transpose_item<32>(wm + (size_t)k0 * 1024 + n0, 1024, WMEM + (size_t)n0 * 2048 + k0, 2048, scr, lane); }
}

__device__ __forceinline__ void phase_norms(Frame& F, const Args& a, int l) {
    const int gw = F.bid * 8 + F.wave, NGW = F.G * 8, lane = F.lane;
    const bf16* PROJ = WSP(bf16, WS_PROJ); bf16* CQN = WSP(bf16, WS_CQN); bf16* CKVN = WSP(bf16, WS_CKVN); bf16* KIDX = WSP(bf16, WS_KIDX); float* WIDX = WSP(float, WS_WIDX); float* KMEAN = WSP(float, WS_KMEAN);
    const float* gcq = (a.in[I_GCQ] + F.z) + l * 512; const float* gckv = (a.in[I_GCKV] + F.z) + l * 256; const float* gk = (a.in[I_GKIDX] + F.z) + l * 64; const float* bk = (a.in[I_BKIDX] + F.z) + l * 64;
    for (int t = gw; t < T; t += NGW) {
        const bf16* row = PROJ + (size_t)t * NPROJ;
        { const v4u w = *(const GAS v4u*)(row + 8 * lane); float v[8] = {bflo(w.x), bfhi(w.x), bflo(w.y), bfhi(w.y), bflo(w.z), bfhi(w.z), bflo(w.w), bfhi(w.w)};
          float ss = 0.f;
#pragma unroll
          for (int j = 0; j < 8; ++j) ss += v[j] * v[j];
          const float rs = 1.0f / sqrtf(wave_sum(ss) * (1.f / 512.f) + LN_EPS);
          const f32x4 g0 = *(const GAS f32x4*)(gcq + 8 * lane), g1 = *(const GAS f32x4*)(gcq + 8 * lane + 4);
          v4u o; o.x = pk2(v[0] * rs * g0[0], v[1] * rs * g0[1]); o.y = pk2(v[2] * rs * g0[2], v[3] * rs * g0[3]); o.z = pk2(v[4] * rs * g1[0], v[5] * rs * g1[1]); o.w = pk2(v[6] * rs * g1[2], v[7] * rs * g1[3]);
          *(GAS v4u*)(CQN + (size_t)t * 512 + 8 * lane) = o; }
        { const v2u w = *(const GAS v2u*)(row + 512 + 4 * lane); float v[4] = {bflo(w.x), bfhi(w.x), bflo(w.y), bfhi(w.y)};
          float ss = (v[0] * v[0] + v[1] * v[1]) + (v[2] * v[2] + v[3] * v[3]);
          const float rs = 1.0f / sqrtf(wave_sum(ss) * (1.f / 256.f) + LN_EPS);
          const f32x4 g0 = *(const GAS f32x4*)(gckv + 4 * lane);
          v2u o; o.x = pk2(v[0] * rs * g0[0], v[1] * rs * g0[1]); o.y = pk2(v[2] * rs * g0[2], v[3] * rs * g0[3]);
          *(GAS v2u*)(CKVN + (size_t)t * 256 + 4 * lane) = o; }
        { const float v = bf2f(row[768 + lane]); const float mu = wave_sum(v) * (1.f / 64.f); const float d = v - mu; const float var = wave_sum(d * d) * (1.f / 64.f);
          KIDX[(size_t)t * 64 + lane] = (bf16)f2bf(d * (1.0f / sqrtf(var + LN_EPS)) * gk[lane] + bk[lane]); }
        if (lane < 16) WIDX[(size_t)t * 16 + lane] = bf2f(row[832 + lane]) * 0.25f;
    }
    for (int task = gw; task < 32 * 6; task += NGW) {
        const int n = task / 6, g = task % 6, rsub = lane >> 4, co = lane & 15;
        float s[8] = {0, 0, 0, 0, 0, 0, 0, 0};
#pragma unroll 16
        for (int i = 0; i < 64; ++i) { const v4u w = *(const GAS v4u*)(PROJ + (size_t)(n * 256 + 4 * i + rsub) * NPROJ + PJ_KB + g * 128 + 8 * co);
            s[0] += bflo(w.x); s[1] += bfhi(w.x); s[2] += bflo(w.y); s[3] += bfhi(w.y); s[4] += bflo(w.z); s[5] += bfhi(w.z); s[6] += bflo(w.w); s[7] += bfhi(w.w); }
#pragma unroll
        for (int j = 0; j < 8; ++j) { s[j] += __shfl_xor(s[j], 16); s[j] += __shfl_xor(s[j], 32); }
        if (rsub == 0) {
#pragma unroll
            for (int j = 0; j < 8; ++j) KMEAN[(size_t)n * 768 + g * 128 + 8 * co + j] = s[j] * (1.f / 256.f); }
    }
}

__device__ __forceinline__ void indexer_item(Frame& F, int item) {
    int tid = F.tid; asm volatile("" : "+v"(tid));
    const int lane = tid & 63, w = F.wave, hi = lane >> 5, kl = lane & 31;
    const bf16* QAI = WSP(bf16, WS_QAI); const bf16* KIDX = WSP(bf16, WS_KIDX); const float* WIDX = WSP(float, WS_WIDX); unsigned* MASKA = WSP(unsigned, WS_MASKA);
    const int t0 = item * 16, myq = t0 + 2 * w + hi;
    const GAS char* SCb = (const GAS char*)WSP(float, WS_SC); unsigned scoff; { const unsigned b_ = myq >> 6, r_ = myq & 63; scoff = (2048u * b_ * (b_ + 1u) + 64u * r_ * (b_ + 1u)) * 4u; }
    LAS unsigned char* reg = F.lds + (2 * w) * 8192;
    LAS unsigned char* myreg = reg + hi * 8192;
    LAS unsigned char* KST = F.lds + 131072;
    bf16x8 af[4];
    { const int rho = kl, qsel = (rho >> 2) & 1, head = (rho & 3) + 4 * (rho >> 3);
      const bf16* src = QAI + (size_t)(t0 + 2 * w + qsel) * NQAI + 768 + head * 64 + 8 * hi;
#pragma unroll
      for (int c = 0; c < 4; ++c) af[c] = *(const GAS bf16x8*)(src + 16 * c); }
    float wv[16];
    { const GAS f32x4* wp = (const GAS f32x4*)(WIDX + (size_t)myq * 16);
#pragma unroll
      for (int j = 0; j < 4; ++j) { const f32x4 v = wp[j]; wv[4 * j] = v[0]; wv[4 * j + 1] = v[1]; wv[4 * j + 2] = v[2]; wv[4 * j + 3] = v[3]; } }
    const int nch = (t0 + 16 + 63) >> 6;
    const int skey = tid >> 3, sch = tid & 7;
    const int sdst = skey * 128 + ((sch ^ ((skey >> 1) & 7)) << 4);
    int bstar = 0, nab = 0; bool allq = false;
#ifndef DBG_IDX_DUMMY
#define DBG_IDX_DUMMY 0
#endif
    {
        { const v4u z = {0u, 0u, 0u, 0u};
#pragma unroll
          for (int i = 0; i < 16; ++i) *(LAS v4u*)(reg + (i * 64 + lane) * 16) = z; }
        const GAS char* kgb = (const GAS char*)KIDX; const unsigned kgo = (unsigned)(skey * 64 + sch * 8) * 2u;
#define KG(c) (*(const GAS v4u*)(kgb + (kgo + (unsigned)(c) * 8192u)))
        v4u R0 = {0u, 0u, 0u, 0u}, R1 = R0;
        { const v4u k0 = KG(0); R1 = KG(1 < nch ? 1 : nch - 1); R0 = KG(2 < nch ? 2 : nch - 1); *(LAS v4u*)(KST + sdst) = k0; }
        __syncthreads();
        int fo[4];
#pragma unroll
        for (int c = 0; c < 4; ++c) fo[c] = kl * 128 + (((2 * c + hi) ^ ((kl >> 1) & 7)) << 4);
        f32x16 AC[2][2];
#define IDX_POST(P, MM) do { \
            _Pragma("unroll") for (int tile = 0; tile < 2; ++tile) { float ps[4] = {0.f, 0.f, 0.f, 0.f}; \
                _Pragma("unroll") for (int r = 0; r < 16; ++r) { const float av = AC[P][tile][r]; const int xi = __float_as_int(av); const float rl = __int_as_float(xi > 0 ? xi : 0); \
                    ps[r & 3] = fmaf(rl, wv[r], ps[r & 3]); } \
                const float score = (ps[0] + ps[1]) + (ps[2] + ps[3]); \
                const int row = 32 * tile + kl; const int key = 64 * (MM) + row; const bool valid = key <= myq; \
                const unsigned bits = __float_as_uint(score); const unsigned u = bits ^ ((unsigned)((int)bits >> 31) | 0x80000000u); const int bin = (int)(u >> 20); \
                *(GAS float*)(SCb + (scoff + 4u * (unsigned)key)) = score; \
                if (valid) __hip_atomic_fetch_add((LAS unsigned*)(myreg + ((bin >> 1) << 2)), 1u << ((bin & 1) << 4), __ATOMIC_RELAXED, __HIP_MEMORY_SCOPE_WORKGROUP); \
            } } while (0)
#define IDX_STEP(J, RW) do { const int mm_ = m + (J); if (mm_ < nch) { \
            const LAS unsigned char* kb_ = KST + ((J) & 1) * 8192; bf16x8 FR[2][4]; \
            _Pragma("unroll") for (int tile = 0; tile < 2; ++tile) _Pragma("unroll") for (int c = 0; c < 4; ++c) FR[tile][c] = *(const LAS bf16x8*)(kb_ + fo[c] + tile * 4096); \
            asm volatile("s_waitcnt lgkmcnt(0)" ::: "memory"); SBAR(); \
            AC[(J) & 1][0] = __builtin_amdgcn_mfma_f32_32x32x16_bf16(af[0], FR[0][0], f32x16{}, 0, 0, 0); AC[(J) & 1][1] = __builtin_amdgcn_mfma_f32_32x32x16_bf16(af[0], FR[1][0], f32x16{}, 0, 0, 0); \
            _Pragma("unroll") for (int c = 1; c < 4; ++c) { AC[(J) & 1][0] = __builtin_amdgcn_mfma_f32_32x32x16_bf16(af[c], FR[0][c], AC[(J) & 1][0], 0, 0, 0); \
                AC[(J) & 1][1] = __builtin_amdgcn_mfma_f32_32x32x16_bf16(af[c], FR[1][c], AC[(J) & 1][1], 0, 0, 0); } \
            SBAR(); \
            if (mm_ >= 1) IDX_POST(((J) + 1) & 1, mm_ - 1); \
            if (mm_ + 1 < nch) *(LAS v4u*)(KST + (((J) + 1) & 1) * 8192 + sdst) = RW; \
            RW = KG(mm_ + 3 < nch ? mm_ + 3 : nch - 1); \
            __syncthreads(); } } while (0)
        for (int m = 0; m < nch; m += 2) { IDX_STEP(0, R1); IDX_STEP(1, R0); }
        if ((nch - 1) & 1) IDX_POST(1, nch - 1); else IDX_POST(0, nch - 1);
#undef IDX_POST
#undef IDX_STEP
#undef KG
        {
            int bsq[2], nbq[2]; bool alq[2];
#pragma unroll
            for (int q = 0; q < 2; ++q) {
                const LAS unsigned* hw = (const LAS unsigned*)(reg + q * 8192) + 32 * lane;
                unsigned wd[32]; unsigned s = 0;
#pragma unroll
                for (int i = 0; i < 8; ++i) { const v4u v = *(const LAS v4u*)(hw + 4 * i); wd[4 * i] = v.x; wd[4 * i + 1] = v.y; wd[4 * i + 2] = v.z; wd[4 * i + 3] = v.w; }
#pragma unroll
                for (int i = 0; i < 32; ++i) s += (wd[i] & 0xffffu) + (wd[i] >> 16);
                unsigned v = s;
#pragma unroll
                for (int off = 1; off < 64; off <<= 1) { const unsigned tt = __shfl_down(v, off); if (lane + off < 64) v += tt; }
                const unsigned sufx = v - s; const unsigned total = __builtin_amdgcn_readfirstlane(v);
                int nbel = 0; int fn = (int)sufx; int cum = (int)sufx;
#pragma unroll
                for (int i = 31; i >= 0; --i) {
                    cum += (int)(wd[i] >> 16);     { const int mk = (cum - 256) >> 31; nbel -= mk; const int cm = cum & mk; fn = cm > fn ? cm : fn; }
                    cum += (int)(wd[i] & 0xffffu); { const int mk = (cum - 256) >> 31; nbel -= mk; const int cm = cum & mk; fn = cm > fn ? cm : fn; }
                }
                const int fb = 64 * lane + 63 - nbel;
                const unsigned long long bm = __ballot(sufx < 256u && v >= 256u);
                const int lstar = bm ? (int)__builtin_ctzll(bm) : 0;
                bsq[q] = __builtin_amdgcn_readlane(fb, lstar); nbq[q] = __builtin_amdgcn_readlane(fn, lstar); alq[q] = total <= 256u;
            }
            bstar = hi ? bsq[1] : bsq[0]; nab = hi ? nbq[1] : nbq[0]; allq = hi ? alq[1] : alq[0];
        }
        { const v4u z = {0u, 0u, 0u, 0u};
#pragma unroll
          for (int i = 0; i < 16; ++i) *(LAS v4u*)(reg + (i * 64 + lane) * 16) = z; }
        asm volatile("s_waitcnt vmcnt(0)" ::: "memory");
        { const int ntile = 2 * nch;
          for (int t8 = 0; t8 < ntile; t8 += 8) {
              float sv[8];
#pragma unroll
              for (int j = 0; j < 8; ++j) sv[j] = __builtin_nontemporal_load((const GAS float*)(SCb + (scoff + 4u * (unsigned)(32 * (t8 + j < ntile ? t8 + j : ntile - 1) + kl))));
#pragma unroll
              for (int j = 0; j < 8; ++j) if (t8 + j < ntile) {
                  const int key = 32 * (t8 + j) + kl; const bool valid = key <= myq; const float score = sv[j];
                  const unsigned bits = __float_as_uint(score); const unsigned u = bits ^ ((unsigned)((int)bits >> 31) | 0x80000000u); const int bin = (int)(u >> 20);
                  const bool above = valid && (allq || bin > bstar), cand = valid && !allq && bin == bstar;
                  const unsigned long long bal = __ballot(above);
                  if (kl == 0) *(LAS unsigned*)(myreg + 6144 + (t8 + j) * 4) = hi ? (unsigned)(bal >> 32) : (unsigned)bal;
                  if (__any(cand)) { if (cand) { const unsigned slot = __hip_atomic_fetch_add((LAS unsigned*)(myreg + 7168), 1u, __ATOMIC_RELAXED, __HIP_MEMORY_SCOPE_WORKGROUP);
                      if (slot < 768u) { v2u e; e.x = u; e.y = (unsigned)key; *(LAS v2u*)(myreg + slot * 8) = e; } } }
              } } }
        {
#pragma unroll
            for (int q = 0; q < 2; ++q) {
                LAS unsigned char* rq = reg + q * 8192;
                const int nbq_ = __builtin_amdgcn_readlane(nab, q * 32); const bool alq_ = __builtin_amdgcn_readlane((int)allq, q * 32) != 0;
                unsigned nc = *(LAS unsigned*)(rq + 7168); nc = nc > 768u ? 768u : nc; nc = __builtin_amdgcn_readfirstlane(nc);
                const int need = 256 - nbq_;
                if (!alq_ && nc > 0u) {
                    for (unsigned i0 = 0; i0 < nc; i0 += 64) { const unsigned i = i0 + lane; const bool act = i < nc;
                        v2u me = {0u, 0u}; if (act) me = *(LAS v2u*)(rq + i * 8);
                        int rank = 0;
                        unsigned j = 0;
                        for (; j + 4 <= nc; j += 4) { const v2u o0 = *(LAS v2u*)(rq + j * 8), o1 = *(LAS v2u*)(rq + j * 8 + 8), o2 = *(LAS v2u*)(rq + j * 8 + 16), o3 = *(LAS v2u*)(rq + j * 8 + 24);
                            rank += ((o0.x > me.x || (o0.x == me.x && o0.y < me.y)) ? 1 : 0) + ((o1.x > me.x || (o1.x == me.x && o1.y < me.y)) ? 1 : 0)
                                  + ((o2.x > me.x || (o2.x == me.x && o2.y < me.y)) ? 1 : 0) + ((o3.x > me.x || (o3.x == me.x && o3.y < me.y)) ? 1 : 0); }
                        for (; j < nc; ++j) { const v2u o = *(LAS v2u*)(rq + j * 8); rank += (o.x > me.x || (o.x == me.x && o.y < me.y)) ? 1 : 0; }
                        if (act && rank < need) __hip_atomic_fetch_or((LAS unsigned*)(rq + 6144 + ((me.y >> 5) << 2)), 1u << (me.y & 31u), __ATOMIC_RELAXED, __HIP_MEMORY_SCOPE_WORKGROUP);
                    }
                }
                LDS_WAIT();
                const v4u mrow = *(LAS v4u*)(rq + 6144 + lane * 16);
                *(GAS v4u*)(MASKA + (size_t)(t0 + 2 * w + q) * 256 + 4 * lane) = mrow;
            }
        }
    }
    __syncthreads();
}
__device__ __forceinline__ void phase_indexer(Frame& F) {
    for (int p = F.bid; p < 256; p += F.G) { indexer_item(F, 511 - p); indexer_item(F, p); }
}

__device__ __forceinline__ void phase_moba_gate(Frame& F) {
    const int gw = F.bid * 8 + F.wave, NGW = F.G * 8, lane = F.lane, n = lane & 31, half = lane >> 5;
    const bf16* PROJ = WSP(bf16, WS_PROJ); const float* KMEAN = WSP(float, WS_KMEAN); unsigned* BLKM = WSP(unsigned, WS_BLKM);
    for (int t = gw; t < T; t += NGW) {
        const int c = t >> 8;
        for (int h = 0; h < 6; ++h) {
            unsigned mask = 1u << c;
            if (c > 0) {
                const bf16* q = PROJ + (size_t)t * NPROJ + PJ_QB + h * 128 + 64 * half; const float* km = KMEAN + (size_t)n * 768 + h * 128 + 64 * half;
                float g = 0.f;
#pragma unroll
                for (int i = 0; i < 8; ++i) { const v4u qw = *(const GAS v4u*)(q + 8 * i); const f32x4 k0 = *(const GAS f32x4*)(km + 8 * i), k1 = *(const GAS f32x4*)(km + 8 * i + 4);
                    g += bflo(qw.x) * k0[0] + bfhi(qw.x) * k0[1] + bflo(qw.y) * k0[2] + bfhi(qw.y) * k0[3] + bflo(qw.z) * k1[0] + bfhi(qw.z) * k1[1] + bflo(qw.w) * k1[2] + bfhi(qw.w) * k1[3]; }
                g += __shfl_xor(g, 32);
                float val = (n < c) ? g : -__builtin_inff();
                for (int rnd = 0; rnd < 3; ++rnd) {
                    float mx = val;
#pragma unroll
                    for (int o = 1; o < 32; o <<= 1) mx = fmaxf(mx, __shfl_xor(mx, o));
                    if (!(mx > -__builtin_inff())) break;
                    const unsigned long long bm = __ballot(val == mx) & 0xffffffffull;
                    const int idx = (int)__builtin_ctzll(bm);
                    mask |= 1u << idx; if (n == idx) val = -__builtin_inff();
                }
            }
            if (lane == 0) BLKM[(size_t)t * 6 + h] = mask;
        }
    }
}

constexpr int CONV_IPQ = 64, CONV_NQ = (CONV_TOTAL + CONV_IPQ - 1) / CONV_IPQ;
__device__ __forceinline__ void phase_attention(Frame& F, const Args& a, int l, int rep) {
    const GAS bf16* PROJ = (const GAS bf16*)WSP(bf16, WS_PROJ); const GAS bf16* QAI = (const GAS bf16*)WSP(bf16, WS_QAI); const GAS bf16* KVA = (const GAS bf16*)WSP(bf16, WS_KVA); const GAS bf16* MKV = (const GAS bf16*)WSP(bf16, WS_MKV);
    GAS bf16* OATT = (GAS bf16*)WSP(bf16, WS_OATT); const GAS unsigned* MASKA = (const GAS unsigned*)WSP(unsigned, WS_MASKA); const GAS unsigned* BLKM = (const GAS unsigned*)WSP(unsigned, WS_BLKM);
    gu32* head = F.ctl + CW_AQ + 64 * l + 32 * rep;
    for (;;) {
        if (F.tid == 0) F.MISC[16] = __hip_atomic_fetch_add(head, 1u, RLX_AGENT);
        __syncthreads();
        const int i = __builtin_amdgcn_readfirstlane((int)F.MISC[16]);
        __syncthreads();
#ifndef DBG_CONV_IN_QUEUE
#define DBG_CONV_IN_QUEUE 1
#endif
        const int nconv = (DBG_CONV_IN_QUEUE && l + 1 < NLAYER) ? CONV_NQ : 0;
        if (i >= 512 + nconv) break;
        if (i >= 384 && i < 384 + nconv) { const int q = i - 384; const int e_ = (q + 1) * CONV_IPQ < CONV_TOTAL ? (q + 1) * CONV_IPQ : CONV_TOTAL;
            { size_t z_ = 0; asm volatile("" : "+s"(z_)); F.z = z_; F.ws = a.ws + z_; int t_ = F.tid; asm volatile("" : "+v"(t_)); F.lane = t_ & 63; }
            conv_items(F, a, l + 1, q * CONV_IPQ + F.wave, 8, e_); continue; }
        int mode, h, qb;
        if (i < 384) { qb = 31 - i / 12; const int k = i % 12; mode = k < 6 ? 1 : 2; h = k < 6 ? k : k - 6; } else { const int m = i - 384 - nconv; mode = 0; h = m & 3; qb = m >> 2; }
        const int qpos0 = qb * 256;
        int tl = F.tid; asm volatile("" : "+v"(tl));
#ifndef ATT_MODES
#define ATT_MODES 7
#endif
        if ((ATT_MODES & 2) && mode == 1) { const float sl = exp2f(-8.f * (float)(2 * h + 1) / 12.f) * LOG2E;
            att::attn_unit<1>(QAI + (size_t)qpos0 * NQAI + h * 128, NQAI, KVA + h * 128, KVA + 768 + h * 128, NKVA, OATT + (size_t)qpos0 * 2048 + h * 128, 2048, 4 * (qb + 1), qpos0, sl, MASKA, nullptr, (LAS char*)F.lds, tl); }
        else if ((ATT_MODES & 4) && mode == 2) { const float sl = exp2f(-8.f * (float)(2 * h + 2) / 12.f) * LOG2E;
            att::attn_unit<2>(PROJ + (size_t)qpos0 * NPROJ + PJ_QB + h * 128, NPROJ, PROJ + PJ_KB + h * 128, PROJ + PJ_VB + h * 128, NPROJ, OATT + (size_t)qpos0 * 2048 + 768 + h * 128, 2048, 4 * (qb + 1), qpos0, sl, nullptr, BLKM + (size_t)qpos0 * 6 + h, (LAS char*)F.lds, tl); }
        else if (ATT_MODES & 1) { att::attn_unit<0>(PROJ + (size_t)qpos0 * NPROJ + PJ_QC + h * 128, NPROJ, MKV + h * 128, MKV + 512 + h * 128, 1024, OATT + (size_t)qpos0 * 2048 + 1536 + h * 128, 2048, 4, qpos0, 0.f, nullptr, nullptr, (LAS char*)F.lds, tl); }
    }
}

__device__ __forceinline__ void phase_ln1_router(Frame& F, const Args& a, int l, int rep) {
    const int lane = F.lane, w = F.wave, tid = F.tid;
    const float* PRE = WSP(float, WS_PRE); float* X1 = WSP(float, WS_X1); bf16* X1B = WSP(bf16, WS_X1B); const float* WR = WSP(float, WS_WR + WDR(l)); int* ROUTE = WSP(int, WS_ROUTE);
    const float* g1 = (a.in[I_LN1G] + F.z) + l * 2048; const float* b1 = (a.in[I_LN1B] + F.z) + l * 2048; const float* bgrp = (a.in[I_BGRP] + F.z) + l * 4; const float* brt = (a.in[I_BRT] + F.z) + l * 32;
    gu32* ecnt = F.ctl + CW_ECNT + 64 * l;
    constexpr int XS = 2052;
    LAS float* xt = (LAS float*)F.lds; LAS float* part = (LAS float*)(F.lds + 16 * XS * 4); LAS float* lg = part + 8 * 16 * 48;
    for (int it = F.bid; it < T / 16; it += F.G) {
        const int t0 = it * 16;
#pragma unroll
        for (int i = 0; i < 2; ++i) {
            const int rl = 2 * w + i, t = t0 + rl;
            const GAS f32x4* xr = (const GAS f32x4*)(PRE + (size_t)t * 2048) + lane;
            f32x4 v[8]; float s = 0.f;
#pragma unroll
            for (int j = 0; j < 8; ++j) { v[j] = xr[64 * j]; s += (v[j].x + v[j].y) + (v[j].z + v[j].w); }
            const float mean = wave_sum(s) * (1.f / 2048.f); float s2 = 0.f;
#pragma unroll
            for (int j = 0; j < 8; ++j) { v[j] = v[j] - mean; s2 += (v[j].x * v[j].x + v[j].y * v[j].y) + (v[j].z * v[j].z + v[j].w * v[j].w); }
            const float rstd = 1.f / sqrtf(wave_sum(s2) * (1.f / 2048.f) + LN_EPS);
#pragma unroll
            for (int j = 0; j < 8; ++j) { const int col = 4 * lane + 256 * j; const f32x4 g = *(const GAS f32x4*)(g1 + col), b = *(const GAS f32x4*)(b1 + col);
                const f32x4 o = v[j] * rstd * g + b;
                *(GAS f32x4*)(X1 + (size_t)t * 2048 + col) = o; v2u ob; ob.x = pk2(o[0], o[1]); ob.y = pk2(o[2], o[3]); *(GAS v2u*)(X1B + (size_t)t * 2048 + col) = ob;
                *(LAS f32x4*)(xt + rl * XS + col) = o; }
        }
        __syncthreads();
        { f32x4 acc[3] = {{0, 0, 0, 0}, {0, 0, 0, 0}, {0, 0, 0, 0}};
          const int ar = lane & 15, kq = lane >> 4;
#pragma unroll 16
          for (int s = 0; s < 64; ++s) { const int k = 256 * w + 4 * s + kq; const float av = xt[ar * XS + k]; const float* wr = WR + (size_t)k * 48 + ar;
#pragma unroll
              for (int c = 0; c < 3; ++c) acc[c] = __builtin_amdgcn_mfma_f32_16x16x4f32(av, wr[16 * c], acc[c], 0, 0, 0); }
#pragma unroll
          for (int c = 0; c < 3; ++c)
#pragma unroll
              for (int r = 0; r < 4; ++r) part[(w * 16 + 4 * kq + r) * 48 + 16 * c + ar] = acc[c][r]; }
        __syncthreads();
        for (int e = tid; e < 16 * 48; e += 512) { float s = 0.f;
#pragma unroll
            for (int ww = 0; ww < 8; ++ww) s += part[ww * 16 * 48 + e]; lg[e] = s; }
        __syncthreads();
        if (tid < 16 && rep == 0) {
            const int t = t0 + tid; const LAS float* L = lg + tid * 48;
            float gl[4]; int gs = 0;
#pragma unroll
            for (int j = 0; j < 4; ++j) gl[j] = L[32 + j] + bgrp[j];
#pragma unroll
            for (int j = 1; j < 4; ++j) if (gl[j] > gl[gs]) gs = j;
            float den = 0.f;
#pragma unroll
            for (int j = 0; j < 4; ++j) den += expf(gl[j] - gl[gs]);
            const float pg = 1.f / den;
            float el[8];
#pragma unroll
            for (int j = 0; j < 8; ++j) el[j] = L[8 * gs + j] + brt[8 * gs + j];
            int i0 = 0;
#pragma unroll
            for (int j = 1; j < 8; ++j) if (el[j] > el[i0]) i0 = j;
            int i1 = (i0 == 0) ? 1 : 0;
#pragma unroll
            for (int j = 0; j < 8; ++j) if (j != i0 && el[j] > el[i1]) i1 = j;
            const float e1 = expf(el[i1] - el[i0]); const float w0 = pg / (1.f + e1), w1 = pg * e1 / (1.f + e1);
            const int x0 = 8 * gs + i0, x1 = 8 * gs + i1;
            const int p0 = (int)__hip_atomic_fetch_add(ecnt + x0, 1u, RLX_AGENT), p1 = (int)__hip_atomic_fetch_add(ecnt + x1, 1u, RLX_AGENT);
            int* R = ROUTE + (size_t)t * 8; R[0] = x0; R[1] = x1; R[2] = (int)__float_as_uint(w0); R[3] = (int)__float_as_uint(w1); R[4] = p0; R[5] = p1;
        }
        __syncthreads();
    }
}

__device__ __forceinline__ void phase_gather(Frame& F, int l) {
    const int lane = F.lane, tid = F.tid;
    gu32* ecnt = F.ctl + CW_ECNT + 64 * l; int* info = F.info + l * 256;
    const bf16* X1B = WSP(bf16, WS_X1B); bf16* XG = WSP(bf16, WS_XG); const int* ROUTE = WSP(int, WS_ROUTE); int* ROWMAP = WSP(int, WS_ROWMAP); float* ROWW = WSP(float, WS_ROWW);
    LAS int* off = (LAS int*)F.lds;
    if (tid == 0) { int o = 0;
#pragma nounroll
        for (int e = 0; e < 32; ++e) { off[e] = o; const int c = (int)__hip_atomic_load(ecnt + e, RLX_AGENT); const int nt = (c + 255) >> 8;
            if (F.bid == 0) {
#pragma nounroll
                for (int j = 0; j < nt; ++j) __hip_atomic_store(info + (o >> 8) + j, e, RLX_AGENT); }
            o += nt << 8; } off[32] = o; if (F.bid == 0) info[128] = o >> 8; }
    __syncthreads();
    for (int e = F.bid; e < 32; e += F.G) { const int c = (int)__hip_atomic_load(ecnt + e, RLX_AGENT); for (int r = off[e] + c + tid; r < off[e + 1]; r += 512) { ROWMAP[r] = -1; ROWW[r] = 0.f; } }
    const int gw = F.bid * 8 + F.wave, NGW = F.G * 8;
    for (int t = gw; t < T; t += NGW) {
        const int* R = ROUTE + (size_t)t * 8; const int e0 = R[0], e1 = R[1], p0 = R[4], p1 = R[5];
        const int d0 = off[e0] + p0, d1 = off[e1] + p1;
        const GAS v4u* src = (const GAS v4u*)(X1B + (size_t)t * 2048) + lane; GAS v4u* o0 = (GAS v4u*)(XG + (size_t)d0 * 2048) + lane; GAS v4u* o1 = (GAS v4u*)(XG + (size_t)d1 * 2048) + lane;
#pragma unroll
        for (int j = 0; j < 4; ++j) { const v4u v = src[64 * j]; o0[64 * j] = v; o1[64 * j] = v; }
        if (lane == 0) { ROWMAP[d0] = 2 * t; ROWMAP[d1] = 2 * t + 1; ROWW[d0] = __uint_as_float((unsigned)R[2]); ROWW[d1] = __uint_as_float((unsigned)R[3]); }
    }
    __syncthreads();
}

__device__ __forceinline__ void phase_ln2(Frame& F, const Args& a, int l, float* xout) {
    const int gw = F.bid * 8 + F.wave, NGW = F.G * 8, lane = F.lane;
    const float* X1 = WSP(float, WS_X1); const bf16* Y = WSP(bf16, WS_Y); bf16* HB = WSP(bf16, WS_HB);
    const float* g2 = (a.in[I_LN2G] + F.z) + l * 2048; const float* b2 = (a.in[I_LN2B] + F.z) + l * 2048;
    for (int t = gw; t < T; t += NGW) {
        const GAS f32x4* xr = (const GAS f32x4*)(X1 + (size_t)t * 2048) + lane; const GAS v2u* y0 = (const GAS v2u*)(Y + (size_t)(2 * t) * 2048) + lane; const GAS v2u* y1 = (const GAS v2u*)(Y + (size_t)(2 * t + 1) * 2048) + lane;
        f32x4 v[8]; float s = 0.f;
#pragma unroll
        for (int j = 0; j < 8; ++j) { const f32x4 xv = xr[64 * j]; const v2u a0 = y0[64 * j], a1 = y1[64 * j];
            v[j][0] = ALPHA * xv[0] + (bflo(a0.x) + bflo(a1.x)); v[j][1] = ALPHA * xv[1] + (bfhi(a0.x) + bfhi(a1.x)); v[j][2] = ALPHA * xv[2] + (bflo(a0.y) + bflo(a1.y)); v[j][3] = ALPHA * xv[3] + (bfhi(a0.y) + bfhi(a1.y));
            s += (v[j].x + v[j].y) + (v[j].z + v[j].w); }
        const float mean = wave_sum(s) * (1.f / 2048.f); float s2 = 0.f;
#pragma unroll
        for (int j = 0; j < 8; ++j) { v[j] = v[j] - mean; s2 += (v[j].x * v[j].x + v[j].y * v[j].y) + (v[j].z * v[j].z + v[j].w * v[j].w); }
        const float rstd = 1.f / sqrtf(wave_sum(s2) * (1.f / 2048.f) + LN_EPS);
#pragma unroll
        for (int j = 0; j < 8; ++j) { const int col = 4 * lane + 256 * j; const f32x4 g = *(const GAS f32x4*)(g2 + col), b = *(const GAS f32x4*)(b2 + col);
            const f32x4 o = v[j] * rstd * g + b;
            *(GAS f32x4*)(xout + (size_t)t * 2048 + col) = o; v2u ob; ob.x = pk2(o[0], o[1]); ob.y = pk2(o[2], o[3]); *(GAS v2u*)(HB + (size_t)t * 2048 + col) = ob; }
    }
}

#ifndef MK_PER_PHASE
#define MK_PER_PHASE 0
#endif
constexpr int NPHASE = 1 + 14 * NLAYER;
#ifndef PH_MASK
#define PH_MASK 0xFFFF
#endif
constexpr bool EN(int k) { return (PH_MASK >> k) & 1; }
#ifndef DBG_DOUBLE_MASK
#define DBG_DOUBLE_MASK 0
#endif
constexpr int REP(int k) { return ((DBG_DOUBLE_MASK >> k) & 1) ? 2 : 1; }
__global__ void __launch_bounds__(512, 2) fwd(Args a) {
    extern __shared__ __attribute__((aligned(16))) unsigned char lds_raw[];
    Frame F;
    F.lds = (LAS unsigned char*)lds_raw; F.MISC = (volatile LAS unsigned*)(F.lds + MISC_OFF);
    F.wave = __builtin_amdgcn_readfirstlane((int)threadIdx.x >> 6); F.lane = lane_id(); F.tid = F.wave * 64 + F.lane; F.G = gridDim.x; F.bid = blockIdx.x;
    F.z = 0; F.ws = a.ws; F.ctl = (gu32*)(F.ws + WS_CTL); F.info = (int*)(F.ws + WS_INFO);
    if (F.tid < 64) F.MISC[F.tid] = 0u;
    __syncthreads();
    XcdBarrier bar = xcd_barrier_post((unsigned*)(F.ctl + CW_BAR), F.MISC + 8, F.wave == 0 ? 1u : 0u);
    const int lo = a.ph_lo, hi = a.ph_hi;
#define ENTER() do { size_t z_ = 0; asm volatile("" : "+s"(z_)); F.z = z_; unsigned char* w_ = a.ws + z_; F.ws = w_; F.ctl = (gu32*)(w_ + WS_CTL); F.info = (int*)(w_ + WS_INFO); int wv_ = F.wave; asm volatile("" : "+s"(wv_)); int t_ = wv_ * 64 + lane_id(); asm volatile("" : "+v"(t_)); F.tid = t_; F.lane = t_ & 63; F.wave = wv_; } while (0)
#define IN(k) (lo <= (k) && (k) < hi)
#define SEAM(k) do { if (lo <= (k) && (k) + 1 < hi) xcd_barrier(bar); } while (0)
    if constexpr (EN(0)) if (IN(0)) for (int rep = 0; rep < REP(0); ++rep) { ENTER(); prologue(F, a); conv_layer(F, a, 0); } SEAM(0);
#pragma unroll
    for (int l = 0; l < NLAYER; ++l) {
        const int pb = 1 + 14 * l;

#if !DBG_CONV_IN_QUEUE
        if (IN(pb + 0)) { ENTER(); if (l > 0) conv_layer(F, a, l); } if (l > 0) SEAM(pb + 0);
#endif
        if constexpr (EN(1)) if (IN(pb + 1)) for (int rep = 0; rep < REP(1); ++rep) { ENTER();
            pg8::Gemm g{WSP(bf16, WS_HB), WSP(bf16, WS_WA + WD(l)), T, NA, DM, DM}; pg8::StaticOrder S; S.init(T, NA, F.G, F.bid);
            pg8::EpiA E; E.proj = WSP(bf16, WS_PROJ); E.gate = WSP(bf16, WS_GATE); E.bgate = (a.in[I_BGATE] + F.z) + l * 6144; E.qs = SM_SCALE * LOG2E;
            pg8::gemm_phase<pg8::EpiA, pg8::StaticOrder, true, true>(F.lds, g, S, E, F.tid);
            if (l == 0) { pg8::Gemm g2{WSP(bf16, WS_MEMB), WSP(bf16, WS_WMEM), 256, 1024, DM, DM}; pg8::StaticOrder S2; S2.init(256, 1024, F.G, F.G - 1 - F.bid);
                pg8::EpiScale E2; E2.O = WSP(bf16, WS_MKV); E2.ldc = 1024; E2.pn_a = 0; E2.sa = 1.f; E2.sb = 1.f;
                int t2_ = F.tid; asm volatile("" : "+v"(t2_));
                pg8::gemm_phase<pg8::EpiScale, pg8::StaticOrder, true, true>(F.lds, g2, S2, E2, t2_); }
        } SEAM(pb + 1);
        if constexpr (EN(2)) if (IN(pb + 2)) for (int rep = 0; rep < REP(2); ++rep) { ENTER(); phase_norms(F, a, l); } SEAM(pb + 2);
        if constexpr (EN(3)) if (IN(pb + 3)) for (int rep = 0; rep < REP(3); ++rep) { ENTER();
            { pg8::Gemm g{WSP(bf16, WS_CQN), WSP(bf16, WS_WC1 + WD(l)), T, NQAI, 512, 512}; pg8::StaticOrder S; S.init(T, NQAI, F.G, F.bid);
              pg8::EpiScale E; E.O = WSP(bf16, WS_QAI); E.ldc = NQAI; E.pn_a = 3; E.sa = SM_SCALE * LOG2E; E.sb = 0.125f;
              pg8::gemm_phase<pg8::EpiScale, pg8::StaticOrder, true, true>(F.lds, g, S, E, F.tid); }
            { pg8::Gemm g{WSP(bf16, WS_CKVN), WSP(bf16, WS_WC2 + WD(l)), T, NKVA, 256, 256}; pg8::StaticOrder S; S.init(T, NKVA, F.G, F.G - 1 - F.bid);
              pg8::EpiScale E; E.O = WSP(bf16, WS_KVA); E.ldc = NKVA; E.pn_a = 0; E.sa = 1.f; E.sb = 1.f;
              pg8::gemm_phase<pg8::EpiScale, pg8::StaticOrder, true, true>(F.lds, g, S, E, F.tid); }
        } SEAM(pb + 3);
        if constexpr (EN(4)) if (IN(pb + 4)) for (int rep = 0; rep < REP(4); ++rep) { ENTER(); if (rep == 0) phase_moba_gate(F); phase_indexer(F); } SEAM(pb + 4);
        if constexpr (EN(6)) if (IN(pb + 6)) for (int rep = 0; rep < REP(6); ++rep) { ENTER(); phase_attention(F, a, l, rep); } SEAM(pb + 6);
        if constexpr (EN(7)) if (IN(pb + 7)) for (int rep = 0; rep < REP(7); ++rep) { ENTER();
#ifdef DBG_UPTEST
            { pg8::Gemm g{WSP(bf16, WS_OATT), WSP(bf16, WS_WUP + WD(l)), T, DM, DM, DM}; pg8::StaticOrder S; S.init(T, DM, F.G, F.bid);
              pg8::EpiUp<0> E; E.gate = WSP(bf16, WS_GATE); E.O = WSP(bf16, WS_MERGED);
              pg8::gemm_phase<pg8::EpiUp<0>, pg8::StaticOrder, true, true>(F.lds, g, S, E, F.tid); }
#else
            { pg8::Gemm g{WSP(bf16, WS_OATT), WSP(bf16, WS_WUP + WD(l)), T, DM, 768, DM}; pg8::StaticOrder S; S.init(T, DM, F.G, F.bid);
              pg8::EpiUp<0> E; E.gate = WSP(bf16, WS_GATE); E.O = WSP(bf16, WS_MERGED);
              pg8::gemm_phase<pg8::EpiUp<0>, pg8::StaticOrder, true, true>(F.lds, g, S, E, F.tid); }
            { pg8::Gemm g{WSP(bf16, WS_OATT) + 768, WSP(bf16, WS_WUP + WD(l)) + 768, T, DM, 768, DM}; pg8::StaticOrder S; S.init(T, DM, F.G, F.bid);
              pg8::EpiUp<1> E; E.gate = WSP(bf16, WS_GATE); E.O = WSP(bf16, WS_MERGED);
              pg8::gemm_phase<pg8::EpiUp<1>, pg8::StaticOrder, true, true>(F.lds, g, S, E, F.tid); }
            { pg8::Gemm g{WSP(bf16, WS_OATT) + 1536, WSP(bf16, WS_WUP + WD(l)) + 1536, T, DM, 512, DM}; pg8::StaticOrder S; S.init(T, DM, F.G, F.bid);
              pg8::EpiUp<2> E; E.gate = WSP(bf16, WS_GATE); E.O = WSP(bf16, WS_MERGED);
              pg8::gemm_phase<pg8::EpiUp<2>, pg8::StaticOrder, true, true>(F.lds, g, S, E, F.tid); }
#endif
        } SEAM(pb + 7);
        if constexpr (EN(8)) if (IN(pb + 8)) for (int rep = 0; rep < REP(8); ++rep) { ENTER();
            pg8::Gemm g{WSP(bf16, WS_MERGED), WSP(bf16, WS_WO + WD(l)), T, DM, DM, DM}; pg8::StaticOrder S; S.init(T, DM, F.G, F.bid);
            pg8::EpiPre E; E.x = (l == 0) ? (a.in[I_X] + F.z) : (const float*)(a.out + F.z); E.pre = WSP(float, WS_PRE); E.alpha = ALPHA;
            pg8::gemm_phase<pg8::EpiPre, pg8::StaticOrder, true, true>(F.lds, g, S, E, F.tid);
        } SEAM(pb + 8);
        if constexpr (EN(9)) if (IN(pb + 9)) for (int rep = 0; rep < REP(9); ++rep) { ENTER(); phase_ln1_router(F, a, l, rep); } SEAM(pb + 9);
        if constexpr (EN(10)) if (IN(pb + 10)) for (int rep = 0; rep < REP(10); ++rep) { ENTER(); phase_gather(F, l); } SEAM(pb + 10);
        if constexpr (EN(11)) if (IN(pb + 11)) for (int rep = 0; rep < REP(11); ++rep) { ENTER();
            const int* info = F.info + l * 256; const int ntile = __builtin_amdgcn_readfirstlane(info[128]);
            pg8::Gemm g{WSP(bf16, WS_XG), WSP(bf16, WS_W13 + WD(l)), MPAD, 32 * 1024, DM, DM}; pg8::MoeOrder S; S.tile_e = info; S.ntile = ntile; S.nN = 4; S.G = F.G; S.c = F.bid;
            pg8::EpiMoeA E; E.hid = WSP(bf16, WS_HID);
            pg8::gemm_phase<pg8::EpiMoeA, pg8::MoeOrder, true, true>(F.lds, g, S, E, F.tid);
        } SEAM(pb + 11);
        if constexpr (EN(12)) if (IN(pb + 12)) for (int rep = 0; rep < REP(12); ++rep) { ENTER();
            const int* info = F.info + l * 256; const int ntile = __builtin_amdgcn_readfirstlane(info[128]);
            pg8::Gemm g{WSP(bf16, WS_HID), WSP(bf16, WS_W2 + WD(l)), MPAD, 32 * 2048, DEXP, DEXP}; pg8::MoeOrder S; S.tile_e = info; S.ntile = ntile; S.nN = 8; S.G = F.G; S.c = F.bid;
            pg8::EpiMoeB E; E.Y = WSP(bf16, WS_Y); E.rowmap = WSP(int, WS_ROWMAP); E.roww = WSP(float, WS_ROWW);
            pg8::gemm_phase<pg8::EpiMoeB, pg8::MoeOrder, true, true>(F.lds, g, S, E, F.tid);
        } SEAM(pb + 12);
        if constexpr (EN(13)) if (IN(pb + 13)) for (int rep = 0; rep < REP(13); ++rep) { ENTER(); phase_ln2(F, a, l, (a.out + F.z)); } if (l + 1 < NLAYER) SEAM(pb + 13);
    }
#ifdef DBG_EXTRA_BARRIERS
    for (int i = 0; i < DBG_EXTRA_BARRIERS; ++i) xcd_barrier(bar);
#endif
#undef IN
#undef SEAM
}


#ifdef DBG_STOP_PHASE
__global__ void dbg_dump(const unsigned char* ws, size_t off, int kind, long n, float* out, long nout) {
    for (long i = blockIdx.x * 256L + threadIdx.x; i < nout; i += gridDim.x * 256L) { const long j = i % n; float v;
        if (kind == 0) v = __builtin_bit_cast(float, (unsigned)((const unsigned short*)(ws + off))[j] << 16);
        else if (kind == 1) v = ((const float*)(ws + off))[j];
        else v = (float)(((const unsigned*)(ws + off))[j] & 0xffffu);
        out[i] = v; }
}
#endif
extern "C" void kernel_launch(void* const* d_in, const int* in_sizes, int n_in, void* d_out, int out_size, void* d_ws, size_t ws_size, hipStream_t stream) {
    static int grid = 0;
    if (grid == 0) {
        if (n_in != 28 || out_size != T * DM || ws_size < WS_END) { fprintf(stderr, "kernel_launch: unexpected shapes (n_in %d out %d ws %zu)\n", n_in, out_size, ws_size); grid = -1; return; }
        int dev = 0, cus = 0;
        if (hipGetDevice(&dev) != hipSuccess || hipDeviceGetAttribute(&cus, hipDeviceAttributeMultiprocessorCount, dev) != hipSuccess) { grid = -1; return; }
        if (hipFuncSetAttribute((const void*)fwd, hipFuncAttributeMaxDynamicSharedMemorySize, LDS_BYTES) != hipSuccess) { fprintf(stderr, "kernel_launch: hipFuncSetAttribute failed\n"); grid = -1; return; }
        int per_cu = 0;
        if (hipOccupancyMaxActiveBlocksPerMultiprocessor(&per_cu, (const void*)fwd, 512, LDS_BYTES) != hipSuccess || per_cu < 1) fprintf(stderr, "kernel_launch: occupancy query says %d\n", per_cu);
        (void)hipGetLastError();
        grid = cus;
    }
    if (grid < 0) return;
    if (hipMemsetAsync((char*)d_ws + WS_CTL, 0, CTL_ZERO_BYTES, stream) != hipSuccess) return;
    Args a{};
    for (int i = 0; i < 28; ++i) a.in[i] = (const float*)d_in[i];
    a.out = (float*)d_out; a.ws = (unsigned char*)d_ws;
#if defined(DBG_STOP_PHASE)
    for (int k = 0; k <= DBG_STOP_PHASE; ++k) { a.ph_lo = k; a.ph_hi = k + 1; hipLaunchKernelGGL(fwd, dim3(grid), dim3(512), LDS_BYTES, stream, a); }
    hipLaunchKernelGGL(dbg_dump, dim3(2048), dim3(256), 0, stream, (const unsigned char*)d_ws, (size_t)DBG_DUMP_OFF, DBG_DUMP_KIND, (long)DBG_DUMP_N, (float*)d_out, (long)out_size);
#elif MK_PER_PHASE
    for (int k = 0; k < NPHASE; ++k) { a.ph_lo = k; a.ph_hi = k + 1; hipLaunchKernelGGL(fwd, dim3(grid), dim3(512), LDS_BYTES, stream, a); }
#else
    a.ph_lo = 0; a.ph_hi = NPHASE;
    hipLaunchKernelGGL(fwd, dim3(grid), dim3(512), LDS_BYTES, stream, a);
#endif
    const hipError_t le = hipPeekAtLastError();
    if (le != hipSuccess) fprintf(stderr, "kernel_launch: launch failed: %s\n", hipGetErrorName(le));
}
```

```cpp
#define DBG_MIX_SCALE 1.0f
#define DBG_ZERO_BR 0
#define DBG_DOUBLE_MASK 0
#define DBG_TIME_MASK 0
#include <hip/hip_runtime.h>
#include <cstdio>
#include <cstdint>

#define GAS __attribute__((address_space(1)))
#define LAS __attribute__((address_space(3)))
typedef unsigned short bf16;
typedef unsigned v4u __attribute__((ext_vector_type(4)));
typedef unsigned v2u __attribute__((ext_vector_type(2)));
typedef float f32x4 __attribute__((ext_vector_type(4)));
typedef float f32x2 __attribute__((ext_vector_type(2)));
typedef float f32x16 __attribute__((ext_vector_type(16)));
typedef short bf16x8 __attribute__((ext_vector_type(8)));
typedef short s16x4 __attribute__((ext_vector_type(4)));
typedef GAS unsigned gu32;
#define RLX_AGENT __ATOMIC_RELAXED, __HIP_MEMORY_SCOPE_AGENT
#define LDS_WAIT() asm volatile("s_waitcnt lgkmcnt(0)" ::: "memory")
#define VM_WAIT() asm volatile("s_waitcnt vmcnt(0)" ::: "memory")
#define SBAR() __builtin_amdgcn_sched_barrier(0)

__device__ __forceinline__ unsigned f2bf(float f) { unsigned u = __builtin_bit_cast(unsigned, f); return (u + 0x7fffu + ((u >> 16) & 1u)) >> 16; }
__device__ __forceinline__ unsigned pk2(float lo, float hi) { return f2bf(lo) | (f2bf(hi) << 16); }
__device__ __forceinline__ float bf2f(unsigned b) { return __builtin_bit_cast(float, b << 16); }
__device__ __forceinline__ float bflo(unsigned w) { return __builtin_bit_cast(float, w << 16); }
__device__ __forceinline__ float bfhi(unsigned w) { return __builtin_bit_cast(float, w & 0xffff0000u); }
typedef __bf16 bf16x2_t __attribute__((ext_vector_type(2)));
__device__ __forceinline__ unsigned cvtpk(float lo, float hi) { f32x2 v = {lo, hi}; bf16x2_t b = __builtin_convertvector(v, bf16x2_t); return __builtin_bit_cast(unsigned, b); }
__device__ __forceinline__ float wave_sum(float v) {
#pragma unroll
    for (int o = 1; o < 64; o <<= 1) v += __shfl_xor(v, o);
    return v;
}

constexpr int T = 8192, DM = 2048, NLAYER = 2;
constexpr int NA = 9984;
constexpr int NPROJ = 3840, NGATE = 6144;
constexpr int PJ_QB = 1024, PJ_KB = 1792, PJ_VB = 2560, PJ_QC = 3328;
constexpr int NQAI = 1792;
constexpr int NKVA = 1536;
constexpr int NEXP = 32, DEXP = 512;
constexpr int MPAD = 24576;
constexpr float LN_EPS = 1e-5f;
constexpr float ALPHA = 1.4142135623730951f;
constexpr float SM_SCALE = 0.088388347648318440f;
constexpr float LOG2E = 1.4426950408889634f;
namespace pg8 {
#define PG8_LAS __attribute__((address_space(3)))
typedef unsigned short bf16_t;
typedef short bf16x8 __attribute__((ext_vector_type(8)));
typedef float f32x4 __attribute__((ext_vector_type(4)));
typedef unsigned u32x4 __attribute__((ext_vector_type(4)));
constexpr int BM = 256, BK = 64, HALF = 128, HTB = HALF * BK * 2  , STAGE_BYTES = 8 * HTB, NXCD = 8, WGM = 8;

__host__ __device__ __forceinline__ int lds_byte(int r, int c) { const int st = (r >> 4) * 2 + (c >> 5), rr = r & 15, cc = c & 31, ob = rr * 64 + cc * 2; return st * 1024 + (ob ^ (((ob >> 9) & 1) << 5)); }
__host__ __device__ __forceinline__ void stage_rc(int b, int& R, int& C) { const int st = b / 1024, sb = b % 1024, swz = sb ^ (((sb >> 9) & 1) << 5); R = (st >> 1) * 16 + swz / 64; C = (st & 1) * 32 + (swz % 64) / 2; }
__host__ __device__ __forceinline__ int perm32(int rho) { const int n = rho >> 4, i = rho & 15; return 8 * (i >> 2) + 4 * n + (i & 3); }

struct Unit { int pm, pn, kofs, nt, kind; };
struct Gemm { const bf16_t* A; const bf16_t* Bt; int M, N, K, ld; };

struct StaticOrder {
    int nM, nN, nwg, G, c;
    __host__ __device__ void init(int M, int N, int G_, int c_) { nM = M / BM; nN = N / BM; nwg = nM * nN; G = G_; c = c_; }
    __host__ __device__ bool next(int i, Unit& u) const {
        const long L = (long)i * G + c; if (L >= nwg) return false;
        int wgid = (int)L; { const int q = nwg / NXCD, r = nwg % NXCD, xcd = wgid % NXCD, off = wgid / NXCD; wgid = (xcd < r ? xcd * (q + 1) : r * (q + 1) + (xcd - r) * q) + off; }
        const int nig = WGM * nN, gid = wgid / nig, fm = gid * WGM, gsz = (nM - fm) < WGM ? (nM - fm) : WGM;
        u.pm = fm + ((wgid % nig) % gsz); u.pn = (wgid % nig) / gsz; return true;
    }
    __device__ __forceinline__ void a_ready(const Unit&) const {}
    __device__ __forceinline__ void done(const Unit&) const {}
};


__device__ __forceinline__ unsigned cvt_pk_bf16(float lo, float hi) { return ::cvtpk(lo, hi); }
__device__ __forceinline__ float sigmoidf_(float v) { return __builtin_amdgcn_rcpf(1.0f + __builtin_amdgcn_exp2f(-1.4426950408889634f * v)); }
__device__ __forceinline__ u32x4 pack8(const f32x4 v0, const f32x4 v1) { u32x4 w; w.x = cvt_pk_bf16(v0[0], v0[1]); w.y = cvt_pk_bf16(v0[2], v0[3]); w.z = cvt_pk_bf16(v1[0], v1[1]); w.w = cvt_pk_bf16(v1[2], v1[3]); return w; }
__device__ __forceinline__ void unpack8(const u32x4 w, f32x4& a, f32x4& b) {
    a[0] = __builtin_bit_cast(float, w.x << 16); a[1] = __builtin_bit_cast(float, w.x & 0xffff0000u); a[2] = __builtin_bit_cast(float, w.y << 16); a[3] = __builtin_bit_cast(float, w.y & 0xffff0000u);
    b[0] = __builtin_bit_cast(float, w.z << 16); b[1] = __builtin_bit_cast(float, w.z & 0xffff0000u); b[2] = __builtin_bit_cast(float, w.w << 16); b[3] = __builtin_bit_cast(float, w.w & 0xffff0000u); }
struct EpiBase { static constexpr bool PERM = true, AFTER_DRAIN = false, CHAIN = false, GATHER = false;
    __device__ __forceinline__ void unit_end(f32x4 (&)[2][2][4][2], const Unit&, int, int, int, int) const {} };

struct EpiA : EpiBase {
    bf16_t* proj; bf16_t* gate; const float* bgate; float qs;
    __device__ __forceinline__ void operator()(const f32x4 (&acc)[2][2][4][2], const Unit& u, int wr, int wc, int fr, int fq) const {
        const int row0 = u.pm * BM + wr * 64 + fr; const int colt = u.pn * BM + wc * 32 + 8 * fq;
        if (u.pn < 15) {
            const float s = ((u.pn >= 4 && u.pn < 7) || u.pn >= 13) ? qs : 1.0f;
#pragma unroll
            for (int ai = 0; ai < 2; ++ai)
#pragma unroll
                for (int m = 0; m < 4; ++m) { bf16_t* rowp = proj + (size_t)(row0 + ai * HALF + m * 16) * 3840 + colt;
#pragma unroll
                    for (int bj = 0; bj < 2; ++bj) *(u32x4*)(rowp + bj * HALF) = pack8(acc[ai][bj][m][0] * s, acc[ai][bj][m][1] * s); }
        } else {
            const int gc = colt - 3840;
            f32x4 bv[2][2];
#pragma unroll
            for (int bj = 0; bj < 2; ++bj)
#pragma unroll
                for (int n = 0; n < 2; ++n) bv[bj][n] = *(const f32x4*)(bgate + gc + bj * HALF + 4 * n);
#pragma unroll
            for (int ai = 0; ai < 2; ++ai)
#pragma unroll
                for (int m = 0; m < 4; ++m) {
                    bf16_t* tp = gate + ((size_t)((((u.pn - 15) >> 3) * 32 + u.pm) * 8 + ((u.pn - 15) & 7)) * 65536) + (size_t)((ai * 4 + m) * 2) * 4096 + (size_t)(((wr * 4 + wc) * 64 + fq * 16 + fr) * 8);
#pragma unroll
                    for (int bj = 0; bj < 2; ++bj) { f32x4 v0 = acc[ai][bj][m][0] + bv[bj][0], v1 = acc[ai][bj][m][1] + bv[bj][1];
#pragma unroll
                        for (int j = 0; j < 4; ++j) { v0[j] = sigmoidf_(v0[j]); v1[j] = sigmoidf_(v1[j]); }
                        *(u32x4*)(tp + bj * 4096) = pack8(v0, v1); } }
        }
    }
};
struct EpiScale : EpiBase {
    bf16_t* O; int ldc; int pn_a; float sa, sb;
    __device__ __forceinline__ void operator()(const f32x4 (&acc)[2][2][4][2], const Unit& u, int wr, int wc, int fr, int fq) const {
        const int row0 = u.pm * BM + wr * 64 + fr; const int colt = u.pn * BM + wc * 32 + 8 * fq; const float s = (u.pn < pn_a) ? sa : sb;
#pragma unroll
        for (int ai = 0; ai < 2; ++ai)
#pragma unroll
            for (int m = 0; m < 4; ++m) { bf16_t* rowp = O + (size_t)(row0 + ai * HALF + m * 16) * ldc + colt;
#pragma unroll
                for (int bj = 0; bj < 2; ++bj) *(u32x4*)(rowp + bj * HALF) = pack8(acc[ai][bj][m][0] * s, acc[ai][bj][m][1] * s); }
    }
};
template <int STEP> struct EpiUp : EpiBase {
    const bf16_t* gate; bf16_t* O;
    __device__ __forceinline__ void operator()(const f32x4 (&acc)[2][2][4][2], const Unit& u, int wr, int wc, int fr, int fq) const {
        const int row0 = u.pm * BM + wr * 64 + fr; const int colt = u.pn * BM + wc * 32 + 8 * fq;
#pragma unroll
        for (int ai = 0; ai < 2; ++ai)
#pragma unroll
            for (int m = 0; m < 4; ++m) { const size_t r = (size_t)(row0 + ai * HALF + m * 16);
#pragma unroll
                for (int bj = 0; bj < 2; ++bj) { const u32x4 wg = *(const u32x4*)(gate + r * 6144 + STEP * 2048 + colt + bj * HALF); f32x4 g0, g1; unpack8(wg, g0, g1);
                    f32x4 v0 = acc[ai][bj][m][0] * g0, v1 = acc[ai][bj][m][1] * g1;
                    if constexpr (STEP > 0) { const u32x4 wp = __builtin_nontemporal_load((const u32x4*)(O + r * 2048 + colt + bj * HALF)); f32x4 p0, p1; unpack8(wp, p0, p1); v0 += p0; v1 += p1; }
                    *(u32x4*)(O + r * 2048 + colt + bj * HALF) = pack8(v0, v1); } }
    }
};
struct EpiPre : EpiBase {
    const float* x; float* pre; float alpha;
    __device__ __forceinline__ void operator()(const f32x4 (&acc)[2][2][4][2], const Unit& u, int wr, int wc, int fr, int fq) const {
        const int row0 = u.pm * BM + wr * 64 + fr; const int colt = u.pn * BM + wc * 32 + 8 * fq;
#pragma unroll
        for (int ai = 0; ai < 2; ++ai)
#pragma unroll
            for (int m = 0; m < 4; ++m) { const size_t off = (size_t)(row0 + ai * HALF + m * 16) * 2048 + colt;
#pragma unroll
                for (int bj = 0; bj < 2; ++bj)
#pragma unroll
                    for (int n = 0; n < 2; ++n) { const f32x4 xv = *(const f32x4*)(x + off + bj * HALF + 4 * n); *(f32x4*)(pre + off + bj * HALF + 4 * n) = xv * alpha + acc[ai][bj][m][n]; } }
    }
};
struct EpiPreB : EpiBase {
    const bf16_t* xb; bf16_t* pre; float alpha;
    __device__ __forceinline__ void operator()(const f32x4 (&acc)[2][2][4][2], const Unit& u, int wr, int wc, int fr, int fq) const {
        const int row0 = u.pm * BM + wr * 64 + fr; const int colt = u.pn * BM + wc * 32 + 8 * fq;
#pragma unroll
        for (int ai = 0; ai < 2; ++ai) {
            u32x4 xw[4][2];
#pragma unroll
            for (int m = 0; m < 4; ++m)
#pragma unroll
                for (int bj = 0; bj < 2; ++bj) xw[m][bj] = *(const u32x4*)(xb + (size_t)(row0 + ai * HALF + m * 16) * 2048 + colt + bj * HALF);
            asm volatile("" : "+v"(xw[0][0]), "+v"(xw[0][1]), "+v"(xw[1][0]), "+v"(xw[1][1]), "+v"(xw[2][0]), "+v"(xw[2][1]), "+v"(xw[3][0]), "+v"(xw[3][1]));
#pragma unroll
            for (int m = 0; m < 4; ++m) { const size_t off = (size_t)(row0 + ai * HALF + m * 16) * 2048 + colt;
#pragma unroll
                for (int bj = 0; bj < 2; ++bj) { f32x4 x0, x1; unpack8(xw[m][bj], x0, x1);
                    *(u32x4*)(pre + off + bj * HALF) = pack8(x0 * alpha + acc[ai][bj][m][0], x1 * alpha + acc[ai][bj][m][1]); } } }
    }
};
struct EpiMoeA : EpiBase {
    static constexpr bool GATHER = true;
    bf16_t* hid; const int* rowsrc;
    __device__ __forceinline__ void operator()(const f32x4 (&acc)[2][2][4][2], const Unit& u, int wr, int wc, int fr, int fq) const {
        const int row0 = u.pm * BM + wr * 64 + fr; const int hc = (u.pn & 3) * 128 + wc * 32 + 8 * fq;
#pragma unroll
        for (int ai = 0; ai < 2; ++ai)
#pragma unroll
            for (int m = 0; m < 4; ++m) { f32x4 h0, h1;
#pragma unroll
                for (int j = 0; j < 4; ++j) { const float a0 = acc[ai][0][m][0][j], a1 = acc[ai][0][m][1][j]; h0[j] = a0 * sigmoidf_(a0) * acc[ai][1][m][0][j]; h1[j] = a1 * sigmoidf_(a1) * acc[ai][1][m][1][j]; }
                *(u32x4*)(hid + (size_t)(row0 + ai * HALF + m * 16) * 512 + hc) = pack8(h0, h1); }
    }
};
struct EpiMoeB : EpiBase {
    bf16_t* Y; const int* rowmap; const float* roww;
    __device__ __forceinline__ void operator()(const f32x4 (&acc)[2][2][4][2], const Unit& u, int wr, int wc, int fr, int fq) const {
        const int row0 = u.pm * BM + wr * 64 + fr; const int colt = (u.pn & 7) * BM + wc * 32 + 8 * fq;
        int dstv[8]; float wv8[8];
#pragma unroll
        for (int g = 0; g < 8; ++g) { const int rg = row0 + (g >> 2) * HALF + (g & 3) * 16; dstv[g] = rowmap[rg]; wv8[g] = roww[rg]; }
        asm volatile("" : "+v"(dstv[0]), "+v"(dstv[1]), "+v"(dstv[2]), "+v"(dstv[3]), "+v"(dstv[4]), "+v"(dstv[5]), "+v"(dstv[6]), "+v"(dstv[7]));
#pragma unroll
        for (int ai = 0; ai < 2; ++ai)
#pragma unroll
            for (int m = 0; m < 4; ++m) { const int dst = dstv[ai * 4 + m]; const float w = wv8[ai * 4 + m];
                if (dst >= 0) {
#pragma unroll
                    for (int bj = 0; bj < 2; ++bj) *(u32x4*)(Y + (size_t)dst * 2048 + colt + bj * HALF) = pack8(acc[ai][bj][m][0] * w, acc[ai][bj][m][1] * w); } }
    }
};
struct MoeOrder {
    const int* tile_e; int m_lo, m_cnt, nN, G, c;
    __device__ __forceinline__ bool next(int i, Unit& u) const {
        const int L = i * G + c; if (c < 0 || c >= G || L >= m_cnt * nN) return false;
        const int ml = L / nN, nl = L - ml * nN, mt = m_lo + ml; u.pm = mt; u.pn = tile_e[mt] * nN + nl; return true; }
    __device__ __forceinline__ void a_ready(const Unit&) const {}
    __device__ __forceinline__ void done(const Unit&) const {}
};


struct EpiUpChain : EpiBase {
    static constexpr bool CHAIN = true;
    const bf16_t* gate; bf16_t* O;
    __device__ __forceinline__ void unit_end(f32x4 (&acc)[2][2][4][2], const Unit& u, int wr, int wc, int fr, int fq) const {
        const int row0 = u.pm * BM + wr * 64 + fr; const int colt = u.pn * BM + wc * 32 + 8 * fq;
        const int gnum = (u.kind == 0) ? 0 : ((u.kind == 1) ? 2048 : 4096); const bool fin = u.kind == 2; const int dofs = fin ? 0 : 2048;
#pragma unroll
        for (int ai = 0; ai < 2; ++ai) {
            u32x4 wn[4][2], wd[4][2];
#pragma unroll
            for (int m = 0; m < 4; ++m) { const bf16_t* gp = gate + ((size_t)(((gnum >> 11) * 32 + u.pm) * 8 + u.pn) * 65536) + (size_t)((ai * 4 + m) * 2) * 4096 + (size_t)(((wr * 4 + wc) * 64 + fq * 16 + fr) * 8);
#pragma unroll
                for (int bj = 0; bj < 2; ++bj) { asm volatile("global_load_dwordx4 %0, %1, off" : "=v"(wn[m][bj]) : "v"(gp + bj * 4096) : "memory");
                                                 asm volatile("global_load_dwordx4 %0, %1, off" : "=v"(wd[m][bj]) : "v"(gp + (fin ? (size_t)0 : (size_t)(32 * 8) * 65536) + bj * 4096) : "memory"); } }
            asm volatile("s_waitcnt vmcnt(0)" : "+v"(wn[0][0]), "+v"(wn[0][1]), "+v"(wn[1][0]), "+v"(wn[1][1]), "+v"(wn[2][0]), "+v"(wn[2][1]), "+v"(wn[3][0]), "+v"(wn[3][1]),
                                                 "+v"(wd[0][0]), "+v"(wd[0][1]), "+v"(wd[1][0]), "+v"(wd[1][1]), "+v"(wd[2][0]), "+v"(wd[2][1]), "+v"(wd[3][0]), "+v"(wd[3][1]) :: "memory");
#pragma unroll
            for (int m = 0; m < 4; ++m) { const size_t r = (size_t)(row0 + ai * HALF + m * 16);
#pragma unroll
                for (int bj = 0; bj < 2; ++bj) { f32x4 n0, n1; unpack8(wn[m][bj], n0, n1);
                    if (fin) { *(u32x4*)(O + r * 2048 + colt + bj * HALF) = pack8(acc[ai][bj][m][0] * n0, acc[ai][bj][m][1] * n1); acc[ai][bj][m][0] = (f32x4){0.f, 0.f, 0.f, 0.f}; acc[ai][bj][m][1] = (f32x4){0.f, 0.f, 0.f, 0.f}; }
                    else { f32x4 d0, d1; unpack8(wd[m][bj], d0, d1);
#pragma unroll
                        for (int j = 0; j < 4; ++j) { acc[ai][bj][m][0][j] *= n0[j] * __builtin_amdgcn_rcpf(fmaxf(d0[j], 1e-30f)); acc[ai][bj][m][1][j] *= n1[j] * __builtin_amdgcn_rcpf(fmaxf(d1[j], 1e-30f)); } } }
                asm volatile("" : "+v"(acc[ai][0][m][0]), "+v"(acc[ai][0][m][1]), "+v"(acc[ai][1][m][0]), "+v"(acc[ai][1][m][1])); }
            asm volatile("" ::: "memory"); }
    }
    __device__ __forceinline__ void operator()(const f32x4 (&)[2][2][4][2], const Unit&, int, int, int, int) const {}
};
struct UpOrder {
    StaticOrder so;
    __device__ __forceinline__ bool next(int i, Unit& u) const { const int ti = i / 3, x = i - 3 * ti; if (!so.next(ti, u)) return false;
        u.kofs = x * 768 * 2; u.nt = (x == 2) ? 8 : 12; u.kind = x; return true; }
    __device__ __forceinline__ void a_ready(const Unit&) const {}
    __device__ __forceinline__ void done(const Unit&) const {}
};
template <class Epi, class Sched, bool ALIGN_EPI = false, bool SP2 = false>
__device__ __forceinline__ void gemm_phase(PG8_LAS unsigned char* lds, const Gemm g, const Sched& S, const Epi& E, const int tid) {
    const int wid = __builtin_amdgcn_readfirstlane(tid >> 6), lane = tid & 63, wr = wid >> 2, wc = wid & 3, fr = lane & 15, fq = lane >> 4;
    const int K = g.ld, nt = g.K / BK;
    unsigned voffA[2], voffB[2];
#pragma unroll
    for (int i = 0; i < 2; ++i) { int R, C; stage_rc(tid * 16 + i * 8192, R, C); const int Rb = Epi::PERM ? ((R & ~31) + perm32(R & 31)) : R;
        voffA[i] = (unsigned)(R * K + C) * 2u; voffB[i] = (unsigned)(Rb * K + C) * 2u; }
    int gR[2], gC2[2];
#pragma unroll
    for (int i = 0; i < 2; ++i) { int R, C; stage_rc(tid * 16 + i * 8192, R, C); gR[i] = R; gC2[i] = C * 2; }
    unsigned vAc[2][2], vAn[2][2];
#define PG8_GVOFF(dst, pm_) do { if constexpr (Epi::GATHER) { _Pragma("unroll") for (int h_ = 0; h_ < 2; ++h_) _Pragma("unroll") for (int i_ = 0; i_ < 2; ++i_) { \
        const int s_ = E.rowsrc[(pm_) * BM + h_ * HALF + gR[i_]]; const unsigned tok_ = s_ < 0 ? 0u : (unsigned)s_ >> 1; dst[h_][i_] = tok_ * (unsigned)(K * 2) + (unsigned)gC2[i_]; } } } while (0)
    const size_t kstep = (size_t)(BK * 2);
    const size_t hstep = (size_t)HALF * K * 2;
    const size_t tstep = 2 * hstep;
    const unsigned ldsw = (unsigned)wid * 1024u;
    const int aoff = lds_byte(wr * 64 + fr, fq * 8), boff = lds_byte(wc * 32 + fr, fq * 8);
#define PG8_SA(b, h) (((b) * 2 + (h)) * HTB)
#define PG8_SB(b, h) ((4 + (b) * 2 + (h)) * HTB)
#define PG8_STAGE(bufoff, gbase, voff) do { _Pragma("unroll") for (int _i = 0; _i < 2; ++_i) \
        __builtin_amdgcn_global_load_lds((const unsigned*)((const char*)(gbase) + (voff)[_i]), (PG8_LAS unsigned*)(lds + (bufoff) + ldsw + _i * 8192), 16, 0, 0); } while (0)
#define PG8_STAGE_A(bufoff, kp, h, nx) do { if constexpr (Epi::GATHER) { unsigned vs_[2] = {(nx) ? vAn[h][0] : vAc[h][0], (nx) ? vAn[h][1] : vAc[h][1]}; PG8_STAGE(bufoff, kp, vs_); } \
        else { PG8_STAGE(bufoff, (kp) + (h) * hstep, voffA); } } while (0)
#define PG8_LDA(dst, b, h) do { _Pragma("unroll") for (int m = 0; m < 4; ++m) _Pragma("unroll") for (int k = 0; k < 2; ++k) dst[m][k] = *(const PG8_LAS bf16x8*)(lds + PG8_SA(b, h) + aoff + m * 2048 + k * 1024); } while (0)
#define PG8_LDB(dst, b, h) do { _Pragma("unroll") for (int n = 0; n < 2; ++n) _Pragma("unroll") for (int k = 0; k < 2; ++k) dst[n][k] = *(const PG8_LAS bf16x8*)(lds + PG8_SB(b, h) + boff + n * 2048 + k * 1024); } while (0)
#define PG8_MMA(ai, bj, At, Bt) do { __builtin_amdgcn_s_setprio(1); _Pragma("unroll") for (int m = 0; m < 4; ++m) _Pragma("unroll") for (int n = 0; n < 2; ++n) _Pragma("unroll") for (int k = 0; k < 2; ++k) \
        acc[ai][bj][m][n] = __builtin_amdgcn_mfma_f32_16x16x32_bf16(Bt[n][k], At[m][k], acc[ai][bj][m][n], 0, 0, 0); __builtin_amdgcn_s_setprio(0); } while (0)
#define PG8_WAIT_V(n) asm volatile("s_waitcnt vmcnt(" #n ")" ::: "memory")
#define PG8_WAIT_L(n) asm volatile("s_waitcnt lgkmcnt(" #n ")" ::: "memory")
#define PG8_BAR __builtin_amdgcn_s_barrier()
#define PG8_SCHED __builtin_amdgcn_sched_barrier(0)
    Unit cur, nxt; int ui = 0;
    if (!S.next(0, cur)) return;
    f32x4 acc[2][2][4][2];
#pragma unroll
    for (int a = 0; a < 2; ++a)
#pragma unroll
        for (int b = 0; b < 2; ++b)
#pragma unroll
            for (int m = 0; m < 4; ++m)
#pragma unroll
                for (int n = 0; n < 2; ++n) acc[a][b][m][n] = (f32x4){0.f, 0.f, 0.f, 0.f};
    bf16x8 At[4][2], B0[2][2], B1[2][2];
    const char* cA = (const char*)g.A + (Epi::GATHER ? (size_t)0 : (size_t)cur.pm * tstep); const char* cB = (const char*)g.Bt + (size_t)cur.pn * tstep;
    PG8_GVOFF(vAc, cur.pm);
    if constexpr (Epi::CHAIN) { cA += cur.kofs; cB += cur.kofs; }
    S.a_ready(cur);
    if constexpr (SP2) {
        PG8_STAGE(PG8_SB(0, 0), cB, voffB); PG8_STAGE(PG8_SB(0, 1), cB + hstep, voffB); PG8_STAGE_A(PG8_SA(0, 0), cA, 0, false); PG8_STAGE_A(PG8_SA(0, 1), cA, 1, false);
        if (wr == 1) PG8_BAR;
        PG8_WAIT_V(2); PG8_BAR;
        PG8_STAGE(PG8_SB(1, 0), cB + kstep, voffB); PG8_STAGE_A(PG8_SA(1, 0), cA + kstep, 0, false); PG8_STAGE(PG8_SB(1, 1), cB + hstep + kstep, voffB);
        PG8_WAIT_V(6); PG8_BAR;
    } else {
        PG8_STAGE(PG8_SB(0, 0), cB, voffB); PG8_STAGE(PG8_SA(0, 0), cA, voffA); PG8_STAGE(PG8_SB(0, 1), cB + hstep, voffB); PG8_STAGE(PG8_SA(0, 1), cA + hstep, voffA);
        if (wr == 1) PG8_BAR;
        PG8_WAIT_V(4); PG8_BAR;
        PG8_STAGE(PG8_SB(1, 0), cB + kstep, voffB); PG8_STAGE(PG8_SA(1, 0), cA + kstep, voffA); PG8_STAGE(PG8_SB(1, 1), cB + hstep + kstep, voffB);
        PG8_WAIT_V(6); PG8_BAR;
    }
    for (;;) {
        const bool has_next = S.next(ui + 1, nxt);
        const char* nA = has_next ? (const char*)g.A + (Epi::GATHER ? (size_t)0 : (size_t)nxt.pm * tstep) + (Epi::CHAIN ? nxt.kofs : 0) : cA;
        if constexpr (Epi::GATHER) { if (has_next) PG8_GVOFF(vAn, nxt.pm); else { _Pragma("unroll") for (int h_ = 0; h_ < 2; ++h_) _Pragma("unroll") for (int i_ = 0; i_ < 2; ++i_) vAn[h_][i_] = vAc[h_][i_]; } } const char* nB = has_next ? (const char*)g.Bt + (size_t)nxt.pn * tstep + (Epi::CHAIN ? nxt.kofs : 0) : cB;
        const int ntc = Epi::CHAIN ? cur.nt : nt;
        for (int t = 0; t < ntc; t += 2) {
            const bool last = (t == ntc - 2);
            const char* a1 = cA + (size_t)(t + 1) * kstep;
            const char* a2 = last ? nA : cA + (size_t)(t + 2) * kstep; const char* b2 = last ? nB : cB + (size_t)(t + 2) * kstep;
            const char* a3 = a2 + kstep; const char* b3 = b2 + kstep;
            if (last && has_next) S.a_ready(nxt);
            if constexpr (SP2) {
            PG8_LDB(B0, 0, 0); PG8_LDB(B1, 0, 1); PG8_SCHED; PG8_LDA(At, 0, 0); PG8_STAGE_A(PG8_SA(1, 1), a1, 1, false);
            PG8_WAIT_V(8); PG8_WAIT_L(0); PG8_BAR; PG8_MMA(0, 0, At, B0); PG8_MMA(0, 1, At, B1); PG8_BAR; PG8_SCHED;
            PG8_LDA(At, 0, 1); PG8_STAGE(PG8_SB(0, 0), b2, voffB); PG8_STAGE(PG8_SB(0, 1), b2 + hstep, voffB); PG8_STAGE_A(PG8_SA(0, 0), a2, 0, last);
            PG8_WAIT_V(8); PG8_WAIT_L(0); PG8_BAR; PG8_MMA(1, 0, At, B0); PG8_MMA(1, 1, At, B1); PG8_BAR; PG8_SCHED;
            PG8_LDB(B0, 1, 0); PG8_LDB(B1, 1, 1); PG8_SCHED; PG8_LDA(At, 1, 0); PG8_STAGE_A(PG8_SA(0, 1), a2, 1, last);
            PG8_WAIT_V(8); PG8_WAIT_L(0); PG8_BAR; PG8_MMA(0, 0, At, B0); PG8_MMA(0, 1, At, B1); PG8_BAR; PG8_SCHED;
            PG8_LDA(At, 1, 1); PG8_STAGE(PG8_SB(1, 0), b3, voffB); PG8_STAGE(PG8_SB(1, 1), b3 + hstep, voffB); PG8_STAGE_A(PG8_SA(1, 0), a3, 0, last);
            PG8_WAIT_V(8); PG8_WAIT_L(0); PG8_BAR; PG8_MMA(1, 0, At, B0); PG8_MMA(1, 1, At, B1); PG8_BAR; PG8_SCHED;
            } else {
            PG8_LDB(B0, 0, 0); PG8_SCHED; PG8_LDA(At, 0, 0); PG8_STAGE(PG8_SA(1, 1), a1 + hstep, voffA);
            PG8_WAIT_L(8); PG8_BAR; PG8_WAIT_L(0); PG8_MMA(0, 0, At, B0); PG8_BAR; PG8_SCHED;
            PG8_LDB(B1, 0, 1); PG8_STAGE(PG8_SB(0, 0), b2, voffB);
            PG8_BAR; PG8_WAIT_L(0); PG8_MMA(0, 1, At, B1); PG8_BAR;
            PG8_LDA(At, 0, 1); PG8_STAGE(PG8_SA(0, 0), a2, voffA);
            PG8_BAR; PG8_WAIT_L(0); PG8_MMA(1, 0, At, B0); PG8_BAR; PG8_SCHED;
            PG8_STAGE(PG8_SB(0, 1), b2 + hstep, voffB);
            PG8_WAIT_V(6); PG8_BAR; PG8_MMA(1, 1, At, B1); PG8_BAR;
            PG8_LDB(B0, 1, 0); PG8_SCHED; PG8_LDA(At, 1, 0); PG8_STAGE(PG8_SA(0, 1), a2 + hstep, voffA);
            PG8_WAIT_L(8); PG8_BAR; PG8_WAIT_L(0); PG8_MMA(0, 0, At, B0); PG8_BAR; PG8_SCHED;
            PG8_LDB(B1, 1, 1); PG8_STAGE(PG8_SB(1, 0), b3, voffB);
            PG8_BAR; PG8_WAIT_L(0); PG8_MMA(0, 1, At, B1); PG8_BAR;
            PG8_LDA(At, 1, 1); PG8_STAGE(PG8_SA(1, 0), a3, voffA);
            PG8_BAR; PG8_WAIT_L(0); PG8_MMA(1, 0, At, B0); PG8_BAR; PG8_SCHED;
            PG8_STAGE(PG8_SB(1, 1), b3 + hstep, voffB);
            PG8_WAIT_V(6); PG8_BAR; PG8_MMA(1, 1, At, B1); PG8_BAR;
            }
        }
        if constexpr (ALIGN_EPI) { if (wr == 0) PG8_BAR; }
        if constexpr (Epi::CHAIN) { E.unit_end(acc, cur, wr, wc, fr, fq); }
        else if constexpr (!Epi::AFTER_DRAIN) { E(acc, cur, wr, wc, fr, fq); S.done(cur); }
        if (!has_next) break;
        if constexpr (!Epi::CHAIN)
#pragma unroll
        for (int a = 0; a < 2; ++a)
#pragma unroll
            for (int b = 0; b < 2; ++b)
#pragma unroll
                for (int m = 0; m < 4; ++m)
#pragma unroll
                    for (int n = 0; n < 2; ++n) acc[a][b][m][n] = (f32x4){0.f, 0.f, 0.f, 0.f};
        cur = nxt; cA = nA; cB = nB; ++ui;
        if constexpr (Epi::GATHER) { _Pragma("unroll") for (int h_ = 0; h_ < 2; ++h_) _Pragma("unroll") for (int i_ = 0; i_ < 2; ++i_) vAc[h_][i_] = vAn[h_][i_]; }
        if constexpr (ALIGN_EPI) { if (wr == 1) PG8_BAR; }
    }
    PG8_WAIT_V(0);
    if constexpr (!ALIGN_EPI) { if (wr == 0) PG8_BAR; }
    PG8_BAR;
    if constexpr (Epi::AFTER_DRAIN) { E.fused(acc, cur, wr, wc, fr, fq, lds, wid, lane); S.done(cur); }
#undef PG8_SA
#undef PG8_SB
#undef PG8_STAGE
#undef PG8_STAGE_A
#undef PG8_GVOFF
#undef PG8_LDA
#undef PG8_LDB
#undef PG8_MMA
#undef PG8_WAIT_V
#undef PG8_WAIT_L
#undef PG8_BAR
#undef PG8_SCHED
}
}

namespace att {
constexpr int D = 128, NW = 8, QBLK = 32, KVBLK = 64;
constexpr int SDEPTH = 1;
constexpr float THR2 = 8.f * 1.4426950408889634f;
constexpr size_t SHM_V = KVBLK * D * 2, SHM_K = KVBLK * D * 2, SHM_ATTN = 2 * SHM_V + 2 * SHM_K + NW * 64 * 4;
#define KSWZ(row, colB) ((row) * 256 + ((colB) ^ (((row) & 7) << 4)))
__device__ __forceinline__ int crow(int r, int hi) { return (r & 3) + 8 * (r >> 2) + 4 * hi; }
constexpr int ccol(int r) { return (r & 3) + 8 * (r >> 2); }

template <int MODE>
__device__ __forceinline__ void partialSM(f32x16& p0, f32x16& p1, float& m_reg, float& alpha, float& sub1_out, int j, int NT, float slope2, float lanec, int lanet, int hi, v2u mw, unsigned bmw) {
  const float NEGINF = -__builtin_inff();
  float base0 = 0.f, base1 = 0.f;
  if constexpr (MODE != 0) {
    base0 = fmaf(slope2 * 64.f, (float)j, lanec); base1 = base0 + 32.f * slope2;
#pragma unroll
    for (int r = 0; r < 16; ++r) { p0[r] = fmaf(slope2, (float)ccol(r), p0[r]); p1[r] = fmaf(slope2, (float)ccol(r), p1[r]); }
  }
  if constexpr (MODE == 1 || MODE == 4) {
    const unsigned w0 = mw.x >> (4 * hi), w1 = mw.y >> (4 * hi);
#pragma unroll
    for (int r = 0; r < 16; ++r) {
      const int m0 = __builtin_amdgcn_sbfe(w0, ccol(r), 1), m1 = __builtin_amdgcn_sbfe(w1, ccol(r), 1);
      p0[r] = __uint_as_float((__float_as_uint(p0[r]) & (unsigned)m0) | (0xff800000u & ~(unsigned)m0));
      p1[r] = __uint_as_float((__float_as_uint(p1[r]) & (unsigned)m1) | (0xff800000u & ~(unsigned)m1));
    }
  }
  if constexpr (MODE == 2) {
    const bool sel = (bmw >> (j >> 2)) & 1u; if (!sel) { base0 = NEGINF; base1 = NEGINF; }
    if (j >= NT - 4) { const int thr0 = lanet - 64 * j, thr1 = thr0 - 32;
#pragma unroll
      for (int r = 0; r < 16; ++r) { p0[r] = (ccol(r) <= thr0) ? p0[r] : NEGINF; p1[r] = (ccol(r) <= thr1) ? p1[r] : NEGINF; }
    }
  }
  float mx0 = p0[0], mx1 = p1[0];
#pragma unroll
  for (int r = 1; r < 16; ++r) { mx0 = fmaxf(mx0, p0[r]); mx1 = fmaxf(mx1, p1[r]); }
  float pmax;
  if constexpr (MODE == 0) pmax = fmaxf(mx0, mx1); else pmax = fmaxf(mx0 + base0, mx1 + base1);
  { auto rr = __builtin_amdgcn_permlane32_swap(__float_as_uint(pmax), __float_as_uint(pmax), false, false);
    pmax = fmaxf(__uint_as_float(rr[0]), __uint_as_float(rr[1])); }
  float mn;
  if (__builtin_expect(__all(pmax - m_reg <= THR2), 1)) { mn = m_reg; alpha = 1.f; }
  else { mn = fmaxf(m_reg, pmax); alpha = __builtin_amdgcn_exp2f(m_reg - mn); m_reg = mn; }
  float sub0, sub1;
  if constexpr (MODE == 0) { sub0 = mn; sub1 = mn; } else { sub0 = mn - base0; sub1 = mn - base1; }
#pragma unroll
  for (int r = 0; r < 16; ++r) p0[r] = __builtin_amdgcn_exp2f(p0[r] - sub0);
  sub1_out = sub1;
}
__device__ __forceinline__ void finishSM(f32x16& p0, f32x16& p1, float sub1, float alpha, float& l_reg, bf16x8& pa0, bf16x8& pa1, bf16x8& pa2, bf16x8& pa3) {
#pragma unroll
  for (int r = 0; r < 16; ++r) p1[r] = __builtin_amdgcn_exp2f(p1[r] - sub1);
  float ps = 0;
#pragma unroll
  for (int r = 0; r < 16; ++r) ps += p0[r];
#pragma unroll
  for (int r = 0; r < 16; ++r) ps += p1[r];
  { auto rr = __builtin_amdgcn_permlane32_swap(__float_as_uint(ps), __float_as_uint(ps), false, false);
    ps = __uint_as_float(rr[0]) + __uint_as_float(rr[1]); }
  l_reg = l_reg * alpha + ps;
#define PK4(P, BASE, OUT) do { unsigned a0 = cvtpk(P[BASE + 0], P[BASE + 1]), a1 = cvtpk(P[BASE + 2], P[BASE + 3]);   \
    unsigned b0 = cvtpk(P[BASE + 4], P[BASE + 5]), b1 = cvtpk(P[BASE + 6], P[BASE + 7]);                              \
    auto r0 = __builtin_amdgcn_permlane32_swap(a0, b0, false, false); auto r1 = __builtin_amdgcn_permlane32_swap(a1, b1, false, false); \
    v4u w = {r0[0], r1[0], r0[1], r1[1]}; OUT = *reinterpret_cast<bf16x8*>(&w); } while (0)
  PK4(p0, 0, pa0); PK4(p0, 8, pa1); PK4(p1, 0, pa2); PK4(p1, 8, pa3);
#undef PK4
}
__device__ __forceinline__ void qkt(f32x16& p0, f32x16& p1, const LAS char* Ks, const bf16x8 (&qs)[8], int r32, int hi) {
  p0 = f32x16{}; p1 = f32x16{};
#pragma unroll
  for (int d0 = 0; d0 < 8; ++d0) { int cb = (d0 * 16 + hi * 8) * 2;
    bf16x8 b0 = *reinterpret_cast<const LAS bf16x8*>(Ks + KSWZ(r32, cb));
    bf16x8 b1 = *reinterpret_cast<const LAS bf16x8*>(Ks + KSWZ(32 + r32, cb));
    const bf16x8 q = qs[d0];
    p0 = __builtin_amdgcn_mfma_f32_32x32x16_bf16(b0, q, p0, 0, 0, 0);
    p1 = __builtin_amdgcn_mfma_f32_32x32x16_bf16(b1, q, p1, 0, 0, 0); }
}
__device__ __forceinline__ int v_st(int k, int c) { const int kk = (k & ~0xC) | ((k & 4) << 1) | ((k & 8) >> 1); return ((kk >> 3) * 4 + (c >> 5)) * 512 + ((kk & 7) * 32 + (c & 31)) * 2; }
__device__ __forceinline__ int v_rd_base(int lane) { return ((lane & 3) << 3) | (((lane >> 2) & 3) << 6) | (((lane >> 4) & 1) << 5) | (((lane >> 5) & 1) << 8); }
constexpr int v_rd_off(int d0, int ks, int half) { return d0 * 512 + ks * 4096 + half * 2048; }
template <int OFF> __device__ __forceinline__ s16x4 tr_read(int vb) {
  s16x4 r; asm volatile("ds_read_b64_tr_b16 %0, %1 offset:%2" : "=&v"(r) : "v"(vb), "i"(OFF) : "memory"); return r;
}
template <int D0> __device__ __forceinline__ void pv_one(f32x16& od, int vb, bf16x8 pa0, bf16x8 pa1, bf16x8 pa2, bf16x8 pa3) {
  const s16x4 l0 = tr_read<v_rd_off(D0, 0, 0)>(vb), h0 = tr_read<v_rd_off(D0, 0, 1)>(vb), l1 = tr_read<v_rd_off(D0, 1, 0)>(vb), h1 = tr_read<v_rd_off(D0, 1, 1)>(vb);
  const s16x4 l2 = tr_read<v_rd_off(D0, 2, 0)>(vb), h2 = tr_read<v_rd_off(D0, 2, 1)>(vb), l3 = tr_read<v_rd_off(D0, 3, 0)>(vb), h3 = tr_read<v_rd_off(D0, 3, 1)>(vb);
  asm volatile("s_waitcnt lgkmcnt(0)" ::: "memory"); SBAR();
#define PK(L, H) (bf16x8){L[0], L[1], L[2], L[3], H[0], H[1], H[2], H[3]}
  od = __builtin_amdgcn_mfma_f32_32x32x16_bf16(pa0, PK(l0, h0), od, 0, 0, 0);
  od = __builtin_amdgcn_mfma_f32_32x32x16_bf16(pa1, PK(l1, h1), od, 0, 0, 0);
  od = __builtin_amdgcn_mfma_f32_32x32x16_bf16(pa2, PK(l2, h2), od, 0, 0, 0);
  od = __builtin_amdgcn_mfma_f32_32x32x16_bf16(pa3, PK(l3, h3), od, 0, 0, 0);
#undef PK
}
__device__ __forceinline__ void pv_d0(f32x16* o, int vb, bf16x8 pa0, bf16x8 pa1, bf16x8 pa2, bf16x8 pa3) {
  pv_one<0>(o[0], vb, pa0, pa1, pa2, pa3); pv_one<1>(o[1], vb, pa0, pa1, pa2, pa3); pv_one<2>(o[2], vb, pa0, pa1, pa2, pa3); pv_one<3>(o[3], vb, pa0, pa1, pa2, pa3);
}

template <int MODE>
__device__ __forceinline__ void attn_unit(const GAS bf16* __restrict__ Qb, int ldq, const GAS bf16* __restrict__ Kh, const GAS bf16* __restrict__ Vh, int ldk, GAS bf16* __restrict__ Ob, int ldo,
                                          int NT, int qpos0, float slope2, const GAS unsigned* __restrict__ maskA, const GAS unsigned* __restrict__ blkm, LAS char* lds, const int tid,
                                          int nvalid = 0, GAS bf16* __restrict__ PO = nullptr, GAS float* __restrict__ PML = nullptr, int hh = 0, int kofs = 0) {
  const int wid = tid >> 6, lane = tid & 63, r32 = lane & 31, hi = lane >> 5;
  LAS char* V_lds = lds; LAS char* K_lds = lds + 2 * SHM_V;
  LAS float* ws = (LAS float*)(lds + 2 * SHM_V + 2 * SHM_K) + wid * 64; LAS float* li_l = ws; LAS float* al_l = ws + 32;
  float m_reg = -1e30f, l_reg = 0; f32x16 o[4] = {};
  bf16x8 qr[8];
  const int qrow = wid * QBLK + r32;
  int trow = qpos0 + qrow, pslot = 0;
  if constexpr (MODE == 3) { unsigned e = ((unsigned)(qpos0 + 256)) | (4u << 16); if (qrow < nvalid) e = blkm[qrow]; trow = (int)(e & 0xffffu); pslot = (int)(e >> 16); }
  if constexpr (MODE == 4) pslot = kofs >> 11;
  const int qpos = (MODE == 2) ? qrow : (MODE == 3) ? trow - qpos0 : (MODE == 4) ? trow - kofs : trow;
  const unsigned bmw = 0xffffffffu;
  const GAS bf16* Qw = Qb + (unsigned)((MODE == 3 ? trow : qrow) * ldq + hi * 8);
#pragma unroll
  for (int d0 = 0; d0 < 8; ++d0) qr[d0] = *reinterpret_cast<const GAS bf16x8*>(Qw + d0 * 16);
  slope2 = __uint_as_float(__builtin_amdgcn_readfirstlane(__float_as_uint(slope2)));
  const float lanec = slope2 * (float)(4 * hi - qpos); const int lanet = qpos - 4 * hi;
  unsigned moff = 0; if constexpr (MODE == 1 || MODE == 4) moff = (unsigned)trow * 1024u + (unsigned)(kofs >> 6) * 8u;
  const int sr = tid >> 4, sc = (tid & 15) * 8, vst0 = v_st(sr, sc), vst1 = v_st(32 + sr, sc);
  const int vb0 = (int)(uintptr_t)V_lds + v_rd_base(lane);
  struct { bf16x8 vs0, vs1, ks0, ks1; } sr_[SDEPTH];
  const unsigned so0 = (unsigned)(sr * ldk + sc) * 2u, so1 = so0 + (unsigned)(32 * ldk) * 2u, tstep_ = (unsigned)(64 * ldk) * 2u;
#define SLOAD(i, k0) do { const unsigned tb_ = (unsigned)((k0) >> 6) * tstep_; \
    sr_[i].vs0 = *reinterpret_cast<const GAS bf16x8*>((const GAS char*)Vh + (tb_ + so0)); sr_[i].vs1 = *reinterpret_cast<const GAS bf16x8*>((const GAS char*)Vh + (tb_ + so1)); \
    sr_[i].ks0 = *reinterpret_cast<const GAS bf16x8*>((const GAS char*)Kh + (tb_ + so0)); sr_[i].ks1 = *reinterpret_cast<const GAS bf16x8*>((const GAS char*)Kh + (tb_ + so1)); } while (0)
#define SWRITE(b, i) do { *(LAS bf16x8*)(V_lds + (b) * SHM_V + vst0) = sr_[i].vs0;          \
    *(LAS bf16x8*)(V_lds + (b) * SHM_V + vst1) = sr_[i].vs1; int kc = sc * 2;               \
    *(LAS bf16x8*)(K_lds + (b) * SHM_K + KSWZ(sr, kc)) = sr_[i].ks0;                       \
    *(LAS bf16x8*)(K_lds + (b) * SHM_K + KSWZ(32 + sr, kc)) = sr_[i].ks1; } while (0)
#define SWAIT() do { if constexpr (SDEPTH == 2) asm volatile("s_waitcnt vmcnt(4)" ::: "memory"); else asm volatile("s_waitcnt vmcnt(0)" ::: "memory"); } while (0)
#define RESC(a) do { if (__any((a) < 1.f)) { if (hi == 0) al_l[r32] = (a); asm volatile("s_waitcnt lgkmcnt(0)" ::: "memory"); \
    _Pragma("unroll") for (int d = 0; d < 4; ++d) _Pragma("unroll") for (int r = 0; r < 16; ++r) o[d][r] *= al_l[crow(r, hi)]; } } while (0)
  v2u mwA = {0u, 0u}, mwB = {0u, 0u};
#define MLOAD(dst, j) do { if constexpr (MODE == 1 || MODE == 4) dst = *reinterpret_cast<const GAS v2u*>((const GAS char*)maskA + (moff + 8u * (unsigned)(j))); } while (0)
#define PSM(P0, P1, AL, S1, J, MW) partialSM<MODE>(P0, P1, m_reg, AL, S1, J, NT, slope2, lanec, lanet, hi, MW, bmw)
  f32x16 pA0, pA1, pB0, pB1; float alA, alB, s1A, s1B; bf16x8 pa0, pa1, pa2, pa3;
  constexpr int SE = 0, SO = SDEPTH - 1;
  MLOAD(mwA, 0); MLOAD(mwB, 1);
  SLOAD(SE, 0); asm volatile("s_waitcnt vmcnt(0)" ::: "memory"); SWRITE(0, SE);
  if constexpr (SDEPTH == 1) SLOAD(SO, KVBLK);
  __syncthreads();
  qkt(pA0, pA1, K_lds, qr, r32, hi); PSM(pA0, pA1, alA, s1A, 0, mwA);
  if constexpr (SDEPTH == 2) { SLOAD(SO, KVBLK); if (2 < NT) SLOAD(SE, 2 * KVBLK); }
  SWAIT(); SWRITE(1, SO); __syncthreads();
  for (int j = 1; j + 1 < NT; j += 2) {
    SBAR(); qkt(pB0, pB1, K_lds + SHM_K, qr, r32, hi);
    finishSM(pA0, pA1, s1A, alA, l_reg, pa0, pa1, pa2, pa3); SBAR();
    MLOAD(mwA, j + 1);
    SLOAD(SO, (j + SDEPTH) * KVBLK); SBAR();
    pv_d0(o, vb0, pa0, pa1, pa2, pa3); PSM(pB0, pB1, alB, s1B, j, mwB);
    __syncthreads(); SWAIT(); SWRITE(0, SE);
    RESC(alB); __syncthreads();
    SBAR(); qkt(pA0, pA1, K_lds, qr, r32, hi);
    finishSM(pB0, pB1, s1B, alB, l_reg, pa0, pa1, pa2, pa3); SBAR();
    if (j + 2 < NT) MLOAD(mwB, j + 2);
    if (SDEPTH == 1 || j + 3 < NT) SLOAD(SE, (j + 1 + SDEPTH) * KVBLK); SBAR();
    pv_d0(o, vb0 + (int)SHM_V, pa0, pa1, pa2, pa3); PSM(pA0, pA1, alA, s1A, j + 1, mwA);
    __syncthreads(); SWAIT(); SWRITE(1, SO);
    RESC(alA); __syncthreads();
  }
  SBAR(); qkt(pB0, pB1, K_lds + SHM_K, qr, r32, hi);
  finishSM(pA0, pA1, s1A, alA, l_reg, pa0, pa1, pa2, pa3); SBAR();
  pv_d0(o, vb0, pa0, pa1, pa2, pa3); PSM(pB0, pB1, alB, s1B, NT - 1, mwB);
  __syncthreads(); RESC(alB);
  finishSM(pB0, pB1, s1B, alB, l_reg, pa0, pa1, pa2, pa3); SBAR();
  pv_d0(o, vb0 + (int)SHM_V, pa0, pa1, pa2, pa3);
  LAS int* dst_l = (LAS int*)(lds + SHM_ATTN) + wid * 32;
  if (hi == 0) { li_l[r32] = l_reg;
    if constexpr (MODE >= 2) { const int prow = pslot * 8192 + trow; dst_l[r32] = prow; f32x2 ml = {m_reg, l_reg}; *reinterpret_cast<GAS f32x2*>(PML + (size_t)(prow * 6 + hh) * 2) = ml; } }
  asm volatile("s_waitcnt lgkmcnt(0)" ::: "memory");
  float rli[16];
#pragma unroll
  for (int r = 0; r < 16; ++r) { const float lq = li_l[crow(r, hi)]; rli[r] = (MODE == 4 && !(lq > 0.f)) ? 0.f : __builtin_amdgcn_rcpf(lq); }
  if constexpr (MODE >= 2) {
#pragma unroll
    for (int r = 0; r < 16; ++r) { const int prow = dst_l[crow(r, hi)]; GAS bf16* Pw = PO + ((size_t)prow * 768 + hh * 128 + r32);
#pragma unroll
      for (int d0 = 0; d0 < 4; ++d0) Pw[d0 * 32] = (bf16)f2bf(o[d0][r] * rli[r]); }
  } else {
  GAS bf16* Ow = Ob + (unsigned)(wid * QBLK * ldo);
#pragma unroll
  for (int r = 0; r < 16; ++r) { int orow = crow(r, hi);
#pragma unroll
    for (int d0 = 0; d0 < 4; ++d0) Ow[(unsigned)(orow * ldo + d0 * 32 + r32)] = (bf16)f2bf(o[d0][r] * rli[r] * ((DBG_ZERO_BR >> MODE) & 1 ? 0.f : 1.f)); }
  }
  __syncthreads();
#undef SLOAD
#undef SWRITE
#undef SWAIT
#undef RESC
#undef MLOAD
#undef PSM
}
}

constexpr size_t MiB = 1u << 20;
constexpr size_t WS_CTL = 0, CTL_ZERO_BYTES = 1 * MiB;
constexpr size_t WS_INFO = 1 * MiB;
constexpr size_t WS_WA = 2 * MiB, WS_WC1 = 41 * MiB, WS_WC2 = 43 * MiB, WS_WUP = 44 * MiB, WS_WO = 52 * MiB, WS_W13 = 60 * MiB, WS_W2 = 188 * MiB, WS_WMEM = 252 * MiB, WS_WR = 256 * MiB;
constexpr size_t WS_MEMB = 257 * MiB, WS_MKV = 258 * MiB, WS_HB = 259 * MiB, WS_PROJ = 291 * MiB, WS_GATE = 351 * MiB, WS_XG = WS_GATE;
constexpr size_t WS_CQN = 447 * MiB, WS_CKVN = 455 * MiB, WS_KIDX = 459 * MiB, WS_WIDX = 460 * MiB, WS_KMEAN = 461 * MiB, WS_QAI = 462 * MiB, WS_KVA = 490 * MiB;
constexpr size_t WS_MASKA = 514 * MiB, WS_BLKM = 522 * MiB, WS_OATT = 523 * MiB, WS_MERGED = 555 * MiB, WS_PRE = 587 * MiB, WS_Y = WS_PRE, WS_X1 = 651 * MiB, WS_X1B = 715 * MiB;
constexpr size_t WS_CNT = 747 * MiB + 512 * 1024;
constexpr size_t WS_ROUTE = 747 * MiB, WS_ROWMAP = 748 * MiB, WS_ROWW = 749 * MiB, WS_HID = 750 * MiB;
constexpr size_t WS_PO = 651 * MiB;
constexpr size_t WS_PML = 750 * MiB;
constexpr size_t WS_LST = 754 * MiB;
constexpr size_t WS_PICK = 758 * MiB;
constexpr size_t WS_CNT2 = 759 * MiB;
constexpr size_t WS_LEN = 760 * MiB;
constexpr size_t WS_PO2 = 587 * MiB;
constexpr size_t WS_PML2 = 762 * MiB;
constexpr int LCAP = 256 * 496;
__host__ __device__ constexpr int LBASE(int h, int n) { return h * LCAP + 256 * (31 * n - n * (n - 1) / 2); }
constexpr size_t WS_SC = WS_PRE;
constexpr size_t WDELTA = 772 * MiB;
constexpr size_t WS_END = 1024 * MiB;
__host__ __device__ constexpr size_t WD(int l) { return l ? WDELTA : 0; }
__host__ __device__ constexpr size_t WDR(int l) { return l ? 512 * 1024 : 0; }
constexpr int CW_TMO = 0;
constexpr int CW_BAR = 4096;
constexpr int CW_ECNT = 16384;
constexpr int CW_AQ = 20480;
constexpr int LDS_BYTES = 163840;
constexpr int MISC_OFF = LDS_BYTES - 256;

#define XB_TMO      128
#define XB_XCNT(j)  (256  + 64 * (j))
#define XB_XSUB(j)  (1280 + 64 * (j))
#define XB_XGEN(j)  (2304 + 64 * (j))
#define XB_TOP      3328
#define XB_TOPGEN   3392
#define XCD_BAR_WORDS 3456
#define XB_SPIN_CAP (1u << 22)
__device__ __forceinline__ unsigned xb_ld(unsigned* p)              { return __hip_atomic_load(p, __ATOMIC_RELAXED, __HIP_MEMORY_SCOPE_AGENT); }
__device__ __forceinline__ unsigned xb_add(unsigned* p, unsigned v) { return __hip_atomic_fetch_add(p, v, __ATOMIC_RELAXED, __HIP_MEMORY_SCOPE_AGENT); }
__device__ __forceinline__ unsigned xb_xcc_id() { return (unsigned)__builtin_amdgcn_s_getreg((3 << 11) | 20) & 0xFu; }
#define XB_SPIN(cond, bar) do { unsigned _sp = 0; while (cond) { __builtin_amdgcn_s_sleep(1); \
    if ((++_sp & 255u) == 0u) { if (xb_ld(&(bar)[XB_TMO])) break; if (_sp > XB_SPIN_CAP) { atomicAdd(&(bar)[XB_TMO], 1u); break; } } } } while (0)
__device__ __forceinline__ int lane_id() { int l; asm volatile("v_mbcnt_lo_u32_b32 %0, -1, 0\n\tv_mbcnt_hi_u32_b32 %0, -1, %0" : "=v"(l)); return l; }
struct XcdBarrier { unsigned* bar; unsigned x; volatile LAS unsigned* st; unsigned w0; };
__device__ __forceinline__ XcdBarrier xcd_barrier_post(unsigned* bar, volatile LAS unsigned* st, unsigned w0) {
    XcdBarrier b; b.bar = bar; b.x = xb_xcc_id(); b.st = st; b.w0 = w0;
    if (w0 && lane_id() == 0) (void)xb_add(&bar[XB_XCNT(b.x)], 1u);
    return b;
}
__device__ __forceinline__ void xcd_barrier_complete(unsigned* bar, unsigned x, unsigned& nloc, unsigned& nx) {
    const unsigned G = gridDim.x * gridDim.y * gridDim.z;
    unsigned sum, cnt, mine, sp = 0u;
    for (;;) {
        sum = 0u; cnt = 0u; mine = 0u;
#pragma unroll
        for (unsigned j = 0; j < 16; ++j) { const unsigned c = xb_ld(&bar[XB_XCNT(j)]); sum += c; cnt += (c > 0u) ? 1u : 0u; mine = (j == x) ? c : mine; }
        if (sum == G) break;
        __builtin_amdgcn_s_sleep(1);
        if ((++sp & 255u) == 0u) { if (xb_ld(&bar[XB_TMO])) break; if (sp > XB_SPIN_CAP) { atomicAdd(&bar[XB_TMO], 1u); break; } }
    }
    nloc = mine > 0u ? mine : 1u; nx = cnt > 0u ? cnt : 1u;
}
__device__ __forceinline__ void xcd_barrier(const XcdBarrier& b) {
    asm volatile("s_waitcnt vmcnt(0)" ::: "memory");
    __syncthreads();
    if (b.w0 && lane_id() == 0) {
        unsigned* bar = b.bar;
        __builtin_amdgcn_s_waitcnt(0);
        unsigned nloc = b.st[0], nx = b.st[1];
        if (nloc == 0u) { xcd_barrier_complete(bar, b.x, nloc, nx); b.st[0] = nloc; b.st[1] = nx; }
        const unsigned old = xb_add(&bar[XB_XSUB(b.x)], 1u);
        const unsigned gen = old / nloc;
        if (old + 1u == (gen + 1u) * nloc) {
            __builtin_amdgcn_fence(__ATOMIC_RELEASE, "agent");
            asm volatile("s_waitcnt vmcnt(0)" ::: "memory");
            const unsigned og = xb_add(&bar[XB_TOP], 1u);
            const unsigned tg = og / nx;
            if (og + 1u == (tg + 1u) * nx) xb_add(&bar[XB_TOPGEN], 1u);
            else XB_SPIN(xb_ld(&bar[XB_TOPGEN]) == tg, bar);
            __builtin_amdgcn_fence(__ATOMIC_ACQUIRE, "agent");
            xb_add(&bar[XB_XGEN(b.x)], 1u);
            asm volatile("s_waitcnt vmcnt(0)" ::: "memory");
        } else {
            XB_SPIN(xb_ld(&bar[XB_XGEN(b.x)]) == gen, bar);
            __builtin_amdgcn_fence(__ATOMIC_ACQUIRE, "agent");
            asm volatile("s_waitcnt vmcnt(0)" ::: "memory");
        }
    }
    __syncthreads();
}

struct Args { const float* in[28]; float* out; unsigned char* ws; int ph_lo, ph_hi; };
struct Frame {
    LAS unsigned char* lds; volatile LAS unsigned* MISC; gu32* ctl; int* info;
    int tid, lane, wave, G, bid;
    unsigned char* ws; size_t z;
};
enum { I_X = 0, I_MEM, I_WMEMKV, I_WIN, I_GCQ, I_GCKV, I_GKIDX, I_BKIDX, I_WUQ, I_WUQI, I_WUKV, I_WUPA, I_WUPB, I_WUPC, I_WGATE, I_BGATE, I_WO, I_LN1G, I_LN1B,
       I_WGRP, I_BGRP, I_WRT, I_BRT, I_W1, I_W3, I_W2, I_LN2G, I_LN2B };
#define WSP(T_, off) ((T_*)(F.ws + (off)))
#ifndef DBG_TSUB
#define DBG_TSUB 0
#endif
#ifndef DBG_TBID
#define DBG_TBID 0
#endif
#define TSUB_START(id) do { if (DBG_TSUB == (id) && F.bid == DBG_TBID && F.wave == 0) { if (lane_id() == 0) F.MISC[22] = (unsigned)__builtin_amdgcn_s_memrealtime(); } } while (0)
#define TSUB_STOP(id) do { if (DBG_TSUB == (id) && F.bid == DBG_TBID && F.wave == 0) { if (lane_id() == 0) { const unsigned t_ = (unsigned)__builtin_amdgcn_s_memrealtime(); F.MISC[20] = F.MISC[20] + (t_ - F.MISC[22]); } } } while (0)

template <int NWD>
__device__ __forceinline__ void transpose_item(const float* src, int ldw, bf16* dst, int ldk, LAS float* scr, int lane) {
    constexpr int ST = NWD + 1, KPI = 64 / NWD;
    float tv[NWD];
#pragma unroll
    for (int i = 0; i < NWD; ++i) { const int kk = KPI * i + lane / NWD; tv[i] = src[(size_t)kk * ldw + (lane % NWD)]; }
#pragma unroll
    for (int i = 0; i < NWD; ++i) { const int kk = KPI * i + lane / NWD; scr[kk * ST + (lane % NWD)] = tv[i]; }
    LDS_WAIT(); asm volatile("" ::: "memory");
    const int c = lane & 7;
#pragma unroll
    for (int j = 0; j < NWD / 8; ++j) { const int n = (lane >> 3) + 8 * j; const LAS float* s = scr + (8 * c) * ST + n;
        v4u o; o.x = cvtpk(s[0 * ST], s[1 * ST]); o.y = cvtpk(s[2 * ST], s[3 * ST]); o.z = cvtpk(s[4 * ST], s[5 * ST]); o.w = cvtpk(s[6 * ST], s[7 * ST]);
        *(GAS v4u*)(dst + (size_t)n * ldk + 8 * c) = o; }
    LDS_WAIT(); asm volatile("" ::: "memory");
}
__device__ __forceinline__ void transpose_pair32(const float* srcA, int ldwA, bf16* dstA, int ldkA, const float* srcB, int ldwB, bf16* dstB, int ldkB, LAS float* scr, int lane) {
    constexpr int ST = 33, T2 = 64 * ST;
    float ta[32], tb[32];
#pragma unroll
    for (int i = 0; i < 32; ++i) { const int kk = 2 * i + (lane >> 5); ta[i] = srcA[(size_t)kk * ldwA + (lane & 31)]; }
#pragma unroll
    for (int i = 0; i < 32; ++i) { const int kk = 2 * i + (lane >> 5); tb[i] = srcB[(size_t)kk * ldwB + (lane & 31)]; }
#pragma unroll
    for (int i = 0; i < 32; ++i) { const int kk = 2 * i + (lane >> 5); scr[kk * ST + (lane & 31)] = ta[i]; }
#pragma unroll
    for (int i = 0; i < 32; ++i) { const int kk = 2 * i + (lane >> 5); scr[T2 + kk * ST + (lane & 31)] = tb[i]; }
    LDS_WAIT(); asm volatile("" ::: "memory");
    const int c = lane & 7;
#pragma unroll
    for (int j = 0; j < 4; ++j) { const int n = (lane >> 3) + 8 * j; const LAS float* sa = scr + (8 * c) * ST + n; const LAS float* sb = sa + T2;
        v4u o; o.x = cvtpk(sa[0 * ST], sa[1 * ST]); o.y = cvtpk(sa[2 * ST], sa[3 * ST]); o.z = cvtpk(sa[4 * ST], sa[5 * ST]); o.w = cvtpk(sa[6 * ST], sa[7 * ST]);
        *(GAS v4u*)(dstA + (size_t)n * ldkA + 8 * c) = o;
        v4u q; q.x = cvtpk(sb[0 * ST], sb[1 * ST]); q.y = cvtpk(sb[2 * ST], sb[3 * ST]); q.z = cvtpk(sb[4 * ST], sb[5 * ST]); q.w = cvtpk(sb[6 * ST], sb[7 * ST]);
        *(GAS v4u*)(dstB + (size_t)n * ldkB + 8 * c) = q; }
    LDS_WAIT(); asm volatile("" ::: "memory");
}
constexpr int CONV_TOTAL = 32 * 229 + 176 + 32 * 192 + 8 * 24 + 8 * 32 + 4 * 48 + 2 * 12 * 64 + 8 * 64 + 32 * 64 + 3 * 32 * 512 + 1536;
constexpr int CONV_E_LO = 32 * 229 + 176 + 32 * 192 + 8 * 24 + 8 * 32 + 4 * 48 + 2 * 12 * 64 + 8 * 64 + 32 * 64, CONV_E_N = 3 * 32 * 512;
constexpr int CONV_REST = CONV_TOTAL - CONV_E_N;
__device__ __forceinline__ void conv_items(Frame& F, const Args& a, int l, int it_begin, int it_stride, int it_end, int hole_lo) {
    LAS float* scr = (LAS float*)(F.lds + F.wave * 16896);
    const int lane = F.lane; const size_t wd = WD(l);
    bf16* WA = WSP(bf16, WS_WA + wd); bf16* WC1 = WSP(bf16, WS_WC1 + wd); bf16* WC2 = WSP(bf16, WS_WC2 + wd); bf16* WUP = WSP(bf16, WS_WUP + wd); bf16* WO = WSP(bf16, WS_WO + wd);
    bf16* W13 = WSP(bf16, WS_W13 + wd); bf16* W2T = WSP(bf16, WS_W2 + wd); float* WR = WSP(float, WS_WR + WDR(l));
    const float* w_in = (a.in[I_WIN] + F.z) + (size_t)l * 2048 * 3664; const float* w_gate = (a.in[I_WGATE] + F.z) + (size_t)l * 2048 * 6144;
    const float* w_uq = (a.in[I_WUQ] + F.z) + (size_t)l * 512 * 768; const float* w_uqi = (a.in[I_WUQI] + F.z) + (size_t)l * 512 * 1024; const float* w_ukv = (a.in[I_WUKV] + F.z) + (size_t)l * 256 * 1536;
    const float* w_upa = (a.in[I_WUPA] + F.z) + (size_t)l * 768 * 2048; const float* w_upb = (a.in[I_WUPB] + F.z) + (size_t)l * 768 * 2048; const float* w_upc = (a.in[I_WUPC] + F.z) + (size_t)l * 512 * 2048;
    const float* w_o = (a.in[I_WO] + F.z) + (size_t)l * 2048 * 2048;
    const float* w1 = (a.in[I_W1] + F.z) + (size_t)l * 32 * 2048 * 512; const float* w3 = (a.in[I_W3] + F.z) + (size_t)l * 32 * 2048 * 512; const float* w2 = (a.in[I_W2] + F.z) + (size_t)l * 32 * 512 * 2048;
    const float* w_grp = (a.in[I_WGRP] + F.z) + (size_t)l * 2048 * 4; const float* w_rt = (a.in[I_WRT] + F.z) + (size_t)l * 2048 * 32;
    constexpr int N_IN = 32 * 229, N_PAD = 176, N_GATE = 32 * 192, N_UQ = 8 * 24, N_UQI = 8 * 32, N_UKV = 4 * 48, N_UPA = 12 * 64, N_UPC = 8 * 64, N_O = 32 * 64, N_E = 32 * 512, N_R = 1536;
    constexpr int TOTAL = N_IN + N_PAD + N_GATE + N_UQ + N_UQI + N_UKV + 2 * N_UPA + N_UPC + N_O + 3 * N_E + N_R;
    static_assert(TOTAL == CONV_TOTAL, "conv item count");
    struct Desc { const float* src; bf16* dst; int ldw, ldk, kind, r; };
    auto desc = [&](int it) -> Desc {
        int r = it >= hole_lo ? it + CONV_E_N : it;
        const float* src = nullptr; bf16* dst = nullptr; int ldw = 0, ldk = 0, kind = 0;
        if (r < N_IN) { const int kb = r / 229, nb = r % 229, n0 = 16 * nb, k0 = 64 * kb, dr = n0 < 848 ? n0 : n0 + 176;
            src = w_in + (size_t)k0 * 3664 + n0; ldw = 3664; dst = WA + (size_t)dr * 2048 + k0; ldk = 2048; kind = 1; }
        else if ((r -= N_IN) < N_PAD) { kind = 2; }
        else if ((r -= N_PAD) < N_GATE) { const int kb = r / 192, nb = r % 192, n0 = 32 * nb, k0 = 64 * kb; src = w_gate + (size_t)k0 * 6144 + n0; ldw = 6144; dst = WA + (size_t)(3840 + n0) * 2048 + k0; ldk = 2048; }
        else if ((r -= N_GATE) < N_UQ) { const int kb = r / 24, nb = r % 24, n0 = 32 * nb, k0 = 64 * kb; src = w_uq + (size_t)k0 * 768 + n0; ldw = 768; dst = WC1 + (size_t)n0 * 512 + k0; ldk = 512; }
        else if ((r -= N_UQ) < N_UQI) { const int kb = r / 32, nb = r % 32, n0 = 32 * nb, k0 = 64 * kb; src = w_uqi + (size_t)k0 * 1024 + n0; ldw = 1024; dst = WC1 + (size_t)(768 + n0) * 512 + k0; ldk = 512; }
        else if ((r -= N_UQI) < N_UKV) { const int kb = r / 48, nb = r % 48, n0 = 32 * nb, k0 = 64 * kb; src = w_ukv + (size_t)k0 * 1536 + n0; ldw = 1536; dst = WC2 + (size_t)n0 * 256 + k0; ldk = 256; }
        else if ((r -= N_UKV) < N_UPA) { const int kb = r / 64, nb = r % 64, n0 = 32 * nb, k0 = 64 * kb; src = w_upa + (size_t)k0 * 2048 + n0; ldw = 2048; dst = WUP + (size_t)n0 * 2048 + k0; ldk = 2048; }
        else if ((r -= N_UPA) < N_UPA) { const int kb = r / 64, nb = r % 64, n0 = 32 * nb, k0 = 64 * kb; src = w_upb + (size_t)k0 * 2048 + n0; ldw = 2048; dst = WUP + (size_t)n0 * 2048 + 768 + k0; ldk = 2048; }
        else if ((r -= N_UPA) < N_UPC) { const int kb = r / 64, nb = r % 64, n0 = 32 * nb, k0 = 64 * kb; src = w_upc + (size_t)k0 * 2048 + n0; ldw = 2048; dst = WUP + (size_t)n0 * 2048 + 1536 + k0; ldk = 2048; }
        else if ((r -= N_UPC) < N_O) { const int kb = r / 64, nb = r % 64, n0 = 32 * nb, k0 = 64 * kb; src = w_o + (size_t)k0 * 2048 + n0; ldw = 2048; dst = WO + (size_t)n0 * 2048 + k0; ldk = 2048; }
        else if ((r -= N_O) < 2 * N_E) { const int which = r / N_E; r -= which * N_E; const int e = r / 512, q = r % 512, kb = q / 16, nb = q % 16, n0 = 32 * nb, k0 = 64 * kb;
            src = (which ? w3 : w1) + (size_t)e * 2048 * 512 + (size_t)k0 * 512 + n0; ldw = 512;
            const int dr = e * 1024 + (n0 >> 7) * 256 + (n0 & 127) + which * 128; dst = W13 + (size_t)dr * 2048 + k0; ldk = 2048; }
        else if ((r -= 2 * N_E) < N_E) { const int e = r / 512, q = r % 512, kb = q / 64, nb = q % 64, n0 = 32 * nb, k0 = 64 * kb;
            src = w2 + (size_t)e * 512 * 2048 + (size_t)k0 * 2048 + n0; ldw = 2048; dst = W2T + (size_t)(e * 2048 + n0) * 512 + k0; ldk = 512; }
        else { r -= N_E; kind = 3; }
        Desc d; d.src = src; d.dst = dst; d.ldw = ldw; d.ldk = ldk; d.kind = kind; d.r = r; return d;
    };
    int it = it_begin;
    while (it < it_end) {
        const Desc A = desc(it); const int itB = it + it_stride;
        if (A.kind == 0 && itB < it_end) { const Desc B = desc(itB);
            if (B.kind == 0) { transpose_pair32(A.src, A.ldw, A.dst, A.ldk, B.src, B.ldw, B.dst, B.ldk, scr, lane); it = itB + it_stride; continue; } }
        const float* src = A.src; bf16* dst = A.dst; const int ldw = A.ldw, ldk = A.ldk, kind = A.kind, r = A.r;
        if (kind == 0) transpose_item<32>(src, ldw, dst, ldk, scr, lane);
        else if (kind == 1) transpose_item<16>(src, ldw, dst, ldk, scr, lane);
        else if (kind == 2) { GAS v4u* p = (GAS v4u*)(WA + (size_t)(848 + r) * 2048) + lane * 4; const v4u z = {0u, 0u, 0u, 0u}; p[0] = z; p[1] = z; p[2] = z; p[3] = z; }
        else { const int idx = r * 64 + lane, j = idx & 7, lm = (idx >> 3) & 63, sc = idx >> 9, c = sc % 3, S = sc / 3, k = 32 * S + 8 * (lm >> 4) + j, col = 16 * c + (lm & 15);
            const float wv_ = col < 32 ? w_rt[k * 32 + col] : (col < 36 ? w_grp[k * 4 + (col - 32)] : 0.f); const unsigned hb = f2bf(wv_); const unsigned lb = f2bf(wv_ - bf2f(hb));
            bf16* WRb = (bf16*)WR; WRb[((sc * 2 + 0) * 64 + lm) * 8 + j] = (bf16)hb; WRb[((sc * 2 + 1) * 64 + lm) * 8 + j] = (bf16)lb; }
        it = itB;
    }
}
__device__ __forceinline__ void conv_layer(Frame& F, const Args& a, int l) { conv_items(F, a, l, F.bid * 8 + F.wave, F.G * 8, CONV_REST, CONV_E_LO); }
__device__ __forceinline__ void prologue(Frame& F, const Args& a) {
    LAS float* scr = (LAS float*)(F.lds + F.wave * 16384);
    const int gw = F.bid * 8 + F.wave, NGW = F.G * 8, lane = F.lane;
    bf16* HB = WSP(bf16, WS_HB); bf16* MEMB = WSP(bf16, WS_MEMB); bf16* WMEM = WSP(bf16, WS_WMEM);
    const float* x = (a.in[I_X] + F.z); const float* mem = (a.in[I_MEM] + F.z); const float* wm = (a.in[I_WMEMKV] + F.z);
    const long NX8 = (long)T * DM / 8, NM8 = 256L * DM / 8;
    for (long ib = (long)gw * 64 + lane; ib < NX8 + NM8; ib += 4L * NGW * 64) {
        f32x4 v0[4], v1[4];
#pragma unroll
        for (int u = 0; u < 4; ++u) { long i = ib + (long)u * NGW * 64; i = i < NX8 + NM8 ? i : ib; const bool inx = i < NX8; const long j = inx ? i : i - NX8; const float* s = (inx ? x : mem) + j * 8;
            v0[u] = *(const GAS f32x4*)s; v1[u] = *(const GAS f32x4*)(s + 4); }
#pragma unroll
        for (int u = 0; u < 4; ++u) { const long i = ib + (long)u * NGW * 64; if (i < NX8 + NM8) { const bool inx = i < NX8; const long j = inx ? i : i - NX8;
            v4u o; o.x = cvtpk(v0[u][0], v0[u][1]); o.y = cvtpk(v0[u][2], v0[u][3]); o.z = cvtpk(v1[u][0], v1[u][1]); o.w = cvtpk(v1[u][2], v1[u][3]);
            *(GAS v4u*)((inx ? HB : MEMB) + j * 8) = o; } }
    }
    for (int it = gw; it < 32 * 32; it += NGW) { const int kb = it / 32, nb = it % 32, n0 = 32 * nb, k0 = 64 * kb;
        transpose_item<32>(wm + (size_t)k0 * 1024 + n0, 1024, WMEM + (size_t)n0 * 2048 + k0, 2048, scr, lane); }
}

__device__ __forceinline__ void phase_norms(Frame& F, const Args& a, int l) {
    const int gw = F.bid * 8 + F.wave, NGW = F.G * 8, lane = F.lane;
    const bf16* PROJ = WSP(bf16, WS_PROJ); bf16* CQN = WSP(bf16, WS_CQN); bf16* CKVN = WSP(bf16, WS_CKVN); bf16* KIDX = WSP(bf16, WS_KIDX); float* WIDX = WSP(float, WS_WIDX); float* KMEAN = WSP(float, WS_KMEAN);
    const float* gcq = (a.in[I_GCQ] + F.z) + l * 512; const float* gckv = (a.in[I_GCKV] + F.z) + l * 256; const float* gk = (a.in[I_GKIDX] + F.z) + l * 64; const float* bk = (a.in[I_BKIDX] + F.z) + l * 64;
    { LAS float* red = (LAS float*)F.lds;
      for (int task = F.bid; task < 32 * 6; task += F.G) {
        const int n = task / 6, g = task % 6, rsub = lane >> 4, co = lane & 15;
        float s[8] = {0, 0, 0, 0, 0, 0, 0, 0};
#pragma unroll
        for (int i = 0; i < 8; ++i) { const v4u w = *(const GAS v4u*)(PROJ + (size_t)(n * 256 + F.wave * 32 + 4 * i + rsub) * NPROJ + PJ_KB + g * 128 + 8 * co);
            s[0] += bflo(w.x); s[1] += bfhi(w.x); s[2] += bflo(w.y); s[3] += bfhi(w.y); s[4] += bflo(w.z); s[5] += bfhi(w.z); s[6] += bflo(w.w); s[7] += bfhi(w.w); }
#pragma unroll
        for (int j = 0; j < 8; ++j) { s[j] += __shfl_xor(s[j], 16); s[j] += __shfl_xor(s[j], 32); }
        if (rsub == 0) {
#pragma unroll
            for (int j = 0; j < 8; ++j) red[F.wave * 128 + 8 * co + j] = s[j]; }
        __syncthreads();
        if (F.tid < 128) { float t = 0.f;
#pragma unroll
            for (int ww = 0; ww < 8; ++ww) t += red[ww * 128 + F.tid];
            KMEAN[(size_t)n * 768 + g * 128 + F.tid] = t * (1.f / 256.f); }
        __syncthreads();
      } }
    for (int tb = gw; tb < T; tb += 4 * NGW) {
        v4u wq[4]; v2u wk[4]; float vk[4], vw[4];
#pragma unroll
        for (int u = 0; u < 4; ++u) { const int t = tb + u * NGW < T ? tb + u * NGW : tb; const bf16* row = PROJ + (size_t)t * NPROJ;
            wq[u] = *(const GAS v4u*)(row + 8 * lane); wk[u] = *(const GAS v2u*)(row + 512 + 4 * lane); vk[u] = bf2f(row[768 + lane]); vw[u] = bf2f(row[832 + (lane & 15)]); }
#pragma unroll
        for (int u = 0; u < 4; ++u) { const int t = tb + u * NGW; if (t < T) {
          { const v4u w = wq[u]; float v[8] = {bflo(w.x), bfhi(w.x), bflo(w.y), bfhi(w.y), bflo(w.z), bfhi(w.z), bflo(w.w), bfhi(w.w)};
            float ss = 0.f;
#pragma unroll
            for (int j = 0; j < 8; ++j) ss += v[j] * v[j];
            const float rs = 1.0f / sqrtf(wave_sum(ss) * (1.f / 512.f) + LN_EPS);
            const f32x4 g0 = *(const GAS f32x4*)(gcq + 8 * lane), g1 = *(const GAS f32x4*)(gcq + 8 * lane + 4);
            v4u o; o.x = cvtpk(v[0] * rs * g0[0], v[1] * rs * g0[1]); o.y = cvtpk(v[2] * rs * g0[2], v[3] * rs * g0[3]); o.z = cvtpk(v[4] * rs * g1[0], v[5] * rs * g1[1]); o.w = cvtpk(v[6] * rs * g1[2], v[7] * rs * g1[3]);
            *(GAS v4u*)(CQN + (size_t)t * 512 + 8 * lane) = o; }
          { const v2u w = wk[u]; float v[4] = {bflo(w.x), bfhi(w.x), bflo(w.y), bfhi(w.y)};
            float ss = (v[0] * v[0] + v[1] * v[1]) + (v[2] * v[2] + v[3] * v[3]);
            const float rs = 1.0f / sqrtf(wave_sum(ss) * (1.f / 256.f) + LN_EPS);
            const f32x4 g0 = *(const GAS f32x4*)(gckv + 4 * lane);
            v2u o; o.x = cvtpk(v[0] * rs * g0[0], v[1] * rs * g0[1]); o.y = cvtpk(v[2] * rs * g0[2], v[3] * rs * g0[3]);
            *(GAS v2u*)(CKVN + (size_t)t * 256 + 4 * lane) = o; }
          { const float v = vk[u]; const float mu = wave_sum(v) * (1.f / 64.f); const float d = v - mu; const float var = wave_sum(d * d) * (1.f / 64.f);
            KIDX[(size_t)t * 64 + lane] = (bf16)f2bf(d * (1.0f / sqrtf(var + LN_EPS)) * gk[lane] + bk[lane]); }
          if (lane < 16) WIDX[(size_t)t * 16 + lane] = vw[u] * 0.25f; } }
    }
}

__device__ __forceinline__ void indexer_item(Frame& F, int item) {
    int tid = F.tid; asm volatile("" : "+v"(tid));
    const int lane = tid & 63, w = F.wave, hi = lane >> 5, kl = lane & 31;
    const bf16* QAI = WSP(bf16, WS_QAI); const bf16* KIDX = WSP(bf16, WS_KIDX); const float* WIDX = WSP(float, WS_WIDX); unsigned* MASKA = WSP(unsigned, WS_MASKA);
    const int t0 = item * 16, myq = t0 + 2 * w + hi;
    const GAS char* SCb = (const GAS char*)WSP(float, WS_SC); unsigned scoff; { const unsigned b_ = myq >> 6, r_ = myq & 63; scoff = (2048u * b_ * (b_ + 1u) + 64u * r_ * (b_ + 1u)) * 4u; }
    LAS unsigned char* reg = F.lds + (2 * w) * 8192;
    LAS unsigned char* myreg = reg + hi * 8192;
    LAS unsigned char* KST = F.lds + 131072;
    bf16x8 af[4];
    { const int rho = kl, qsel = (rho >> 2) & 1, head = (rho & 3) + 4 * (rho >> 3);
      const bf16* src = QAI + (size_t)(t0 + 2 * w + qsel) * NQAI + 768 + head * 64 + 8 * hi;
#pragma unroll
      for (int c = 0; c < 4; ++c) af[c] = *(const GAS bf16x8*)(src + 16 * c); }
    float wv[16];
    { const GAS f32x4* wp = (const GAS f32x4*)(WIDX + (size_t)myq * 16);
#pragma unroll
      for (int j = 0; j < 4; ++j) { const f32x4 v = wp[j]; wv[4 * j] = v[0]; wv[4 * j + 1] = v[1]; wv[4 * j + 2] = v[2]; wv[4 * j + 3] = v[3]; } }
    const int nch = (t0 + 16 + 63) >> 6;
    const int skey = tid >> 3, sch = tid & 7;
    const int sdst = skey * 128 + ((sch ^ ((skey >> 1) & 7)) << 4);
    int bstar = 0, nab = 0; bool allq = false;
#ifndef DBG_IDX_DUMMY
#define DBG_IDX_DUMMY 0
#endif
    {
        TSUB_START(1);
        { const v4u z = {0u, 0u, 0u, 0u};
#pragma unroll
          for (int i = 0; i < 16; ++i) *(LAS v4u*)(reg + (i * 64 + lane) * 16) = z; }
        const GAS char* kgb = (const GAS char*)KIDX; const unsigned kgo = (unsigned)(skey * 64 + sch * 8) * 2u;
#define KG(c) (*(const GAS v4u*)(kgb + (kgo + (unsigned)(c) * 8192u)))
        v4u R0 = {0u, 0u, 0u, 0u}, R1 = R0;
        { const v4u k0 = KG(0); R1 = KG(1 < nch ? 1 : nch - 1); R0 = KG(2 < nch ? 2 : nch - 1); *(LAS v4u*)(KST + sdst) = k0; }
        __syncthreads();
        int fo[4];
#pragma unroll
        for (int c = 0; c < 4; ++c) fo[c] = kl * 128 + (((2 * c + hi) ^ ((kl >> 1) & 7)) << 4);
        f32x16 AC[2][2];
#define IDX_POST(P, MM) do { \
            _Pragma("unroll") for (int tile = 0; tile < 2; ++tile) { f32x2 pa = {0.f, 0.f}, pb = {0.f, 0.f}; \
                _Pragma("unroll") for (int r = 0; r < 16; r += 4) { float rl[4]; \
                    _Pragma("unroll") for (int q_ = 0; q_ < 4; ++q_) { const float av = AC[P][tile][r + q_]; const int xi = __float_as_int(av); rl[q_] = __int_as_float(xi > 0 ? xi : 0); } \
                    pa = __builtin_elementwise_fma((f32x2){rl[0], rl[1]}, (f32x2){wv[r], wv[r + 1]}, pa); pb = __builtin_elementwise_fma((f32x2){rl[2], rl[3]}, (f32x2){wv[r + 2], wv[r + 3]}, pb); } \
                const float score = (pa.x + pa.y) + (pb.x + pb.y); \
                const int row = 32 * tile + kl; const int key = 64 * (MM) + row; const bool valid = key <= myq; \
                const unsigned bits = __float_as_uint(score); const unsigned u = bits ^ ((unsigned)((int)bits >> 31) | 0x80000000u); const int bin = (int)(u >> 20); \
                *(GAS float*)(SCb + (scoff + 4u * (unsigned)key)) = score; \
                if (valid) __hip_atomic_fetch_add((LAS unsigned*)(myreg + ((bin >> 1) << 2)), 1u << ((bin & 1) << 4), __ATOMIC_RELAXED, __HIP_MEMORY_SCOPE_WORKGROUP); \
            } } while (0)
#define IDX_STEP(J, RW) do { const int mm_ = m + (J); if (mm_ < nch) { \
            const LAS unsigned char* kb_ = KST + ((J) & 1) * 8192; bf16x8 FR[2][4]; \
            _Pragma("unroll") for (int tile = 0; tile < 2; ++tile) _Pragma("unroll") for (int c = 0; c < 4; ++c) FR[tile][c] = *(const LAS bf16x8*)(kb_ + fo[c] + tile * 4096); \
            asm volatile("s_waitcnt lgkmcnt(0)" ::: "memory"); SBAR(); \
            AC[(J) & 1][0] = __builtin_amdgcn_mfma_f32_32x32x16_bf16(af[0], FR[0][0], f32x16{}, 0, 0, 0); AC[(J) & 1][1] = __builtin_amdgcn_mfma_f32_32x32x16_bf16(af[0], FR[1][0], f32x16{}, 0, 0, 0); \
            _Pragma("unroll") for (int c = 1; c < 4; ++c) { AC[(J) & 1][0] = __builtin_amdgcn_mfma_f32_32x32x16_bf16(af[c], FR[0][c], AC[(J) & 1][0], 0, 0, 0); \
                AC[(J) & 1][1] = __builtin_amdgcn_mfma_f32_32x32x16_bf16(af[c], FR[1][c], AC[(J) & 1][1], 0, 0, 0); } \
            SBAR(); \
            if (mm_ >= 1) IDX_POST(((J) + 1) & 1, mm_ - 1); \
            if (mm_ + 1 < nch) *(LAS v4u*)(KST + (((J) + 1) & 1) * 8192 + sdst) = RW; \
            RW = KG(mm_ + 3 < nch ? mm_ + 3 : nch - 1); \
            __syncthreads(); } } while (0)
        for (int m = 0; m < nch; m += 2) { IDX_STEP(0, R1); IDX_STEP(1, R0); }
        if ((nch - 1) & 1) IDX_POST(1, nch - 1); else IDX_POST(0, nch - 1);
#undef IDX_POST
#undef IDX_STEP
#undef KG
        TSUB_STOP(1); TSUB_START(2);
        {
            int bsq[2], nbq[2]; bool alq[2];
#pragma unroll
            for (int q = 0; q < 2; ++q) {
                const LAS unsigned* hw = (const LAS unsigned*)(reg + q * 8192) + 32 * lane;
                unsigned wd[32]; unsigned s = 0;
#pragma unroll
                for (int i = 0; i < 8; ++i) { const v4u v = *(const LAS v4u*)(hw + 4 * i); wd[4 * i] = v.x; wd[4 * i + 1] = v.y; wd[4 * i + 2] = v.z; wd[4 * i + 3] = v.w; }
#pragma unroll
                for (int i = 0; i < 32; ++i) s += (wd[i] & 0xffffu) + (wd[i] >> 16);
                unsigned v = s;
#pragma unroll
                for (int off = 1; off < 64; off <<= 1) { const unsigned tt = __shfl_down(v, off); if (lane + off < 64) v += tt; }
                const unsigned sufx = v - s; const unsigned total = __builtin_amdgcn_readfirstlane(v);
                int nbel = 0; int fn = (int)sufx; int cum = (int)sufx;
#pragma unroll
                for (int i = 31; i >= 0; --i) {
                    cum += (int)(wd[i] >> 16);     { const int mk = (cum - 256) >> 31; nbel -= mk; const int cm = cum & mk; fn = cm > fn ? cm : fn; }
                    cum += (int)(wd[i] & 0xffffu); { const int mk = (cum - 256) >> 31; nbel -= mk; const int cm = cum & mk; fn = cm > fn ? cm : fn; }
                }
                const int fb = 64 * lane + 63 - nbel;
                const unsigned long long bm = __ballot(sufx < 256u && v >= 256u);
                const int lstar = bm ? (int)__builtin_ctzll(bm) : 0;
                bsq[q] = __builtin_amdgcn_readlane(fb, lstar); nbq[q] = __builtin_amdgcn_readlane(fn, lstar); alq[q] = total <= 256u;
            }
            bstar = hi ? bsq[1] : bsq[0]; nab = hi ? nbq[1] : nbq[0]; allq = hi ? alq[1] : alq[0];
        }
        TSUB_STOP(2); TSUB_START(3);
        { const v4u z = {0u, 0u, 0u, 0u};
#pragma unroll
          for (int i = 0; i < 16; ++i) *(LAS v4u*)(reg + (i * 64 + lane) * 16) = z; }
        asm volatile("s_waitcnt vmcnt(0)" ::: "memory");
        { const int ntile = 2 * nch;
          auto p1_load = [&](float (&sv)[16], int tb) {
#pragma unroll
              for (int j = 0; j < 16; ++j) { const int tt = tb + j < ntile ? tb + j : ntile - 1; sv[j] = __builtin_nontemporal_load((const GAS float*)(SCb + (scoff + 4u * (unsigned)(32 * tt + kl)))); } };
          auto p1_proc = [&](float (&sv)[16], int tb) {
#pragma unroll
              for (int j = 0; j < 16; ++j) if (tb + j < ntile) {
                  const int key = 32 * (tb + j) + kl; const bool valid = key <= myq; const float score = sv[j];
                  const unsigned bits = __float_as_uint(score); const unsigned u = bits ^ ((unsigned)((int)bits >> 31) | 0x80000000u); const int bin = (int)(u >> 20);
                  const bool above = valid && (allq || bin > bstar), cand = valid && !allq && bin == bstar;
                  const unsigned long long bal = __ballot(above);
                  if (kl == 0) *(LAS unsigned*)(myreg + 6144 + (tb + j) * 4) = hi ? (unsigned)(bal >> 32) : (unsigned)bal;
                  if (__any(cand)) { if (cand) { const unsigned slot = __hip_atomic_fetch_add((LAS unsigned*)(myreg + 7168), 1u, __ATOMIC_RELAXED, __HIP_MEMORY_SCOPE_WORKGROUP);
                      if (slot < 768u) { v2u e; e.x = ~(unsigned)key; e.y = u; *(LAS v2u*)(myreg + slot * 8) = e; } } }
              } };
          float sa[16], sb[16];
          p1_load(sa, 0);
          for (int tb = 0; tb < ntile; tb += 32) { p1_load(sb, tb + 16); p1_proc(sa, tb); p1_load(sa, tb + 32); p1_proc(sb, tb + 16); } }
        TSUB_STOP(3); TSUB_START(4);
        {
            if (kl == 0) *(LAS int*)(myreg + 7172) = allq ? 0 : 256 - nab;
            __syncthreads();
            int f = w;
#pragma nounroll
            for (int q = 0; q < 16; ++q) {
                LAS unsigned char* rq = F.lds + q * 8192;
                unsigned nc = *(LAS unsigned*)(rq + 7168); nc = nc > 768u ? 768u : nc; nc = __builtin_amdgcn_readfirstlane(nc);
                const int need = __builtin_amdgcn_readfirstlane(*(LAS int*)(rq + 7172));
                const int nck = need > 0 ? (int)((nc + 63u) >> 6) : 0;
                for (; f < nck; f += 8) { const unsigned i = (unsigned)f * 64u + lane; const bool act = i < nc;
                    unsigned long long me = 0ull; if (act) me = *(LAS unsigned long long*)(rq + i * 8);
                    int rank = 0;
                    unsigned j = 0;
                    for (; j + 4 <= nc; j += 4) { const unsigned long long o0 = *(LAS unsigned long long*)(rq + j * 8), o1 = *(LAS unsigned long long*)(rq + j * 8 + 8), o2 = *(LAS unsigned long long*)(rq + j * 8 + 16), o3 = *(LAS unsigned long long*)(rq + j * 8 + 24);
                        rank += (o0 > me ? 1 : 0) + (o1 > me ? 1 : 0) + (o2 > me ? 1 : 0) + (o3 > me ? 1 : 0); }
                    for (; j < nc; ++j) { const unsigned long long o = *(LAS unsigned long long*)(rq + j * 8); rank += o > me ? 1 : 0; }
                    const unsigned key = ~(unsigned)me;
                    if (act && rank < need) __hip_atomic_fetch_or((LAS unsigned*)(rq + 6144 + ((key >> 5) << 2)), 1u << (key & 31u), __ATOMIC_RELAXED, __HIP_MEMORY_SCOPE_WORKGROUP);
                }
                f -= nck;
            }
            __syncthreads();
#pragma unroll
            for (int q = 0; q < 2; ++q) {
                const v4u mrow = *(LAS v4u*)(reg + q * 8192 + 6144 + lane * 16);
                *(GAS v4u*)(MASKA + (size_t)(t0 + 2 * w + q) * 256 + 4 * lane) = mrow;
            }
        }
        TSUB_STOP(4);
    }
    __syncthreads();
}
__device__ __forceinline__ void phase_indexer(Frame& F) {
    for (int p = F.bid; p < 256; p += F.G) { indexer_item(F, 511 - p); indexer_item(F, p); }
}

__device__ __forceinline__ void phase_moba_gate(Frame& F) {
    const int lane = F.lane, tk = lane & 31, half = lane >> 5;
    const bf16* PROJ = WSP(bf16, WS_PROJ); const float* KMEAN = WSP(float, WS_KMEAN); unsigned* PICK = WSP(unsigned, WS_PICK); int* CNT2 = WSP(int, WS_CNT2);
    for (int item = F.wave * F.G + F.bid; item < 256 * 6; item += 8 * F.G) {
        const int grp = item / 6, h = item - grp * 6, t = grp * 32 + tk, c = grp >> 3;
        unsigned m0 = 0u, m1 = 0u, m2 = 0u;
        if (c > 0) {
            float qv[64];
            { const GAS v4u* qp = (const GAS v4u*)(PROJ + (size_t)t * NPROJ + PJ_QB + h * 128 + 64 * half);
#pragma unroll
              for (int i = 0; i < 8; ++i) { const v4u w = qp[i]; qv[8 * i] = bflo(w.x); qv[8 * i + 1] = bfhi(w.x); qv[8 * i + 2] = bflo(w.y); qv[8 * i + 3] = bfhi(w.y); qv[8 * i + 4] = bflo(w.z); qv[8 * i + 5] = bfhi(w.z); qv[8 * i + 6] = bflo(w.w); qv[8 * i + 7] = bfhi(w.w); } }
            float b0 = -__builtin_inff(), b1 = b0, b2 = b0;
            const float* kmh = KMEAN + h * 128 + 64 * half;
            f32x4 ka[16], kb[16];
#define GATE_LOAD(K_, n_) do { const GAS f32x4* kp_ = (const GAS f32x4*)(kmh + (size_t)((n_) < c ? (n_) : c - 1) * 768); _Pragma("unroll") for (int i = 0; i < 16; ++i) K_[i] = kp_[i]; } while (0)
#define GATE_SCORE(K_, n_) do { if ((n_) < c) { float g0 = 0.f, g1 = 0.f, g2 = 0.f, g3 = 0.f; \
                _Pragma("unroll") for (int i = 0; i < 16; ++i) { g0 = fmaf(qv[4 * i], K_[i][0], g0); g1 = fmaf(qv[4 * i + 1], K_[i][1], g1); g2 = fmaf(qv[4 * i + 2], K_[i][2], g2); g3 = fmaf(qv[4 * i + 3], K_[i][3], g3); } \
                float g = (g0 + g1) + (g2 + g3); g += __shfl_xor(g, 32); const unsigned bit = 1u << (n_); \
                if (g > b0) { b2 = b1; m2 = m1; b1 = b0; m1 = m0; b0 = g; m0 = bit; } else if (g > b1) { b2 = b1; m2 = m1; b1 = g; m1 = bit; } else if (g > b2) { b2 = g; m2 = bit; } } } while (0)
            GATE_LOAD(ka, 0);
            for (int n = 0; n < c; n += 2) { GATE_LOAD(kb, n + 1); GATE_SCORE(ka, n); GATE_LOAD(ka, n + 2); GATE_SCORE(kb, n + 1); }
#undef GATE_LOAD
#undef GATE_SCORE
        }
        const unsigned n0 = m0 ? (unsigned)__builtin_ctz(m0) : 255u, n1 = m1 ? (unsigned)__builtin_ctz(m1) : 255u, n2 = m2 ? (unsigned)__builtin_ctz(m2) : 255u;
        if (half == 0) PICK[(size_t)t * 6 + h] = n0 | (n1 << 8) | (n2 << 16);
        int cn = 0;
        for (int n = 0; n < c; ++n) { const unsigned long long b = __ballot(half == 0 && (n0 == (unsigned)n || n1 == (unsigned)n || n2 == (unsigned)n)); if (lane == n) cn = (int)__builtin_popcountll(b); }
        if (lane < 32) CNT2[(h * 256 + grp) * 32 + lane] = cn;
    }
}
__device__ __forceinline__ void phase_moba_lists(Frame& F) {
    const int lane = F.lane, tk = lane & 31, half = lane >> 5;
    const unsigned* PICK = WSP(unsigned, WS_PICK); const int* CNT2 = WSP(int, WS_CNT2); unsigned* LST = WSP(unsigned, WS_LST); int* LEN = WSP(int, WS_LEN);
    for (int item = F.wave * F.G + F.bid; item < 256 * 6; item += 8 * F.G) {
        const int grp = item / 6, h = item - grp * 6, t = grp * 32 + tk, c = grp >> 3;
        int before = 0, total = 0;
        { const int* cp = CNT2 + (h * 256 + 128 * half) * 32 + tk;
#pragma unroll 32
          for (int g = 0; g < 128; ++g) { const int v = cp[g * 32]; total += v; before += (128 * half + g < grp) ? v : 0; } }
        before += __shfl_xor(before, 32); total += __shfl_xor(total, 32);
        if (grp == 0 && lane < 32) LEN[h * 32 + lane] = total;
        if (c > 0) {
            const unsigned pk = PICK[(size_t)t * 6 + h]; const unsigned n0 = pk & 255u, n1 = (pk >> 8) & 255u, n2 = (pk >> 16) & 255u;
            int r0 = 0, r1 = 0, r2 = 0; const unsigned long long lt = (1ull << tk) - 1ull;
            for (int n = 0; n < c; ++n) { const unsigned long long b = __ballot(half == 0 && (n0 == (unsigned)n || n1 == (unsigned)n || n2 == (unsigned)n));
                const int rk = __builtin_amdgcn_readlane(before, n) + (int)__builtin_popcountll(b & lt);
                if (n0 == (unsigned)n) r0 = rk; if (n1 == (unsigned)n) r1 = rk; if (n2 == (unsigned)n) r2 = rk; }
            if (half == 0) { const int hb = h * LCAP;
                if (n0 < 32u) LST[hb + 256 * (31 * (int)n0 - (int)n0 * ((int)n0 - 1) / 2) + r0] = (unsigned)t | (1u << 16);
                if (n1 < 32u) LST[hb + 256 * (31 * (int)n1 - (int)n1 * ((int)n1 - 1) / 2) + r1] = (unsigned)t | (2u << 16);
                if (n2 < 32u) LST[hb + 256 * (31 * (int)n2 - (int)n2 * ((int)n2 - 1) / 2) + r2] = (unsigned)t | (3u << 16); }
        }
    }
}
__device__ __forceinline__ void phase_attn_merge(Frame& F) {
    const int gw = F.bid * 8 + F.wave, NGW = F.G * 8, lane = F.lane;
    const unsigned* PICK = WSP(unsigned, WS_PICK); const bf16* PO = WSP(bf16, WS_PO); const float* PML = WSP(float, WS_PML); const bf16* PO2 = WSP(bf16, WS_PO2); const float* PML2 = WSP(float, WS_PML2); bf16* OATT = WSP(bf16, WS_OATT);
    for (int tp = gw; tp < T / 2; tp += NGW) {
#pragma unroll 3
        for (int i = 0; i < 6; ++i) { const int p = lane + 64 * i, t = 2 * tp + p / 192, wi = p % 192, hx = wi >> 4, d8 = wi & 15; const bool dsa = hx < 6; const int h = dsa ? hx : hx - 6;
            unsigned pk = 0xffffffu; if (!dsa) pk = PICK[(size_t)t * 6 + h];
            const int ns = (t >> 11) + 1;
            const bool val[4] = {true, dsa ? 1 < ns : (pk & 255u) < 32u, dsa ? 2 < ns : ((pk >> 8) & 255u) < 32u, dsa ? 3 < ns : ((pk >> 16) & 255u) < 32u};
            const bf16* pob = dsa ? PO2 : PO; const float* pmb = dsa ? PML2 : PML;
            float m[4], lv[4]; v4u po[4];
#pragma unroll
            for (int sl = 0; sl < 4; ++sl) { const size_t r = (size_t)sl * T + t; const f32x2 ml = *(const GAS f32x2*)(pmb + (r * 6 + h) * 2); m[sl] = val[sl] ? ml.x : -3e38f; lv[sl] = val[sl] ? ml.y : 0.f;
                const v4u x = *(const GAS v4u*)(pob + r * 768 + h * 128 + 8 * d8); const v4u z = {0u, 0u, 0u, 0u}; po[sl] = val[sl] ? x : z; }
            const float M = fmaxf(fmaxf(m[0], m[1]), fmaxf(m[2], m[3]));
            float w[4], W = 0.f;
#pragma unroll
            for (int sl = 0; sl < 4; ++sl) { w[sl] = val[sl] ? __builtin_amdgcn_exp2f(m[sl] - M) * lv[sl] : 0.f; W += w[sl]; }
            const float inv = 1.f / W;
            float o[8] = {0, 0, 0, 0, 0, 0, 0, 0};
#pragma unroll
            for (int sl = 0; sl < 4; ++sl) { const float ws_ = w[sl] * inv;
                o[0] = fmaf(ws_, bflo(po[sl].x), o[0]); o[1] = fmaf(ws_, bfhi(po[sl].x), o[1]); o[2] = fmaf(ws_, bflo(po[sl].y), o[2]); o[3] = fmaf(ws_, bfhi(po[sl].y), o[3]);
                o[4] = fmaf(ws_, bflo(po[sl].z), o[4]); o[5] = fmaf(ws_, bfhi(po[sl].z), o[5]); o[6] = fmaf(ws_, bflo(po[sl].w), o[6]); o[7] = fmaf(ws_, bfhi(po[sl].w), o[7]); }
            v4u ob; ob.x = cvtpk(o[0], o[1]); ob.y = cvtpk(o[2], o[3]); ob.z = cvtpk(o[4], o[5]); ob.w = cvtpk(o[6], o[7]);
            *(GAS v4u*)(OATT + (size_t)t * 2048 + hx * 128 + 8 * d8) = ob; }
    }
}

constexpr int CONV_IPQ = 128, CONV_NQE = CONV_E_N / CONV_IPQ, CONV_NQR = (CONV_REST + CONV_IPQ - 1) / CONV_IPQ;
__device__ __forceinline__ void phase_attention(Frame& F, const Args& a, int l, int rep) {
    const GAS bf16* PROJ = (const GAS bf16*)WSP(bf16, WS_PROJ); const GAS bf16* QAI = (const GAS bf16*)WSP(bf16, WS_QAI); const GAS bf16* KVA = (const GAS bf16*)WSP(bf16, WS_KVA); const GAS bf16* MKV = (const GAS bf16*)WSP(bf16, WS_MKV);
    GAS bf16* OATT = (GAS bf16*)WSP(bf16, WS_OATT); const GAS unsigned* MASKA = (const GAS unsigned*)WSP(unsigned, WS_MASKA);
    GAS bf16* PO = (GAS bf16*)WSP(bf16, WS_PO); GAS float* PML = (GAS float*)WSP(float, WS_PML); const GAS unsigned* LST = (const GAS unsigned*)WSP(unsigned, WS_LST);
    LAS int* cum = (LAS int*)(F.lds + LDS_BYTES - 256 - 2048); LAS int* lenl = cum + 256;
    { const int* LEN = WSP(int, WS_LEN);
      if (F.wave == 0) { const int l3 = 3 * F.lane; const int e0 = LEN[l3], e1 = LEN[l3 + 1], e2 = LEN[l3 + 2]; const int v0 = (e0 + 255) >> 8, v1 = (e1 + 255) >> 8, v2 = (e2 + 255) >> 8;
          const int s_ = v0 + v1 + v2; int inc = s_;
#pragma unroll
          for (int o = 1; o < 64; o <<= 1) { const int u = __shfl_up(inc, o); if (F.lane >= o) inc += u; }
          const int exc = inc - s_; cum[l3] = exc; cum[l3 + 1] = exc + v0; cum[l3 + 2] = exc + v0 + v1; lenl[l3] = e0; lenl[l3 + 1] = e1; lenl[l3 + 2] = e2; if (F.lane == 63) cum[192] = inc; }
      __syncthreads(); }
    const int U = __builtin_amdgcn_readfirstlane(cum[192]);
    gu32* head = F.ctl + CW_AQ + 64 * l + 32 * rep;
    for (;;) {
        if (F.tid == 0) F.MISC[16] = __hip_atomic_fetch_add(head, 1u, RLX_AGENT);
        __syncthreads();
        const int i = __builtin_amdgcn_readfirstlane((int)F.MISC[16]);
        __syncthreads();
        const int nconv = CONV_NQE + ((l + 1 < NLAYER) ? CONV_NQR : 0), R = (nconv + 287) / 288, NS = 288 * (1 + R);
        if (i >= NS + 384 + U + 128) break;
        const int slot = i / (1 + R), sub = i - slot * (1 + R);
        if (i < NS && sub > 0) { int q = slot * R + sub - 1, lc = l, b_ = CONV_E_LO, e_ = CONV_E_LO + CONV_E_N, hole = 0x7fffffff;
            if (q >= nconv) continue;
            if (q >= CONV_NQE) { q -= CONV_NQE; lc = l + 1; b_ = 0; e_ = CONV_REST; hole = CONV_E_LO; }
            b_ += q * CONV_IPQ; e_ = b_ + CONV_IPQ < e_ ? b_ + CONV_IPQ : e_;
            { size_t z_ = 0; asm volatile("" : "+s"(z_)); F.z = z_; F.ws = a.ws + z_; int t_ = F.tid; asm volatile("" : "+v"(t_)); F.lane = t_ & 63; }
            TSUB_START(7); conv_items(F, a, lc, b_ + F.wave, 8, e_, hole); TSUB_STOP(7); continue; }
        int tl = F.tid; asm volatile("" : "+v"(tl));
        TSUB_START(6);
        if (i < NS + 192) { int h, qb, seg, nt;
            if (i < NS) { h = slot % 6; const int f = slot / 6; nt = 32; if (f < 8) { qb = 8 + f; seg = 0; } else if (f < 24) { const int g = f - 8; qb = 16 + (g >> 1); seg = g & 1; } else { const int g = f - 24; qb = 24 + g / 3; seg = g - 3 * (g / 3); } }
            else { const int e6 = i - NS; h = e6 % 6; const int e = e6 / 6, r = 7 - (e >> 2); qb = r + 8 * (e & 3); seg = qb >> 3; nt = 4 * (r + 1); }
            const int qpos0 = qb * 256, kofs = seg * 2048; const float sl = exp2f(-8.f * (float)(2 * h + 1) / 12.f) * LOG2E;
            att::attn_unit<4>(QAI + (size_t)qpos0 * NQAI + h * 128, NQAI, KVA + (size_t)kofs * NKVA + h * 128, KVA + (size_t)kofs * NKVA + 768 + h * 128, NKVA, nullptr, 0, nt, qpos0, sl, MASKA, nullptr, (LAS char*)F.lds, tl,
                              256, (GAS bf16*)WSP(bf16, WS_PO2), (GAS float*)WSP(float, WS_PML2), h, kofs); }
        else if (i < NS + 384) { const int m = i - NS - 192, qb = 31 - m / 6, h = m % 6, qpos0 = qb * 256; const float sl = exp2f(-8.f * (float)(2 * h + 2) / 12.f) * LOG2E;
            att::attn_unit<2>(PROJ + (size_t)qpos0 * NPROJ + PJ_QB + h * 128, NPROJ, PROJ + (size_t)qpos0 * NPROJ + PJ_KB + h * 128, PROJ + (size_t)qpos0 * NPROJ + PJ_VB + h * 128, NPROJ, nullptr, 0, 4, qpos0, sl, nullptr, nullptr, (LAS char*)F.lds, tl, 256, PO, PML, h); }
        else if (i < NS + 384 + U) { const int u = i - NS - 384; int lo = 0, hi_ = 192;
#pragma nounroll
            while (hi_ - lo > 1) { const int mid = (lo + hi_) >> 1; if (__builtin_amdgcn_readfirstlane(cum[mid]) <= u) lo = mid; else hi_ = mid; }
            const int h = lo >> 5, n = lo & 31, k = u - __builtin_amdgcn_readfirstlane(cum[lo]), len = __builtin_amdgcn_readfirstlane(lenl[lo]), kpos0 = n * 256;
            const int nv = len - 256 * k < 256 ? len - 256 * k : 256; const float sl = exp2f(-8.f * (float)(2 * h + 2) / 12.f) * LOG2E;
            att::attn_unit<3>(PROJ + PJ_QB + h * 128, NPROJ, PROJ + (size_t)kpos0 * NPROJ + PJ_KB + h * 128, PROJ + (size_t)kpos0 * NPROJ + PJ_VB + h * 128, NPROJ, nullptr, 0, 4, kpos0, sl, nullptr, LST + (h * LCAP + 256 * (31 * n - n * (n - 1) / 2) + 256 * k), (LAS char*)F.lds, tl, nv, PO, PML, h); }
        else { const int m = i - NS - 384 - U, h = m & 3, qpos0 = (m >> 2) * 256;
            att::attn_unit<0>(PROJ + (size_t)qpos0 * NPROJ + PJ_QC + h * 128, NPROJ, MKV + h * 128, MKV + 512 + h * 128, 1024, OATT + (size_t)qpos0 * 2048 + 1536 + h * 128, 2048, 4, qpos0, 0.f, nullptr, nullptr, (LAS char*)F.lds, tl); }
        TSUB_STOP(6);
    }
}

__device__ __forceinline__ void phase_ln1_router(Frame& F, const Args& a, int l, int rep) {
    const int lane = F.lane, w = F.wave, tid = F.tid;
    const bf16* PRE = WSP(bf16, WS_PRE); bf16* X1B = WSP(bf16, WS_X1B); const float* WR = WSP(float, WS_WR + WDR(l)); int* ROUTE = WSP(int, WS_ROUTE); int* CNT = WSP(int, WS_CNT);
    const float* g1 = (a.in[I_LN1G] + F.z) + l * 2048; const float* b1 = (a.in[I_LN1B] + F.z) + l * 2048; const float* bgrp = (a.in[I_BGRP] + F.z) + l * 4; const float* brt = (a.in[I_BRT] + F.z) + l * 32;
    constexpr int XS = 2052, NIT = T / 16;
    constexpr int XP = 4112;
    LAS unsigned char* xh = F.lds; LAS unsigned char* xl = F.lds + 16 * XP; LAS float* part = (LAS float*)(F.lds + 32 * XP); LAS float* bias = part + 8 * 16 * 48;
    const GAS bf16x8* WRB = (const GAS bf16x8*)WSP(bf16, WS_WR + WDR(l));
    if (tid < 36) bias[tid] = tid < 32 ? brt[tid] : bgrp[tid - 32];
    const int ar = lane & 15, kq = lane >> 4;
    v4u va[4], vb[4];
    int it = F.bid;
    if (it < NIT) { const GAS v4u* xr = (const GAS v4u*)(PRE + (size_t)(it * 16 + 2 * w) * 2048) + lane;
#pragma unroll
        for (int j = 0; j < 4; ++j) va[j] = xr[64 * j];
#pragma unroll
        for (int j = 0; j < 4; ++j) vb[j] = xr[256 + 64 * j]; }
    auto ln_row = [&](const v4u (&vw)[4], int rl, int t) {
        f32x4 v[8]; float s = 0.f;
#pragma unroll
        for (int j = 0; j < 4; ++j) { v[2 * j] = (f32x4){bflo(vw[j].x), bfhi(vw[j].x), bflo(vw[j].y), bfhi(vw[j].y)}; v[2 * j + 1] = (f32x4){bflo(vw[j].z), bfhi(vw[j].z), bflo(vw[j].w), bfhi(vw[j].w)}; }
#pragma unroll
        for (int j = 0; j < 8; ++j) s += (v[j].x + v[j].y) + (v[j].z + v[j].w);
        const float mean = wave_sum(s) * (1.f / 2048.f); float s2 = 0.f;
#pragma unroll
        for (int j = 0; j < 8; ++j) { v[j] = v[j] - mean; s2 += (v[j].x * v[j].x + v[j].y * v[j].y) + (v[j].z * v[j].z + v[j].w * v[j].w); }
        const float rstd = 1.f / sqrtf(wave_sum(s2) * (1.f / 2048.f) + LN_EPS);
#pragma unroll
        for (int j = 0; j < 4; ++j) { const int col = 8 * lane + 512 * j;
            const f32x4 ga = *(const GAS f32x4*)(g1 + col), gb = *(const GAS f32x4*)(g1 + col + 4), ba = *(const GAS f32x4*)(b1 + col), bb = *(const GAS f32x4*)(b1 + col + 4);
            const f32x4 o0 = v[2 * j] * rstd * ga + ba, o1 = v[2 * j + 1] * rstd * gb + bb;
            v4u ob; ob.x = cvtpk(o0[0], o0[1]); ob.y = cvtpk(o0[2], o0[3]); ob.z = cvtpk(o1[0], o1[1]); ob.w = cvtpk(o1[2], o1[3]); *(GAS v4u*)(X1B + (size_t)t * 2048 + col) = ob;
            { float lo[8];
#pragma unroll
              for (int q = 0; q < 4; ++q) { lo[q] = o0[q] - bf2f(f2bf(o0[q])); lo[4 + q] = o1[q] - bf2f(f2bf(o1[q])); }
              v4u oh; oh.x = pk2(o0[0], o0[1]); oh.y = pk2(o0[2], o0[3]); oh.z = pk2(o1[0], o1[1]); oh.w = pk2(o1[2], o1[3]);
              v4u ol; ol.x = pk2(lo[0], lo[1]); ol.y = pk2(lo[2], lo[3]); ol.z = pk2(lo[4], lo[5]); ol.w = pk2(lo[6], lo[7]);
              *(LAS v4u*)(xh + rl * XP + col * 2) = oh; *(LAS v4u*)(xl + rl * XP + col * 2) = ol; } }
    };
    for (; it < NIT; it += F.G) {
        const int t0 = it * 16;
        ln_row(va, 2 * w, t0 + 2 * w); ln_row(vb, 2 * w + 1, t0 + 2 * w + 1);
        __syncthreads();
        { const int nx = it + F.G;
          if (nx < NIT) { const GAS v4u* xr = (const GAS v4u*)(PRE + (size_t)(nx * 16 + 2 * w) * 2048) + lane;
#pragma unroll
            for (int j = 0; j < 4; ++j) va[j] = xr[64 * j];
#pragma unroll
            for (int j = 0; j < 4; ++j) vb[j] = xr[256 + 64 * j]; } }
        asm volatile("" ::: "memory");
        { f32x4 acc[3] = {{0, 0, 0, 0}, {0, 0, 0, 0}, {0, 0, 0, 0}};
#pragma unroll 4
          for (int s = 0; s < 8; ++s) { const int S = 8 * w + s;
              const bf16x8 ah = *(const LAS bf16x8*)(xh + ar * XP + (32 * S + 8 * kq) * 2), al = *(const LAS bf16x8*)(xl + ar * XP + (32 * S + 8 * kq) * 2);
              const GAS bf16x8* wr = WRB + (size_t)S * 384 + lane;
              bf16x8 bh[3], bl[3];
#pragma unroll
              for (int c = 0; c < 3; ++c) { bh[c] = wr[c * 128]; bl[c] = wr[c * 128 + 64]; }
#pragma unroll
              for (int c = 0; c < 3; ++c) { acc[c] = __builtin_amdgcn_mfma_f32_16x16x32_bf16(al, bh[c], acc[c], 0, 0, 0); acc[c] = __builtin_amdgcn_mfma_f32_16x16x32_bf16(ah, bl[c], acc[c], 0, 0, 0);
                  acc[c] = __builtin_amdgcn_mfma_f32_16x16x32_bf16(ah, bh[c], acc[c], 0, 0, 0); } }
#pragma unroll
          for (int c = 0; c < 3; ++c)
#pragma unroll
              for (int r = 0; r < 4; ++r) part[(w * 16 + 4 * kq + r) * 48 + 16 * c + ar] = acc[c][r]; }
        __syncthreads();
        if (w == 0) {
            const LAS float* Pp = part + ar * 48;
            float gl[4]; int gs = 0;
#pragma unroll
            for (int j = 0; j < 4; ++j) { float s = 0.f;
#pragma unroll
                for (int ww = 0; ww < 8; ++ww) s += Pp[ww * 768 + 32 + j];
                gl[j] = s + bias[32 + j]; }
#pragma unroll
            for (int j = 1; j < 4; ++j) if (gl[j] > gl[gs]) gs = j;
            float den = 0.f;
#pragma unroll
            for (int j = 0; j < 4; ++j) den += expf(gl[j] - gl[gs]);
            const float pg = 1.f / den;
            float el[8];
#pragma unroll
            for (int j = 0; j < 8; ++j) { float s = 0.f;
#pragma unroll
                for (int ww = 0; ww < 8; ++ww) s += Pp[ww * 768 + 8 * gs + j];
                el[j] = s + bias[8 * gs + j]; }
            int i0 = 0;
#pragma unroll
            for (int j = 1; j < 8; ++j) if (el[j] > el[i0]) i0 = j;
            int i1 = (i0 == 0) ? 1 : 0;
#pragma unroll
            for (int j = 0; j < 8; ++j) if (j != i0 && el[j] > el[i1]) i1 = j;
            const float e1 = expf(el[i1] - el[i0]); const float w0 = pg / (1.f + e1), w1 = pg * e1 / (1.f + e1);
            const int x0 = 8 * gs + i0, x1 = 8 * gs + i1, el_ = lane & 31;
            int lp0 = 0, lp1 = 0, cn = 0;
#pragma unroll
            for (int j = 0; j < 16; ++j) { const int y0 = __builtin_amdgcn_readlane(x0, j), y1 = __builtin_amdgcn_readlane(x1, j);
                const int m0 = (y0 == x0) | (y1 == x0), m1 = (y0 == x1) | (y1 == x1);
                lp0 += (j < ar) ? m0 : 0; lp1 += (j < ar) ? m1 : 0; cn += (y0 == el_) + (y1 == el_); }
            if (lane < 32) CNT[it * 32 + lane] = cn;
            if (lane < 16) { int* R = ROUTE + (size_t)(t0 + lane) * 8; R[0] = x0; R[1] = x1; R[2] = (int)__float_as_uint(w0); R[3] = (int)__float_as_uint(w1); R[4] = lp0; R[5] = lp1; }
        }
    }
}

__device__ __forceinline__ void phase_gather(Frame& F, int l) {
    const int lane = F.lane, tid = F.tid, w = F.wave;
    int* info = F.info + l * 256;
    const bf16* X1B = WSP(bf16, WS_X1B); bf16* XG = WSP(bf16, WS_XG); const int* ROUTE = WSP(int, WS_ROUTE); int* ROWMAP = WSP(int, WS_ROWMAP); float* ROWW = WSP(float, WS_ROWW); const int* CNT = WSP(int, WS_CNT);
    if (F.bid >= 32) return;
    LAS int* off = (LAS int*)F.lds;
    LAS int* TOT = off + 64;
    LAS int* CS = off + 128;
    LAS int* PT = off + 1024;
    { const int e = tid & 31, c = tid >> 5; int v[32]; int s = 0;
#pragma unroll
      for (int j = 0; j < 32; ++j) v[j] = CNT[(32 * c + j) * 32 + e];
#pragma unroll
      for (int j = 0; j < 32; ++j) s += v[j];
      CS[c * 32 + e] = s;
      __syncthreads();
      int base = 0, tot = 0;
#pragma unroll
      for (int c2 = 0; c2 < 16; ++c2) { const int x = CS[c2 * 32 + e]; base += c2 < c ? x : 0; tot += x; }
      if (c == 0) TOT[e] = tot;
      int p = base;
#pragma unroll
      for (int j = 0; j < 32; ++j) { PT[(32 * c + j) * 32 + e] = p; p += v[j]; } }
    __syncthreads();
    if (w == 0) { const int c = lane < 32 ? TOT[lane & 31] : 0; const int nt = (c + 255) >> 8; int inc = nt;
#pragma unroll
        for (int o = 1; o < 32; o <<= 1) { const int u = __shfl_up(inc, o); if (lane >= o) inc += u; }
        const int exc = inc - nt;
        if (lane < 32) off[lane] = exc << 8;
        if (lane == 31) off[32] = inc << 8;
        if (F.bid == 0) { if (lane < 32) {
#pragma nounroll
                for (int j = 0; j < nt; ++j) __hip_atomic_store(info + exc + j, lane, RLX_AGENT); }
            if (lane == 31) info[128] = inc; } }
    __syncthreads();
    for (int e = F.bid; e < 32; e += F.G) { const int c = TOT[e]; for (int r = off[e] + c + tid; r < off[e + 1]; r += 512) { ROWMAP[r] = -1; ROWW[r] = 0.f; } }
    const int gw = F.bid * 8 + F.wave, NGW = F.G * 8;
    for (int tb = gw * 64 + lane; tb < T; tb += (F.G < 32 ? F.G : 32) * 512) {
        const int t = tb; const int* R = ROUTE + (size_t)t * 8; const int e0 = R[0], e1 = R[1], p0 = R[4], p1 = R[5];
        const int d0 = off[e0] + PT[(t >> 4) * 32 + e0] + p0, d1 = off[e1] + PT[(t >> 4) * 32 + e1] + p1;
        ROWMAP[d0] = 2 * t; ROWMAP[d1] = 2 * t + 1; ROWW[d0] = __uint_as_float((unsigned)R[2]); ROWW[d1] = __uint_as_float((unsigned)R[3]);
    }
    __syncthreads();
}

__device__ __forceinline__ void phase_ln2(Frame& F, const Args& a, int l, float* xout) {
    const int gw = F.bid * 8 + F.wave, NGW = F.G * 8, lane = F.lane;
    const bf16* X1B = WSP(bf16, WS_X1B); const bf16* Y = WSP(bf16, WS_Y); bf16* HB = WSP(bf16, WS_HB);
    const float* g2 = (a.in[I_LN2G] + F.z) + l * 2048; const float* b2 = (a.in[I_LN2B] + F.z) + l * 2048;
    for (int tb = gw; tb < T; tb += 2 * NGW) {
        v4u xv[2][4], a0[2][4], a1[2][4];
#pragma unroll
        for (int u = 0; u < 2; ++u) { const int t = tb + u * NGW < T ? tb + u * NGW : tb;
            const GAS v4u* xr = (const GAS v4u*)(X1B + (size_t)t * 2048) + lane; const GAS v4u* y0 = (const GAS v4u*)(Y + (size_t)(2 * t) * 2048) + lane; const GAS v4u* y1 = (const GAS v4u*)(Y + (size_t)(2 * t + 1) * 2048) + lane;
#pragma unroll
            for (int j = 0; j < 4; ++j) { xv[u][j] = xr[64 * j]; a0[u][j] = y0[64 * j]; a1[u][j] = y1[64 * j]; } }
#pragma unroll
        for (int u = 0; u < 2; ++u) { const int t = tb + u * NGW; if (t < T) {
        f32x4 v[8]; float s = 0.f;
#pragma unroll
        for (int j = 0; j < 4; ++j) { const v4u x_ = xv[u][j], b0 = a0[u][j], b1 = a1[u][j];
            v[2 * j][0] = ALPHA * bflo(x_.x) + (bflo(b0.x) + bflo(b1.x)); v[2 * j][1] = ALPHA * bfhi(x_.x) + (bfhi(b0.x) + bfhi(b1.x)); v[2 * j][2] = ALPHA * bflo(x_.y) + (bflo(b0.y) + bflo(b1.y)); v[2 * j][3] = ALPHA * bfhi(x_.y) + (bfhi(b0.y) + bfhi(b1.y));
            v[2 * j + 1][0] = ALPHA * bflo(x_.z) + (bflo(b0.z) + bflo(b1.z)); v[2 * j + 1][1] = ALPHA * bfhi(x_.z) + (bfhi(b0.z) + bfhi(b1.z)); v[2 * j + 1][2] = ALPHA * bflo(x_.w) + (bflo(b0.w) + bflo(b1.w)); v[2 * j + 1][3] = ALPHA * bfhi(x_.w) + (bfhi(b0.w) + bfhi(b1.w)); }
#pragma unroll
        for (int j = 0; j < 8; ++j) s += (v[j].x + v[j].y) + (v[j].z + v[j].w);
        const float mean = wave_sum(s) * (1.f / 2048.f); float s2 = 0.f;
#pragma unroll
        for (int j = 0; j < 8; ++j) { v[j] = v[j] - mean; s2 += (v[j].x * v[j].x + v[j].y * v[j].y) + (v[j].z * v[j].z + v[j].w * v[j].w); }
        const float rstd = 1.f / sqrtf(wave_sum(s2) * (1.f / 2048.f) + LN_EPS);
#pragma unroll
        for (int j = 0; j < 4; ++j) { const int col = 8 * lane + 512 * j;
            const f32x4 ga = *(const GAS f32x4*)(g2 + col), gb = *(const GAS f32x4*)(g2 + col + 4), ba = *(const GAS f32x4*)(b2 + col), bb = *(const GAS f32x4*)(b2 + col + 4);
            const f32x4 o0 = v[2 * j] * rstd * ga + ba, o1 = v[2 * j + 1] * rstd * gb + bb;
            if (l + 1 == NLAYER) { *(GAS f32x4*)(xout + (size_t)t * 2048 + col) = o0; *(GAS f32x4*)(xout + (size_t)t * 2048 + col + 4) = o1; }
            else { v4u ob; ob.x = cvtpk(o0[0], o0[1]); ob.y = cvtpk(o0[2], o0[3]); ob.z = cvtpk(o1[0], o1[1]); ob.w = cvtpk(o1[2], o1[3]); *(GAS v4u*)(HB + (size_t)t * 2048 + col) = ob; } }
        } }
    }
}

#ifndef MK_PER_PHASE
#define MK_PER_PHASE 0
#endif
constexpr int NPHASE = 1 + 15 * NLAYER;
#ifndef PH_MASK
#define PH_MASK 0xFFFF
#endif
constexpr bool EN(int k) { return (PH_MASK >> k) & 1; }
#ifndef DBG_DOUBLE_MASK
#define DBG_DOUBLE_MASK 0
#endif
constexpr int REP(int k) { return ((DBG_DOUBLE_MASK >> k) & 1) ? 2 : 1; }
__global__ void __launch_bounds__(512, 2) fwd(Args a) {
    extern __shared__ __attribute__((aligned(16))) unsigned char lds_raw[];
    Frame F;
    F.lds = (LAS unsigned char*)lds_raw; F.MISC = (volatile LAS unsigned*)(F.lds + MISC_OFF);
    F.wave = __builtin_amdgcn_readfirstlane((int)threadIdx.x >> 6); F.lane = lane_id(); F.tid = F.wave * 64 + F.lane; F.G = gridDim.x; F.bid = blockIdx.x;
    F.z = 0; F.ws = a.ws; F.ctl = (gu32*)(F.ws + WS_CTL); F.info = (int*)(F.ws + WS_INFO);
    if (F.tid < 64) F.MISC[F.tid] = 0u;
    __syncthreads();
    XcdBarrier bar = xcd_barrier_post((unsigned*)(F.ctl + CW_BAR), F.MISC + 8, F.wave == 0 ? 1u : 0u);
    const int lo = a.ph_lo, hi = a.ph_hi;
#define ENTER() do { size_t z_ = 0; asm volatile("" : "+s"(z_)); F.z = z_; unsigned char* w_ = a.ws + z_; F.ws = w_; F.ctl = (gu32*)(w_ + WS_CTL); F.info = (int*)(w_ + WS_INFO); int wv_ = F.wave; asm volatile("" : "+s"(wv_)); int t_ = wv_ * 64 + lane_id(); asm volatile("" : "+v"(t_)); F.tid = t_; F.lane = t_ & 63; F.wave = wv_; } while (0)
#ifndef DBG_TIME_MASK
#define DBG_TIME_MASK 0
#endif
#ifndef DBG_TIME_LMASK
#define DBG_TIME_LMASK 3
#endif
#define TSTART(k) do { if (((DBG_TIME_MASK >> (k)) & 1) && ((DBG_TIME_LMASK >> l) & 1) && F.bid == 0 && F.wave == 0) { if (lane_id() == 0) { const unsigned long long t_ = __builtin_amdgcn_s_memrealtime(); F.MISC[22] = (unsigned)t_; } } } while (0)
#define TSTOP(k) do { if (((DBG_TIME_MASK >> (k)) & 1) && ((DBG_TIME_LMASK >> l) & 1) && F.bid == 0 && F.wave == 0) { if (lane_id() == 0) { const unsigned t_ = (unsigned)__builtin_amdgcn_s_memrealtime(); F.MISC[20] = F.MISC[20] + (t_ - F.MISC[22]); } } } while (0)
#define IN(k) (lo <= (k) && (k) < hi)
#define SEAM(k) do { if (lo <= (k) && (k) + 1 < hi) xcd_barrier(bar); } while (0)
    { const int l = 0; TSTART(0); if constexpr (EN(0)) if (IN(0)) for (int rep = 0; rep < REP(0); ++rep) { ENTER(); prologue(F, a); conv_layer(F, a, 0); } SEAM(0); TSTOP(0); }
#pragma unroll
    for (int l = 0; l < NLAYER; ++l) {
        const int pb = 1 + 15 * l;

        TSTART(1); if constexpr (EN(1)) if (IN(pb + 1)) for (int rep = 0; rep < REP(1); ++rep) { ENTER();
            pg8::Gemm g{WSP(bf16, WS_HB), WSP(bf16, WS_WA + WD(l)), T, NA, DM, DM}; pg8::StaticOrder S; S.init(T, NA, F.G, F.bid);
            pg8::EpiA E; E.proj = WSP(bf16, WS_PROJ); E.gate = WSP(bf16, WS_GATE); E.bgate = (a.in[I_BGATE] + F.z) + l * 6144; E.qs = SM_SCALE * LOG2E;
            pg8::gemm_phase<pg8::EpiA, pg8::StaticOrder, true, true>(F.lds, g, S, E, F.tid);
            if (l == 0) { pg8::Gemm g2{WSP(bf16, WS_MEMB), WSP(bf16, WS_WMEM), 256, 1024, DM, DM}; pg8::StaticOrder S2; S2.init(256, 1024, F.G, F.G - 1 - F.bid);
                pg8::EpiScale E2; E2.O = WSP(bf16, WS_MKV); E2.ldc = 1024; E2.pn_a = 0; E2.sa = 1.f; E2.sb = 1.f;
                int t2_ = F.tid; asm volatile("" : "+v"(t2_));
                pg8::gemm_phase<pg8::EpiScale, pg8::StaticOrder, true, true>(F.lds, g2, S2, E2, t2_); }
        } SEAM(pb + 1); TSTOP(1);
        TSTART(2); if constexpr (EN(2)) if (IN(pb + 2)) for (int rep = 0; rep < REP(2); ++rep) { ENTER(); phase_norms(F, a, l); } SEAM(pb + 2); TSTOP(2);
        TSTART(3); if constexpr (EN(3)) if (IN(pb + 3)) for (int rep = 0; rep < REP(3); ++rep) { ENTER();
            phase_moba_gate(F);
            { int t3_ = F.tid; asm volatile("" : "+v"(t3_)); F.tid = t3_; }
            { pg8::Gemm g{WSP(bf16, WS_CQN), WSP(bf16, WS_WC1 + WD(l)), T, NQAI, 512, 512}; pg8::StaticOrder S; S.init(T, NQAI, F.G, F.bid);
              pg8::EpiScale E; E.O = WSP(bf16, WS_QAI); E.ldc = NQAI; E.pn_a = 3; E.sa = SM_SCALE * LOG2E; E.sb = 0.125f;
              pg8::gemm_phase<pg8::EpiScale, pg8::StaticOrder, true, true>(F.lds, g, S, E, F.tid); }
            { pg8::Gemm g{WSP(bf16, WS_CKVN), WSP(bf16, WS_WC2 + WD(l)), T, NKVA, 256, 256}; pg8::StaticOrder S; S.init(T, NKVA, F.G, F.G - 1 - F.bid);
              pg8::EpiScale E; E.O = WSP(bf16, WS_KVA); E.ldc = NKVA; E.pn_a = 0; E.sa = 1.f; E.sb = 1.f;
              pg8::gemm_phase<pg8::EpiScale, pg8::StaticOrder, true, true>(F.lds, g, S, E, F.tid); }
        } SEAM(pb + 3); TSTOP(3);
        TSTART(4); if constexpr (EN(4)) if (IN(pb + 4)) for (int rep = 0; rep < REP(4); ++rep) { ENTER(); TSUB_START(5); phase_moba_lists(F); TSUB_STOP(5); TSUB_START(8); phase_indexer(F); TSUB_STOP(8); } SEAM(pb + 4); TSTOP(4);
        TSTART(5); if constexpr (EN(5)) if (IN(pb + 5)) for (int rep = 0; rep < REP(5); ++rep) { ENTER(); phase_attention(F, a, l, rep); } SEAM(pb + 5); TSTOP(5);
        TSTART(6); if constexpr (EN(6)) if (IN(pb + 6)) for (int rep = 0; rep < REP(6); ++rep) { ENTER(); phase_attn_merge(F); } SEAM(pb + 6); TSTOP(6);
        TSTART(7); if constexpr (EN(7)) if (IN(pb + 7)) for (int rep = 0; rep < REP(7); ++rep) { ENTER();
{ pg8::Gemm g{WSP(bf16, WS_OATT), WSP(bf16, WS_WUP + WD(l)), T, DM, DM, DM}; pg8::UpOrder S; S.so.init(T, DM, F.G, F.bid);
              pg8::EpiUpChain E; E.gate = WSP(bf16, WS_GATE); E.O = WSP(bf16, WS_MERGED);
              pg8::gemm_phase<pg8::EpiUpChain, pg8::UpOrder, true, true>(F.lds, g, S, E, F.tid); }
        } SEAM(pb + 7); TSTOP(7);
        TSTART(8); if constexpr (EN(8)) if (IN(pb + 8)) for (int rep = 0; rep < REP(8); ++rep) { ENTER();
            pg8::Gemm g{WSP(bf16, WS_MERGED), WSP(bf16, WS_WO + WD(l)), T, DM, DM, DM}; pg8::StaticOrder S; S.init(T, DM, F.G, F.bid);
            pg8::EpiPreB E; E.xb = WSP(bf16, WS_HB); E.pre = WSP(bf16, WS_PRE); E.alpha = ALPHA;
            pg8::gemm_phase<pg8::EpiPreB, pg8::StaticOrder, true, true>(F.lds, g, S, E, F.tid);
        } SEAM(pb + 8); TSTOP(8);
        TSTART(9); if constexpr (EN(9)) if (IN(pb + 9)) for (int rep = 0; rep < REP(9); ++rep) { ENTER(); phase_ln1_router(F, a, l, rep); } SEAM(pb + 9); TSTOP(9);
        TSTART(10); if constexpr (EN(10)) if (IN(pb + 10)) for (int rep = 0; rep < REP(10); ++rep) { ENTER(); phase_gather(F, l); } SEAM(pb + 10); TSTOP(10);
        TSTART(11); if constexpr (EN(11)) if (IN(pb + 11)) for (int rep = 0; rep < REP(11); ++rep) { ENTER();
            const int* info = F.info + l * 256; const int ntile = __builtin_amdgcn_readfirstlane(info[128]); const int n1 = ntile < 64 ? ntile : 64;
            pg8::Gemm g{WSP(bf16, WS_X1B), WSP(bf16, WS_W13 + WD(l)), MPAD, 32 * 1024, DM, DM};        pg8::MoeOrder S; S.tile_e = info; S.m_lo = 0; S.m_cnt = n1; S.nN = 4; S.G = F.G; S.c = F.bid;
            pg8::EpiMoeA E; E.hid = WSP(bf16, WS_HID); E.rowsrc = WSP(int, WS_ROWMAP);
            pg8::gemm_phase<pg8::EpiMoeA, pg8::MoeOrder, true, true>(F.lds, g, S, E, F.tid);
        } SEAM(pb + 11); TSTOP(11);
        TSTART(12); if constexpr (EN(12)) if (IN(pb + 12)) for (int rep = 0; rep < REP(12); ++rep) { ENTER();
            const int* info = F.info + l * 256; const int ntile = __builtin_amdgcn_readfirstlane(info[128]); const int n1 = ntile < 64 ? ntile : 64; int nA2 = (ntile - n1) * 4; nA2 = nA2 < F.G ? nA2 : F.G;
            { pg8::Gemm g{WSP(bf16, WS_X1B), WSP(bf16, WS_W13 + WD(l)), MPAD, 32 * 1024, DM, DM};        pg8::MoeOrder S; S.tile_e = info; S.m_lo = n1; S.m_cnt = ntile - n1; S.nN = 4; S.G = nA2; S.c = F.bid;
              pg8::EpiMoeA E; E.hid = WSP(bf16, WS_HID); E.rowsrc = WSP(int, WS_ROWMAP);
              pg8::gemm_phase<pg8::EpiMoeA, pg8::MoeOrder, true, true>(F.lds, g, S, E, F.tid); }
            { pg8::Gemm g{WSP(bf16, WS_HID), WSP(bf16, WS_W2 + WD(l)), MPAD, 32 * 2048, DEXP, DEXP}; pg8::MoeOrder S; S.tile_e = info; S.m_lo = 0; S.m_cnt = n1; S.nN = 8; S.G = F.G - nA2; S.c = F.bid - nA2;
              pg8::EpiMoeB E; E.Y = WSP(bf16, WS_Y); E.rowmap = WSP(int, WS_ROWMAP); E.roww = WSP(float, WS_ROWW);
              int t2_ = F.tid; asm volatile("" : "+v"(t2_));
              pg8::gemm_phase<pg8::EpiMoeB, pg8::MoeOrder, true, true>(F.lds, g, S, E, t2_); }
        } SEAM(pb + 12); TSTOP(12);
        TSTART(13); if constexpr (EN(13)) if (IN(pb + 13)) for (int rep = 0; rep < REP(13); ++rep) { ENTER();
            const int* info = F.info + l * 256; const int ntile = __builtin_amdgcn_readfirstlane(info[128]); const int n1 = ntile < 64 ? ntile : 64;
            pg8::Gemm g{WSP(bf16, WS_HID), WSP(bf16, WS_W2 + WD(l)), MPAD, 32 * 2048, DEXP, DEXP}; pg8::MoeOrder S; S.tile_e = info; S.m_lo = n1; S.m_cnt = ntile - n1; S.nN = 8; S.G = F.G; S.c = F.bid;
            pg8::EpiMoeB E; E.Y = WSP(bf16, WS_Y); E.rowmap = WSP(int, WS_ROWMAP); E.roww = WSP(float, WS_ROWW);
            pg8::gemm_phase<pg8::EpiMoeB, pg8::MoeOrder, true, true>(F.lds, g, S, E, F.tid);
        } SEAM(pb + 13); TSTOP(13);
        TSTART(14); if constexpr (EN(14)) if (IN(pb + 14)) for (int rep = 0; rep < REP(14); ++rep) { ENTER(); phase_ln2(F, a, l, (a.out + F.z)); } if (l + 1 < NLAYER) SEAM(pb + 14); TSTOP(14);
    }
#ifdef DBG_EXTRA_BARRIERS
    for (int i = 0; i < DBG_EXTRA_BARRIERS; ++i) xcd_barrier(bar);
#endif
    if ((DBG_TIME_MASK || DBG_TSUB) && F.bid == (DBG_TSUB ? DBG_TBID : 0) && F.wave == 0) { if (lane_id() == 0) { const unsigned long long t0_ = __builtin_amdgcn_s_memrealtime(); const unsigned w_ = F.MISC[20]; while (__builtin_amdgcn_s_memrealtime() - t0_ < (unsigned long long)w_) __builtin_amdgcn_s_sleep(8); } }
#undef IN
#undef SEAM
}


#ifdef DBG_STOP_PHASE
__global__ void dbg_dump(const unsigned char* ws, size_t off, int kind, long n, float* out, long nout) {
    for (long i = blockIdx.x * 256L + threadIdx.x; i < nout; i += gridDim.x * 256L) { const long j = i % n; float v;
        if (kind == 0) v = __builtin_bit_cast(float, (unsigned)((const unsigned short*)(ws + off))[j] << 16);
        else if (kind == 1) v = ((const float*)(ws + off))[j];
        else v = (float)(((const unsigned*)(ws + off))[j] & 0xffffu);
        out[i] = v; }
}
#endif
extern "C" void kernel_launch(void* const* d_in, const int* in_sizes, int n_in, void* d_out, int out_size, void* d_ws, size_t ws_size, hipStream_t stream) {
    static int grid = 0;
    if (grid == 0) {
        if (n_in != 28 || out_size != T * DM || ws_size < WS_END) { fprintf(stderr, "kernel_launch: unexpected shapes (n_in %d out %d ws %zu)\n", n_in, out_size, ws_size); grid = -1; return; }
        int dev = 0, cus = 0;
        if (hipGetDevice(&dev) != hipSuccess || hipDeviceGetAttribute(&cus, hipDeviceAttributeMultiprocessorCount, dev) != hipSuccess) { grid = -1; return; }
        if (hipFuncSetAttribute((const void*)fwd, hipFuncAttributeMaxDynamicSharedMemorySize, LDS_BYTES) != hipSuccess) { fprintf(stderr, "kernel_launch: hipFuncSetAttribute failed\n"); grid = -1; return; }
        int per_cu = 0;
        if (hipOccupancyMaxActiveBlocksPerMultiprocessor(&per_cu, (const void*)fwd, 512, LDS_BYTES) != hipSuccess || per_cu < 1) fprintf(stderr, "kernel_launch: occupancy query says %d\n", per_cu);
        (void)hipGetLastError();
        grid = cus;
    }
    if (grid < 0) return;
    if (hipMemsetAsync((char*)d_ws + WS_CTL, 0, CTL_ZERO_BYTES, stream) != hipSuccess) return;
    Args a{};
    for (int i = 0; i < 28; ++i) a.in[i] = (const float*)d_in[i];
    a.out = (float*)d_out; a.ws = (unsigned char*)d_ws;
#if defined(DBG_STOP_PHASE)
    for (int k = 0; k <= DBG_STOP_PHASE; ++k) { a.ph_lo = k; a.ph_hi = k + 1; hipLaunchKernelGGL(fwd, dim3(grid), dim3(512), LDS_BYTES, stream, a); }
    hipLaunchKernelGGL(dbg_dump, dim3(2048), dim3(256), 0, stream, (const unsigned char*)d_ws, (size_t)DBG_DUMP_OFF, DBG_DUMP_KIND, (long)DBG_DUMP_N, (float*)d_out, (long)out_size);
#elif MK_PER_PHASE
    for (int k = 0; k < NPHASE; ++k) { a.ph_lo = k; a.ph_hi = k + 1; hipLaunchKernelGGL(fwd, dim3(grid), dim3(512), LDS_BYTES, stream, a); }
#else
    a.ph_lo = 0; a.ph_hi = NPHASE;
    hipLaunchKernelGGL(fwd, dim3(grid), dim3(512), LDS_BYTES, stream, a);
#endif
    const hipError_t le = hipPeekAtLastError();
    if (le != hipSuccess) fprintf(stderr, "kernel_launch: launch failed: %s\n", hipGetErrorName(le));
}
```

```cpp
#define DBG_MIX_SCALE 1.0f
#define DBG_ZERO_BR 0
#define DBG_DOUBLE_MASK 0
#define DBG_TIME_MASK 0
#include <hip/hip_runtime.h>
#include <cstdio>
#include <cstdint>

#define GAS __attribute__((address_space(1)))
#define LAS __attribute__((address_space(3)))
typedef unsigned short bf16;
typedef unsigned v4u __attribute__((ext_vector_type(4)));
typedef unsigned v2u __attribute__((ext_vector_type(2)));
typedef float f32x4 __attribute__((ext_vector_type(4)));
typedef float f32x2 __attribute__((ext_vector_type(2)));
typedef float f32x16 __attribute__((ext_vector_type(16)));
typedef short bf16x8 __attribute__((ext_vector_type(8)));
typedef short s16x4 __attribute__((ext_vector_type(4)));
typedef GAS unsigned gu32;
#define RLX_AGENT __ATOMIC_RELAXED, __HIP_MEMORY_SCOPE_AGENT
#define LDS_WAIT() asm volatile("s_waitcnt lgkmcnt(0)" ::: "memory")
#define VM_WAIT() asm volatile("s_waitcnt vmcnt(0)" ::: "memory")
#define SBAR() __builtin_amdgcn_sched_barrier(0)

__device__ __forceinline__ unsigned f2bf(float f) { unsigned u = __builtin_bit_cast(unsigned, f); return (u + 0x7fffu + ((u >> 16) & 1u)) >> 16; }
__device__ __forceinline__ unsigned pk2(float lo, float hi) { return f2bf(lo) | (f2bf(hi) << 16); }
__device__ __forceinline__ float bf2f(unsigned b) { return __builtin_bit_cast(float, b << 16); }
__device__ __forceinline__ float bflo(unsigned w) { return __builtin_bit_cast(float, w << 16); }
__device__ __forceinline__ float bfhi(unsigned w) { return __builtin_bit_cast(float, w & 0xffff0000u); }
typedef __bf16 bf16x2_t __attribute__((ext_vector_type(2)));
__device__ __forceinline__ unsigned cvtpk(float lo, float hi) { f32x2 v = {lo, hi}; bf16x2_t b = __builtin_convertvector(v, bf16x2_t); return __builtin_bit_cast(unsigned, b); }
__device__ __forceinline__ float wave_sum(float v) {
#pragma unroll
    for (int o = 1; o < 64; o <<= 1) v += __shfl_xor(v, o);
    return v;
}

constexpr int T = 8192, DM = 2048, NLAYER = 2;
constexpr int NA = 9984;
constexpr int NPROJ = 3840, NGATE = 6144;
constexpr int PJ_QB = 1024, PJ_KB = 1792, PJ_VB = 2560, PJ_QC = 3328;
constexpr int NQAI = 1792;
constexpr int NKVA = 1536;
constexpr int NEXP = 32, DEXP = 512;
constexpr int MPAD = 24576;
constexpr float LN_EPS = 1e-5f;
constexpr float ALPHA = 1.4142135623730951f;
constexpr float SM_SCALE = 0.088388347648318440f;
constexpr float LOG2E = 1.4426950408889634f;
namespace pg8 {
#define PG8_LAS __attribute__((address_space(3)))
typedef unsigned short bf16_t;
typedef short bf16x8 __attribute__((ext_vector_type(8)));
typedef float f32x4 __attribute__((ext_vector_type(4)));
typedef unsigned u32x4 __attribute__((ext_vector_type(4)));
constexpr int BM = 256, BK = 64, HALF = 128, HTB = HALF * BK * 2  , STAGE_BYTES = 8 * HTB, NXCD = 8, WGM = 8;

__host__ __device__ __forceinline__ int lds_byte(int r, int c) { const int st = (r >> 4) * 2 + (c >> 5), rr = r & 15, cc = c & 31, ob = rr * 64 + cc * 2; return st * 1024 + (ob ^ (((ob >> 9) & 1) << 5)); }
__host__ __device__ __forceinline__ void stage_rc(int b, int& R, int& C) { const int st = b / 1024, sb = b % 1024, swz = sb ^ (((sb >> 9) & 1) << 5); R = (st >> 1) * 16 + swz / 64; C = (st & 1) * 32 + (swz % 64) / 2; }
__host__ __device__ __forceinline__ int perm32(int rho) { const int n = rho >> 4, i = rho & 15; return 8 * (i >> 2) + 4 * n + (i & 3); }

struct Unit { int pm, pn, kofs, nt, kind; };
struct Gemm { const bf16_t* A; const bf16_t* Bt; int M, N, K, ld; };

struct StaticOrder {
    int nM, nN, nwg, G, c;
    __host__ __device__ void init(int M, int N, int G_, int c_) { nM = M / BM; nN = N / BM; nwg = nM * nN; G = G_; c = c_; }
    __host__ __device__ bool next(int i, Unit& u) const {
        const long L = (long)i * G + c; if (L >= nwg) return false;
        int wgid = (int)L; { const int q = nwg / NXCD, r = nwg % NXCD, xcd = wgid % NXCD, off = wgid / NXCD; wgid = (xcd < r ? xcd * (q + 1) : r * (q + 1) + (xcd - r) * q) + off; }
        const int nig = WGM * nN, gid = wgid / nig, fm = gid * WGM, gsz = (nM - fm) < WGM ? (nM - fm) : WGM;
        u.pm = fm + ((wgid % nig) % gsz); u.pn = (wgid % nig) / gsz; return true;
    }
    __device__ __forceinline__ void a_ready(const Unit&) const {}
    __device__ __forceinline__ void done(const Unit&) const {}
};


__device__ __forceinline__ unsigned cvt_pk_bf16(float lo, float hi) { return ::cvtpk(lo, hi); }
__device__ __forceinline__ float sigmoidf_(float v) { return __builtin_amdgcn_rcpf(1.0f + __builtin_amdgcn_exp2f(-1.4426950408889634f * v)); }
__device__ __forceinline__ u32x4 pack8(const f32x4 v0, const f32x4 v1) { u32x4 w; w.x = cvt_pk_bf16(v0[0], v0[1]); w.y = cvt_pk_bf16(v0[2], v0[3]); w.z = cvt_pk_bf16(v1[0], v1[1]); w.w = cvt_pk_bf16(v1[2], v1[3]); return w; }
__device__ __forceinline__ void unpack8(const u32x4 w, f32x4& a, f32x4& b) {
    a[0] = __builtin_bit_cast(float, w.x << 16); a[1] = __builtin_bit_cast(float, w.x & 0xffff0000u); a[2] = __builtin_bit_cast(float, w.y << 16); a[3] = __builtin_bit_cast(float, w.y & 0xffff0000u);
    b[0] = __builtin_bit_cast(float, w.z << 16); b[1] = __builtin_bit_cast(float, w.z & 0xffff0000u); b[2] = __builtin_bit_cast(float, w.w << 16); b[3] = __builtin_bit_cast(float, w.w & 0xffff0000u); }
struct EpiBase { static constexpr bool PERM = true, AFTER_DRAIN = false, CHAIN = false, GATHER = false;
    __device__ __forceinline__ void unit_end(f32x4 (&)[2][2][4][2], const Unit&, int, int, int, int) const {} };

struct EpiA : EpiBase {
    bf16_t* proj; bf16_t* gate; const float* bgate; float qs;
    __device__ __forceinline__ void operator()(const f32x4 (&acc)[2][2][4][2], const Unit& u, int wr, int wc, int fr, int fq) const {
        const int row0 = u.pm * BM + wr * 64 + fr; const int colt = u.pn * BM + wc * 32 + 8 * fq;
        if (u.pn < 15) {
            const float s = ((u.pn >= 4 && u.pn < 7) || u.pn >= 13) ? qs : 1.0f;
#pragma unroll
            for (int ai = 0; ai < 2; ++ai)
#pragma unroll
                for (int m = 0; m < 4; ++m) { bf16_t* rowp = proj + (size_t)(row0 + ai * HALF + m * 16) * 3840 + colt;
#pragma unroll
                    for (int bj = 0; bj < 2; ++bj) *(u32x4*)(rowp + bj * HALF) = pack8(acc[ai][bj][m][0] * s, acc[ai][bj][m][1] * s); }
        } else {
            const int gc = colt - 3840;
            f32x4 bv[2][2];
#pragma unroll
            for (int bj = 0; bj < 2; ++bj)
#pragma unroll
                for (int n = 0; n < 2; ++n) bv[bj][n] = *(const f32x4*)(bgate + gc + bj * HALF + 4 * n);
#pragma unroll
            for (int ai = 0; ai < 2; ++ai)
#pragma unroll
                for (int m = 0; m < 4; ++m) {
                    bf16_t* tp = gate + ((size_t)((((u.pn - 15) >> 3) * 32 + u.pm) * 8 + ((u.pn - 15) & 7)) * 65536) + (size_t)((ai * 4 + m) * 2) * 4096 + (size_t)(((wr * 4 + wc) * 64 + fq * 16 + fr) * 8);
#pragma unroll
                    for (int bj = 0; bj < 2; ++bj) { f32x4 v0 = acc[ai][bj][m][0] + bv[bj][0], v1 = acc[ai][bj][m][1] + bv[bj][1];
#pragma unroll
                        for (int j = 0; j < 4; ++j) { v0[j] = sigmoidf_(v0[j]); v1[j] = sigmoidf_(v1[j]); }
                        *(u32x4*)(tp + bj * 4096) = pack8(v0, v1); } }
        }
    }
};
struct EpiScale : EpiBase {
    bf16_t* O; int ldc; int pn_a; float sa, sb;
    __device__ __forceinline__ void operator()(const f32x4 (&acc)[2][2][4][2], const Unit& u, int wr, int wc, int fr, int fq) const {
        const int row0 = u.pm * BM + wr * 64 + fr; const int colt = u.pn * BM + wc * 32 + 8 * fq; const float s = (u.pn < pn_a) ? sa : sb;
#pragma unroll
        for (int ai = 0; ai < 2; ++ai)
#pragma unroll
            for (int m = 0; m < 4; ++m) { bf16_t* rowp = O + (size_t)(row0 + ai * HALF + m * 16) * ldc + colt;
#pragma unroll
                for (int bj = 0; bj < 2; ++bj) *(u32x4*)(rowp + bj * HALF) = pack8(acc[ai][bj][m][0] * s, acc[ai][bj][m][1] * s); }
    }
};
template <int STEP> struct EpiUp : EpiBase {
    const bf16_t* gate; bf16_t* O;
    __device__ __forceinline__ void operator()(const f32x4 (&acc)[2][2][4][2], const Unit& u, int wr, int wc, int fr, int fq) const {
        const int row0 = u.pm * BM + wr * 64 + fr; const int colt = u.pn * BM + wc * 32 + 8 * fq;
#pragma unroll
        for (int ai = 0; ai < 2; ++ai)
#pragma unroll
            for (int m = 0; m < 4; ++m) { const size_t r = (size_t)(row0 + ai * HALF + m * 16);
#pragma unroll
                for (int bj = 0; bj < 2; ++bj) { const u32x4 wg = *(const u32x4*)(gate + r * 6144 + STEP * 2048 + colt + bj * HALF); f32x4 g0, g1; unpack8(wg, g0, g1);
                    f32x4 v0 = acc[ai][bj][m][0] * g0, v1 = acc[ai][bj][m][1] * g1;
                    if constexpr (STEP > 0) { const u32x4 wp = __builtin_nontemporal_load((const u32x4*)(O + r * 2048 + colt + bj * HALF)); f32x4 p0, p1; unpack8(wp, p0, p1); v0 += p0; v1 += p1; }
                    *(u32x4*)(O + r * 2048 + colt + bj * HALF) = pack8(v0, v1); } }
    }
};
struct EpiPre : EpiBase {
    const float* x; float* pre; float alpha;
    __device__ __forceinline__ void operator()(const f32x4 (&acc)[2][2][4][2], const Unit& u, int wr, int wc, int fr, int fq) const {
        const int row0 = u.pm * BM + wr * 64 + fr; const int colt = u.pn * BM + wc * 32 + 8 * fq;
#pragma unroll
        for (int ai = 0; ai < 2; ++ai)
#pragma unroll
            for (int m = 0; m < 4; ++m) { const size_t off = (size_t)(row0 + ai * HALF + m * 16) * 2048 + colt;
#pragma unroll
                for (int bj = 0; bj < 2; ++bj)
#pragma unroll
                    for (int n = 0; n < 2; ++n) { const f32x4 xv = *(const f32x4*)(x + off + bj * HALF + 4 * n); *(f32x4*)(pre + off + bj * HALF + 4 * n) = xv * alpha + acc[ai][bj][m][n]; } }
    }
};
struct EpiPreB : EpiBase {
    const bf16_t* xb; bf16_t* pre; float alpha;
    __device__ __forceinline__ void operator()(const f32x4 (&acc)[2][2][4][2], const Unit& u, int wr, int wc, int fr, int fq) const {
        const int row0 = u.pm * BM + wr * 64 + fr; const int colt = u.pn * BM + wc * 32 + 8 * fq;
#pragma unroll
        for (int ai = 0; ai < 2; ++ai) {
            u32x4 xw[4][2];
#pragma unroll
            for (int m = 0; m < 4; ++m)
#pragma unroll
                for (int bj = 0; bj < 2; ++bj) xw[m][bj] = *(const u32x4*)(xb + (size_t)(row0 + ai * HALF + m * 16) * 2048 + colt + bj * HALF);
            asm volatile("" : "+v"(xw[0][0]), "+v"(xw[0][1]), "+v"(xw[1][0]), "+v"(xw[1][1]), "+v"(xw[2][0]), "+v"(xw[2][1]), "+v"(xw[3][0]), "+v"(xw[3][1]));
#pragma unroll
            for (int m = 0; m < 4; ++m) { const size_t off = (size_t)(row0 + ai * HALF + m * 16) * 2048 + colt;
#pragma unroll
                for (int bj = 0; bj < 2; ++bj) { f32x4 x0, x1; unpack8(xw[m][bj], x0, x1);
                    *(u32x4*)(pre + off + bj * HALF) = pack8(x0 * alpha + acc[ai][bj][m][0], x1 * alpha + acc[ai][bj][m][1]); } } }
    }
};
struct EpiMoeA : EpiBase {
    static constexpr bool GATHER = true;
    bf16_t* hid; const int* rowsrc;
    __device__ __forceinline__ void operator()(const f32x4 (&acc)[2][2][4][2], const Unit& u, int wr, int wc, int fr, int fq) const {
        const int row0 = u.pm * BM + wr * 64 + fr; const int hc = (u.pn & 3) * 128 + wc * 32 + 8 * fq;
#pragma unroll
        for (int ai = 0; ai < 2; ++ai)
#pragma unroll
            for (int m = 0; m < 4; ++m) { f32x4 h0, h1;
#pragma unroll
                for (int j = 0; j < 4; ++j) { const float a0 = acc[ai][0][m][0][j], a1 = acc[ai][0][m][1][j]; h0[j] = a0 * sigmoidf_(a0) * acc[ai][1][m][0][j]; h1[j] = a1 * sigmoidf_(a1) * acc[ai][1][m][1][j]; }
                *(u32x4*)(hid + (size_t)(row0 + ai * HALF + m * 16) * 512 + hc) = pack8(h0, h1); }
    }
};
struct EpiMoeB : EpiBase {
    bf16_t* Y; const int* rowmap; const float* roww;
    __device__ __forceinline__ void operator()(const f32x4 (&acc)[2][2][4][2], const Unit& u, int wr, int wc, int fr, int fq) const {
        const int row0 = u.pm * BM + wr * 64 + fr; const int colt = (u.pn & 7) * BM + wc * 32 + 8 * fq;
        int dstv[8]; float wv8[8];
#pragma unroll
        for (int g = 0; g < 8; ++g) { const int rg = row0 + (g >> 2) * HALF + (g & 3) * 16; dstv[g] = rowmap[rg]; wv8[g] = roww[rg]; }
        asm volatile("" : "+v"(dstv[0]), "+v"(dstv[1]), "+v"(dstv[2]), "+v"(dstv[3]), "+v"(dstv[4]), "+v"(dstv[5]), "+v"(dstv[6]), "+v"(dstv[7]));
#pragma unroll
        for (int ai = 0; ai < 2; ++ai)
#pragma unroll
            for (int m = 0; m < 4; ++m) { const int dst = dstv[ai * 4 + m]; const float w = wv8[ai * 4 + m];
                if (dst >= 0) {
#pragma unroll
                    for (int bj = 0; bj < 2; ++bj) *(u32x4*)(Y + (size_t)dst * 2048 + colt + bj * HALF) = pack8(acc[ai][bj][m][0] * w, acc[ai][bj][m][1] * w); } }
    }
};
struct MoeOrder {
    const int* tile_e; int m_lo, m_cnt, nN, G, c;
    __device__ __forceinline__ bool next(int i, Unit& u) const {
        const int L = i * G + c; if (c < 0 || c >= G || L >= m_cnt * nN) return false;
        const int ml = L / nN, nl = L - ml * nN, mt = m_lo + ml; u.pm = mt; u.pn = tile_e[mt] * nN + nl; return true; }
    __device__ __forceinline__ void a_ready(const Unit&) const {}
    __device__ __forceinline__ void done(const Unit&) const {}
};


struct EpiUpChain : EpiBase {
    static constexpr bool CHAIN = true;
    const bf16_t* gate; bf16_t* O;
    __device__ __forceinline__ void unit_end(f32x4 (&acc)[2][2][4][2], const Unit& u, int wr, int wc, int fr, int fq) const {
        const int row0 = u.pm * BM + wr * 64 + fr; const int colt = u.pn * BM + wc * 32 + 8 * fq;
        const int gnum = (u.kind == 0) ? 0 : ((u.kind == 1) ? 2048 : 4096); const bool fin = u.kind == 2; const int dofs = fin ? 0 : 2048;
#pragma unroll
        for (int ai = 0; ai < 2; ++ai) {
            u32x4 wn[4][2], wd[4][2];
#pragma unroll
            for (int m = 0; m < 4; ++m) { const bf16_t* gp = gate + ((size_t)(((gnum >> 11) * 32 + u.pm) * 8 + u.pn) * 65536) + (size_t)((ai * 4 + m) * 2) * 4096 + (size_t)(((wr * 4 + wc) * 64 + fq * 16 + fr) * 8);
#pragma unroll
                for (int bj = 0; bj < 2; ++bj) { asm volatile("global_load_dwordx4 %0, %1, off" : "=v"(wn[m][bj]) : "v"(gp + bj * 4096) : "memory");
                                                 asm volatile("global_load_dwordx4 %0, %1, off" : "=v"(wd[m][bj]) : "v"(gp + (fin ? (size_t)0 : (size_t)(32 * 8) * 65536) + bj * 4096) : "memory"); } }
            asm volatile("s_waitcnt vmcnt(0)" : "+v"(wn[0][0]), "+v"(wn[0][1]), "+v"(wn[1][0]), "+v"(wn[1][1]), "+v"(wn[2][0]), "+v"(wn[2][1]), "+v"(wn[3][0]), "+v"(wn[3][1]),
                                                 "+v"(wd[0][0]), "+v"(wd[0][1]), "+v"(wd[1][0]), "+v"(wd[1][1]), "+v"(wd[2][0]), "+v"(wd[2][1]), "+v"(wd[3][0]), "+v"(wd[3][1]) :: "memory");
#pragma unroll
            for (int m = 0; m < 4; ++m) { const size_t r = (size_t)(row0 + ai * HALF + m * 16);
#pragma unroll
                for (int bj = 0; bj < 2; ++bj) { f32x4 n0, n1; unpack8(wn[m][bj], n0, n1);
                    if (fin) { *(u32x4*)(O + r * 2048 + colt + bj * HALF) = pack8(acc[ai][bj][m][0] * n0, acc[ai][bj][m][1] * n1); acc[ai][bj][m][0] = (f32x4){0.f, 0.f, 0.f, 0.f}; acc[ai][bj][m][1] = (f32x4){0.f, 0.f, 0.f, 0.f}; }
                    else { f32x4 d0, d1; unpack8(wd[m][bj], d0, d1);
#pragma unroll
                        for (int j = 0; j < 4; ++j) { acc[ai][bj][m][0][j] *= n0[j] * __builtin_amdgcn_rcpf(fmaxf(d0[j], 1e-30f)); acc[ai][bj][m][1][j] *= n1[j] * __builtin_amdgcn_rcpf(fmaxf(d1[j], 1e-30f)); } } }
                asm volatile("" : "+v"(acc[ai][0][m][0]), "+v"(acc[ai][0][m][1]), "+v"(acc[ai][1][m][0]), "+v"(acc[ai][1][m][1])); }
            asm volatile("" ::: "memory"); }
    }
    __device__ __forceinline__ void operator()(const f32x4 (&)[2][2][4][2], const Unit&, int, int, int, int) const {}
};
struct UpOrder {
    StaticOrder so;
    __device__ __forceinline__ bool next(int i, Unit& u) const { const int ti = i / 3, x = i - 3 * ti; if (!so.next(ti, u)) return false;
        u.kofs = x * 768 * 2; u.nt = (x == 2) ? 8 : 12; u.kind = x; return true; }
    __device__ __forceinline__ void a_ready(const Unit&) const {}
    __device__ __forceinline__ void done(const Unit&) const {}
};
template <class Epi, class Sched, bool ALIGN_EPI = false, bool SP2 = false>
__device__ __forceinline__ void gemm_phase(PG8_LAS unsigned char* lds, const Gemm g, const Sched& S, const Epi& E, const int tid) {
    const int wid = __builtin_amdgcn_readfirstlane(tid >> 6), lane = tid & 63, wr = wid >> 2, wc = wid & 3, fr = lane & 15, fq = lane >> 4;
    const int K = g.ld, nt = g.K / BK;
    unsigned voffA[2], voffB[2];
#pragma unroll
    for (int i = 0; i < 2; ++i) { int R, C; stage_rc(tid * 16 + i * 8192, R, C); const int Rb = Epi::PERM ? ((R & ~31) + perm32(R & 31)) : R;
        voffA[i] = (unsigned)(R * K + C) * 2u; voffB[i] = (unsigned)(Rb * K + C) * 2u; }
    int gR[2], gC2[2];
#pragma unroll
    for (int i = 0; i < 2; ++i) { int R, C; stage_rc(tid * 16 + i * 8192, R, C); gR[i] = R; gC2[i] = C * 2; }
    unsigned vAc[2][2], vAn[2][2];
#define PG8_GVOFF(dst, pm_) do { if constexpr (Epi::GATHER) { _Pragma("unroll") for (int h_ = 0; h_ < 2; ++h_) _Pragma("unroll") for (int i_ = 0; i_ < 2; ++i_) { \
        const int s_ = E.rowsrc[(pm_) * BM + h_ * HALF + gR[i_]]; const unsigned tok_ = s_ < 0 ? 0u : (unsigned)s_ >> 1; dst[h_][i_] = tok_ * (unsigned)(K * 2) + (unsigned)gC2[i_]; } } } while (0)
    const size_t kstep = (size_t)(BK * 2);
    const size_t hstep = (size_t)HALF * K * 2;
    const size_t tstep = 2 * hstep;
    const unsigned ldsw = (unsigned)wid * 1024u;
    const int aoff = lds_byte(wr * 64 + fr, fq * 8), boff = lds_byte(wc * 32 + fr, fq * 8);
#define PG8_SA(b, h) (((b) * 2 + (h)) * HTB)
#define PG8_SB(b, h) ((4 + (b) * 2 + (h)) * HTB)
#define PG8_STAGE(bufoff, gbase, voff) do { _Pragma("unroll") for (int _i = 0; _i < 2; ++_i) \
        __builtin_amdgcn_global_load_lds((const unsigned*)((const char*)(gbase) + (voff)[_i]), (PG8_LAS unsigned*)(lds + (bufoff) + ldsw + _i * 8192), 16, 0, 0); } while (0)
#define PG8_STAGE_A(bufoff, kp, h, nx) do { if constexpr (Epi::GATHER) { unsigned vs_[2] = {(nx) ? vAn[h][0] : vAc[h][0], (nx) ? vAn[h][1] : vAc[h][1]}; PG8_STAGE(bufoff, kp, vs_); } \
        else { PG8_STAGE(bufoff, (kp) + (h) * hstep, voffA); } } while (0)
#define PG8_LDA(dst, b, h) do { _Pragma("unroll") for (int m = 0; m < 4; ++m) _Pragma("unroll") for (int k = 0; k < 2; ++k) dst[m][k] = *(const PG8_LAS bf16x8*)(lds + PG8_SA(b, h) + aoff + m * 2048 + k * 1024); } while (0)
#define PG8_LDB(dst, b, h) do { _Pragma("unroll") for (int n = 0; n < 2; ++n) _Pragma("unroll") for (int k = 0; k < 2; ++k) dst[n][k] = *(const PG8_LAS bf16x8*)(lds + PG8_SB(b, h) + boff + n * 2048 + k * 1024); } while (0)
#define PG8_MMA(ai, bj, At, Bt) do { __builtin_amdgcn_s_setprio(1); _Pragma("unroll") for (int m = 0; m < 4; ++m) _Pragma("unroll") for (int n = 0; n < 2; ++n) _Pragma("unroll") for (int k = 0; k < 2; ++k) \
        acc[ai][bj][m][n] = __builtin_amdgcn_mfma_f32_16x16x32_bf16(Bt[n][k], At[m][k], acc[ai][bj][m][n], 0, 0, 0); __builtin_amdgcn_s_setprio(0); } while (0)
#define PG8_WAIT_V(n) asm volatile("s_waitcnt vmcnt(" #n ")" ::: "memory")
#define PG8_WAIT_L(n) asm volatile("s_waitcnt lgkmcnt(" #n ")" ::: "memory")
#define PG8_BAR __builtin_amdgcn_s_barrier()
#define PG8_SCHED __builtin_amdgcn_sched_barrier(0)
    Unit cur, nxt; int ui = 0;
    if (!S.next(0, cur)) return;
    f32x4 acc[2][2][4][2];
#pragma unroll
    for (int a = 0; a < 2; ++a)
#pragma unroll
        for (int b = 0; b < 2; ++b)
#pragma unroll
            for (int m = 0; m < 4; ++m)
#pragma unroll
                for (int n = 0; n < 2; ++n) acc[a][b][m][n] = (f32x4){0.f, 0.f, 0.f, 0.f};
    bf16x8 At[4][2], B0[2][2], B1[2][2];
    const char* cA = (const char*)g.A + (Epi::GATHER ? (size_t)0 : (size_t)cur.pm * tstep); const char* cB = (const char*)g.Bt + (size_t)cur.pn * tstep;
    PG8_GVOFF(vAc, cur.pm);
    if constexpr (Epi::CHAIN) { cA += cur.kofs; cB += cur.kofs; }
    S.a_ready(cur);
    if constexpr (SP2) {
        PG8_STAGE(PG8_SB(0, 0), cB, voffB); PG8_STAGE(PG8_SB(0, 1), cB + hstep, voffB); PG8_STAGE_A(PG8_SA(0, 0), cA, 0, false); PG8_STAGE_A(PG8_SA(0, 1), cA, 1, false);
        if (wr == 1) PG8_BAR;
        PG8_WAIT_V(2); PG8_BAR;
        PG8_STAGE(PG8_SB(1, 0), cB + kstep, voffB); PG8_STAGE_A(PG8_SA(1, 0), cA + kstep, 0, false); PG8_STAGE(PG8_SB(1, 1), cB + hstep + kstep, voffB);
        PG8_WAIT_V(6); PG8_BAR;
    } else {
        PG8_STAGE(PG8_SB(0, 0), cB, voffB); PG8_STAGE(PG8_SA(0, 0), cA, voffA); PG8_STAGE(PG8_SB(0, 1), cB + hstep, voffB); PG8_STAGE(PG8_SA(0, 1), cA + hstep, voffA);
        if (wr == 1) PG8_BAR;
        PG8_WAIT_V(4); PG8_BAR;
        PG8_STAGE(PG8_SB(1, 0), cB + kstep, voffB); PG8_STAGE(PG8_SA(1, 0), cA + kstep, voffA); PG8_STAGE(PG8_SB(1, 1), cB + hstep + kstep, voffB);
        PG8_WAIT_V(6); PG8_BAR;
    }
    for (;;) {
        const bool has_next = S.next(ui + 1, nxt);
        const char* nA = has_next ? (const char*)g.A + (Epi::GATHER ? (size_t)0 : (size_t)nxt.pm * tstep) + (Epi::CHAIN ? nxt.kofs : 0) : cA;
        if constexpr (Epi::GATHER) { if (has_next) PG8_GVOFF(vAn, nxt.pm); else { _Pragma("unroll") for (int h_ = 0; h_ < 2; ++h_) _Pragma("unroll") for (int i_ = 0; i_ < 2; ++i_) vAn[h_][i_] = vAc[h_][i_]; } } const char* nB = has_next ? (const char*)g.Bt + (size_t)nxt.pn * tstep + (Epi::CHAIN ? nxt.kofs : 0) : cB;
        const int ntc = Epi::CHAIN ? cur.nt : nt;
        for (int t = 0; t < ntc; t += 2) {
            const bool last = (t == ntc - 2);
            const char* a1 = cA + (size_t)(t + 1) * kstep;
            const char* a2 = last ? nA : cA + (size_t)(t + 2) * kstep; const char* b2 = last ? nB : cB + (size_t)(t + 2) * kstep;
            const char* a3 = a2 + kstep; const char* b3 = b2 + kstep;
            if (last && has_next) S.a_ready(nxt);
            if constexpr (SP2) {
            PG8_LDB(B0, 0, 0); PG8_LDB(B1, 0, 1); PG8_SCHED; PG8_LDA(At, 0, 0); PG8_STAGE_A(PG8_SA(1, 1), a1, 1, false);
            PG8_WAIT_V(8); PG8_WAIT_L(0); PG8_BAR; PG8_MMA(0, 0, At, B0); PG8_MMA(0, 1, At, B1); PG8_BAR; PG8_SCHED;
            PG8_LDA(At, 0, 1); PG8_STAGE(PG8_SB(0, 0), b2, voffB); PG8_STAGE(PG8_SB(0, 1), b2 + hstep, voffB); PG8_STAGE_A(PG8_SA(0, 0), a2, 0, last);
            PG8_WAIT_V(8); PG8_WAIT_L(0); PG8_BAR; PG8_MMA(1, 0, At, B0); PG8_MMA(1, 1, At, B1); PG8_BAR; PG8_SCHED;
            PG8_LDB(B0, 1, 0); PG8_LDB(B1, 1, 1); PG8_SCHED; PG8_LDA(At, 1, 0); PG8_STAGE_A(PG8_SA(0, 1), a2, 1, last);
            PG8_WAIT_V(8); PG8_WAIT_L(0); PG8_BAR; PG8_MMA(0, 0, At, B0); PG8_MMA(0, 1, At, B1); PG8_BAR; PG8_SCHED;
            PG8_LDA(At, 1, 1); PG8_STAGE(PG8_SB(1, 0), b3, voffB); PG8_STAGE(PG8_SB(1, 1), b3 + hstep, voffB); PG8_STAGE_A(PG8_SA(1, 0), a3, 0, last);
            PG8_WAIT_V(8); PG8_WAIT_L(0); PG8_BAR; PG8_MMA(1, 0, At, B0); PG8_MMA(1, 1, At, B1); PG8_BAR; PG8_SCHED;
            } else {
            PG8_LDB(B0, 0, 0); PG8_SCHED; PG8_LDA(At, 0, 0); PG8_STAGE(PG8_SA(1, 1), a1 + hstep, voffA);
            PG8_WAIT_L(8); PG8_BAR; PG8_WAIT_L(0); PG8_MMA(0, 0, At, B0); PG8_BAR; PG8_SCHED;
            PG8_LDB(B1, 0, 1); PG8_STAGE(PG8_SB(0, 0), b2, voffB);
            PG8_BAR; PG8_WAIT_L(0); PG8_MMA(0, 1, At, B1); PG8_BAR;
            PG8_LDA(At, 0, 1); PG8_STAGE(PG8_SA(0, 0), a2, voffA);
            PG8_BAR; PG8_WAIT_L(0); PG8_MMA(1, 0, At, B0); PG8_BAR; PG8_SCHED;
            PG8_STAGE(PG8_SB(0, 1), b2 + hstep, voffB);
            PG8_WAIT_V(6); PG8_BAR; PG8_MMA(1, 1, At, B1); PG8_BAR;
            PG8_LDB(B0, 1, 0); PG8_SCHED; PG8_LDA(At, 1, 0); PG8_STAGE(PG8_SA(0, 1), a2 + hstep, voffA);
            PG8_WAIT_L(8); PG8_BAR; PG8_WAIT_L(0); PG8_MMA(0, 0, At, B0); PG8_BAR; PG8_SCHED;
            PG8_LDB(B1, 1, 1); PG8_STAGE(PG8_SB(1, 0), b3, voffB);
            PG8_BAR; PG8_WAIT_L(0); PG8_MMA(0, 1, At, B1); PG8_BAR;
            PG8_LDA(At, 1, 1); PG8_STAGE(PG8_SA(1, 0), a3, voffA);
            PG8_BAR; PG8_WAIT_L(0); PG8_MMA(1, 0, At, B0); PG8_BAR; PG8_SCHED;
            PG8_STAGE(PG8_SB(1, 1), b3 + hstep, voffB);
            PG8_WAIT_V(6); PG8_BAR; PG8_MMA(1, 1, At, B1); PG8_BAR;
            }
        }
        if constexpr (ALIGN_EPI) { if (wr == 0) PG8_BAR; }
        if constexpr (Epi::CHAIN) { E.unit_end(acc, cur, wr, wc, fr, fq); }
        else if constexpr (!Epi::AFTER_DRAIN) { E(acc, cur, wr, wc, fr, fq); S.done(cur); }
        if (!has_next) break;
        if constexpr (!Epi::CHAIN)
#pragma unroll
        for (int a = 0; a < 2; ++a)
#pragma unroll
            for (int b = 0; b < 2; ++b)
#pragma unroll
                for (int m = 0; m < 4; ++m)
#pragma unroll
                    for (int n = 0; n < 2; ++n) acc[a][b][m][n] = (f32x4){0.f, 0.f, 0.f, 0.f};
        cur = nxt; cA = nA; cB = nB; ++ui;
        if constexpr (Epi::GATHER) { _Pragma("unroll") for (int h_ = 0; h_ < 2; ++h_) _Pragma("unroll") for (int i_ = 0; i_ < 2; ++i_) vAc[h_][i_] = vAn[h_][i_]; }
        if constexpr (ALIGN_EPI) { if (wr == 1) PG8_BAR; }
    }
    PG8_WAIT_V(0);
    if constexpr (!ALIGN_EPI) { if (wr == 0) PG8_BAR; }
    PG8_BAR;
    if constexpr (Epi::AFTER_DRAIN) { E.fused(acc, cur, wr, wc, fr, fq, lds, wid, lane); S.done(cur); }
#undef PG8_SA
#undef PG8_SB
#undef PG8_STAGE
#undef PG8_STAGE_A
#undef PG8_GVOFF
#undef PG8_LDA
#undef PG8_LDB
#undef PG8_MMA
#undef PG8_WAIT_V
#undef PG8_WAIT_L
#undef PG8_BAR
#undef PG8_SCHED
}
}

namespace att {
constexpr int D = 128, NW = 8, QBLK = 32, KVBLK = 64;
constexpr int SDEPTH = 1;
constexpr float THR2 = 8.f * 1.4426950408889634f;
constexpr size_t SHM_V = KVBLK * D * 2, SHM_K = KVBLK * D * 2, SHM_ATTN = 2 * SHM_V + 2 * SHM_K + NW * 64 * 4;
#define KSWZ(row, colB) ((row) * 256 + ((colB) ^ (((row) & 7) << 4)))
__device__ __forceinline__ int crow(int r, int hi) { return (r & 3) + 8 * (r >> 2) + 4 * hi; }
constexpr int ccol(int r) { return (r & 3) + 8 * (r >> 2); }

template <int MODE>
__device__ __forceinline__ void partialSM(f32x16& p0, f32x16& p1, float& m_reg, float& alpha, float& sub1_out, int j, int NT, float slope2, float lanec, int lanet, int hi, v2u mw, unsigned bmw) {
  const float NEGINF = -__builtin_inff();
  float base0 = 0.f, base1 = 0.f;
  if constexpr (MODE != 0) {
    base0 = fmaf(slope2 * 64.f, (float)j, lanec); base1 = base0 + 32.f * slope2;
#pragma unroll
    for (int r = 0; r < 16; ++r) { p0[r] = fmaf(slope2, (float)ccol(r), p0[r]); p1[r] = fmaf(slope2, (float)ccol(r), p1[r]); }
  }
  if constexpr (MODE == 1 || MODE == 4) {
    const unsigned w0 = mw.x >> (4 * hi), w1 = mw.y >> (4 * hi);
#pragma unroll
    for (int r = 0; r < 16; ++r) {
      const int m0 = __builtin_amdgcn_sbfe(w0, ccol(r), 1), m1 = __builtin_amdgcn_sbfe(w1, ccol(r), 1);
      p0[r] = __uint_as_float((__float_as_uint(p0[r]) & (unsigned)m0) | (0xff800000u & ~(unsigned)m0));
      p1[r] = __uint_as_float((__float_as_uint(p1[r]) & (unsigned)m1) | (0xff800000u & ~(unsigned)m1));
    }
  }
  if constexpr (MODE == 2) {
    const bool sel = (bmw >> (j >> 2)) & 1u; if (!sel) { base0 = NEGINF; base1 = NEGINF; }
    if (j >= NT - 4) { const int thr0 = lanet - 64 * j, thr1 = thr0 - 32;
#pragma unroll
      for (int r = 0; r < 16; ++r) { p0[r] = (ccol(r) <= thr0) ? p0[r] : NEGINF; p1[r] = (ccol(r) <= thr1) ? p1[r] : NEGINF; }
    }
  }
  float mx0 = p0[0], mx1 = p1[0];
#pragma unroll
  for (int r = 1; r < 16; ++r) { mx0 = fmaxf(mx0, p0[r]); mx1 = fmaxf(mx1, p1[r]); }
  float pmax;
  if constexpr (MODE == 0) pmax = fmaxf(mx0, mx1); else pmax = fmaxf(mx0 + base0, mx1 + base1);
  { auto rr = __builtin_amdgcn_permlane32_swap(__float_as_uint(pmax), __float_as_uint(pmax), false, false);
    pmax = fmaxf(__uint_as_float(rr[0]), __uint_as_float(rr[1])); }
  float mn;
  if (__builtin_expect(__all(pmax - m_reg <= THR2), 1)) { mn = m_reg; alpha = 1.f; }
  else { mn = fmaxf(m_reg, pmax); alpha = __builtin_amdgcn_exp2f(m_reg - mn); m_reg = mn; }
  float sub0, sub1;
  if constexpr (MODE == 0) { sub0 = mn; sub1 = mn; } else { sub0 = mn - base0; sub1 = mn - base1; }
#pragma unroll
  for (int r = 0; r < 16; ++r) p0[r] = __builtin_amdgcn_exp2f(p0[r] - sub0);
  sub1_out = sub1;
}
__device__ __forceinline__ void finishSM(f32x16& p0, f32x16& p1, float sub1, float alpha, float& l_reg, bf16x8& pa0, bf16x8& pa1, bf16x8& pa2, bf16x8& pa3) {
#pragma unroll
  for (int r = 0; r < 16; ++r) p1[r] = __builtin_amdgcn_exp2f(p1[r] - sub1);
  float ps = 0;
#pragma unroll
  for (int r = 0; r < 16; ++r) ps += p0[r];
#pragma unroll
  for (int r = 0; r < 16; ++r) ps += p1[r];
  { auto rr = __builtin_amdgcn_permlane32_swap(__float_as_uint(ps), __float_as_uint(ps), false, false);
    ps = __uint_as_float(rr[0]) + __uint_as_float(rr[1]); }
  l_reg = l_reg * alpha + ps;
#define PK4(P, BASE, OUT) do { unsigned a0 = cvtpk(P[BASE + 0], P[BASE + 1]), a1 = cvtpk(P[BASE + 2], P[BASE + 3]);   \
    unsigned b0 = cvtpk(P[BASE + 4], P[BASE + 5]), b1 = cvtpk(P[BASE + 6], P[BASE + 7]);                              \
    auto r0 = __builtin_amdgcn_permlane32_swap(a0, b0, false, false); auto r1 = __builtin_amdgcn_permlane32_swap(a1, b1, false, false); \
    v4u w = {r0[0], r1[0], r0[1], r1[1]}; OUT = *reinterpret_cast<bf16x8*>(&w); } while (0)
  PK4(p0, 0, pa0); PK4(p0, 8, pa1); PK4(p1, 0, pa2); PK4(p1, 8, pa3);
#undef PK4
}
__device__ __forceinline__ void qkt(f32x16& p0, f32x16& p1, const LAS char* Ks, const bf16x8 (&qs)[8], int r32, int hi) {
  p0 = f32x16{}; p1 = f32x16{};
#pragma unroll
  for (int d0 = 0; d0 < 8; ++d0) { int cb = (d0 * 16 + hi * 8) * 2;
    bf16x8 b0 = *reinterpret_cast<const LAS bf16x8*>(Ks + KSWZ(r32, cb));
    bf16x8 b1 = *reinterpret_cast<const LAS bf16x8*>(Ks + KSWZ(32 + r32, cb));
    const bf16x8 q = qs[d0];
    p0 = __builtin_amdgcn_mfma_f32_32x32x16_bf16(b0, q, p0, 0, 0, 0);
    p1 = __builtin_amdgcn_mfma_f32_32x32x16_bf16(b1, q, p1, 0, 0, 0); }
}
__device__ __forceinline__ int v_st(int k, int c) { const int kk = (k & ~0xC) | ((k & 4) << 1) | ((k & 8) >> 1); return ((kk >> 3) * 4 + (c >> 5)) * 512 + ((kk & 7) * 32 + (c & 31)) * 2; }
__device__ __forceinline__ int v_rd_base(int lane) { return ((lane & 3) << 3) | (((lane >> 2) & 3) << 6) | (((lane >> 4) & 1) << 5) | (((lane >> 5) & 1) << 8); }
constexpr int v_rd_off(int d0, int ks, int half) { return d0 * 512 + ks * 4096 + half * 2048; }
template <int OFF> __device__ __forceinline__ s16x4 tr_read(int vb) {
  s16x4 r; asm volatile("ds_read_b64_tr_b16 %0, %1 offset:%2" : "=&v"(r) : "v"(vb), "i"(OFF) : "memory"); return r;
}
template <int D0> __device__ __forceinline__ void pv_one(f32x16& od, int vb, bf16x8 pa0, bf16x8 pa1, bf16x8 pa2, bf16x8 pa3) {
  const s16x4 l0 = tr_read<v_rd_off(D0, 0, 0)>(vb), h0 = tr_read<v_rd_off(D0, 0, 1)>(vb), l1 = tr_read<v_rd_off(D0, 1, 0)>(vb), h1 = tr_read<v_rd_off(D0, 1, 1)>(vb);
  const s16x4 l2 = tr_read<v_rd_off(D0, 2, 0)>(vb), h2 = tr_read<v_rd_off(D0, 2, 1)>(vb), l3 = tr_read<v_rd_off(D0, 3, 0)>(vb), h3 = tr_read<v_rd_off(D0, 3, 1)>(vb);
  asm volatile("s_waitcnt lgkmcnt(0)" ::: "memory"); SBAR();
#define PK(L, H) (bf16x8){L[0], L[1], L[2], L[3], H[0], H[1], H[2], H[3]}
  od = __builtin_amdgcn_mfma_f32_32x32x16_bf16(pa0, PK(l0, h0), od, 0, 0, 0);
  od = __builtin_amdgcn_mfma_f32_32x32x16_bf16(pa1, PK(l1, h1), od, 0, 0, 0);
  od = __builtin_amdgcn_mfma_f32_32x32x16_bf16(pa2, PK(l2, h2), od, 0, 0, 0);
  od = __builtin_amdgcn_mfma_f32_32x32x16_bf16(pa3, PK(l3, h3), od, 0, 0, 0);
#undef PK
}
__device__ __forceinline__ void pv_d0(f32x16* o, int vb, bf16x8 pa0, bf16x8 pa1, bf16x8 pa2, bf16x8 pa3) {
  pv_one<0>(o[0], vb, pa0, pa1, pa2, pa3); pv_one<1>(o[1], vb, pa0, pa1, pa2, pa3); pv_one<2>(o[2], vb, pa0, pa1, pa2, pa3); pv_one<3>(o[3], vb, pa0, pa1, pa2, pa3);
}

template <int MODE>
__device__ __forceinline__ void attn_unit(const GAS bf16* __restrict__ Qb, int ldq, const GAS bf16* __restrict__ Kh, const GAS bf16* __restrict__ Vh, int ldk, GAS bf16* __restrict__ Ob, int ldo,
                                          int NT, int qpos0, float slope2, const GAS unsigned* __restrict__ maskA, const GAS unsigned* __restrict__ blkm, LAS char* lds, const int tid,
                                          int nvalid = 0, GAS bf16* __restrict__ PO = nullptr, GAS float* __restrict__ PML = nullptr, int hh = 0, int kofs = 0) {
  const int wid = tid >> 6, lane = tid & 63, r32 = lane & 31, hi = lane >> 5;
  LAS char* V_lds = lds; LAS char* K_lds = lds + 2 * SHM_V;
  LAS float* ws = (LAS float*)(lds + 2 * SHM_V + 2 * SHM_K) + wid * 64; LAS float* li_l = ws; LAS float* al_l = ws + 32;
  float m_reg = -1e30f, l_reg = 0; f32x16 o[4] = {};
  bf16x8 qr[8];
  const int qrow = wid * QBLK + r32;
  int trow = qpos0 + qrow, pslot = 0;
  if constexpr (MODE == 3) { unsigned e = ((unsigned)(qpos0 + 256)) | (4u << 16); if (qrow < nvalid) e = blkm[qrow]; trow = (int)(e & 0xffffu); pslot = (int)(e >> 16); }
  if constexpr (MODE == 4) pslot = kofs >> 11;
  const int qpos = (MODE == 2) ? qrow : (MODE == 3) ? trow - qpos0 : (MODE == 4) ? trow - kofs : trow;
  const unsigned bmw = 0xffffffffu;
  const GAS bf16* Qw = Qb + (unsigned)((MODE == 3 ? trow : qrow) * ldq + hi * 8);
#pragma unroll
  for (int d0 = 0; d0 < 8; ++d0) qr[d0] = *reinterpret_cast<const GAS bf16x8*>(Qw + d0 * 16);
  slope2 = __uint_as_float(__builtin_amdgcn_readfirstlane(__float_as_uint(slope2)));
  const float lanec = slope2 * (float)(4 * hi - qpos); const int lanet = qpos - 4 * hi;
  unsigned moff = 0; if constexpr (MODE == 1 || MODE == 4) moff = (unsigned)trow * 1024u + (unsigned)(kofs >> 6) * 8u;
  const int sr = tid >> 4, sc = (tid & 15) * 8, vst0 = v_st(sr, sc), vst1 = v_st(32 + sr, sc);
  const int vb0 = (int)(uintptr_t)V_lds + v_rd_base(lane);
  struct { bf16x8 vs0, vs1, ks0, ks1; } sr_[SDEPTH];
  const unsigned so0 = (unsigned)(sr * ldk + sc) * 2u, so1 = so0 + (unsigned)(32 * ldk) * 2u, tstep_ = (unsigned)(64 * ldk) * 2u;
#define SLOAD(i, k0) do { const unsigned tb_ = (unsigned)((k0) >> 6) * tstep_; \
    sr_[i].vs0 = *reinterpret_cast<const GAS bf16x8*>((const GAS char*)Vh + (tb_ + so0)); sr_[i].vs1 = *reinterpret_cast<const GAS bf16x8*>((const GAS char*)Vh + (tb_ + so1)); \
    sr_[i].ks0 = *reinterpret_cast<const GAS bf16x8*>((const GAS char*)Kh + (tb_ + so0)); sr_[i].ks1 = *reinterpret_cast<const GAS bf16x8*>((const GAS char*)Kh + (tb_ + so1)); } while (0)
#define SWRITE(b, i) do { *(LAS bf16x8*)(V_lds + (b) * SHM_V + vst0) = sr_[i].vs0;          \
    *(LAS bf16x8*)(V_lds + (b) * SHM_V + vst1) = sr_[i].vs1; int kc = sc * 2;               \
    *(LAS bf16x8*)(K_lds + (b) * SHM_K + KSWZ(sr, kc)) = sr_[i].ks0;                       \
    *(LAS bf16x8*)(K_lds + (b) * SHM_K + KSWZ(32 + sr, kc)) = sr_[i].ks1; } while (0)
#define SWAIT() do { if constexpr (SDEPTH == 2) asm volatile("s_waitcnt vmcnt(4)" ::: "memory"); else asm volatile("s_waitcnt vmcnt(0)" ::: "memory"); } while (0)
#define RESC(a) do { if (__any((a) < 1.f)) { if (hi == 0) al_l[r32] = (a); asm volatile("s_waitcnt lgkmcnt(0)" ::: "memory"); \
    _Pragma("unroll") for (int d = 0; d < 4; ++d) _Pragma("unroll") for (int r = 0; r < 16; ++r) o[d][r] *= al_l[crow(r, hi)]; } } while (0)
  v2u mwA = {0u, 0u}, mwB = {0u, 0u};
#define MLOAD(dst, j) do { if constexpr (MODE == 1 || MODE == 4) dst = *reinterpret_cast<const GAS v2u*>((const GAS char*)maskA + (moff + 8u * (unsigned)(j))); } while (0)
#define PSM(P0, P1, AL, S1, J, MW) partialSM<MODE>(P0, P1, m_reg, AL, S1, J, NT, slope2, lanec, lanet, hi, MW, bmw)
  f32x16 pA0, pA1, pB0, pB1; float alA, alB, s1A, s1B; bf16x8 pa0, pa1, pa2, pa3;
  constexpr int SE = 0, SO = SDEPTH - 1;
  MLOAD(mwA, 0); MLOAD(mwB, 1);
  SLOAD(SE, 0); asm volatile("s_waitcnt vmcnt(0)" ::: "memory"); SWRITE(0, SE);
  if constexpr (SDEPTH == 1) SLOAD(SO, KVBLK);
  __syncthreads();
  qkt(pA0, pA1, K_lds, qr, r32, hi); PSM(pA0, pA1, alA, s1A, 0, mwA);
  if constexpr (SDEPTH == 2) { SLOAD(SO, KVBLK); if (2 < NT) SLOAD(SE, 2 * KVBLK); }
  SWAIT(); SWRITE(1, SO); __syncthreads();
  for (int j = 1; j + 1 < NT; j += 2) {
    SBAR(); qkt(pB0, pB1, K_lds + SHM_K, qr, r32, hi);
    finishSM(pA0, pA1, s1A, alA, l_reg, pa0, pa1, pa2, pa3); SBAR();
    MLOAD(mwA, j + 1);
    SLOAD(SO, (j + SDEPTH) * KVBLK); SBAR();
    pv_d0(o, vb0, pa0, pa1, pa2, pa3); PSM(pB0, pB1, alB, s1B, j, mwB);
    __syncthreads(); SWAIT(); SWRITE(0, SE);
    RESC(alB); __syncthreads();
    SBAR(); qkt(pA0, pA1, K_lds, qr, r32, hi);
    finishSM(pB0, pB1, s1B, alB, l_reg, pa0, pa1, pa2, pa3); SBAR();
    if (j + 2 < NT) MLOAD(mwB, j + 2);
    if (SDEPTH == 1 || j + 3 < NT) SLOAD(SE, (j + 1 + SDEPTH) * KVBLK); SBAR();
    pv_d0(o, vb0 + (int)SHM_V, pa0, pa1, pa2, pa3); PSM(pA0, pA1, alA, s1A, j + 1, mwA);
    __syncthreads(); SWAIT(); SWRITE(1, SO);
    RESC(alA); __syncthreads();
  }
  SBAR(); qkt(pB0, pB1, K_lds + SHM_K, qr, r32, hi);
  finishSM(pA0, pA1, s1A, alA, l_reg, pa0, pa1, pa2, pa3); SBAR();
  pv_d0(o, vb0, pa0, pa1, pa2, pa3); PSM(pB0, pB1, alB, s1B, NT - 1, mwB);
  __syncthreads(); RESC(alB);
  finishSM(pB0, pB1, s1B, alB, l_reg, pa0, pa1, pa2, pa3); SBAR();
  pv_d0(o, vb0 + (int)SHM_V, pa0, pa1, pa2, pa3);
  LAS int* dst_l = (LAS int*)(lds + SHM_ATTN) + wid * 32;
  if (hi == 0) { li_l[r32] = l_reg;
    if constexpr (MODE >= 2) { const int prow = pslot * 8192 + trow; dst_l[r32] = prow; f32x2 ml = {m_reg, l_reg}; *reinterpret_cast<GAS f32x2*>(PML + (size_t)(prow * 6 + hh) * 2) = ml; } }
  asm volatile("s_waitcnt lgkmcnt(0)" ::: "memory");
  float rli[16];
#pragma unroll
  for (int r = 0; r < 16; ++r) { const float lq = li_l[crow(r, hi)]; rli[r] = (MODE == 4 && !(lq > 0.f)) ? 0.f : __builtin_amdgcn_rcpf(lq); }
  if constexpr (MODE >= 2) {
#pragma unroll
    for (int r = 0; r < 16; ++r) { const int prow = dst_l[crow(r, hi)]; GAS bf16* Pw = PO + ((size_t)prow * 768 + hh * 128 + r32);
#pragma unroll
      for (int d0 = 0; d0 < 4; ++d0) Pw[d0 * 32] = (bf16)f2bf(o[d0][r] * rli[r]); }
  } else {
  GAS bf16* Ow = Ob + (unsigned)(wid * QBLK * ldo);
#pragma unroll
  for (int r = 0; r < 16; ++r) { int orow = crow(r, hi);
#pragma unroll
    for (int d0 = 0; d0 < 4; ++d0) Ow[(unsigned)(orow * ldo + d0 * 32 + r32)] = (bf16)f2bf(o[d0][r] * rli[r] * ((DBG_ZERO_BR >> MODE) & 1 ? 0.f : 1.f)); }
  }
  __syncthreads();
#undef SLOAD
#undef SWRITE
#undef SWAIT
#undef RESC
#undef MLOAD
#undef PSM
}
}

constexpr size_t MiB = 1u << 20;
constexpr size_t WS_CTL = 0, CTL_ZERO_BYTES = 1 * MiB;
constexpr size_t WS_INFO = 1 * MiB;
constexpr size_t WS_WA = 2 * MiB, WS_WC1 = 41 * MiB, WS_WC2 = 43 * MiB, WS_WUP = 44 * MiB, WS_WO = 52 * MiB, WS_W13 = 60 * MiB, WS_W2 = 188 * MiB, WS_WMEM = 252 * MiB, WS_WR = 256 * MiB;
constexpr size_t WS_MEMB = 257 * MiB, WS_MKV = 258 * MiB, WS_HB = 259 * MiB, WS_PROJ = 291 * MiB, WS_GATE = 351 * MiB, WS_XG = WS_GATE;
constexpr size_t WS_CQN = 447 * MiB, WS_CKVN = 455 * MiB, WS_KIDX = 459 * MiB, WS_WIDX = 460 * MiB, WS_KMEAN = 461 * MiB, WS_QAI = 462 * MiB, WS_KVA = 490 * MiB;
constexpr size_t WS_MASKA = 514 * MiB, WS_BLKM = 522 * MiB, WS_OATT = 523 * MiB, WS_MERGED = 555 * MiB, WS_PRE = 587 * MiB, WS_Y = WS_PRE, WS_X1 = 651 * MiB, WS_X1B = 715 * MiB;
constexpr size_t WS_CNT = 747 * MiB + 512 * 1024;
constexpr size_t WS_ROUTE = 747 * MiB, WS_ROWMAP = 748 * MiB, WS_ROWW = 749 * MiB, WS_HID = 750 * MiB;
constexpr size_t WS_PO = 651 * MiB;
constexpr size_t WS_PML = 750 * MiB;
constexpr size_t WS_LST = 754 * MiB;
constexpr size_t WS_PICK = 758 * MiB;
constexpr size_t WS_CNT2 = 759 * MiB;
constexpr size_t WS_LEN = 760 * MiB;
constexpr size_t WS_PO2 = 587 * MiB;
constexpr size_t WS_PML2 = 762 * MiB;
constexpr int LCAP = 256 * 496;
__host__ __device__ constexpr int LBASE(int h, int n) { return h * LCAP + 256 * (31 * n - n * (n - 1) / 2); }
constexpr size_t WS_SC = WS_PRE;
constexpr size_t WDELTA = 772 * MiB;
constexpr size_t WS_END = 1024 * MiB;
__host__ __device__ constexpr size_t WD(int l) { return l ? WDELTA : 0; }
__host__ __device__ constexpr size_t WDR(int l) { return l ? 512 * 1024 : 0; }
constexpr int CW_TMO = 0;
constexpr int CW_BAR = 4096;
constexpr int CW_ECNT = 16384;
constexpr int CW_AQ = 20480;
constexpr int LDS_BYTES = 163840;
constexpr int MISC_OFF = LDS_BYTES - 256;

#define XB_TMO      128
#define XB_XCNT(j)  (256  + 64 * (j))
#define XB_XSUB(j)  (1280 + 64 * (j))
#define XB_XGEN(j)  (2304 + 64 * (j))
#define XB_TOP      3328
#define XB_TOPGEN   3392
#define XCD_BAR_WORDS 3456
#define XB_SPIN_CAP (1u << 22)
__device__ __forceinline__ unsigned xb_ld(unsigned* p)              { return __hip_atomic_load(p, __ATOMIC_RELAXED, __HIP_MEMORY_SCOPE_AGENT); }
__device__ __forceinline__ unsigned xb_add(unsigned* p, unsigned v) { return __hip_atomic_fetch_add(p, v, __ATOMIC_RELAXED, __HIP_MEMORY_SCOPE_AGENT); }
__device__ __forceinline__ unsigned xb_xcc_id() { return (unsigned)__builtin_amdgcn_s_getreg((3 << 11) | 20) & 0xFu; }
#define XB_SPIN(cond, bar) do { unsigned _sp = 0; while (cond) { __builtin_amdgcn_s_sleep(1); \
    if ((++_sp & 255u) == 0u) { if (xb_ld(&(bar)[XB_TMO])) break; if (_sp > XB_SPIN_CAP) { atomicAdd(&(bar)[XB_TMO], 1u); break; } } } } while (0)
__device__ __forceinline__ int lane_id() { int l; asm volatile("v_mbcnt_lo_u32_b32 %0, -1, 0\n\tv_mbcnt_hi_u32_b32 %0, -1, %0" : "=v"(l)); return l; }
struct XcdBarrier { unsigned* bar; unsigned x; volatile LAS unsigned* st; unsigned w0; };
__device__ __forceinline__ XcdBarrier xcd_barrier_post(unsigned* bar, volatile LAS unsigned* st, unsigned w0) {
    XcdBarrier b; b.bar = bar; b.x = xb_xcc_id(); b.st = st; b.w0 = w0;
    if (w0 && lane_id() == 0) (void)xb_add(&bar[XB_XCNT(b.x)], 1u);
    return b;
}
__device__ __forceinline__ void xcd_barrier_complete(unsigned* bar, unsigned x, unsigned& nloc, unsigned& nx) {
    const unsigned G = gridDim.x * gridDim.y * gridDim.z;
    unsigned sum, cnt, mine, sp = 0u;
    for (;;) {
        sum = 0u; cnt = 0u; mine = 0u;
#pragma unroll
        for (unsigned j = 0; j < 16; ++j) { const unsigned c = xb_ld(&bar[XB_XCNT(j)]); sum += c; cnt += (c > 0u) ? 1u : 0u; mine = (j == x) ? c : mine; }
        if (sum == G) break;
        __builtin_amdgcn_s_sleep(1);
        if ((++sp & 255u) == 0u) { if (xb_ld(&bar[XB_TMO])) break; if (sp > XB_SPIN_CAP) { atomicAdd(&bar[XB_TMO], 1u); break; } }
    }
    nloc = mine > 0u ? mine : 1u; nx = cnt > 0u ? cnt : 1u;
}
__device__ __forceinline__ void xcd_barrier(const XcdBarrier& b) {
    asm volatile("s_waitcnt vmcnt(0)" ::: "memory");
    __syncthreads();
    if (b.w0 && lane_id() == 0) {
        unsigned* bar = b.bar;
        __builtin_amdgcn_s_waitcnt(0);
        unsigned nloc = b.st[0], nx = b.st[1];
        if (nloc == 0u) { xcd_barrier_complete(bar, b.x, nloc, nx); b.st[0] = nloc; b.st[1] = nx; }
        const unsigned old = xb_add(&bar[XB_XSUB(b.x)], 1u);
        const unsigned gen = old / nloc;
        if (old + 1u == (gen + 1u) * nloc) {
            __builtin_amdgcn_fence(__ATOMIC_RELEASE, "agent");
            asm volatile("s_waitcnt vmcnt(0)" ::: "memory");
            const unsigned og = xb_add(&bar[XB_TOP], 1u);
            const unsigned tg = og / nx;
            if (og + 1u == (tg + 1u) * nx) xb_add(&bar[XB_TOPGEN], 1u);
            else XB_SPIN(xb_ld(&bar[XB_TOPGEN]) == tg, bar);
            __builtin_amdgcn_fence(__ATOMIC_ACQUIRE, "agent");
            xb_add(&bar[XB_XGEN(b.x)], 1u);
            asm volatile("s_waitcnt vmcnt(0)" ::: "memory");
        } else {
            XB_SPIN(xb_ld(&bar[XB_XGEN(b.x)]) == gen, bar);
            __builtin_amdgcn_fence(__ATOMIC_ACQUIRE, "agent");
            asm volatile("s_waitcnt vmcnt(0)" ::: "memory");
        }
    }
    __syncthreads();
}

struct Args { const float* in[28]; float* out; unsigned char* ws; int ph_lo, ph_hi; };
struct Frame {
    LAS unsigned char* lds; volatile LAS unsigned* MISC; gu32* ctl; int* info;
    int tid, lane, wave, G, bid;
    unsigned char* ws; size_t z;
};
enum { I_X = 0, I_MEM, I_WMEMKV, I_WIN, I_GCQ, I_GCKV, I_GKIDX, I_BKIDX, I_WUQ, I_WUQI, I_WUKV, I_WUPA, I_WUPB, I_WUPC, I_WGATE, I_BGATE, I_WO, I_LN1G, I_LN1B,
       I_WGRP, I_BGRP, I_WRT, I_BRT, I_W1, I_W3, I_W2, I_LN2G, I_LN2B };
#define WSP(T_, off) ((T_*)(F.ws + (off)))
#ifndef DBG_TSUB
#define DBG_TSUB 0
#endif
#ifndef DBG_TBID
#define DBG_TBID 0
#endif
#define TSUB_START(id) do { if (DBG_TSUB == (id) && F.bid == DBG_TBID && F.wave == 0) { if (lane_id() == 0) F.MISC[22] = (unsigned)__builtin_amdgcn_s_memrealtime(); } } while (0)
#define TSUB_STOP(id) do { if (DBG_TSUB == (id) && F.bid == DBG_TBID && F.wave == 0) { if (lane_id() == 0) { const unsigned t_ = (unsigned)__builtin_amdgcn_s_memrealtime(); F.MISC[20] = F.MISC[20] + (t_ - F.MISC[22]); } } } while (0)

template <int NWD>
__device__ __forceinline__ void transpose_item(const float* src, int ldw, bf16* dst, int ldk, LAS float* scr, int lane) {
    constexpr int ST = NWD + 1, KPI = 64 / NWD;
    float tv[NWD];
#pragma unroll
    for (int i = 0; i < NWD; ++i) { const int kk = KPI * i + lane / NWD; tv[i] = src[(size_t)kk * ldw + (lane % NWD)]; }
#pragma unroll
    for (int i = 0; i < NWD; ++i) { const int kk = KPI * i + lane / NWD; scr[kk * ST + (lane % NWD)] = tv[i]; }
    LDS_WAIT(); asm volatile("" ::: "memory");
    const int c = lane & 7;
#pragma unroll
    for (int j = 0; j < NWD / 8; ++j) { const int n = (lane >> 3) + 8 * j; const LAS float* s = scr + (8 * c) * ST + n;
        v4u o; o.x = cvtpk(s[0 * ST], s[1 * ST]); o.y = cvtpk(s[2 * ST], s[3 * ST]); o.z = cvtpk(s[4 * ST], s[5 * ST]); o.w = cvtpk(s[6 * ST], s[7 * ST]);
        *(GAS v4u*)(dst + (size_t)n * ldk + 8 * c) = o; }
    LDS_WAIT(); asm volatile("" ::: "memory");
}
constexpr int CONV_TOTAL = 32 * 229 + 176 + 32 * 192 + 8 * 24 + 8 * 32 + 4 * 48 + 2 * 12 * 64 + 8 * 64 + 32 * 64 + 3 * 32 * 512 + 1536;
constexpr int CONV_E_LO = 32 * 229 + 176 + 32 * 192 + 8 * 24 + 8 * 32 + 4 * 48 + 2 * 12 * 64 + 8 * 64 + 32 * 64, CONV_E_N = 3 * 32 * 512;
constexpr int CONV_REST = CONV_TOTAL - CONV_E_N;
__device__ __forceinline__ void conv_items(Frame& F, const Args& a, int l, int it_begin, int it_stride, int it_end, int hole_lo) {
    LAS float* scr = (LAS float*)(F.lds + F.wave * 16384);
    const int lane = F.lane; const size_t wd = WD(l);
    bf16* WA = WSP(bf16, WS_WA + wd); bf16* WC1 = WSP(bf16, WS_WC1 + wd); bf16* WC2 = WSP(bf16, WS_WC2 + wd); bf16* WUP = WSP(bf16, WS_WUP + wd); bf16* WO = WSP(bf16, WS_WO + wd);
    bf16* W13 = WSP(bf16, WS_W13 + wd); bf16* W2T = WSP(bf16, WS_W2 + wd); float* WR = WSP(float, WS_WR + WDR(l));
    const float* w_in = (a.in[I_WIN] + F.z) + (size_t)l * 2048 * 3664; const float* w_gate = (a.in[I_WGATE] + F.z) + (size_t)l * 2048 * 6144;
    const float* w_uq = (a.in[I_WUQ] + F.z) + (size_t)l * 512 * 768; const float* w_uqi = (a.in[I_WUQI] + F.z) + (size_t)l * 512 * 1024; const float* w_ukv = (a.in[I_WUKV] + F.z) + (size_t)l * 256 * 1536;
    const float* w_upa = (a.in[I_WUPA] + F.z) + (size_t)l * 768 * 2048; const float* w_upb = (a.in[I_WUPB] + F.z) + (size_t)l * 768 * 2048; const float* w_upc = (a.in[I_WUPC] + F.z) + (size_t)l * 512 * 2048;
    const float* w_o = (a.in[I_WO] + F.z) + (size_t)l * 2048 * 2048;
    const float* w1 = (a.in[I_W1] + F.z) + (size_t)l * 32 * 2048 * 512; const float* w3 = (a.in[I_W3] + F.z) + (size_t)l * 32 * 2048 * 512; const float* w2 = (a.in[I_W2] + F.z) + (size_t)l * 32 * 512 * 2048;
    const float* w_grp = (a.in[I_WGRP] + F.z) + (size_t)l * 2048 * 4; const float* w_rt = (a.in[I_WRT] + F.z) + (size_t)l * 2048 * 32;
    constexpr int N_IN = 32 * 229, N_PAD = 176, N_GATE = 32 * 192, N_UQ = 8 * 24, N_UQI = 8 * 32, N_UKV = 4 * 48, N_UPA = 12 * 64, N_UPC = 8 * 64, N_O = 32 * 64, N_E = 32 * 512, N_R = 1536;
    constexpr int TOTAL = N_IN + N_PAD + N_GATE + N_UQ + N_UQI + N_UKV + 2 * N_UPA + N_UPC + N_O + 3 * N_E + N_R;
    static_assert(TOTAL == CONV_TOTAL, "conv item count");
    for (int it = it_begin; it < it_end; it += it_stride) {
        int r = it >= hole_lo ? it + CONV_E_N : it;
        const float* src = nullptr; bf16* dst = nullptr; int ldw = 0, ldk = 0, kind = 0;
        if (r < N_IN) { const int kb = r / 229, nb = r % 229, n0 = 16 * nb, k0 = 64 * kb, dr = n0 < 848 ? n0 : n0 + 176;
            src = w_in + (size_t)k0 * 3664 + n0; ldw = 3664; dst = WA + (size_t)dr * 2048 + k0; ldk = 2048; kind = 1; }
        else if ((r -= N_IN) < N_PAD) { kind = 2; }
        else if ((r -= N_PAD) < N_GATE) { const int kb = r / 192, nb = r % 192, n0 = 32 * nb, k0 = 64 * kb; src = w_gate + (size_t)k0 * 6144 + n0; ldw = 6144; dst = WA + (size_t)(3840 + n0) * 2048 + k0; ldk = 2048; }
        else if ((r -= N_GATE) < N_UQ) { const int kb = r / 24, nb = r % 24, n0 = 32 * nb, k0 = 64 * kb; src = w_uq + (size_t)k0 * 768 + n0; ldw = 768; dst = WC1 + (size_t)n0 * 512 + k0; ldk = 512; }
        else if ((r -= N_UQ) < N_UQI) { const int kb = r / 32, nb = r % 32, n0 = 32 * nb, k0 = 64 * kb; src = w_uqi + (size_t)k0 * 1024 + n0; ldw = 1024; dst = WC1 + (size_t)(768 + n0) * 512 + k0; ldk = 512; }
        else if ((r -= N_UQI) < N_UKV) { const int kb = r / 48, nb = r % 48, n0 = 32 * nb, k0 = 64 * kb; src = w_ukv + (size_t)k0 * 1536 + n0; ldw = 1536; dst = WC2 + (size_t)n0 * 256 + k0; ldk = 256; }
        else if ((r -= N_UKV) < N_UPA) { const int kb = r / 64, nb = r % 64, n0 = 32 * nb, k0 = 64 * kb; src = w_upa + (size_t)k0 * 2048 + n0; ldw = 2048; dst = WUP + (size_t)n0 * 2048 + k0; ldk = 2048; }
        else if ((r -= N_UPA) < N_UPA) { const int kb = r / 64, nb = r % 64, n0 = 32 * nb, k0 = 64 * kb; src = w_upb + (size_t)k0 * 2048 + n0; ldw = 2048; dst = WUP + (size_t)n0 * 2048 + 768 + k0; ldk = 2048; }
        else if ((r -= N_UPA) < N_UPC) { const int kb = r / 64, nb = r % 64, n0 = 32 * nb, k0 = 64 * kb; src = w_upc + (size_t)k0 * 2048 + n0; ldw = 2048; dst = WUP + (size_t)n0 * 2048 + 1536 + k0; ldk = 2048; }
        else if ((r -= N_UPC) < N_O) { const int kb = r / 64, nb = r % 64, n0 = 32 * nb, k0 = 64 * kb; src = w_o + (size_t)k0 * 2048 + n0; ldw = 2048; dst = WO + (size_t)n0 * 2048 + k0; ldk = 2048; }
        else if ((r -= N_O) < 2 * N_E) { const int which = r / N_E; r -= which * N_E; const int e = r / 512, q = r % 512, kb = q / 16, nb = q % 16, n0 = 32 * nb, k0 = 64 * kb;
            src = (which ? w3 : w1) + (size_t)e * 2048 * 512 + (size_t)k0 * 512 + n0; ldw = 512;
            const int dr = e * 1024 + (n0 >> 7) * 256 + (n0 & 127) + which * 128; dst = W13 + (size_t)dr * 2048 + k0; ldk = 2048; }
        else if ((r -= 2 * N_E) < N_E) { const int e = r / 512, q = r % 512, kb = q / 64, nb = q % 64, n0 = 32 * nb, k0 = 64 * kb;
            src = w2 + (size_t)e * 512 * 2048 + (size_t)k0 * 2048 + n0; ldw = 2048; dst = W2T + (size_t)(e * 2048 + n0) * 512 + k0; ldk = 512; }
        else { r -= N_E; kind = 3; }
        if (kind == 0) transpose_item<32>(src, ldw, dst, ldk, scr, lane);
        else if (kind == 1) transpose_item<16>(src, ldw, dst, ldk, scr, lane);
        else if (kind == 2) { GAS v4u* p = (GAS v4u*)(WA + (size_t)(848 + r) * 2048) + lane * 4; const v4u z = {0u, 0u, 0u, 0u}; p[0] = z; p[1] = z; p[2] = z; p[3] = z; }
        else { const int idx = r * 64 + lane, j = idx & 7, lm = (idx >> 3) & 63, sc = idx >> 9, c = sc % 3, S = sc / 3, k = 32 * S + 8 * (lm >> 4) + j, col = 16 * c + (lm & 15);
            const float wv_ = col < 32 ? w_rt[k * 32 + col] : (col < 36 ? w_grp[k * 4 + (col - 32)] : 0.f); const unsigned hb = f2bf(wv_); const unsigned lb = f2bf(wv_ - bf2f(hb));
            bf16* WRb = (bf16*)WR; WRb[((sc * 2 + 0) * 64 + lm) * 8 + j] = (bf16)hb; WRb[((sc * 2 + 1) * 64 + lm) * 8 + j] = (bf16)lb; }
    }
}
__device__ __forceinline__ void conv_layer(Frame& F, const Args& a, int l) { conv_items(F, a, l, F.bid * 8 + F.wave, F.G * 8, CONV_REST, CONV_E_LO); }
__device__ __forceinline__ void prologue(Frame& F, const Args& a) {
    LAS float* scr = (LAS float*)(F.lds + F.wave * 16384);
    const int gw = F.bid * 8 + F.wave, NGW = F.G * 8, lane = F.lane;
    bf16* HB = WSP(bf16, WS_HB); bf16* MEMB = WSP(bf16, WS_MEMB); bf16* WMEM = WSP(bf16, WS_WMEM);
    const float* x = (a.in[I_X] + F.z); const float* mem = (a.in[I_MEM] + F.z); const float* wm = (a.in[I_WMEMKV] + F.z);
    const long NX8 = (long)T * DM / 8, NM8 = 256L * DM / 8;
    for (long ib = (long)gw * 64 + lane; ib < NX8 + NM8; ib += 4L * NGW * 64) {
        f32x4 v0[4], v1[4];
#pragma unroll
        for (int u = 0; u < 4; ++u) { long i = ib + (long)u * NGW * 64; i = i < NX8 + NM8 ? i : ib; const bool inx = i < NX8; const long j = inx ? i : i - NX8; const float* s = (inx ? x : mem) + j * 8;
            v0[u] = *(const GAS f32x4*)s; v1[u] = *(const GAS f32x4*)(s + 4); }
#pragma unroll
        for (int u = 0; u < 4; ++u) { const long i = ib + (long)u * NGW * 64; if (i < NX8 + NM8) { const bool inx = i < NX8; const long j = inx ? i : i - NX8;
            v4u o; o.x = cvtpk(v0[u][0], v0[u][1]); o.y = cvtpk(v0[u][2], v0[u][3]); o.z = cvtpk(v1[u][0], v1[u][1]); o.w = cvtpk(v1[u][2], v1[u][3]);
            *(GAS v4u*)((inx ? HB : MEMB) + j * 8) = o; } }
    }
    for (int it = gw; it < 32 * 32; it += NGW) { const int kb = it / 32, nb = it % 32, n0 = 32 * nb, k0 = 64 * kb;
        transpose_item<32>(wm + (size_t)k0 * 1024 + n0, 1024, WMEM + (size_t)n0 * 2048 + k0, 2048, scr, lane); }
}

__device__ __forceinline__ void phase_norms(Frame& F, const Args& a, int l) {
    const int gw = F.bid * 8 + F.wave, NGW = F.G * 8, lane = F.lane;
    const bf16* PROJ = WSP(bf16, WS_PROJ); bf16* CQN = WSP(bf16, WS_CQN); bf16* CKVN = WSP(bf16, WS_CKVN); bf16* KIDX = WSP(bf16, WS_KIDX); float* WIDX = WSP(float, WS_WIDX); float* KMEAN = WSP(float, WS_KMEAN);
    const float* gcq = (a.in[I_GCQ] + F.z) + l * 512; const float* gckv = (a.in[I_GCKV] + F.z) + l * 256; const float* gk = (a.in[I_GKIDX] + F.z) + l * 64; const float* bk = (a.in[I_BKIDX] + F.z) + l * 64;
    { LAS float* red = (LAS float*)F.lds;
      for (int task = F.bid; task < 32 * 6; task += F.G) {
        const int n = task / 6, g = task % 6, rsub = lane >> 4, co = lane & 15;
        float s[8] = {0, 0, 0, 0, 0, 0, 0, 0};
#pragma unroll
        for (int i = 0; i < 8; ++i) { const v4u w = *(const GAS v4u*)(PROJ + (size_t)(n * 256 + F.wave * 32 + 4 * i + rsub) * NPROJ + PJ_KB + g * 128 + 8 * co);
            s[0] += bflo(w.x); s[1] += bfhi(w.x); s[2] += bflo(w.y); s[3] += bfhi(w.y); s[4] += bflo(w.z); s[5] += bfhi(w.z); s[6] += bflo(w.w); s[7] += bfhi(w.w); }
#pragma unroll
        for (int j = 0; j < 8; ++j) { s[j] += __shfl_xor(s[j], 16); s[j] += __shfl_xor(s[j], 32); }
        if (rsub == 0) {
#pragma unroll
            for (int j = 0; j < 8; ++j) red[F.wave * 128 + 8 * co + j] = s[j]; }
        __syncthreads();
        if (F.tid < 128) { float t = 0.f;
#pragma unroll
            for (int ww = 0; ww < 8; ++ww) t += red[ww * 128 + F.tid];
            KMEAN[(size_t)n * 768 + g * 128 + F.tid] = t * (1.f / 256.f); }
        __syncthreads();
      } }
    for (int tb = gw; tb < T; tb += 4 * NGW) {
        v4u wq[4]; v2u wk[4]; float vk[4], vw[4];
#pragma unroll
        for (int u = 0; u < 4; ++u) { const int t = tb + u * NGW < T ? tb + u * NGW : tb; const bf16* row = PROJ + (size_t)t * NPROJ;
            wq[u] = *(const GAS v4u*)(row + 8 * lane); wk[u] = *(const GAS v2u*)(row + 512 + 4 * lane); vk[u] = bf2f(row[768 + lane]); vw[u] = bf2f(row[832 + (lane & 15)]); }
#pragma unroll
        for (int u = 0; u < 4; ++u) { const int t = tb + u * NGW; if (t < T) {
          { const v4u w = wq[u]; float v[8] = {bflo(w.x), bfhi(w.x), bflo(w.y), bfhi(w.y), bflo(w.z), bfhi(w.z), bflo(w.w), bfhi(w.w)};
            float ss = 0.f;
#pragma unroll
            for (int j = 0; j < 8; ++j) ss += v[j] * v[j];
            const float rs = 1.0f / sqrtf(wave_sum(ss) * (1.f / 512.f) + LN_EPS);
            const f32x4 g0 = *(const GAS f32x4*)(gcq + 8 * lane), g1 = *(const GAS f32x4*)(gcq + 8 * lane + 4);
            v4u o; o.x = cvtpk(v[0] * rs * g0[0], v[1] * rs * g0[1]); o.y = cvtpk(v[2] * rs * g0[2], v[3] * rs * g0[3]); o.z = cvtpk(v[4] * rs * g1[0], v[5] * rs * g1[1]); o.w = cvtpk(v[6] * rs * g1[2], v[7] * rs * g1[3]);
            *(GAS v4u*)(CQN + (size_t)t * 512 + 8 * lane) = o; }
          { const v2u w = wk[u]; float v[4] = {bflo(w.x), bfhi(w.x), bflo(w.y), bfhi(w.y)};
            float ss = (v[0] * v[0] + v[1] * v[1]) + (v[2] * v[2] + v[3] * v[3]);
            const float rs = 1.0f / sqrtf(wave_sum(ss) * (1.f / 256.f) + LN_EPS);
            const f32x4 g0 = *(const GAS f32x4*)(gckv + 4 * lane);
            v2u o; o.x = cvtpk(v[0] * rs * g0[0], v[1] * rs * g0[1]); o.y = cvtpk(v[2] * rs * g0[2], v[3] * rs * g0[3]);
            *(GAS v2u*)(CKVN + (size_t)t * 256 + 4 * lane) = o; }
          { const float v = vk[u]; const float mu = wave_sum(v) * (1.f / 64.f); const float d = v - mu; const float var = wave_sum(d * d) * (1.f / 64.f);
            KIDX[(size_t)t * 64 + lane] = (bf16)f2bf(d * (1.0f / sqrtf(var + LN_EPS)) * gk[lane] + bk[lane]); }
          if (lane < 16) WIDX[(size_t)t * 16 + lane] = vw[u] * 0.25f; } }
    }
}

__device__ __forceinline__ void indexer_item(Frame& F, int item) {
    int tid = F.tid; asm volatile("" : "+v"(tid));
    const int lane = tid & 63, w = F.wave, hi = lane >> 5, kl = lane & 31;
    const bf16* QAI = WSP(bf16, WS_QAI); const bf16* KIDX = WSP(bf16, WS_KIDX); const float* WIDX = WSP(float, WS_WIDX); unsigned* MASKA = WSP(unsigned, WS_MASKA);
    const int t0 = item * 16, myq = t0 + 2 * w + hi;
    const GAS char* SCb = (const GAS char*)WSP(float, WS_SC); unsigned scoff; { const unsigned b_ = myq >> 6, r_ = myq & 63; scoff = (2048u * b_ * (b_ + 1u) + 64u * r_ * (b_ + 1u)) * 4u; }
    LAS unsigned char* reg = F.lds + (2 * w) * 8192;
    LAS unsigned char* myreg = reg + hi * 8192;
    LAS unsigned char* KST = F.lds + 131072;
    bf16x8 af[4];
    { const int rho = kl, qsel = (rho >> 2) & 1, head = (rho & 3) + 4 * (rho >> 3);
      const bf16* src = QAI + (size_t)(t0 + 2 * w + qsel) * NQAI + 768 + head * 64 + 8 * hi;
#pragma unroll
      for (int c = 0; c < 4; ++c) af[c] = *(const GAS bf16x8*)(src + 16 * c); }
    float wv[16];
    { const GAS f32x4* wp = (const GAS f32x4*)(WIDX + (size_t)myq * 16);
#pragma unroll
      for (int j = 0; j < 4; ++j) { const f32x4 v = wp[j]; wv[4 * j] = v[0]; wv[4 * j + 1] = v[1]; wv[4 * j + 2] = v[2]; wv[4 * j + 3] = v[3]; } }
    const int nch = (t0 + 16 + 63) >> 6;
    const int skey = tid >> 3, sch = tid & 7;
    const int sdst = skey * 128 + ((sch ^ ((skey >> 1) & 7)) << 4);
    int bstar = 0, nab = 0; bool allq = false;
#ifndef DBG_IDX_DUMMY
#define DBG_IDX_DUMMY 0
#endif
    {
        TSUB_START(1);
        { const v4u z = {0u, 0u, 0u, 0u};
#pragma unroll
          for (int i = 0; i < 16; ++i) *(LAS v4u*)(reg + (i * 64 + lane) * 16) = z; }
        const GAS char* kgb = (const GAS char*)KIDX; const unsigned kgo = (unsigned)(skey * 64 + sch * 8) * 2u;
#define KG(c) (*(const GAS v4u*)(kgb + (kgo + (unsigned)(c) * 8192u)))
        v4u R0 = {0u, 0u, 0u, 0u}, R1 = R0;
        { const v4u k0 = KG(0); R1 = KG(1 < nch ? 1 : nch - 1); R0 = KG(2 < nch ? 2 : nch - 1); *(LAS v4u*)(KST + sdst) = k0; }
        __syncthreads();
        int fo[4];
#pragma unroll
        for (int c = 0; c < 4; ++c) fo[c] = kl * 128 + (((2 * c + hi) ^ ((kl >> 1) & 7)) << 4);
        f32x16 AC[2][2];
#define IDX_POST(P, MM) do { \
            _Pragma("unroll") for (int tile = 0; tile < 2; ++tile) { f32x2 pa = {0.f, 0.f}, pb = {0.f, 0.f}; \
                _Pragma("unroll") for (int r = 0; r < 16; r += 4) { float rl[4]; \
                    _Pragma("unroll") for (int q_ = 0; q_ < 4; ++q_) { const float av = AC[P][tile][r + q_]; const int xi = __float_as_int(av); rl[q_] = __int_as_float(xi > 0 ? xi : 0); } \
                    pa = __builtin_elementwise_fma((f32x2){rl[0], rl[1]}, (f32x2){wv[r], wv[r + 1]}, pa); pb = __builtin_elementwise_fma((f32x2){rl[2], rl[3]}, (f32x2){wv[r + 2], wv[r + 3]}, pb); } \
                const float score = (pa.x + pa.y) + (pb.x + pb.y); \
                const int row = 32 * tile + kl; const int key = 64 * (MM) + row; const bool valid = key <= myq; \
                const unsigned bits = __float_as_uint(score); const unsigned u = bits ^ ((unsigned)((int)bits >> 31) | 0x80000000u); const int bin = (int)(u >> 20); \
                *(GAS float*)(SCb + (scoff + 4u * (unsigned)key)) = score; \
                if (valid) __hip_atomic_fetch_add((LAS unsigned*)(myreg + ((bin >> 1) << 2)), 1u << ((bin & 1) << 4), __ATOMIC_RELAXED, __HIP_MEMORY_SCOPE_WORKGROUP); \
            } } while (0)
#define IDX_STEP(J, RW) do { const int mm_ = m + (J); if (mm_ < nch) { \
            const LAS unsigned char* kb_ = KST + ((J) & 1) * 8192; bf16x8 FR[2][4]; \
            _Pragma("unroll") for (int tile = 0; tile < 2; ++tile) _Pragma("unroll") for (int c = 0; c < 4; ++c) FR[tile][c] = *(const LAS bf16x8*)(kb_ + fo[c] + tile * 4096); \
            asm volatile("s_waitcnt lgkmcnt(0)" ::: "memory"); SBAR(); \
            AC[(J) & 1][0] = __builtin_amdgcn_mfma_f32_32x32x16_bf16(af[0], FR[0][0], f32x16{}, 0, 0, 0); AC[(J) & 1][1] = __builtin_amdgcn_mfma_f32_32x32x16_bf16(af[0], FR[1][0], f32x16{}, 0, 0, 0); \
            _Pragma("unroll") for (int c = 1; c < 4; ++c) { AC[(J) & 1][0] = __builtin_amdgcn_mfma_f32_32x32x16_bf16(af[c], FR[0][c], AC[(J) & 1][0], 0, 0, 0); \
                AC[(J) & 1][1] = __builtin_amdgcn_mfma_f32_32x32x16_bf16(af[c], FR[1][c], AC[(J) & 1][1], 0, 0, 0); } \
            SBAR(); \
            if (mm_ >= 1) IDX_POST(((J) + 1) & 1, mm_ - 1); \
            if (mm_ + 1 < nch) *(LAS v4u*)(KST + (((J) + 1) & 1) * 8192 + sdst) = RW; \
            RW = KG(mm_ + 3 < nch ? mm_ + 3 : nch - 1); \
            __syncthreads(); } } while (0)
        for (int m = 0; m < nch; m += 2) { IDX_STEP(0, R1); IDX_STEP(1, R0); }
        if ((nch - 1) & 1) IDX_POST(1, nch - 1); else IDX_POST(0, nch - 1);
#undef IDX_POST
#undef IDX_STEP
#undef KG
        TSUB_STOP(1); TSUB_START(2);
        {
            int bsq[2], nbq[2]; bool alq[2];
#pragma unroll
            for (int q = 0; q < 2; ++q) {
                const LAS unsigned* hw = (const LAS unsigned*)(reg + q * 8192) + 32 * lane;
                unsigned wd[32]; unsigned s = 0;
#pragma unroll
                for (int i = 0; i < 8; ++i) { const v4u v = *(const LAS v4u*)(hw + 4 * i); wd[4 * i] = v.x; wd[4 * i + 1] = v.y; wd[4 * i + 2] = v.z; wd[4 * i + 3] = v.w; }
#pragma unroll
                for (int i = 0; i < 32; ++i) s += (wd[i] & 0xffffu) + (wd[i] >> 16);
                unsigned v = s;
#pragma unroll
                for (int off = 1; off < 64; off <<= 1) { const unsigned tt = __shfl_down(v, off); if (lane + off < 64) v += tt; }
                const unsigned sufx = v - s; const unsigned total = __builtin_amdgcn_readfirstlane(v);
                int nbel = 0; int fn = (int)sufx; int cum = (int)sufx;
#pragma unroll
                for (int i = 31; i >= 0; --i) {
                    cum += (int)(wd[i] >> 16);     { const int mk = (cum - 256) >> 31; nbel -= mk; const int cm = cum & mk; fn = cm > fn ? cm : fn; }
                    cum += (int)(wd[i] & 0xffffu); { const int mk = (cum - 256) >> 31; nbel -= mk; const int cm = cum & mk; fn = cm > fn ? cm : fn; }
                }
                const int fb = 64 * lane + 63 - nbel;
                const unsigned long long bm = __ballot(sufx < 256u && v >= 256u);
                const int lstar = bm ? (int)__builtin_ctzll(bm) : 0;
                bsq[q] = __builtin_amdgcn_readlane(fb, lstar); nbq[q] = __builtin_amdgcn_readlane(fn, lstar); alq[q] = total <= 256u;
            }
            bstar = hi ? bsq[1] : bsq[0]; nab = hi ? nbq[1] : nbq[0]; allq = hi ? alq[1] : alq[0];
        }
        TSUB_STOP(2); TSUB_START(3);
        { const v4u z = {0u, 0u, 0u, 0u};
#pragma unroll
          for (int i = 0; i < 16; ++i) *(LAS v4u*)(reg + (i * 64 + lane) * 16) = z; }
        asm volatile("s_waitcnt vmcnt(0)" ::: "memory");
        { const int ntile = 2 * nch;
          auto p1_load = [&](float (&sv)[16], int tb) {
#pragma unroll
              for (int j = 0; j < 16; ++j) { const int tt = tb + j < ntile ? tb + j : ntile - 1; sv[j] = __builtin_nontemporal_load((const GAS float*)(SCb + (scoff + 4u * (unsigned)(32 * tt + kl)))); } };
          auto p1_proc = [&](float (&sv)[16], int tb) {
#pragma unroll
              for (int j = 0; j < 16; ++j) if (tb + j < ntile) {
                  const int key = 32 * (tb + j) + kl; const bool valid = key <= myq; const float score = sv[j];
                  const unsigned bits = __float_as_uint(score); const unsigned u = bits ^ ((unsigned)((int)bits >> 31) | 0x80000000u); const int bin = (int)(u >> 20);
                  const bool above = valid && (allq || bin > bstar), cand = valid && !allq && bin == bstar;
                  const unsigned long long bal = __ballot(above);
                  if (kl == 0) *(LAS unsigned*)(myreg + 6144 + (tb + j) * 4) = hi ? (unsigned)(bal >> 32) : (unsigned)bal;
                  if (__any(cand)) { if (cand) { const unsigned slot = __hip_atomic_fetch_add((LAS unsigned*)(myreg + 7168), 1u, __ATOMIC_RELAXED, __HIP_MEMORY_SCOPE_WORKGROUP);
                      if (slot < 768u) { v2u e; e.x = ~(unsigned)key; e.y = u; *(LAS v2u*)(myreg + slot * 8) = e; } } }
              } };
          float sa[16], sb[16];
          p1_load(sa, 0);
          for (int tb = 0; tb < ntile; tb += 32) { p1_load(sb, tb + 16); p1_proc(sa, tb); p1_load(sa, tb + 32); p1_proc(sb, tb + 16); } }
        TSUB_STOP(3); TSUB_START(4);
        {
            if (kl == 0) *(LAS int*)(myreg + 7172) = allq ? 0 : 256 - nab;
            __syncthreads();
            int f = w;
#pragma nounroll
            for (int q = 0; q < 16; ++q) {
                LAS unsigned char* rq = F.lds + q * 8192;
                unsigned nc = *(LAS unsigned*)(rq + 7168); nc = nc > 768u ? 768u : nc; nc = __builtin_amdgcn_readfirstlane(nc);
                const int need = __builtin_amdgcn_readfirstlane(*(LAS int*)(rq + 7172));
                const int nck = need > 0 ? (int)((nc + 63u) >> 6) : 0;
                for (; f < nck; f += 8) { const unsigned i = (unsigned)f * 64u + lane; const bool act = i < nc;
                    unsigned long long me = 0ull; if (act) me = *(LAS unsigned long long*)(rq + i * 8);
                    int rank = 0;
                    unsigned j = 0;
                    for (; j + 4 <= nc; j += 4) { const unsigned long long o0 = *(LAS unsigned long long*)(rq + j * 8), o1 = *(LAS unsigned long long*)(rq + j * 8 + 8), o2 = *(LAS unsigned long long*)(rq + j * 8 + 16), o3 = *(LAS unsigned long long*)(rq + j * 8 + 24);
                        rank += (o0 > me ? 1 : 0) + (o1 > me ? 1 : 0) + (o2 > me ? 1 : 0) + (o3 > me ? 1 : 0); }
                    for (; j < nc; ++j) { const unsigned long long o = *(LAS unsigned long long*)(rq + j * 8); rank += o > me ? 1 : 0; }
                    const unsigned key = ~(unsigned)me;
                    if (act && rank < need) __hip_atomic_fetch_or((LAS unsigned*)(rq + 6144 + ((key >> 5) << 2)), 1u << (key & 31u), __ATOMIC_RELAXED, __HIP_MEMORY_SCOPE_WORKGROUP);
                }
                f -= nck;
            }
            __syncthreads();
#pragma unroll
            for (int q = 0; q < 2; ++q) {
                const v4u mrow = *(LAS v4u*)(reg + q * 8192 + 6144 + lane * 16);
                *(GAS v4u*)(MASKA + (size_t)(t0 + 2 * w + q) * 256 + 4 * lane) = mrow;
            }
        }
        TSUB_STOP(4);
    }
    __syncthreads();
}
__device__ __forceinline__ void phase_indexer(Frame& F) {
    for (int p = F.bid; p < 256; p += F.G) { indexer_item(F, 511 - p); indexer_item(F, p); }
}

__device__ __forceinline__ void phase_moba_gate(Frame& F) {
    const int lane = F.lane, tk = lane & 31, half = lane >> 5;
    const bf16* PROJ = WSP(bf16, WS_PROJ); const float* KMEAN = WSP(float, WS_KMEAN); unsigned* PICK = WSP(unsigned, WS_PICK); int* CNT2 = WSP(int, WS_CNT2);
    for (int item = F.wave * F.G + F.bid; item < 256 * 6; item += 8 * F.G) {
        const int grp = item / 6, h = item - grp * 6, t = grp * 32 + tk, c = grp >> 3;
        unsigned m0 = 0u, m1 = 0u, m2 = 0u;
        if (c > 0) {
            float qv[64];
            { const GAS v4u* qp = (const GAS v4u*)(PROJ + (size_t)t * NPROJ + PJ_QB + h * 128 + 64 * half);
#pragma unroll
              for (int i = 0; i < 8; ++i) { const v4u w = qp[i]; qv[8 * i] = bflo(w.x); qv[8 * i + 1] = bfhi(w.x); qv[8 * i + 2] = bflo(w.y); qv[8 * i + 3] = bfhi(w.y); qv[8 * i + 4] = bflo(w.z); qv[8 * i + 5] = bfhi(w.z); qv[8 * i + 6] = bflo(w.w); qv[8 * i + 7] = bfhi(w.w); } }
            float b0 = -__builtin_inff(), b1 = b0, b2 = b0;
            const float* kmh = KMEAN + h * 128 + 64 * half;
            f32x4 ka[16], kb[16];
#define GATE_LOAD(K_, n_) do { const GAS f32x4* kp_ = (const GAS f32x4*)(kmh + (size_t)((n_) < c ? (n_) : c - 1) * 768); _Pragma("unroll") for (int i = 0; i < 16; ++i) K_[i] = kp_[i]; } while (0)
#define GATE_SCORE(K_, n_) do { if ((n_) < c) { float g0 = 0.f, g1 = 0.f, g2 = 0.f, g3 = 0.f; \
                _Pragma("unroll") for (int i = 0; i < 16; ++i) { g0 = fmaf(qv[4 * i], K_[i][0], g0); g1 = fmaf(qv[4 * i + 1], K_[i][1], g1); g2 = fmaf(qv[4 * i + 2], K_[i][2], g2); g3 = fmaf(qv[4 * i + 3], K_[i][3], g3); } \
                float g = (g0 + g1) + (g2 + g3); g += __shfl_xor(g, 32); const unsigned bit = 1u << (n_); \
                if (g > b0) { b2 = b1; m2 = m1; b1 = b0; m1 = m0; b0 = g; m0 = bit; } else if (g > b1) { b2 = b1; m2 = m1; b1 = g; m1 = bit; } else if (g > b2) { b2 = g; m2 = bit; } } } while (0)
            GATE_LOAD(ka, 0);
            for (int n = 0; n < c; n += 2) { GATE_LOAD(kb, n + 1); GATE_SCORE(ka, n); GATE_LOAD(ka, n + 2); GATE_SCORE(kb, n + 1); }
#undef GATE_LOAD
#undef GATE_SCORE
        }
        const unsigned n0 = m0 ? (unsigned)__builtin_ctz(m0) : 255u, n1 = m1 ? (unsigned)__builtin_ctz(m1) : 255u, n2 = m2 ? (unsigned)__builtin_ctz(m2) : 255u;
        if (half == 0) PICK[(size_t)t * 6 + h] = n0 | (n1 << 8) | (n2 << 16);
        int cn = 0;
        for (int n = 0; n < c; ++n) { const unsigned long long b = __ballot(half == 0 && (n0 == (unsigned)n || n1 == (unsigned)n || n2 == (unsigned)n)); if (lane == n) cn = (int)__builtin_popcountll(b); }
        if (lane < 32) CNT2[(h * 256 + grp) * 32 + lane] = cn;
    }
}
__device__ __forceinline__ void phase_moba_lists(Frame& F) {
    const int lane = F.lane, tk = lane & 31, half = lane >> 5;
    const unsigned* PICK = WSP(unsigned, WS_PICK); const int* CNT2 = WSP(int, WS_CNT2); unsigned* LST = WSP(unsigned, WS_LST); int* LEN = WSP(int, WS_LEN);
    for (int item = F.wave * F.G + F.bid; item < 256 * 6; item += 8 * F.G) {
        const int grp = item / 6, h = item - grp * 6, t = grp * 32 + tk, c = grp >> 3;
        int before = 0, total = 0;
        { const int* cp = CNT2 + (h * 256 + 128 * half) * 32 + tk;
#pragma unroll 32
          for (int g = 0; g < 128; ++g) { const int v = cp[g * 32]; total += v; before += (128 * half + g < grp) ? v : 0; } }
        before += __shfl_xor(before, 32); total += __shfl_xor(total, 32);
        if (grp == 0 && lane < 32) LEN[h * 32 + lane] = total;
        if (c > 0) {
            const unsigned pk = PICK[(size_t)t * 6 + h]; const unsigned n0 = pk & 255u, n1 = (pk >> 8) & 255u, n2 = (pk >> 16) & 255u;
            int r0 = 0, r1 = 0, r2 = 0; const unsigned long long lt = (1ull << tk) - 1ull;
            for (int n = 0; n < c; ++n) { const unsigned long long b = __ballot(half == 0 && (n0 == (unsigned)n || n1 == (unsigned)n || n2 == (unsigned)n));
                const int rk = __builtin_amdgcn_readlane(before, n) + (int)__builtin_popcountll(b & lt);
                if (n0 == (unsigned)n) r0 = rk; if (n1 == (unsigned)n) r1 = rk; if (n2 == (unsigned)n) r2 = rk; }
            if (half == 0) { const int hb = h * LCAP;
                if (n0 < 32u) LST[hb + 256 * (31 * (int)n0 - (int)n0 * ((int)n0 - 1) / 2) + r0] = (unsigned)t | (1u << 16);
                if (n1 < 32u) LST[hb + 256 * (31 * (int)n1 - (int)n1 * ((int)n1 - 1) / 2) + r1] = (unsigned)t | (2u << 16);
                if (n2 < 32u) LST[hb + 256 * (31 * (int)n2 - (int)n2 * ((int)n2 - 1) / 2) + r2] = (unsigned)t | (3u << 16); }
        }
    }
}
__device__ __forceinline__ void phase_attn_merge(Frame& F) {
    const int gw = F.bid * 8 + F.wave, NGW = F.G * 8, lane = F.lane;
    const unsigned* PICK = WSP(unsigned, WS_PICK); const bf16* PO = WSP(bf16, WS_PO); const float* PML = WSP(float, WS_PML); const bf16* PO2 = WSP(bf16, WS_PO2); const float* PML2 = WSP(float, WS_PML2); bf16* OATT = WSP(bf16, WS_OATT);
    for (int tp = gw; tp < T / 2; tp += NGW) {
#pragma unroll 3
        for (int i = 0; i < 6; ++i) { const int p = lane + 64 * i, t = 2 * tp + p / 192, wi = p % 192, hx = wi >> 4, d8 = wi & 15; const bool dsa = hx < 6; const int h = dsa ? hx : hx - 6;
            unsigned pk = 0xffffffu; if (!dsa) pk = PICK[(size_t)t * 6 + h];
            const int ns = (t >> 11) + 1;
            const bool val[4] = {true, dsa ? 1 < ns : (pk & 255u) < 32u, dsa ? 2 < ns : ((pk >> 8) & 255u) < 32u, dsa ? 3 < ns : ((pk >> 16) & 255u) < 32u};
            const bf16* pob = dsa ? PO2 : PO; const float* pmb = dsa ? PML2 : PML;
            float m[4], lv[4]; v4u po[4];
#pragma unroll
            for (int sl = 0; sl < 4; ++sl) { const size_t r = (size_t)sl * T + t; const f32x2 ml = *(const GAS f32x2*)(pmb + (r * 6 + h) * 2); m[sl] = val[sl] ? ml.x : -3e38f; lv[sl] = val[sl] ? ml.y : 0.f;
                const v4u x = *(const GAS v4u*)(pob + r * 768 + h * 128 + 8 * d8); const v4u z = {0u, 0u, 0u, 0u}; po[sl] = val[sl] ? x : z; }
            const float M = fmaxf(fmaxf(m[0], m[1]), fmaxf(m[2], m[3]));
            float w[4], W = 0.f;
#pragma unroll
            for (int sl = 0; sl < 4; ++sl) { w[sl] = val[sl] ? __builtin_amdgcn_exp2f(m[sl] - M) * lv[sl] : 0.f; W += w[sl]; }
            const float inv = 1.f / W;
            float o[8] = {0, 0, 0, 0, 0, 0, 0, 0};
#pragma unroll
            for (int sl = 0; sl < 4; ++sl) { const float ws_ = w[sl] * inv;
                o[0] = fmaf(ws_, bflo(po[sl].x), o[0]); o[1] = fmaf(ws_, bfhi(po[sl].x), o[1]); o[2] = fmaf(ws_, bflo(po[sl].y), o[2]); o[3] = fmaf(ws_, bfhi(po[sl].y), o[3]);
                o[4] = fmaf(ws_, bflo(po[sl].z), o[4]); o[5] = fmaf(ws_, bfhi(po[sl].z), o[5]); o[6] = fmaf(ws_, bflo(po[sl].w), o[6]); o[7] = fmaf(ws_, bfhi(po[sl].w), o[7]); }
            v4u ob; ob.x = cvtpk(o[0], o[1]); ob.y = cvtpk(o[2], o[3]); ob.z = cvtpk(o[4], o[5]); ob.w = cvtpk(o[6], o[7]);
            *(GAS v4u*)(OATT + (size_t)t * 2048 + hx * 128 + 8 * d8) = ob; }
    }
}

constexpr int CONV_IPQ = 128, CONV_NQE = CONV_E_N / CONV_IPQ, CONV_NQR = (CONV_REST + CONV_IPQ - 1) / CONV_IPQ;
__device__ __forceinline__ void phase_attention(Frame& F, const Args& a, int l, int rep) {
    const GAS bf16* PROJ = (const GAS bf16*)WSP(bf16, WS_PROJ); const GAS bf16* QAI = (const GAS bf16*)WSP(bf16, WS_QAI); const GAS bf16* KVA = (const GAS bf16*)WSP(bf16, WS_KVA); const GAS bf16* MKV = (const GAS bf16*)WSP(bf16, WS_MKV);
    GAS bf16* OATT = (GAS bf16*)WSP(bf16, WS_OATT); const GAS unsigned* MASKA = (const GAS unsigned*)WSP(unsigned, WS_MASKA);
    GAS bf16* PO = (GAS bf16*)WSP(bf16, WS_PO); GAS float* PML = (GAS float*)WSP(float, WS_PML); const GAS unsigned* LST = (const GAS unsigned*)WSP(unsigned, WS_LST);
    LAS int* cum = (LAS int*)(F.lds + LDS_BYTES - 256 - 2048); LAS int* lenl = cum + 256;
    { const int* LEN = WSP(int, WS_LEN);
      if (F.wave == 0) { const int l3 = 3 * F.lane; const int e0 = LEN[l3], e1 = LEN[l3 + 1], e2 = LEN[l3 + 2]; const int v0 = (e0 + 255) >> 8, v1 = (e1 + 255) >> 8, v2 = (e2 + 255) >> 8;
          const int s_ = v0 + v1 + v2; int inc = s_;
#pragma unroll
          for (int o = 1; o < 64; o <<= 1) { const int u = __shfl_up(inc, o); if (F.lane >= o) inc += u; }
          const int exc = inc - s_; cum[l3] = exc; cum[l3 + 1] = exc + v0; cum[l3 + 2] = exc + v0 + v1; lenl[l3] = e0; lenl[l3 + 1] = e1; lenl[l3 + 2] = e2; if (F.lane == 63) cum[192] = inc; }
      __syncthreads(); }
    const int U = __builtin_amdgcn_readfirstlane(cum[192]);
    gu32* head = F.ctl + CW_AQ + 64 * l + 32 * rep;
    for (;;) {
        if (F.tid == 0) F.MISC[16] = __hip_atomic_fetch_add(head, 1u, RLX_AGENT);
        __syncthreads();
        const int i = __builtin_amdgcn_readfirstlane((int)F.MISC[16]);
        __syncthreads();
        const int nconv = CONV_NQE + ((l + 1 < NLAYER) ? CONV_NQR : 0), R = (nconv + 287) / 288, NS = 288 * (1 + R);
        if (i >= NS + 384 + U + 128) break;
        const int slot = i / (1 + R), sub = i - slot * (1 + R);
        if (i < NS && sub > 0) { int q = slot * R + sub - 1, lc = l, b_ = CONV_E_LO, e_ = CONV_E_LO + CONV_E_N, hole = 0x7fffffff;
            if (q >= nconv) continue;
            if (q >= CONV_NQE) { q -= CONV_NQE; lc = l + 1; b_ = 0; e_ = CONV_REST; hole = CONV_E_LO; }
            b_ += q * CONV_IPQ; e_ = b_ + CONV_IPQ < e_ ? b_ + CONV_IPQ : e_;
            { size_t z_ = 0; asm volatile("" : "+s"(z_)); F.z = z_; F.ws = a.ws + z_; int t_ = F.tid; asm volatile("" : "+v"(t_)); F.lane = t_ & 63; }
            TSUB_START(7); conv_items(F, a, lc, b_ + F.wave, 8, e_, hole); TSUB_STOP(7); continue; }
        int tl = F.tid; asm volatile("" : "+v"(tl));
        TSUB_START(6);
        if (i < NS + 192) { int h, qb, seg, nt;
            if (i < NS) { h = slot % 6; const int f = slot / 6; nt = 32; if (f < 8) { qb = 8 + f; seg = 0; } else if (f < 24) { const int g = f - 8; qb = 16 + (g >> 1); seg = g & 1; } else { const int g = f - 24; qb = 24 + g / 3; seg = g - 3 * (g / 3); } }
            else { const int e6 = i - NS; h = e6 % 6; const int e = e6 / 6, r = 7 - (e >> 2); qb = r + 8 * (e & 3); seg = qb >> 3; nt = 4 * (r + 1); }
            const int qpos0 = qb * 256, kofs = seg * 2048; const float sl = exp2f(-8.f * (float)(2 * h + 1) / 12.f) * LOG2E;
            att::attn_unit<4>(QAI + (size_t)qpos0 * NQAI + h * 128, NQAI, KVA + (size_t)kofs * NKVA + h * 128, KVA + (size_t)kofs * NKVA + 768 + h * 128, NKVA, nullptr, 0, nt, qpos0, sl, MASKA, nullptr, (LAS char*)F.lds, tl,
                              256, (GAS bf16*)WSP(bf16, WS_PO2), (GAS float*)WSP(float, WS_PML2), h, kofs); }
        else if (i < NS + 384) { const int m = i - NS - 192, qb = 31 - m / 6, h = m % 6, qpos0 = qb * 256; const float sl = exp2f(-8.f * (float)(2 * h + 2) / 12.f) * LOG2E;
            att::attn_unit<2>(PROJ + (size_t)qpos0 * NPROJ + PJ_QB + h * 128, NPROJ, PROJ + (size_t)qpos0 * NPROJ + PJ_KB + h * 128, PROJ + (size_t)qpos0 * NPROJ + PJ_VB + h * 128, NPROJ, nullptr, 0, 4, qpos0, sl, nullptr, nullptr, (LAS char*)F.lds, tl, 256, PO, PML, h); }
        else if (i < NS + 384 + U) { const int u = i - NS - 384; int lo = 0, hi_ = 192;
#pragma nounroll
            while (hi_ - lo > 1) { const int mid = (lo + hi_) >> 1; if (__builtin_amdgcn_readfirstlane(cum[mid]) <= u) lo = mid; else hi_ = mid; }
            const int h = lo >> 5, n = lo & 31, k = u - __builtin_amdgcn_readfirstlane(cum[lo]), len = __builtin_amdgcn_readfirstlane(lenl[lo]), kpos0 = n * 256;
            const int nv = len - 256 * k < 256 ? len - 256 * k : 256; const float sl = exp2f(-8.f * (float)(2 * h + 2) / 12.f) * LOG2E;
            att::attn_unit<3>(PROJ + PJ_QB + h * 128, NPROJ, PROJ + (size_t)kpos0 * NPROJ + PJ_KB + h * 128, PROJ + (size_t)kpos0 * NPROJ + PJ_VB + h * 128, NPROJ, nullptr, 0, 4, kpos0, sl, nullptr, LST + (h * LCAP + 256 * (31 * n - n * (n - 1) / 2) + 256 * k), (LAS char*)F.lds, tl, nv, PO, PML, h); }
        else { const int m = i - NS - 384 - U, h = m & 3, qpos0 = (m >> 2) * 256;
            att::attn_unit<0>(PROJ + (size_t)qpos0 * NPROJ + PJ_QC + h * 128, NPROJ, MKV + h * 128, MKV + 512 + h * 128, 1024, OATT + (size_t)qpos0 * 2048 + 1536 + h * 128, 2048, 4, qpos0, 0.f, nullptr, nullptr, (LAS char*)F.lds, tl); }
        TSUB_STOP(6);
    }
}

__device__ __forceinline__ void phase_ln1_router(Frame& F, const Args& a, int l, int rep) {
    const int lane = F.lane, w = F.wave, tid = F.tid;
    const bf16* PRE = WSP(bf16, WS_PRE); bf16* X1B = WSP(bf16, WS_X1B); const float* WR = WSP(float, WS_WR + WDR(l)); int* ROUTE = WSP(int, WS_ROUTE); int* CNT = WSP(int, WS_CNT);
    const float* g1 = (a.in[I_LN1G] + F.z) + l * 2048; const float* b1 = (a.in[I_LN1B] + F.z) + l * 2048; const float* bgrp = (a.in[I_BGRP] + F.z) + l * 4; const float* brt = (a.in[I_BRT] + F.z) + l * 32;
    constexpr int XS = 2052, NIT = T / 16;
    constexpr int XP = 4112;
    LAS unsigned char* xh = F.lds; LAS unsigned char* xl = F.lds + 16 * XP; LAS float* part = (LAS float*)(F.lds + 32 * XP); LAS float* bias = part + 8 * 16 * 48;
    const GAS bf16x8* WRB = (const GAS bf16x8*)WSP(bf16, WS_WR + WDR(l));
    if (tid < 36) bias[tid] = tid < 32 ? brt[tid] : bgrp[tid - 32];
    const int ar = lane & 15, kq = lane >> 4;
    v4u va[4], vb[4];
    int it = F.bid;
    if (it < NIT) { const GAS v4u* xr = (const GAS v4u*)(PRE + (size_t)(it * 16 + 2 * w) * 2048) + lane;
#pragma unroll
        for (int j = 0; j < 4; ++j) va[j] = xr[64 * j];
#pragma unroll
        for (int j = 0; j < 4; ++j) vb[j] = xr[256 + 64 * j]; }
    auto ln_row = [&](const v4u (&vw)[4], int rl, int t) {
        f32x4 v[8]; float s = 0.f;
#pragma unroll
        for (int j = 0; j < 4; ++j) { v[2 * j] = (f32x4){bflo(vw[j].x), bfhi(vw[j].x), bflo(vw[j].y), bfhi(vw[j].y)}; v[2 * j + 1] = (f32x4){bflo(vw[j].z), bfhi(vw[j].z), bflo(vw[j].w), bfhi(vw[j].w)}; }
#pragma unroll
        for (int j = 0; j < 8; ++j) s += (v[j].x + v[j].y) + (v[j].z + v[j].w);
        const float mean = wave_sum(s) * (1.f / 2048.f); float s2 = 0.f;
#pragma unroll
        for (int j = 0; j < 8; ++j) { v[j] = v[j] - mean; s2 += (v[j].x * v[j].x + v[j].y * v[j].y) + (v[j].z * v[j].z + v[j].w * v[j].w); }
        const float rstd = 1.f / sqrtf(wave_sum(s2) * (1.f / 2048.f) + LN_EPS);
#pragma unroll
        for (int j = 0; j < 4; ++j) { const int col = 8 * lane + 512 * j;
            const f32x4 ga = *(const GAS f32x4*)(g1 + col), gb = *(const GAS f32x4*)(g1 + col + 4), ba = *(const GAS f32x4*)(b1 + col), bb = *(const GAS f32x4*)(b1 + col + 4);
            const f32x4 o0 = v[2 * j] * rstd * ga + ba, o1 = v[2 * j + 1] * rstd * gb + bb;
            v4u ob; ob.x = cvtpk(o0[0], o0[1]); ob.y = cvtpk(o0[2], o0[3]); ob.z = cvtpk(o1[0], o1[1]); ob.w = cvtpk(o1[2], o1[3]); *(GAS v4u*)(X1B + (size_t)t * 2048 + col) = ob;
            { float lo[8];
#pragma unroll
              for (int q = 0; q < 4; ++q) { lo[q] = o0[q] - bf2f(f2bf(o0[q])); lo[4 + q] = o1[q] - bf2f(f2bf(o1[q])); }
              v4u oh; oh.x = pk2(o0[0], o0[1]); oh.y = pk2(o0[2], o0[3]); oh.z = pk2(o1[0], o1[1]); oh.w = pk2(o1[2], o1[3]);
              v4u ol; ol.x = pk2(lo[0], lo[1]); ol.y = pk2(lo[2], lo[3]); ol.z = pk2(lo[4], lo[5]); ol.w = pk2(lo[6], lo[7]);
              *(LAS v4u*)(xh + rl * XP + col * 2) = oh; *(LAS v4u*)(xl + rl * XP + col * 2) = ol; } }
    };
    for (; it < NIT; it += F.G) {
        const int t0 = it * 16;
        ln_row(va, 2 * w, t0 + 2 * w); ln_row(vb, 2 * w + 1, t0 + 2 * w + 1);
        __syncthreads();
        { const int nx = it + F.G;
          if (nx < NIT) { const GAS v4u* xr = (const GAS v4u*)(PRE + (size_t)(nx * 16 + 2 * w) * 2048) + lane;
#pragma unroll
            for (int j = 0; j < 4; ++j) va[j] = xr[64 * j];
#pragma unroll
            for (int j = 0; j < 4; ++j) vb[j] = xr[256 + 64 * j]; } }
        asm volatile("" ::: "memory");
        { f32x4 acc[3] = {{0, 0, 0, 0}, {0, 0, 0, 0}, {0, 0, 0, 0}};
#pragma unroll 4
          for (int s = 0; s < 8; ++s) { const int S = 8 * w + s;
              const bf16x8 ah = *(const LAS bf16x8*)(xh + ar * XP + (32 * S + 8 * kq) * 2), al = *(const LAS bf16x8*)(xl + ar * XP + (32 * S + 8 * kq) * 2);
              const GAS bf16x8* wr = WRB + (size_t)S * 384 + lane;
              bf16x8 bh[3], bl[3];
#pragma unroll
              for (int c = 0; c < 3; ++c) { bh[c] = wr[c * 128]; bl[c] = wr[c * 128 + 64]; }
#pragma unroll
              for (int c = 0; c < 3; ++c) { acc[c] = __builtin_amdgcn_mfma_f32_16x16x32_bf16(al, bh[c], acc[c], 0, 0, 0); acc[c] = __builtin_amdgcn_mfma_f32_16x16x32_bf16(ah, bl[c], acc[c], 0, 0, 0);
                  acc[c] = __builtin_amdgcn_mfma_f32_16x16x32_bf16(ah, bh[c], acc[c], 0, 0, 0); } }
#pragma unroll
          for (int c = 0; c < 3; ++c)
#pragma unroll
              for (int r = 0; r < 4; ++r) part[(w * 16 + 4 * kq + r) * 48 + 16 * c + ar] = acc[c][r]; }
        __syncthreads();
        if (w == 0) {
            const LAS float* Pp = part + ar * 48;
            float gl[4]; int gs = 0;
#pragma unroll
            for (int j = 0; j < 4; ++j) { float s = 0.f;
#pragma unroll
                for (int ww = 0; ww < 8; ++ww) s += Pp[ww * 768 + 32 + j];
                gl[j] = s + bias[32 + j]; }
#pragma unroll
            for (int j = 1; j < 4; ++j) if (gl[j] > gl[gs]) gs = j;
            float den = 0.f;
#pragma unroll
            for (int j = 0; j < 4; ++j) den += expf(gl[j] - gl[gs]);
            const float pg = 1.f / den;
            float el[8];
#pragma unroll
            for (int j = 0; j < 8; ++j) { float s = 0.f;
#pragma unroll
                for (int ww = 0; ww < 8; ++ww) s += Pp[ww * 768 + 8 * gs + j];
                el[j] = s + bias[8 * gs + j]; }
            int i0 = 0;
#pragma unroll
            for (int j = 1; j < 8; ++j) if (el[j] > el[i0]) i0 = j;
            int i1 = (i0 == 0) ? 1 : 0;
#pragma unroll
            for (int j = 0; j < 8; ++j) if (j != i0 && el[j] > el[i1]) i1 = j;
            const float e1 = expf(el[i1] - el[i0]); const float w0 = pg / (1.f + e1), w1 = pg * e1 / (1.f + e1);
            const int x0 = 8 * gs + i0, x1 = 8 * gs + i1, el_ = lane & 31;
            int lp0 = 0, lp1 = 0, cn = 0;
#pragma unroll
            for (int j = 0; j < 16; ++j) { const int y0 = __builtin_amdgcn_readlane(x0, j), y1 = __builtin_amdgcn_readlane(x1, j);
                const int m0 = (y0 == x0) | (y1 == x0), m1 = (y0 == x1) | (y1 == x1);
                lp0 += (j < ar) ? m0 : 0; lp1 += (j < ar) ? m1 : 0; cn += (y0 == el_) + (y1 == el_); }
            if (lane < 32) CNT[it * 32 + lane] = cn;
            if (lane < 16) { int* R = ROUTE + (size_t)(t0 + lane) * 8; R[0] = x0; R[1] = x1; R[2] = (int)__float_as_uint(w0); R[3] = (int)__float_as_uint(w1); R[4] = lp0; R[5] = lp1; }
        }
    }
}

__device__ __forceinline__ void phase_gather(Frame& F, int l) {
    const int lane = F.lane, tid = F.tid, w = F.wave;
    int* info = F.info + l * 256;
    const bf16* X1B = WSP(bf16, WS_X1B); bf16* XG = WSP(bf16, WS_XG); const int* ROUTE = WSP(int, WS_ROUTE); int* ROWMAP = WSP(int, WS_ROWMAP); float* ROWW = WSP(float, WS_ROWW); const int* CNT = WSP(int, WS_CNT);
    if (F.bid >= 32) return;
    LAS int* off = (LAS int*)F.lds;
    LAS int* TOT = off + 64;
    LAS int* CS = off + 128;
    LAS int* PT = off + 1024;
    { const int e = tid & 31, c = tid >> 5; int v[32]; int s = 0;
#pragma unroll
      for (int j = 0; j < 32; ++j) v[j] = CNT[(32 * c + j) * 32 + e];
#pragma unroll
      for (int j = 0; j < 32; ++j) s += v[j];
      CS[c * 32 + e] = s;
      __syncthreads();
      int base = 0, tot = 0;
#pragma unroll
      for (int c2 = 0; c2 < 16; ++c2) { const int x = CS[c2 * 32 + e]; base += c2 < c ? x : 0; tot += x; }
      if (c == 0) TOT[e] = tot;
      int p = base;
#pragma unroll
      for (int j = 0; j < 32; ++j) { PT[(32 * c + j) * 32 + e] = p; p += v[j]; } }
    __syncthreads();
    if (w == 0) { const int c = lane < 32 ? TOT[lane & 31] : 0; const int nt = (c + 255) >> 8; int inc = nt;
#pragma unroll
        for (int o = 1; o < 32; o <<= 1) { const int u = __shfl_up(inc, o); if (lane >= o) inc += u; }
        const int exc = inc - nt;
        if (lane < 32) off[lane] = exc << 8;
        if (lane == 31) off[32] = inc << 8;
        if (F.bid == 0) { if (lane < 32) {
#pragma nounroll
                for (int j = 0; j < nt; ++j) __hip_atomic_store(info + exc + j, lane, RLX_AGENT); }
            if (lane == 31) info[128] = inc; } }
    __syncthreads();
    for (int e = F.bid; e < 32; e += F.G) { const int c = TOT[e]; for (int r = off[e] + c + tid; r < off[e + 1]; r += 512) { ROWMAP[r] = -1; ROWW[r] = 0.f; } }
    const int gw = F.bid * 8 + F.wave, NGW = F.G * 8;
    for (int tb = gw * 64 + lane; tb < T; tb += (F.G < 32 ? F.G : 32) * 512) {
        const int t = tb; const int* R = ROUTE + (size_t)t * 8; const int e0 = R[0], e1 = R[1], p0 = R[4], p1 = R[5];
        const int d0 = off[e0] + PT[(t >> 4) * 32 + e0] + p0, d1 = off[e1] + PT[(t >> 4) * 32 + e1] + p1;
        ROWMAP[d0] = 2 * t; ROWMAP[d1] = 2 * t + 1; ROWW[d0] = __uint_as_float((unsigned)R[2]); ROWW[d1] = __uint_as_float((unsigned)R[3]);
    }
    __syncthreads();
}

__device__ __forceinline__ void phase_ln2(Frame& F, const Args& a, int l, float* xout) {
    const int gw = F.bid * 8 + F.wave, NGW = F.G * 8, lane = F.lane;
    const bf16* X1B = WSP(bf16, WS_X1B); const bf16* Y = WSP(bf16, WS_Y); bf16* HB = WSP(bf16, WS_HB);
    const float* g2 = (a.in[I_LN2G] + F.z) + l * 2048; const float* b2 = (a.in[I_LN2B] + F.z) + l * 2048;
    for (int tb = gw; tb < T; tb += 2 * NGW) {
        v4u xv[2][4], a0[2][4], a1[2][4];
#pragma unroll
        for (int u = 0; u < 2; ++u) { const int t = tb + u * NGW < T ? tb + u * NGW : tb;
            const GAS v4u* xr = (const GAS v4u*)(X1B + (size_t)t * 2048) + lane; const GAS v4u* y0 = (const GAS v4u*)(Y + (size_t)(2 * t) * 2048) + lane; const GAS v4u* y1 = (const GAS v4u*)(Y + (size_t)(2 * t + 1) * 2048) + lane;
#pragma unroll
            for (int j = 0; j < 4; ++j) { xv[u][j] = xr[64 * j]; a0[u][j] = y0[64 * j]; a1[u][j] = y1[64 * j]; } }
#pragma unroll
        for (int u = 0; u < 2; ++u) { const int t = tb + u * NGW; if (t < T) {
        f32x4 v[8]; float s = 0.f;
#pragma unroll
        for (int j = 0; j < 4; ++j) { const v4u x_ = xv[u][j], b0 = a0[u][j], b1 = a1[u][j];
            v[2 * j][0] = ALPHA * bflo(x_.x) + (bflo(b0.x) + bflo(b1.x)); v[2 * j][1] = ALPHA * bfhi(x_.x) + (bfhi(b0.x) + bfhi(b1.x)); v[2 * j][2] = ALPHA * bflo(x_.y) + (bflo(b0.y) + bflo(b1.y)); v[2 * j][3] = ALPHA * bfhi(x_.y) + (bfhi(b0.y) + bfhi(b1.y));
            v[2 * j + 1][0] = ALPHA * bflo(x_.z) + (bflo(b0.z) + bflo(b1.z)); v[2 * j + 1][1] = ALPHA * bfhi(x_.z) + (bfhi(b0.z) + bfhi(b1.z)); v[2 * j + 1][2] = ALPHA * bflo(x_.w) + (bflo(b0.w) + bflo(b1.w)); v[2 * j + 1][3] = ALPHA * bfhi(x_.w) + (bfhi(b0.w) + bfhi(b1.w)); }
#pragma unroll
        for (int j = 0; j < 8; ++j) s += (v[j].x + v[j].y) + (v[j].z + v[j].w);
        const float mean = wave_sum(s) * (1.f / 2048.f); float s2 = 0.f;
#pragma unroll
        for (int j = 0; j < 8; ++j) { v[j] = v[j] - mean; s2 += (v[j].x * v[j].x + v[j].y * v[j].y) + (v[j].z * v[j].z + v[j].w * v[j].w); }
        const float rstd = 1.f / sqrtf(wave_sum(s2) * (1.f / 2048.f) + LN_EPS);
#pragma unroll
        for (int j = 0; j < 4; ++j) { const int col = 8 * lane + 512 * j;
            const f32x4 ga = *(const GAS f32x4*)(g2 + col), gb = *(const GAS f32x4*)(g2 + col + 4), ba = *(const GAS f32x4*)(b2 + col), bb = *(const GAS f32x4*)(b2 + col + 4);
            const f32x4 o0 = v[2 * j] * rstd * ga + ba, o1 = v[2 * j + 1] * rstd * gb + bb;
            if (l + 1 == NLAYER) { *(GAS f32x4*)(xout + (size_t)t * 2048 + col) = o0; *(GAS f32x4*)(xout + (size_t)t * 2048 + col + 4) = o1; }
            else { v4u ob; ob.x = cvtpk(o0[0], o0[1]); ob.y = cvtpk(o0[2], o0[3]); ob.z = cvtpk(o1[0], o1[1]); ob.w = cvtpk(o1[2], o1[3]); *(GAS v4u*)(HB + (size_t)t * 2048 + col) = ob; } }
        } }
    }
}

#ifndef MK_PER_PHASE
#define MK_PER_PHASE 0
#endif
constexpr int NPHASE = 1 + 15 * NLAYER;
#ifndef PH_MASK
#define PH_MASK 0xFFFF
#endif
constexpr bool EN(int k) { return (PH_MASK >> k) & 1; }
#ifndef DBG_DOUBLE_MASK
#define DBG_DOUBLE_MASK 0
#endif
constexpr int REP(int k) { return ((DBG_DOUBLE_MASK >> k) & 1) ? 2 : 1; }
__global__ void __launch_bounds__(512, 2) fwd(Args a) {
    extern __shared__ __attribute__((aligned(16))) unsigned char lds_raw[];
    Frame F;
    F.lds = (LAS unsigned char*)lds_raw; F.MISC = (volatile LAS unsigned*)(F.lds + MISC_OFF);
    F.wave = __builtin_amdgcn_readfirstlane((int)threadIdx.x >> 6); F.lane = lane_id(); F.tid = F.wave * 64 + F.lane; F.G = gridDim.x; F.bid = blockIdx.x;
    F.z = 0; F.ws = a.ws; F.ctl = (gu32*)(F.ws + WS_CTL); F.info = (int*)(F.ws + WS_INFO);
    if (F.tid < 64) F.MISC[F.tid] = 0u;
    __syncthreads();
    XcdBarrier bar = xcd_barrier_post((unsigned*)(F.ctl + CW_BAR), F.MISC + 8, F.wave == 0 ? 1u : 0u);
    const int lo = a.ph_lo, hi = a.ph_hi;
#define ENTER() do { size_t z_ = 0; asm volatile("" : "+s"(z_)); F.z = z_; unsigned char* w_ = a.ws + z_; F.ws = w_; F.ctl = (gu32*)(w_ + WS_CTL); F.info = (int*)(w_ + WS_INFO); int wv_ = F.wave; asm volatile("" : "+s"(wv_)); int t_ = wv_ * 64 + lane_id(); asm volatile("" : "+v"(t_)); F.tid = t_; F.lane = t_ & 63; F.wave = wv_; } while (0)
#ifndef DBG_TIME_MASK
#define DBG_TIME_MASK 0
#endif
#ifndef DBG_TIME_LMASK
#define DBG_TIME_LMASK 3
#endif
#define TSTART(k) do { if (((DBG_TIME_MASK >> (k)) & 1) && ((DBG_TIME_LMASK >> l) & 1) && F.bid == 0 && F.wave == 0) { if (lane_id() == 0) { const unsigned long long t_ = __builtin_amdgcn_s_memrealtime(); F.MISC[22] = (unsigned)t_; } } } while (0)
#define TSTOP(k) do { if (((DBG_TIME_MASK >> (k)) & 1) && ((DBG_TIME_LMASK >> l) & 1) && F.bid == 0 && F.wave == 0) { if (lane_id() == 0) { const unsigned t_ = (unsigned)__builtin_amdgcn_s_memrealtime(); F.MISC[20] = F.MISC[20] + (t_ - F.MISC[22]); } } } while (0)
#define IN(k) (lo <= (k) && (k) < hi)
#define SEAM(k) do { if (lo <= (k) && (k) + 1 < hi) xcd_barrier(bar); } while (0)
    { const int l = 0; TSTART(0); if constexpr (EN(0)) if (IN(0)) for (int rep = 0; rep < REP(0); ++rep) { ENTER(); prologue(F, a); conv_layer(F, a, 0); } SEAM(0); TSTOP(0); }
#pragma unroll
    for (int l = 0; l < NLAYER; ++l) {
        const int pb = 1 + 15 * l;

        TSTART(1); if constexpr (EN(1)) if (IN(pb + 1)) for (int rep = 0; rep < REP(1); ++rep) { ENTER();
            pg8::Gemm g{WSP(bf16, WS_HB), WSP(bf16, WS_WA + WD(l)), T, NA, DM, DM}; pg8::StaticOrder S; S.init(T, NA, F.G, F.bid);
            pg8::EpiA E; E.proj = WSP(bf16, WS_PROJ); E.gate = WSP(bf16, WS_GATE); E.bgate = (a.in[I_BGATE] + F.z) + l * 6144; E.qs = SM_SCALE * LOG2E;
            pg8::gemm_phase<pg8::EpiA, pg8::StaticOrder, true, true>(F.lds, g, S, E, F.tid);
            if (l == 0) { pg8::Gemm g2{WSP(bf16, WS_MEMB), WSP(bf16, WS_WMEM), 256, 1024, DM, DM}; pg8::StaticOrder S2; S2.init(256, 1024, F.G, F.G - 1 - F.bid);
                pg8::EpiScale E2; E2.O = WSP(bf16, WS_MKV); E2.ldc = 1024; E2.pn_a = 0; E2.sa = 1.f; E2.sb = 1.f;
                int t2_ = F.tid; asm volatile("" : "+v"(t2_));
                pg8::gemm_phase<pg8::EpiScale, pg8::StaticOrder, true, true>(F.lds, g2, S2, E2, t2_); }
        } SEAM(pb + 1); TSTOP(1);
        TSTART(2); if constexpr (EN(2)) if (IN(pb + 2)) for (int rep = 0; rep < REP(2); ++rep) { ENTER(); phase_norms(F, a, l); } SEAM(pb + 2); TSTOP(2);
        TSTART(3); if constexpr (EN(3)) if (IN(pb + 3)) for (int rep = 0; rep < REP(3); ++rep) { ENTER();
            phase_moba_gate(F);
            { int t3_ = F.tid; asm volatile("" : "+v"(t3_)); F.tid = t3_; }
            { pg8::Gemm g{WSP(bf16, WS_CQN), WSP(bf16, WS_WC1 + WD(l)), T, NQAI, 512, 512}; pg8::StaticOrder S; S.init(T, NQAI, F.G, F.bid);
              pg8::EpiScale E; E.O = WSP(bf16, WS_QAI); E.ldc = NQAI; E.pn_a = 3; E.sa = SM_SCALE * LOG2E; E.sb = 0.125f;
              pg8::gemm_phase<pg8::EpiScale, pg8::StaticOrder, true, true>(F.lds, g, S, E, F.tid); }
            { pg8::Gemm g{WSP(bf16, WS_CKVN), WSP(bf16, WS_WC2 + WD(l)), T, NKVA, 256, 256}; pg8::StaticOrder S; S.init(T, NKVA, F.G, F.G - 1 - F.bid);
              pg8::EpiScale E; E.O = WSP(bf16, WS_KVA); E.ldc = NKVA; E.pn_a = 0; E.sa = 1.f; E.sb = 1.f;
              pg8::gemm_phase<pg8::EpiScale, pg8::StaticOrder, true, true>(F.lds, g, S, E, F.tid); }
        } SEAM(pb + 3); TSTOP(3);
        TSTART(4); if constexpr (EN(4)) if (IN(pb + 4)) for (int rep = 0; rep < REP(4); ++rep) { ENTER(); TSUB_START(5); phase_moba_lists(F); TSUB_STOP(5); TSUB_START(8); phase_indexer(F); TSUB_STOP(8); } SEAM(pb + 4); TSTOP(4);
        TSTART(5); if constexpr (EN(5)) if (IN(pb + 5)) for (int rep = 0; rep < REP(5); ++rep) { ENTER(); phase_attention(F, a, l, rep); } SEAM(pb + 5); TSTOP(5);
        TSTART(6); if constexpr (EN(6)) if (IN(pb + 6)) for (int rep = 0; rep < REP(6); ++rep) { ENTER(); phase_attn_merge(F); } SEAM(pb + 6); TSTOP(6);
        TSTART(7); if constexpr (EN(7)) if (IN(pb + 7)) for (int rep = 0; rep < REP(7); ++rep) { ENTER();
{ pg8::Gemm g{WSP(bf16, WS_OATT), WSP(bf16, WS_WUP + WD(l)), T, DM, DM, DM}; pg8::UpOrder S; S.so.init(T, DM, F.G, F.bid);
              pg8::EpiUpChain E; E.gate = WSP(bf16, WS_GATE); E.O = WSP(bf16, WS_MERGED);
              pg8::gemm_phase<pg8::EpiUpChain, pg8::UpOrder, true, true>(F.lds, g, S, E, F.tid); }
        } SEAM(pb + 7); TSTOP(7);
        TSTART(8); if constexpr (EN(8)) if (IN(pb + 8)) for (int rep = 0; rep < REP(8); ++rep) { ENTER();
            pg8::Gemm g{WSP(bf16, WS_MERGED), WSP(bf16, WS_WO + WD(l)), T, DM, DM, DM}; pg8::StaticOrder S; S.init(T, DM, F.G, F.bid);
            pg8::EpiPreB E; E.xb = WSP(bf16, WS_HB); E.pre = WSP(bf16, WS_PRE); E.alpha = ALPHA;
            pg8::gemm_phase<pg8::EpiPreB, pg8::StaticOrder, true, true>(F.lds, g, S, E, F.tid);
        } SEAM(pb + 8); TSTOP(8);
        TSTART(9); if constexpr (EN(9)) if (IN(pb + 9)) for (int rep = 0; rep < REP(9); ++rep) { ENTER(); phase_ln1_router(F, a, l, rep); } SEAM(pb + 9); TSTOP(9);
        TSTART(10); if constexpr (EN(10)) if (IN(pb + 10)) for (int rep = 0; rep < REP(10); ++rep) { ENTER(); phase_gather(F, l); } SEAM(pb + 10); TSTOP(10);
        TSTART(11); if constexpr (EN(11)) if (IN(pb + 11)) for (int rep = 0; rep < REP(11); ++rep) { ENTER();
            const int* info = F.info + l * 256; const int ntile = __builtin_amdgcn_readfirstlane(info[128]); const int n1 = ntile < 64 ? ntile : 64;
            pg8::Gemm g{WSP(bf16, WS_X1B), WSP(bf16, WS_W13 + WD(l)), MPAD, 32 * 1024, DM, DM};        pg8::MoeOrder S; S.tile_e = info; S.m_lo = 0; S.m_cnt = n1; S.nN = 4; S.G = F.G; S.c = F.bid;
            pg8::EpiMoeA E; E.hid = WSP(bf16, WS_HID); E.rowsrc = WSP(int, WS_ROWMAP);
            pg8::gemm_phase<pg8::EpiMoeA, pg8::MoeOrder, true, true>(F.lds, g, S, E, F.tid);
        } SEAM(pb + 11); TSTOP(11);
        TSTART(12); if constexpr (EN(12)) if (IN(pb + 12)) for (int rep = 0; rep < REP(12); ++rep) { ENTER();
            const int* info = F.info + l * 256; const int ntile = __builtin_amdgcn_readfirstlane(info[128]); const int n1 = ntile < 64 ? ntile : 64; int nA2 = (ntile - n1) * 4; nA2 = nA2 < F.G ? nA2 : F.G;
            { pg8::Gemm g{WSP(bf16, WS_X1B), WSP(bf16, WS_W13 + WD(l)), MPAD, 32 * 1024, DM, DM};        pg8::MoeOrder S; S.tile_e = info; S.m_lo = n1; S.m_cnt = ntile - n1; S.nN = 4; S.G = nA2; S.c = F.bid;
              pg8::EpiMoeA E; E.hid = WSP(bf16, WS_HID); E.rowsrc = WSP(int, WS_ROWMAP);
              pg8::gemm_phase<pg8::EpiMoeA, pg8::MoeOrder, true, true>(F.lds, g, S, E, F.tid); }
            { pg8::Gemm g{WSP(bf16, WS_HID), WSP(bf16, WS_W2 + WD(l)), MPAD, 32 * 2048, DEXP, DEXP}; pg8::MoeOrder S; S.tile_e = info; S.m_lo = 0; S.m_cnt = n1; S.nN = 8; S.G = F.G - nA2; S.c = F.bid - nA2;
              pg8::EpiMoeB E; E.Y = WSP(bf16, WS_Y); E.rowmap = WSP(int, WS_ROWMAP); E.roww = WSP(float, WS_ROWW);
              int t2_ = F.tid; asm volatile("" : "+v"(t2_));
              pg8::gemm_phase<pg8::EpiMoeB, pg8::MoeOrder, true, true>(F.lds, g, S, E, t2_); }
        } SEAM(pb + 12); TSTOP(12);
        TSTART(13); if constexpr (EN(13)) if (IN(pb + 13)) for (int rep = 0; rep < REP(13); ++rep) { ENTER();
            const int* info = F.info + l * 256; const int ntile = __builtin_amdgcn_readfirstlane(info[128]); const int n1 = ntile < 64 ? ntile : 64;
            pg8::Gemm g{WSP(bf16, WS_HID), WSP(bf16, WS_W2 + WD(l)), MPAD, 32 * 2048, DEXP, DEXP}; pg8::MoeOrder S; S.tile_e = info; S.m_lo = n1; S.m_cnt = ntile - n1; S.nN = 8; S.G = F.G; S.c = F.bid;
            pg8::EpiMoeB E; E.Y = WSP(bf16, WS_Y); E.rowmap = WSP(int, WS_ROWMAP); E.roww = WSP(float, WS_ROWW);
            pg8::gemm_phase<pg8::EpiMoeB, pg8::MoeOrder, true, true>(F.lds, g, S, E, F.tid);
        } SEAM(pb + 13); TSTOP(13);
        TSTART(14); if constexpr (EN(14)) if (IN(pb + 14)) for (int rep = 0; rep < REP(14); ++rep) { ENTER(); phase_ln2(F, a, l, (a.out + F.z)); } if (l + 1 < NLAYER) SEAM(pb + 14); TSTOP(14);
    }
#ifdef DBG_EXTRA_BARRIERS
    for (int i = 0; i < DBG_EXTRA_BARRIERS; ++i) xcd_barrier(bar);
#endif
    if ((DBG_TIME_MASK || DBG_TSUB) && F.bid == (DBG_TSUB ? DBG_TBID : 0) && F.wave == 0) { if (lane_id() == 0) { const unsigned long long t0_ = __builtin_amdgcn_s_memrealtime(); const unsigned w_ = F.MISC[20]; while (__builtin_amdgcn_s_memrealtime() - t0_ < (unsigned long long)w_) __builtin_amdgcn_s_sleep(8); } }
#undef IN
#undef SEAM
}


#ifdef DBG_STOP_PHASE
__global__ void dbg_dump(const unsigned char* ws, size_t off, int kind, long n, float* out, long nout) {
    for (long i = blockIdx.x * 256L + threadIdx.x; i < nout; i += gridDim.x * 256L) { const long j = i % n; float v;
        if (kind == 0) v = __builtin_bit_cast(float, (unsigned)((const unsigned short*)(ws + off))[j] << 16);
        else if (kind == 1) v = ((const float*)(ws + off))[j];
        else v = (float)(((const unsigned*)(ws + off))[j] & 0xffffu);
        out[i] = v; }
}
#endif
extern "C" void kernel_launch(void* const* d_in, const int* in_sizes, int n_in, void* d_out, int out_size, void* d_ws, size_t ws_size, hipStream_t stream) {
    static int grid = 0;
    if (grid == 0) {
        if (n_in != 28 || out_size != T * DM || ws_size < WS_END) { fprintf(stderr, "kernel_launch: unexpected shapes (n_in %d out %d ws %zu)\n", n_in, out_size, ws_size); grid = -1; return; }
        int dev = 0, cus = 0;
        if (hipGetDevice(&dev) != hipSuccess || hipDeviceGetAttribute(&cus, hipDeviceAttributeMultiprocessorCount, dev) != hipSuccess) { grid = -1; return; }
        if (hipFuncSetAttribute((const void*)fwd, hipFuncAttributeMaxDynamicSharedMemorySize, LDS_BYTES) != hipSuccess) { fprintf(stderr, "kernel_launch: hipFuncSetAttribute failed\n"); grid = -1; return; }
        int per_cu = 0;
        if (hipOccupancyMaxActiveBlocksPerMultiprocessor(&per_cu, (const void*)fwd, 512, LDS_BYTES) != hipSuccess || per_cu < 1) fprintf(stderr, "kernel_launch: occupancy query says %d\n", per_cu);
        (void)hipGetLastError();
        grid = cus;
    }
    if (grid < 0) return;
    if (hipMemsetAsync((char*)d_ws + WS_CTL, 0, CTL_ZERO_BYTES, stream) != hipSuccess) return;
    Args a{};
    for (int i = 0; i < 28; ++i) a.in[i] = (const float*)d_in[i];
    a.out = (float*)d_out; a.ws = (unsigned char*)d_ws;
#if defined(DBG_STOP_PHASE)
    for (int k = 0; k <= DBG_STOP_PHASE; ++k) { a.ph_lo = k; a.ph_hi = k + 1; hipLaunchKernelGGL(fwd, dim3(grid), dim3(512), LDS_BYTES, stream, a); }
    hipLaunchKernelGGL(dbg_dump, dim3(2048), dim3(256), 0, stream, (const unsigned char*)d_ws, (size_t)DBG_DUMP_OFF, DBG_DUMP_KIND, (long)DBG_DUMP_N, (float*)d_out, (long)out_size);
#elif MK_PER_PHASE
    for (int k = 0; k < NPHASE; ++k) { a.ph_lo = k; a.ph_hi = k + 1; hipLaunchKernelGGL(fwd, dim3(grid), dim3(512), LDS_BYTES, stream, a); }
#else
    a.ph_lo = 0; a.ph_hi = NPHASE;
    hipLaunchKernelGGL(fwd, dim3(grid), dim3(512), LDS_BYTES, stream, a);
#endif
    const hipError_t le = hipPeekAtLastError();
    if (le != hipSuccess) fprintf(stderr, "kernel_launch: launch failed: %s\n", hipGetErrorName(le));
}
```

```cpp
#define DBG_MIX_SCALE 1.0f
#define DBG_ZERO_BR 0
#define DBG_DOUBLE_MASK 0
#define DBG_TIME_MASK 0
#include <hip/hip_runtime.h>
#include <cstdio>
#include <cstdint>

#define GAS __attribute__((address_space(1)))
#define LAS __attribute__((address_space(3)))
typedef unsigned short bf16;
typedef unsigned v4u __attribute__((ext_vector_type(4)));
typedef unsigned v2u __attribute__((ext_vector_type(2)));
typedef float f32x4 __attribute__((ext_vector_type(4)));
typedef float f32x2 __attribute__((ext_vector_type(2)));
typedef float f32x16 __attribute__((ext_vector_type(16)));
typedef short bf16x8 __attribute__((ext_vector_type(8)));
typedef short s16x4 __attribute__((ext_vector_type(4)));
typedef GAS unsigned gu32;
#define RLX_AGENT __ATOMIC_RELAXED, __HIP_MEMORY_SCOPE_AGENT
#define LDS_WAIT() asm volatile("s_waitcnt lgkmcnt(0)" ::: "memory")
#define VM_WAIT() asm volatile("s_waitcnt vmcnt(0)" ::: "memory")
#define SBAR() __builtin_amdgcn_sched_barrier(0)

__device__ __forceinline__ unsigned f2bf(float f) { unsigned u = __builtin_bit_cast(unsigned, f); return (u + 0x7fffu + ((u >> 16) & 1u)) >> 16; }
__device__ __forceinline__ unsigned pk2(float lo, float hi) { return f2bf(lo) | (f2bf(hi) << 16); }
__device__ __forceinline__ float bf2f(unsigned b) { return __builtin_bit_cast(float, b << 16); }
__device__ __forceinline__ float bflo(unsigned w) { return __builtin_bit_cast(float, w << 16); }
__device__ __forceinline__ float bfhi(unsigned w) { return __builtin_bit_cast(float, w & 0xffff0000u); }
typedef __bf16 bf16x2_t __attribute__((ext_vector_type(2)));
__device__ __forceinline__ unsigned cvtpk(float lo, float hi) { f32x2 v = {lo, hi}; bf16x2_t b = __builtin_convertvector(v, bf16x2_t); return __builtin_bit_cast(unsigned, b); }
__device__ __forceinline__ float wave_sum(float v) {
#pragma unroll
    for (int o = 1; o < 64; o <<= 1) v += __shfl_xor(v, o);
    return v;
}

constexpr int T = 8192, DM = 2048, NLAYER = 2;
constexpr int NA = 9984;
constexpr int NPROJ = 3840, NGATE = 6144;
constexpr int PJ_QB = 1024, PJ_KB = 1792, PJ_VB = 2560, PJ_QC = 3328;
constexpr int NQAI = 1792;
constexpr int NKVA = 1536;
constexpr int NEXP = 32, DEXP = 512;
constexpr int MPAD = 24576;
constexpr float LN_EPS = 1e-5f;
constexpr float ALPHA = 1.4142135623730951f;
constexpr float SM_SCALE = 0.088388347648318440f;
constexpr float LOG2E = 1.4426950408889634f;
namespace pg8 {
#define PG8_LAS __attribute__((address_space(3)))
typedef unsigned short bf16_t;
typedef short bf16x8 __attribute__((ext_vector_type(8)));
typedef float f32x4 __attribute__((ext_vector_type(4)));
typedef unsigned u32x4 __attribute__((ext_vector_type(4)));
constexpr int BM = 256, BK = 64, HALF = 128, HTB = HALF * BK * 2  , STAGE_BYTES = 8 * HTB, NXCD = 8, WGM = 8;

__host__ __device__ __forceinline__ int lds_byte(int r, int c) { const int st = (r >> 4) * 2 + (c >> 5), rr = r & 15, cc = c & 31, ob = rr * 64 + cc * 2; return st * 1024 + (ob ^ (((ob >> 9) & 1) << 5)); }
__host__ __device__ __forceinline__ void stage_rc(int b, int& R, int& C) { const int st = b / 1024, sb = b % 1024, swz = sb ^ (((sb >> 9) & 1) << 5); R = (st >> 1) * 16 + swz / 64; C = (st & 1) * 32 + (swz % 64) / 2; }
__host__ __device__ __forceinline__ int perm32(int rho) { const int n = rho >> 4, i = rho & 15; return 8 * (i >> 2) + 4 * n + (i & 3); }

struct Unit { int pm, pn, kofs, nt, kind; };
struct Gemm { const bf16_t* A; const bf16_t* Bt; int M, N, K, ld; };

struct StaticOrder {
    int nM, nN, nwg, G, c;
    __host__ __device__ void init(int M, int N, int G_, int c_) { nM = M / BM; nN = N / BM; nwg = nM * nN; G = G_; c = c_; }
    __host__ __device__ bool next(int i, Unit& u) const {
        const long L = (long)i * G + c; if (L >= nwg) return false;
        int wgid = (int)L; { const int q = nwg / NXCD, r = nwg % NXCD, xcd = wgid % NXCD, off = wgid / NXCD; wgid = (xcd < r ? xcd * (q + 1) : r * (q + 1) + (xcd - r) * q) + off; }
        const int nig = WGM * nN, gid = wgid / nig, fm = gid * WGM, gsz = (nM - fm) < WGM ? (nM - fm) : WGM;
        u.pm = fm + ((wgid % nig) % gsz); u.pn = (wgid % nig) / gsz; return true;
    }
    __device__ __forceinline__ void a_ready(const Unit&) const {}
    __device__ __forceinline__ void done(const Unit&) const {}
};


__device__ __forceinline__ unsigned cvt_pk_bf16(float lo, float hi) { return ::cvtpk(lo, hi); }
__device__ __forceinline__ float sigmoidf_(float v) { return __builtin_amdgcn_rcpf(1.0f + __builtin_amdgcn_exp2f(-1.4426950408889634f * v)); }
__device__ __forceinline__ u32x4 pack8(const f32x4 v0, const f32x4 v1) { u32x4 w; w.x = cvt_pk_bf16(v0[0], v0[1]); w.y = cvt_pk_bf16(v0[2], v0[3]); w.z = cvt_pk_bf16(v1[0], v1[1]); w.w = cvt_pk_bf16(v1[2], v1[3]); return w; }
__device__ __forceinline__ void unpack8(const u32x4 w, f32x4& a, f32x4& b) {
    a[0] = __builtin_bit_cast(float, w.x << 16); a[1] = __builtin_bit_cast(float, w.x & 0xffff0000u); a[2] = __builtin_bit_cast(float, w.y << 16); a[3] = __builtin_bit_cast(float, w.y & 0xffff0000u);
    b[0] = __builtin_bit_cast(float, w.z << 16); b[1] = __builtin_bit_cast(float, w.z & 0xffff0000u); b[2] = __builtin_bit_cast(float, w.w << 16); b[3] = __builtin_bit_cast(float, w.w & 0xffff0000u); }
struct EpiBase { static constexpr bool PERM = true, AFTER_DRAIN = false, CHAIN = false, GATHER = false;
    __device__ __forceinline__ void unit_end(f32x4 (&)[2][2][4][2], const Unit&, int, int, int, int) const {} };

struct EpiA : EpiBase {
    bf16_t* proj; bf16_t* gate; const float* bgate; float qs;
    __device__ __forceinline__ void operator()(const f32x4 (&acc)[2][2][4][2], const Unit& u, int wr, int wc, int fr, int fq) const {
        const int row0 = u.pm * BM + wr * 64 + fr; const int colt = u.pn * BM + wc * 32 + 8 * fq;
        if (u.pn < 15) {
            const float s = ((u.pn >= 4 && u.pn < 7) || u.pn >= 13) ? qs : 1.0f;
#pragma unroll
            for (int ai = 0; ai < 2; ++ai)
#pragma unroll
                for (int m = 0; m < 4; ++m) { bf16_t* rowp = proj + (size_t)(row0 + ai * HALF + m * 16) * 3840 + colt;
#pragma unroll
                    for (int bj = 0; bj < 2; ++bj) *(u32x4*)(rowp + bj * HALF) = pack8(acc[ai][bj][m][0] * s, acc[ai][bj][m][1] * s); }
        } else {
            const int gc = colt - 3840;
            f32x4 bv[2][2];
#pragma unroll
            for (int bj = 0; bj < 2; ++bj)
#pragma unroll
                for (int n = 0; n < 2; ++n) bv[bj][n] = *(const f32x4*)(bgate + gc + bj * HALF + 4 * n);
#pragma unroll
            for (int ai = 0; ai < 2; ++ai)
#pragma unroll
                for (int m = 0; m < 4; ++m) {
                    bf16_t* tp = gate + ((size_t)((((u.pn - 15) >> 3) * 32 + u.pm) * 8 + ((u.pn - 15) & 7)) * 65536) + (size_t)((ai * 4 + m) * 2) * 4096 + (size_t)(((wr * 4 + wc) * 64 + fq * 16 + fr) * 8);
#pragma unroll
                    for (int bj = 0; bj < 2; ++bj) { f32x4 v0 = acc[ai][bj][m][0] + bv[bj][0], v1 = acc[ai][bj][m][1] + bv[bj][1];
#pragma unroll
                        for (int j = 0; j < 4; ++j) { v0[j] = sigmoidf_(v0[j]); v1[j] = sigmoidf_(v1[j]); }
                        *(u32x4*)(tp + bj * 4096) = pack8(v0, v1); } }
        }
    }
};
struct EpiScale : EpiBase {
    bf16_t* O; int ldc; int pn_a; float sa, sb;
    __device__ __forceinline__ void operator()(const f32x4 (&acc)[2][2][4][2], const Unit& u, int wr, int wc, int fr, int fq) const {
        const int row0 = u.pm * BM + wr * 64 + fr; const int colt = u.pn * BM + wc * 32 + 8 * fq; const float s = (u.pn < pn_a) ? sa : sb;
#pragma unroll
        for (int ai = 0; ai < 2; ++ai)
#pragma unroll
            for (int m = 0; m < 4; ++m) { bf16_t* rowp = O + (size_t)(row0 + ai * HALF + m * 16) * ldc + colt;
#pragma unroll
                for (int bj = 0; bj < 2; ++bj) *(u32x4*)(rowp + bj * HALF) = pack8(acc[ai][bj][m][0] * s, acc[ai][bj][m][1] * s); }
    }
};
template <int STEP> struct EpiUp : EpiBase {
    const bf16_t* gate; bf16_t* O;
    __device__ __forceinline__ void operator()(const f32x4 (&acc)[2][2][4][2], const Unit& u, int wr, int wc, int fr, int fq) const {
        const int row0 = u.pm * BM + wr * 64 + fr; const int colt = u.pn * BM + wc * 32 + 8 * fq;
#pragma unroll
        for (int ai = 0; ai < 2; ++ai)
#pragma unroll
            for (int m = 0; m < 4; ++m) { const size_t r = (size_t)(row0 + ai * HALF + m * 16);
#pragma unroll
                for (int bj = 0; bj < 2; ++bj) { const u32x4 wg = *(const u32x4*)(gate + r * 6144 + STEP * 2048 + colt + bj * HALF); f32x4 g0, g1; unpack8(wg, g0, g1);
                    f32x4 v0 = acc[ai][bj][m][0] * g0, v1 = acc[ai][bj][m][1] * g1;
                    if constexpr (STEP > 0) { const u32x4 wp = __builtin_nontemporal_load((const u32x4*)(O + r * 2048 + colt + bj * HALF)); f32x4 p0, p1; unpack8(wp, p0, p1); v0 += p0; v1 += p1; }
                    *(u32x4*)(O + r * 2048 + colt + bj * HALF) = pack8(v0, v1); } }
    }
};
struct EpiPre : EpiBase {
    const float* x; float* pre; float alpha;
    __device__ __forceinline__ void operator()(const f32x4 (&acc)[2][2][4][2], const Unit& u, int wr, int wc, int fr, int fq) const {
        const int row0 = u.pm * BM + wr * 64 + fr; const int colt = u.pn * BM + wc * 32 + 8 * fq;
#pragma unroll
        for (int ai = 0; ai < 2; ++ai)
#pragma unroll
            for (int m = 0; m < 4; ++m) { const size_t off = (size_t)(row0 + ai * HALF + m * 16) * 2048 + colt;
#pragma unroll
                for (int bj = 0; bj < 2; ++bj)
#pragma unroll
                    for (int n = 0; n < 2; ++n) { const f32x4 xv = *(const f32x4*)(x + off + bj * HALF + 4 * n); *(f32x4*)(pre + off + bj * HALF + 4 * n) = xv * alpha + acc[ai][bj][m][n]; } }
    }
};
struct EpiPreB : EpiBase {
    const bf16_t* xb; bf16_t* pre; float alpha;
    __device__ __forceinline__ void operator()(const f32x4 (&acc)[2][2][4][2], const Unit& u, int wr, int wc, int fr, int fq) const {
        const int row0 = u.pm * BM + wr * 64 + fr; const int colt = u.pn * BM + wc * 32 + 8 * fq;
#pragma unroll
        for (int ai = 0; ai < 2; ++ai) {
            u32x4 xw[4][2];
#pragma unroll
            for (int m = 0; m < 4; ++m)
#pragma unroll
                for (int bj = 0; bj < 2; ++bj) xw[m][bj] = *(const u32x4*)(xb + (size_t)(row0 + ai * HALF + m * 16) * 2048 + colt + bj * HALF);
            asm volatile("" : "+v"(xw[0][0]), "+v"(xw[0][1]), "+v"(xw[1][0]), "+v"(xw[1][1]), "+v"(xw[2][0]), "+v"(xw[2][1]), "+v"(xw[3][0]), "+v"(xw[3][1]));
#pragma unroll
            for (int m = 0; m < 4; ++m) { const size_t off = (size_t)(row0 + ai * HALF + m * 16) * 2048 + colt;
#pragma unroll
                for (int bj = 0; bj < 2; ++bj) { f32x4 x0, x1; unpack8(xw[m][bj], x0, x1);
                    *(u32x4*)(pre + off + bj * HALF) = pack8(x0 * alpha + acc[ai][bj][m][0], x1 * alpha + acc[ai][bj][m][1]); } } }
    }
};
struct EpiMoeA : EpiBase {
    static constexpr bool GATHER = true;
    bf16_t* hid; const int* rowsrc;
    __device__ __forceinline__ void operator()(const f32x4 (&acc)[2][2][4][2], const Unit& u, int wr, int wc, int fr, int fq) const {
        const int row0 = u.pm * BM + wr * 64 + fr; const int hc = (u.pn & 3) * 128 + wc * 32 + 8 * fq;
#pragma unroll
        for (int ai = 0; ai < 2; ++ai)
#pragma unroll
            for (int m = 0; m < 4; ++m) { f32x4 h0, h1;
#pragma unroll
                for (int j = 0; j < 4; ++j) { const float a0 = acc[ai][0][m][0][j], a1 = acc[ai][0][m][1][j]; h0[j] = a0 * sigmoidf_(a0) * acc[ai][1][m][0][j]; h1[j] = a1 * sigmoidf_(a1) * acc[ai][1][m][1][j]; }
                *(u32x4*)(hid + (size_t)(row0 + ai * HALF + m * 16) * 512 + hc) = pack8(h0, h1); }
    }
};
struct EpiMoeB : EpiBase {
    bf16_t* Y; const int* rowmap; const float* roww;
    __device__ __forceinline__ void operator()(const f32x4 (&acc)[2][2][4][2], const Unit& u, int wr, int wc, int fr, int fq) const {
        const int row0 = u.pm * BM + wr * 64 + fr; const int colt = (u.pn & 7) * BM + wc * 32 + 8 * fq;
        int dstv[8]; float wv8[8];
#pragma unroll
        for (int g = 0; g < 8; ++g) { const int rg = row0 + (g >> 2) * HALF + (g & 3) * 16; dstv[g] = rowmap[rg]; wv8[g] = roww[rg]; }
        asm volatile("" : "+v"(dstv[0]), "+v"(dstv[1]), "+v"(dstv[2]), "+v"(dstv[3]), "+v"(dstv[4]), "+v"(dstv[5]), "+v"(dstv[6]), "+v"(dstv[7]));
#pragma unroll
        for (int ai = 0; ai < 2; ++ai)
#pragma unroll
            for (int m = 0; m < 4; ++m) { const int dst = dstv[ai * 4 + m]; const float w = wv8[ai * 4 + m];
                if (dst >= 0) {
#pragma unroll
                    for (int bj = 0; bj < 2; ++bj) *(u32x4*)(Y + (size_t)dst * 2048 + colt + bj * HALF) = pack8(acc[ai][bj][m][0] * w, acc[ai][bj][m][1] * w); } }
    }
};
struct MoeOrder {
    const int* tile_e; int m_lo, m_cnt, nN, G, c;
    __device__ __forceinline__ bool next(int i, Unit& u) const {
        const int L = i * G + c; if (c < 0 || c >= G || L >= m_cnt * nN) return false;
        const int ml = L / nN, nl = L - ml * nN, mt = m_lo + ml; u.pm = mt; u.pn = tile_e[mt] * nN + nl; return true; }
    __device__ __forceinline__ void a_ready(const Unit&) const {}
    __device__ __forceinline__ void done(const Unit&) const {}
};


struct EpiUpChain : EpiBase {
    static constexpr bool CHAIN = true;
    const bf16_t* gate; bf16_t* O;
    __device__ __forceinline__ void unit_end(f32x4 (&acc)[2][2][4][2], const Unit& u, int wr, int wc, int fr, int fq) const {
        const int row0 = u.pm * BM + wr * 64 + fr; const int colt = u.pn * BM + wc * 32 + 8 * fq;
        const int gnum = (u.kind == 0) ? 0 : ((u.kind == 1) ? 2048 : 4096); const bool fin = u.kind == 2; const int dofs = fin ? 0 : 2048;
#pragma unroll
        for (int ai = 0; ai < 2; ++ai) {
            u32x4 wn[4][2], wd[4][2];
#pragma unroll
            for (int m = 0; m < 4; ++m) { const bf16_t* gp = gate + ((size_t)(((gnum >> 11) * 32 + u.pm) * 8 + u.pn) * 65536) + (size_t)((ai * 4 + m) * 2) * 4096 + (size_t)(((wr * 4 + wc) * 64 + fq * 16 + fr) * 8);
#pragma unroll
                for (int bj = 0; bj < 2; ++bj) { asm volatile("global_load_dwordx4 %0, %1, off" : "=v"(wn[m][bj]) : "v"(gp + bj * 4096) : "memory");
                                                 asm volatile("global_load_dwordx4 %0, %1, off" : "=v"(wd[m][bj]) : "v"(gp + (fin ? (size_t)0 : (size_t)(32 * 8) * 65536) + bj * 4096) : "memory"); } }
            asm volatile("s_waitcnt vmcnt(0)" : "+v"(wn[0][0]), "+v"(wn[0][1]), "+v"(wn[1][0]), "+v"(wn[1][1]), "+v"(wn[2][0]), "+v"(wn[2][1]), "+v"(wn[3][0]), "+v"(wn[3][1]),
                                                 "+v"(wd[0][0]), "+v"(wd[0][1]), "+v"(wd[1][0]), "+v"(wd[1][1]), "+v"(wd[2][0]), "+v"(wd[2][1]), "+v"(wd[3][0]), "+v"(wd[3][1]) :: "memory");
#pragma unroll
            for (int m = 0; m < 4; ++m) { const size_t r = (size_t)(row0 + ai * HALF + m * 16);
#pragma unroll
                for (int bj = 0; bj < 2; ++bj) { f32x4 n0, n1; unpack8(wn[m][bj], n0, n1);
                    if (fin) { *(u32x4*)(O + r * 2048 + colt + bj * HALF) = pack8(acc[ai][bj][m][0] * n0, acc[ai][bj][m][1] * n1); acc[ai][bj][m][0] = (f32x4){0.f, 0.f, 0.f, 0.f}; acc[ai][bj][m][1] = (f32x4){0.f, 0.f, 0.f, 0.f}; }
                    else { f32x4 d0, d1; unpack8(wd[m][bj], d0, d1);
#pragma unroll
                        for (int j = 0; j < 4; ++j) { acc[ai][bj][m][0][j] *= n0[j] * __builtin_amdgcn_rcpf(fmaxf(d0[j], 1e-30f)); acc[ai][bj][m][1][j] *= n1[j] * __builtin_amdgcn_rcpf(fmaxf(d1[j], 1e-30f)); } } }
                asm volatile("" : "+v"(acc[ai][0][m][0]), "+v"(acc[ai][0][m][1]), "+v"(acc[ai][1][m][0]), "+v"(acc[ai][1][m][1])); }
            asm volatile("" ::: "memory"); }
    }
    __device__ __forceinline__ void operator()(const f32x4 (&)[2][2][4][2], const Unit&, int, int, int, int) const {}
};
struct UpOrder {
    StaticOrder so;
    __device__ __forceinline__ bool next(int i, Unit& u) const { const int ti = i / 3, x = i - 3 * ti; if (!so.next(ti, u)) return false;
        u.kofs = x * 768 * 2; u.nt = (x == 2) ? 8 : 12; u.kind = x; return true; }
    __device__ __forceinline__ void a_ready(const Unit&) const {}
    __device__ __forceinline__ void done(const Unit&) const {}
};
template <class Epi, class Sched, bool ALIGN_EPI = false, bool SP2 = false>
__device__ __forceinline__ void gemm_phase(PG8_LAS unsigned char* lds, const Gemm g, const Sched& S, const Epi& E, const int tid) {
    const int wid = __builtin_amdgcn_readfirstlane(tid >> 6), lane = tid & 63, wr = wid >> 2, wc = wid & 3, fr = lane & 15, fq = lane >> 4;
    const int K = g.ld, nt = g.K / BK;
    unsigned voffA[2], voffB[2];
#pragma unroll
    for (int i = 0; i < 2; ++i) { int R, C; stage_rc(tid * 16 + i * 8192, R, C); const int Rb = Epi::PERM ? ((R & ~31) + perm32(R & 31)) : R;
        voffA[i] = (unsigned)(R * K + C) * 2u; voffB[i] = (unsigned)(Rb * K + C) * 2u; }
    int gR[2], gC2[2];
#pragma unroll
    for (int i = 0; i < 2; ++i) { int R, C; stage_rc(tid * 16 + i * 8192, R, C); gR[i] = R; gC2[i] = C * 2; }
    unsigned vAc[2][2], vAn[2][2];
#define PG8_GVOFF(dst, pm_) do { if constexpr (Epi::GATHER) { _Pragma("unroll") for (int h_ = 0; h_ < 2; ++h_) _Pragma("unroll") for (int i_ = 0; i_ < 2; ++i_) { \
        const int s_ = E.rowsrc[(pm_) * BM + h_ * HALF + gR[i_]]; const unsigned tok_ = s_ < 0 ? 0u : (unsigned)s_ >> 1; dst[h_][i_] = tok_ * (unsigned)(K * 2) + (unsigned)gC2[i_]; } } } while (0)
    const size_t kstep = (size_t)(BK * 2);
    const size_t hstep = (size_t)HALF * K * 2;
    const size_t tstep = 2 * hstep;
    const unsigned ldsw = (unsigned)wid * 1024u;
    const int aoff = lds_byte(wr * 64 + fr, fq * 8), boff = lds_byte(wc * 32 + fr, fq * 8);
#define PG8_SA(b, h) (((b) * 2 + (h)) * HTB)
#define PG8_SB(b, h) ((4 + (b) * 2 + (h)) * HTB)
#define PG8_STAGE(bufoff, gbase, voff) do { _Pragma("unroll") for (int _i = 0; _i < 2; ++_i) \
        __builtin_amdgcn_global_load_lds((const unsigned*)((const char*)(gbase) + (voff)[_i]), (PG8_LAS unsigned*)(lds + (bufoff) + ldsw + _i * 8192), 16, 0, 0); } while (0)
#define PG8_STAGE_A(bufoff, kp, h, nx) do { if constexpr (Epi::GATHER) { unsigned vs_[2] = {(nx) ? vAn[h][0] : vAc[h][0], (nx) ? vAn[h][1] : vAc[h][1]}; PG8_STAGE(bufoff, kp, vs_); } \
        else { PG8_STAGE(bufoff, (kp) + (h) * hstep, voffA); } } while (0)
#define PG8_LDA(dst, b, h) do { _Pragma("unroll") for (int m = 0; m < 4; ++m) _Pragma("unroll") for (int k = 0; k < 2; ++k) dst[m][k] = *(const PG8_LAS bf16x8*)(lds + PG8_SA(b, h) + aoff + m * 2048 + k * 1024); } while (0)
#define PG8_LDB(dst, b, h) do { _Pragma("unroll") for (int n = 0; n < 2; ++n) _Pragma("unroll") for (int k = 0; k < 2; ++k) dst[n][k] = *(const PG8_LAS bf16x8*)(lds + PG8_SB(b, h) + boff + n * 2048 + k * 1024); } while (0)
#define PG8_MMA(ai, bj, At, Bt) do { __builtin_amdgcn_s_setprio(1); _Pragma("unroll") for (int m = 0; m < 4; ++m) _Pragma("unroll") for (int n = 0; n < 2; ++n) _Pragma("unroll") for (int k = 0; k < 2; ++k) \
        acc[ai][bj][m][n] = __builtin_amdgcn_mfma_f32_16x16x32_bf16(Bt[n][k], At[m][k], acc[ai][bj][m][n], 0, 0, 0); __builtin_amdgcn_s_setprio(0); } while (0)
#define PG8_WAIT_V(n) asm volatile("s_waitcnt vmcnt(" #n ")" ::: "memory")
#define PG8_WAIT_L(n) asm volatile("s_waitcnt lgkmcnt(" #n ")" ::: "memory")
#define PG8_BAR __builtin_amdgcn_s_barrier()
#define PG8_SCHED __builtin_amdgcn_sched_barrier(0)
    Unit cur, nxt; int ui = 0;
    if (!S.next(0, cur)) return;
    f32x4 acc[2][2][4][2];
#pragma unroll
    for (int a = 0; a < 2; ++a)
#pragma unroll
        for (int b = 0; b < 2; ++b)
#pragma unroll
            for (int m = 0; m < 4; ++m)
#pragma unroll
                for (int n = 0; n < 2; ++n) acc[a][b][m][n] = (f32x4){0.f, 0.f, 0.f, 0.f};
    bf16x8 At[4][2], B0[2][2], B1[2][2];
    const char* cA = (const char*)g.A + (Epi::GATHER ? (size_t)0 : (size_t)cur.pm * tstep); const char* cB = (const char*)g.Bt + (size_t)cur.pn * tstep;
    PG8_GVOFF(vAc, cur.pm);
    if constexpr (Epi::CHAIN) { cA += cur.kofs; cB += cur.kofs; }
    S.a_ready(cur);
    if constexpr (SP2) {
        PG8_STAGE(PG8_SB(0, 0), cB, voffB); PG8_STAGE(PG8_SB(0, 1), cB + hstep, voffB); PG8_STAGE_A(PG8_SA(0, 0), cA, 0, false); PG8_STAGE_A(PG8_SA(0, 1), cA, 1, false);
        if (wr == 1) PG8_BAR;
        PG8_WAIT_V(2); PG8_BAR;
        PG8_STAGE(PG8_SB(1, 0), cB + kstep, voffB); PG8_STAGE_A(PG8_SA(1, 0), cA + kstep, 0, false); PG8_STAGE(PG8_SB(1, 1), cB + hstep + kstep, voffB);
        PG8_WAIT_V(6); PG8_BAR;
    } else {
        PG8_STAGE(PG8_SB(0, 0), cB, voffB); PG8_STAGE(PG8_SA(0, 0), cA, voffA); PG8_STAGE(PG8_SB(0, 1), cB + hstep, voffB); PG8_STAGE(PG8_SA(0, 1), cA + hstep, voffA);
        if (wr == 1) PG8_BAR;
        PG8_WAIT_V(4); PG8_BAR;
        PG8_STAGE(PG8_SB(1, 0), cB + kstep, voffB); PG8_STAGE(PG8_SA(1, 0), cA + kstep, voffA); PG8_STAGE(PG8_SB(1, 1), cB + hstep + kstep, voffB);
        PG8_WAIT_V(6); PG8_BAR;
    }
    for (;;) {
        const bool has_next = S.next(ui + 1, nxt);
        const char* nA = has_next ? (const char*)g.A + (Epi::GATHER ? (size_t)0 : (size_t)nxt.pm * tstep) + (Epi::CHAIN ? nxt.kofs : 0) : cA;
        if constexpr (Epi::GATHER) { if (has_next) PG8_GVOFF(vAn, nxt.pm); else { _Pragma("unroll") for (int h_ = 0; h_ < 2; ++h_) _Pragma("unroll") for (int i_ = 0; i_ < 2; ++i_) vAn[h_][i_] = vAc[h_][i_]; } } const char* nB = has_next ? (const char*)g.Bt + (size_t)nxt.pn * tstep + (Epi::CHAIN ? nxt.kofs : 0) : cB;
        const int ntc = Epi::CHAIN ? cur.nt : nt;
        for (int t = 0; t < ntc; t += 2) {
            const bool last = (t == ntc - 2);
            const char* a1 = cA + (size_t)(t + 1) * kstep;
            const char* a2 = last ? nA : cA + (size_t)(t + 2) * kstep; const char* b2 = last ? nB : cB + (size_t)(t + 2) * kstep;
            const char* a3 = a2 + kstep; const char* b3 = b2 + kstep;
            if (last && has_next) S.a_ready(nxt);
            if constexpr (SP2) {
            PG8_LDB(B0, 0, 0); PG8_LDB(B1, 0, 1); PG8_SCHED; PG8_LDA(At, 0, 0); PG8_STAGE_A(PG8_SA(1, 1), a1, 1, false);
            PG8_WAIT_V(8); PG8_WAIT_L(0); PG8_BAR; PG8_MMA(0, 0, At, B0); PG8_MMA(0, 1, At, B1); PG8_BAR; PG8_SCHED;
            PG8_LDA(At, 0, 1); PG8_STAGE(PG8_SB(0, 0), b2, voffB); PG8_STAGE(PG8_SB(0, 1), b2 + hstep, voffB); PG8_STAGE_A(PG8_SA(0, 0), a2, 0, last);
            PG8_WAIT_V(8); PG8_WAIT_L(0); PG8_BAR; PG8_MMA(1, 0, At, B0); PG8_MMA(1, 1, At, B1); PG8_BAR; PG8_SCHED;
            PG8_LDB(B0, 1, 0); PG8_LDB(B1, 1, 1); PG8_SCHED; PG8_LDA(At, 1, 0); PG8_STAGE_A(PG8_SA(0, 1), a2, 1, last);
            PG8_WAIT_V(8); PG8_WAIT_L(0); PG8_BAR; PG8_MMA(0, 0, At, B0); PG8_MMA(0, 1, At, B1); PG8_BAR; PG8_SCHED;
            PG8_LDA(At, 1, 1); PG8_STAGE(PG8_SB(1, 0), b3, voffB); PG8_STAGE(PG8_SB(1, 1), b3 + hstep, voffB); PG8_STAGE_A(PG8_SA(1, 0), a3, 0, last);
            PG8_WAIT_V(8); PG8_WAIT_L(0); PG8_BAR; PG8_MMA(1, 0, At, B0); PG8_MMA(1, 1, At, B1); PG8_BAR; PG8_SCHED;
            } else {
            PG8_LDB(B0, 0, 0); PG8_SCHED; PG8_LDA(At, 0, 0); PG8_STAGE(PG8_SA(1, 1), a1 + hstep, voffA);
            PG8_WAIT_L(8); PG8_BAR; PG8_WAIT_L(0); PG8_MMA(0, 0, At, B0); PG8_BAR; PG8_SCHED;
            PG8_LDB(B1, 0, 1); PG8_STAGE(PG8_SB(0, 0), b2, voffB);
            PG8_BAR; PG8_WAIT_L(0); PG8_MMA(0, 1, At, B1); PG8_BAR;
            PG8_LDA(At, 0, 1); PG8_STAGE(PG8_SA(0, 0), a2, voffA);
            PG8_BAR; PG8_WAIT_L(0); PG8_MMA(1, 0, At, B0); PG8_BAR; PG8_SCHED;
            PG8_STAGE(PG8_SB(0, 1), b2 + hstep, voffB);
            PG8_WAIT_V(6); PG8_BAR; PG8_MMA(1, 1, At, B1); PG8_BAR;
            PG8_LDB(B0, 1, 0); PG8_SCHED; PG8_LDA(At, 1, 0); PG8_STAGE(PG8_SA(0, 1), a2 + hstep, voffA);
            PG8_WAIT_L(8); PG8_BAR; PG8_WAIT_L(0); PG8_MMA(0, 0, At, B0); PG8_BAR; PG8_SCHED;
            PG8_LDB(B1, 1, 1); PG8_STAGE(PG8_SB(1, 0), b3, voffB);
            PG8_BAR; PG8_WAIT_L(0); PG8_MMA(0, 1, At, B1); PG8_BAR;
            PG8_LDA(At, 1, 1); PG8_STAGE(PG8_SA(1, 0), a3, voffA);
            PG8_BAR; PG8_WAIT_L(0); PG8_MMA(1, 0, At, B0); PG8_BAR; PG8_SCHED;
            PG8_STAGE(PG8_SB(1, 1), b3 + hstep, voffB);
            PG8_WAIT_V(6); PG8_BAR; PG8_MMA(1, 1, At, B1); PG8_BAR;
            }
        }
        if constexpr (ALIGN_EPI) { if (wr == 0) PG8_BAR; }
        if constexpr (Epi::CHAIN) { E.unit_end(acc, cur, wr, wc, fr, fq); }
        else if constexpr (!Epi::AFTER_DRAIN) { E(acc, cur, wr, wc, fr, fq); S.done(cur); }
        if (!has_next) break;
        if constexpr (!Epi::CHAIN)
#pragma unroll
        for (int a = 0; a < 2; ++a)
#pragma unroll
            for (int b = 0; b < 2; ++b)
#pragma unroll
                for (int m = 0; m < 4; ++m)
#pragma unroll
                    for (int n = 0; n < 2; ++n) acc[a][b][m][n] = (f32x4){0.f, 0.f, 0.f, 0.f};
        cur = nxt; cA = nA; cB = nB; ++ui;
        if constexpr (Epi::GATHER) { _Pragma("unroll") for (int h_ = 0; h_ < 2; ++h_) _Pragma("unroll") for (int i_ = 0; i_ < 2; ++i_) vAc[h_][i_] = vAn[h_][i_]; }
        if constexpr (ALIGN_EPI) { if (wr == 1) PG8_BAR; }
    }
    PG8_WAIT_V(0);
    if constexpr (!ALIGN_EPI) { if (wr == 0) PG8_BAR; }
    PG8_BAR;
    if constexpr (Epi::AFTER_DRAIN) { E.fused(acc, cur, wr, wc, fr, fq, lds, wid, lane); S.done(cur); }
#undef PG8_SA
#undef PG8_SB
#undef PG8_STAGE
#undef PG8_STAGE_A
#undef PG8_GVOFF
#undef PG8_LDA
#undef PG8_LDB
#undef PG8_MMA
#undef PG8_WAIT_V
#undef PG8_WAIT_L
#undef PG8_BAR
#undef PG8_SCHED
}
}

namespace att {
constexpr int D = 128, NW = 8, QBLK = 32, KVBLK = 64;
constexpr int SDEPTH = 1;
constexpr float THR2 = 8.f * 1.4426950408889634f;
constexpr size_t SHM_V = KVBLK * D * 2, SHM_K = KVBLK * D * 2, SHM_ATTN = 2 * SHM_V + 2 * SHM_K + NW * 64 * 4;
#define KSWZ(row, colB) ((row) * 256 + ((colB) ^ (((row) & 7) << 4)))
__device__ __forceinline__ int crow(int r, int hi) { return (r & 3) + 8 * (r >> 2) + 4 * hi; }
constexpr int ccol(int r) { return (r & 3) + 8 * (r >> 2); }

template <int MODE>
__device__ __forceinline__ void partialSM(f32x16& p0, f32x16& p1, float& m_reg, float& alpha, float& sub1_out, int j, int NT, float slope2, float lanec, int lanet, int hi, v2u mw, unsigned bmw) {
  const float NEGINF = -__builtin_inff();
  float base0 = 0.f, base1 = 0.f;
  if constexpr (MODE != 0) {
    base0 = fmaf(slope2 * 64.f, (float)j, lanec); base1 = base0 + 32.f * slope2;
#pragma unroll
    for (int r = 0; r < 16; ++r) { p0[r] = fmaf(slope2, (float)ccol(r), p0[r]); p1[r] = fmaf(slope2, (float)ccol(r), p1[r]); }
  }
  if constexpr (MODE == 1 || MODE == 4) {
    const unsigned w0 = mw.x >> (4 * hi), w1 = mw.y >> (4 * hi);
#pragma unroll
    for (int r = 0; r < 16; ++r) {
      const int m0 = __builtin_amdgcn_sbfe(w0, ccol(r), 1), m1 = __builtin_amdgcn_sbfe(w1, ccol(r), 1);
      p0[r] = __uint_as_float((__float_as_uint(p0[r]) & (unsigned)m0) | (0xff800000u & ~(unsigned)m0));
      p1[r] = __uint_as_float((__float_as_uint(p1[r]) & (unsigned)m1) | (0xff800000u & ~(unsigned)m1));
    }
  }
  if constexpr (MODE == 2) {
    const bool sel = (bmw >> (j >> 2)) & 1u; if (!sel) { base0 = NEGINF; base1 = NEGINF; }
    if (j >= NT - 4) { const int thr0 = lanet - 64 * j, thr1 = thr0 - 32;
#pragma unroll
      for (int r = 0; r < 16; ++r) { p0[r] = (ccol(r) <= thr0) ? p0[r] : NEGINF; p1[r] = (ccol(r) <= thr1) ? p1[r] : NEGINF; }
    }
  }
  float mx0 = p0[0], mx1 = p1[0];
#pragma unroll
  for (int r = 1; r < 16; ++r) { mx0 = fmaxf(mx0, p0[r]); mx1 = fmaxf(mx1, p1[r]); }
  float pmax;
  if constexpr (MODE == 0) pmax = fmaxf(mx0, mx1); else pmax = fmaxf(mx0 + base0, mx1 + base1);
  { auto rr = __builtin_amdgcn_permlane32_swap(__float_as_uint(pmax), __float_as_uint(pmax), false, false);
    pmax = fmaxf(__uint_as_float(rr[0]), __uint_as_float(rr[1])); }
  float mn;
  if (__builtin_expect(__all(pmax - m_reg <= THR2), 1)) { mn = m_reg; alpha = 1.f; }
  else { mn = fmaxf(m_reg, pmax); alpha = __builtin_amdgcn_exp2f(m_reg - mn); m_reg = mn; }
  float sub0, sub1;
  if constexpr (MODE == 0) { sub0 = mn; sub1 = mn; } else { sub0 = mn - base0; sub1 = mn - base1; }
#pragma unroll
  for (int r = 0; r < 16; ++r) p0[r] = __builtin_amdgcn_exp2f(p0[r] - sub0);
  sub1_out = sub1;
}
__device__ __forceinline__ void finishSM(f32x16& p0, f32x16& p1, float sub1, float alpha, float& l_reg, bf16x8& pa0, bf16x8& pa1, bf16x8& pa2, bf16x8& pa3) {
#pragma unroll
  for (int r = 0; r < 16; ++r) p1[r] = __builtin_amdgcn_exp2f(p1[r] - sub1);
  float ps = 0;
#pragma unroll
  for (int r = 0; r < 16; ++r) ps += p0[r];
#pragma unroll
  for (int r = 0; r < 16; ++r) ps += p1[r];
  { auto rr = __builtin_amdgcn_permlane32_swap(__float_as_uint(ps), __float_as_uint(ps), false, false);
    ps = __uint_as_float(rr[0]) + __uint_as_float(rr[1]); }
  l_reg = l_reg * alpha + ps;
#define PK4(P, BASE, OUT) do { unsigned a0 = cvtpk(P[BASE + 0], P[BASE + 1]), a1 = cvtpk(P[BASE + 2], P[BASE + 3]);   \
    unsigned b0 = cvtpk(P[BASE + 4], P[BASE + 5]), b1 = cvtpk(P[BASE + 6], P[BASE + 7]);                              \
    auto r0 = __builtin_amdgcn_permlane32_swap(a0, b0, false, false); auto r1 = __builtin_amdgcn_permlane32_swap(a1, b1, false, false); \
    v4u w = {r0[0], r1[0], r0[1], r1[1]}; OUT = *reinterpret_cast<bf16x8*>(&w); } while (0)
  PK4(p0, 0, pa0); PK4(p0, 8, pa1); PK4(p1, 0, pa2); PK4(p1, 8, pa3);
#undef PK4
}
__device__ __forceinline__ void qkt(f32x16& p0, f32x16& p1, const LAS char* Ks, const bf16x8 (&qs)[8], int r32, int hi) {
  p0 = f32x16{}; p1 = f32x16{};
#pragma unroll
  for (int d0 = 0; d0 < 8; ++d0) { int cb = (d0 * 16 + hi * 8) * 2;
    bf16x8 b0 = *reinterpret_cast<const LAS bf16x8*>(Ks + KSWZ(r32, cb));
    bf16x8 b1 = *reinterpret_cast<const LAS bf16x8*>(Ks + KSWZ(32 + r32, cb));
    const bf16x8 q = qs[d0];
    p0 = __builtin_amdgcn_mfma_f32_32x32x16_bf16(b0, q, p0, 0, 0, 0);
    p1 = __builtin_amdgcn_mfma_f32_32x32x16_bf16(b1, q, p1, 0, 0, 0); }
}
__device__ __forceinline__ int v_st(int k, int c) { const int kk = (k & ~0xC) | ((k & 4) << 1) | ((k & 8) >> 1); return ((kk >> 3) * 4 + (c >> 5)) * 512 + ((kk & 7) * 32 + (c & 31)) * 2; }
__device__ __forceinline__ int v_rd_base(int lane) { return ((lane & 3) << 3) | (((lane >> 2) & 3) << 6) | (((lane >> 4) & 1) << 5) | (((lane >> 5) & 1) << 8); }
constexpr int v_rd_off(int d0, int ks, int half) { return d0 * 512 + ks * 4096 + half * 2048; }
template <int OFF> __device__ __forceinline__ s16x4 tr_read(int vb) {
  s16x4 r; asm volatile("ds_read_b64_tr_b16 %0, %1 offset:%2" : "=&v"(r) : "v"(vb), "i"(OFF) : "memory"); return r;
}
template <int D0> __device__ __forceinline__ void pv_one(f32x16& od, int vb, bf16x8 pa0, bf16x8 pa1, bf16x8 pa2, bf16x8 pa3) {
  const s16x4 l0 = tr_read<v_rd_off(D0, 0, 0)>(vb), h0 = tr_read<v_rd_off(D0, 0, 1)>(vb), l1 = tr_read<v_rd_off(D0, 1, 0)>(vb), h1 = tr_read<v_rd_off(D0, 1, 1)>(vb);
  const s16x4 l2 = tr_read<v_rd_off(D0, 2, 0)>(vb), h2 = tr_read<v_rd_off(D0, 2, 1)>(vb), l3 = tr_read<v_rd_off(D0, 3, 0)>(vb), h3 = tr_read<v_rd_off(D0, 3, 1)>(vb);
  asm volatile("s_waitcnt lgkmcnt(0)" ::: "memory"); SBAR();
#define PK(L, H) (bf16x8){L[0], L[1], L[2], L[3], H[0], H[1], H[2], H[3]}
  od = __builtin_amdgcn_mfma_f32_32x32x16_bf16(pa0, PK(l0, h0), od, 0, 0, 0);
  od = __builtin_amdgcn_mfma_f32_32x32x16_bf16(pa1, PK(l1, h1), od, 0, 0, 0);
  od = __builtin_amdgcn_mfma_f32_32x32x16_bf16(pa2, PK(l2, h2), od, 0, 0, 0);
  od = __builtin_amdgcn_mfma_f32_32x32x16_bf16(pa3, PK(l3, h3), od, 0, 0, 0);
#undef PK
}
__device__ __forceinline__ void pv_d0(f32x16* o, int vb, bf16x8 pa0, bf16x8 pa1, bf16x8 pa2, bf16x8 pa3) {
  pv_one<0>(o[0], vb, pa0, pa1, pa2, pa3); pv_one<1>(o[1], vb, pa0, pa1, pa2, pa3); pv_one<2>(o[2], vb, pa0, pa1, pa2, pa3); pv_one<3>(o[3], vb, pa0, pa1, pa2, pa3);
}

template <int MODE>
__device__ __forceinline__ void attn_unit(const GAS bf16* __restrict__ Qb, int ldq, const GAS bf16* __restrict__ Kh, const GAS bf16* __restrict__ Vh, int ldk, GAS bf16* __restrict__ Ob, int ldo,
                                          int NT, int qpos0, float slope2, const GAS unsigned* __restrict__ maskA, const GAS unsigned* __restrict__ blkm, LAS char* lds, const int tid,
                                          int nvalid = 0, GAS bf16* __restrict__ PO = nullptr, GAS float* __restrict__ PML = nullptr, int hh = 0, int kofs = 0) {
  const int wid = tid >> 6, lane = tid & 63, r32 = lane & 31, hi = lane >> 5;
  LAS char* V_lds = lds; LAS char* K_lds = lds + 2 * SHM_V;
  LAS float* ws = (LAS float*)(lds + 2 * SHM_V + 2 * SHM_K) + wid * 64; LAS float* li_l = ws; LAS float* al_l = ws + 32;
  float m_reg = -1e30f, l_reg = 0; f32x16 o[4] = {};
  bf16x8 qr[8];
  const int qrow = wid * QBLK + r32;
  int trow = qpos0 + qrow, pslot = 0;
  if constexpr (MODE == 3) { unsigned e = ((unsigned)(qpos0 + 256)) | (4u << 16); if (qrow < nvalid) e = blkm[qrow]; trow = (int)(e & 0xffffu); pslot = (int)(e >> 16); }
  if constexpr (MODE == 4) pslot = kofs >> 11;
  const int qpos = (MODE == 2) ? qrow : (MODE == 3) ? trow - qpos0 : (MODE == 4) ? trow - kofs : trow;
  const unsigned bmw = 0xffffffffu;
  const GAS bf16* Qw = Qb + (unsigned)((MODE == 3 ? trow : qrow) * ldq + hi * 8);
#pragma unroll
  for (int d0 = 0; d0 < 8; ++d0) qr[d0] = *reinterpret_cast<const GAS bf16x8*>(Qw + d0 * 16);
  slope2 = __uint_as_float(__builtin_amdgcn_readfirstlane(__float_as_uint(slope2)));
  const float lanec = slope2 * (float)(4 * hi - qpos); const int lanet = qpos - 4 * hi;
  unsigned moff = 0; if constexpr (MODE == 1 || MODE == 4) moff = (unsigned)trow * 1024u + (unsigned)(kofs >> 6) * 8u;
  const int sr = tid >> 4, sc = (tid & 15) * 8, vst0 = v_st(sr, sc), vst1 = v_st(32 + sr, sc);
  const int vb0 = (int)(uintptr_t)V_lds + v_rd_base(lane);
  struct { bf16x8 vs0, vs1, ks0, ks1; } sr_[SDEPTH];
  const unsigned so0 = (unsigned)(sr * ldk + sc) * 2u, so1 = so0 + (unsigned)(32 * ldk) * 2u, tstep_ = (unsigned)(64 * ldk) * 2u;
#define SLOAD(i, k0) do { const unsigned tb_ = (unsigned)((k0) >> 6) * tstep_; \
    sr_[i].vs0 = *reinterpret_cast<const GAS bf16x8*>((const GAS char*)Vh + (tb_ + so0)); sr_[i].vs1 = *reinterpret_cast<const GAS bf16x8*>((const GAS char*)Vh + (tb_ + so1)); \
    sr_[i].ks0 = *reinterpret_cast<const GAS bf16x8*>((const GAS char*)Kh + (tb_ + so0)); sr_[i].ks1 = *reinterpret_cast<const GAS bf16x8*>((const GAS char*)Kh + (tb_ + so1)); } while (0)
#define SWRITE(b, i) do { *(LAS bf16x8*)(V_lds + (b) * SHM_V + vst0) = sr_[i].vs0;          \
    *(LAS bf16x8*)(V_lds + (b) * SHM_V + vst1) = sr_[i].vs1; int kc = sc * 2;               \
    *(LAS bf16x8*)(K_lds + (b) * SHM_K + KSWZ(sr, kc)) = sr_[i].ks0;                       \
    *(LAS bf16x8*)(K_lds + (b) * SHM_K + KSWZ(32 + sr, kc)) = sr_[i].ks1; } while (0)
#define SWAIT() do { if constexpr (SDEPTH == 2) asm volatile("s_waitcnt vmcnt(4)" ::: "memory"); else asm volatile("s_waitcnt vmcnt(0)" ::: "memory"); } while (0)
#define RESC(a) do { if (__any((a) < 1.f)) { if (hi == 0) al_l[r32] = (a); asm volatile("s_waitcnt lgkmcnt(0)" ::: "memory"); \
    _Pragma("unroll") for (int d = 0; d < 4; ++d) _Pragma("unroll") for (int r = 0; r < 16; ++r) o[d][r] *= al_l[crow(r, hi)]; } } while (0)
  v2u mwA = {0u, 0u}, mwB = {0u, 0u};
#define MLOAD(dst, j) do { if constexpr (MODE == 1 || MODE == 4) dst = *reinterpret_cast<const GAS v2u*>((const GAS char*)maskA + (moff + 8u * (unsigned)(j))); } while (0)
#define PSM(P0, P1, AL, S1, J, MW) partialSM<MODE>(P0, P1, m_reg, AL, S1, J, NT, slope2, lanec, lanet, hi, MW, bmw)
  f32x16 pA0, pA1, pB0, pB1; float alA, alB, s1A, s1B; bf16x8 pa0, pa1, pa2, pa3;
  constexpr int SE = 0, SO = SDEPTH - 1;
  MLOAD(mwA, 0); MLOAD(mwB, 1);
  SLOAD(SE, 0); asm volatile("s_waitcnt vmcnt(0)" ::: "memory"); SWRITE(0, SE);
  if constexpr (SDEPTH == 1) SLOAD(SO, KVBLK);
  __syncthreads();
  qkt(pA0, pA1, K_lds, qr, r32, hi); PSM(pA0, pA1, alA, s1A, 0, mwA);
  if constexpr (SDEPTH == 2) { SLOAD(SO, KVBLK); if (2 < NT) SLOAD(SE, 2 * KVBLK); }
  SWAIT(); SWRITE(1, SO); __syncthreads();
  for (int j = 1; j + 1 < NT; j += 2) {
    SBAR(); qkt(pB0, pB1, K_lds + SHM_K, qr, r32, hi);
    finishSM(pA0, pA1, s1A, alA, l_reg, pa0, pa1, pa2, pa3); SBAR();
    MLOAD(mwA, j + 1);
    SLOAD(SO, (j + SDEPTH) * KVBLK); SBAR();
    pv_d0(o, vb0, pa0, pa1, pa2, pa3); PSM(pB0, pB1, alB, s1B, j, mwB);
    __syncthreads(); SWAIT(); SWRITE(0, SE);
    RESC(alB); __syncthreads();
    SBAR(); qkt(pA0, pA1, K_lds, qr, r32, hi);
    finishSM(pB0, pB1, s1B, alB, l_reg, pa0, pa1, pa2, pa3); SBAR();
    if (j + 2 < NT) MLOAD(mwB, j + 2);
    if (SDEPTH == 1 || j + 3 < NT) SLOAD(SE, (j + 1 + SDEPTH) * KVBLK); SBAR();
    pv_d0(o, vb0 + (int)SHM_V, pa0, pa1, pa2, pa3); PSM(pA0, pA1, alA, s1A, j + 1, mwA);
    __syncthreads(); SWAIT(); SWRITE(1, SO);
    RESC(alA); __syncthreads();
  }
  SBAR(); qkt(pB0, pB1, K_lds + SHM_K, qr, r32, hi);
  finishSM(pA0, pA1, s1A, alA, l_reg, pa0, pa1, pa2, pa3); SBAR();
  pv_d0(o, vb0, pa0, pa1, pa2, pa3); PSM(pB0, pB1, alB, s1B, NT - 1, mwB);
  __syncthreads(); RESC(alB);
  finishSM(pB0, pB1, s1B, alB, l_reg, pa0, pa1, pa2, pa3); SBAR();
  pv_d0(o, vb0 + (int)SHM_V, pa0, pa1, pa2, pa3);
  LAS int* dst_l = (LAS int*)(lds + SHM_ATTN) + wid * 32;
  if (hi == 0) { li_l[r32] = l_reg;
    if constexpr (MODE >= 2) { const int prow = pslot * 8192 + trow; dst_l[r32] = prow; f32x2 ml = {m_reg, l_reg}; *reinterpret_cast<GAS f32x2*>(PML + (size_t)(prow * 6 + hh) * 2) = ml; } }
  asm volatile("s_waitcnt lgkmcnt(0)" ::: "memory");
  float rli[16];
#pragma unroll
  for (int r = 0; r < 16; ++r) { const float lq = li_l[crow(r, hi)]; rli[r] = (MODE == 4 && !(lq > 0.f)) ? 0.f : __builtin_amdgcn_rcpf(lq); }
  if constexpr (MODE >= 2) {
#pragma unroll
    for (int r = 0; r < 16; ++r) { const int prow = dst_l[crow(r, hi)]; GAS bf16* Pw = PO + ((size_t)prow * 768 + hh * 128 + r32);
#pragma unroll
      for (int d0 = 0; d0 < 4; ++d0) Pw[d0 * 32] = (bf16)f2bf(o[d0][r] * rli[r]); }
  } else {
  GAS bf16* Ow = Ob + (unsigned)(wid * QBLK * ldo);
#pragma unroll
  for (int r = 0; r < 16; ++r) { int orow = crow(r, hi);
#pragma unroll
    for (int d0 = 0; d0 < 4; ++d0) Ow[(unsigned)(orow * ldo + d0 * 32 + r32)] = (bf16)f2bf(o[d0][r] * rli[r] * ((DBG_ZERO_BR >> MODE) & 1 ? 0.f : 1.f)); }
  }
  __syncthreads();
#undef SLOAD
#undef SWRITE
#undef SWAIT
#undef RESC
#undef MLOAD
#undef PSM
}
}

constexpr size_t MiB = 1u << 20;
constexpr size_t WS_CTL = 0, CTL_ZERO_BYTES = 1 * MiB;
constexpr size_t WS_INFO = 1 * MiB;
constexpr size_t WS_WA = 2 * MiB, WS_WC1 = 41 * MiB, WS_WC2 = 43 * MiB, WS_WUP = 44 * MiB, WS_WO = 52 * MiB, WS_W13 = 60 * MiB, WS_W2 = 188 * MiB, WS_WMEM = 252 * MiB, WS_WR = 256 * MiB;
constexpr size_t WS_MEMB = 257 * MiB, WS_MKV = 258 * MiB, WS_HB = 259 * MiB, WS_PROJ = 291 * MiB, WS_GATE = 351 * MiB, WS_XG = WS_GATE;
constexpr size_t WS_CQN = 447 * MiB, WS_CKVN = 455 * MiB, WS_KIDX = 459 * MiB, WS_WIDX = 460 * MiB, WS_KMEAN = 461 * MiB, WS_QAI = 462 * MiB, WS_KVA = 490 * MiB;
constexpr size_t WS_MASKA = 514 * MiB, WS_BLKM = 522 * MiB, WS_OATT = 523 * MiB, WS_MERGED = 555 * MiB, WS_PRE = 587 * MiB, WS_Y = WS_PRE, WS_X1 = 651 * MiB, WS_X1B = 715 * MiB;
constexpr size_t WS_CNT = 747 * MiB + 512 * 1024;
constexpr size_t WS_ROUTE = 747 * MiB, WS_ROWMAP = 748 * MiB, WS_ROWW = 749 * MiB, WS_HID = 750 * MiB;
constexpr size_t WS_PO = 651 * MiB;
constexpr size_t WS_PML = 750 * MiB;
constexpr size_t WS_LST = 754 * MiB;
constexpr size_t WS_PICK = 758 * MiB;
constexpr size_t WS_CNT2 = 759 * MiB;
constexpr size_t WS_LEN = 760 * MiB;
constexpr size_t WS_PO2 = 587 * MiB;
constexpr size_t WS_PML2 = 762 * MiB;
constexpr int LCAP = 256 * 496;
__host__ __device__ constexpr int LBASE(int h, int n) { return h * LCAP + 256 * (31 * n - n * (n - 1) / 2); }
constexpr size_t WS_SC = WS_PRE;
constexpr size_t WDELTA = 772 * MiB;
constexpr size_t WS_END = 1024 * MiB;
__host__ __device__ constexpr size_t WD(int l) { return l ? WDELTA : 0; }
__host__ __device__ constexpr size_t WDR(int l) { return l ? 512 * 1024 : 0; }
constexpr int CW_TMO = 0;
constexpr int CW_BAR = 4096;
constexpr int CW_ECNT = 16384;
constexpr int CW_AQ = 20480;
constexpr int LDS_BYTES = 163840;
constexpr int MISC_OFF = LDS_BYTES - 256;

#define XB_TMO      128
#define XB_XCNT(j)  (256  + 64 * (j))
#define XB_XSUB(j)  (1280 + 64 * (j))
#define XB_XGEN(j)  (2304 + 64 * (j))
#define XB_TOP      3328
#define XB_TOPGEN   3392
#define XCD_BAR_WORDS 3456
#define XB_SPIN_CAP (1u << 22)
__device__ __forceinline__ unsigned xb_ld(unsigned* p)              { return __hip_atomic_load(p, __ATOMIC_RELAXED, __HIP_MEMORY_SCOPE_AGENT); }
__device__ __forceinline__ unsigned xb_add(unsigned* p, unsigned v) { return __hip_atomic_fetch_add(p, v, __ATOMIC_RELAXED, __HIP_MEMORY_SCOPE_AGENT); }
__device__ __forceinline__ unsigned xb_xcc_id() { return (unsigned)__builtin_amdgcn_s_getreg((3 << 11) | 20) & 0xFu; }
#define XB_SPIN(cond, bar) do { unsigned _sp = 0; while (cond) { __builtin_amdgcn_s_sleep(1); \
    if ((++_sp & 255u) == 0u) { if (xb_ld(&(bar)[XB_TMO])) break; if (_sp > XB_SPIN_CAP) { atomicAdd(&(bar)[XB_TMO], 1u); break; } } } } while (0)
__device__ __forceinline__ int lane_id() { int l; asm volatile("v_mbcnt_lo_u32_b32 %0, -1, 0\n\tv_mbcnt_hi_u32_b32 %0, -1, %0" : "=v"(l)); return l; }
struct XcdBarrier { unsigned* bar; unsigned x; volatile LAS unsigned* st; unsigned w0; };
__device__ __forceinline__ XcdBarrier xcd_barrier_post(unsigned* bar, volatile LAS unsigned* st, unsigned w0) {
    XcdBarrier b; b.bar = bar; b.x = xb_xcc_id(); b.st = st; b.w0 = w0;
    if (w0 && lane_id() == 0) (void)xb_add(&bar[XB_XCNT(b.x)], 1u);
    return b;
}
__device__ __forceinline__ void xcd_barrier_complete(unsigned* bar, unsigned x, unsigned& nloc, unsigned& nx) {
    const unsigned G = gridDim.x * gridDim.y * gridDim.z;
    unsigned sum, cnt, mine, sp = 0u;
    for (;;) {
        sum = 0u; cnt = 0u; mine = 0u;
#pragma unroll
        for (unsigned j = 0; j < 16; ++j) { const unsigned c = xb_ld(&bar[XB_XCNT(j)]); sum += c; cnt += (c > 0u) ? 1u : 0u; mine = (j == x) ? c : mine; }
        if (sum == G) break;
        __builtin_amdgcn_s_sleep(1);
        if ((++sp & 255u) == 0u) { if (xb_ld(&bar[XB_TMO])) break; if (sp > XB_SPIN_CAP) { atomicAdd(&bar[XB_TMO], 1u); break; } }
    }
    nloc = mine > 0u ? mine : 1u; nx = cnt > 0u ? cnt : 1u;
}
__device__ __forceinline__ void xcd_barrier(const XcdBarrier& b) {
    asm volatile("s_waitcnt vmcnt(0)" ::: "memory");
    __syncthreads();
    if (b.w0 && lane_id() == 0) {
        unsigned* bar = b.bar;
        __builtin_amdgcn_s_waitcnt(0);
        unsigned nloc = b.st[0], nx = b.st[1];
        if (nloc == 0u) { xcd_barrier_complete(bar, b.x, nloc, nx); b.st[0] = nloc; b.st[1] = nx; }
        const unsigned old = xb_add(&bar[XB_XSUB(b.x)], 1u);
        const unsigned gen = old / nloc;
        if (old + 1u == (gen + 1u) * nloc) {
            __builtin_amdgcn_fence(__ATOMIC_RELEASE, "agent");
            asm volatile("s_waitcnt vmcnt(0)" ::: "memory");
            const unsigned og = xb_add(&bar[XB_TOP], 1u);
            const unsigned tg = og / nx;
            if (og + 1u == (tg + 1u) * nx) xb_add(&bar[XB_TOPGEN], 1u);
            else XB_SPIN(xb_ld(&bar[XB_TOPGEN]) == tg, bar);
            __builtin_amdgcn_fence(__ATOMIC_ACQUIRE, "agent");
            xb_add(&bar[XB_XGEN(b.x)], 1u);
            asm volatile("s_waitcnt vmcnt(0)" ::: "memory");
        } else {
            XB_SPIN(xb_ld(&bar[XB_XGEN(b.x)]) == gen, bar);
            __builtin_amdgcn_fence(__ATOMIC_ACQUIRE, "agent");
            asm volatile("s_waitcnt vmcnt(0)" ::: "memory");
        }
    }
    __syncthreads();
}

struct Args { const float* in[28]; float* out; unsigned char* ws; int ph_lo, ph_hi; };
struct Frame {
    LAS unsigned char* lds; volatile LAS unsigned* MISC; gu32* ctl; int* info;
    int tid, lane, wave, G, bid;
    unsigned char* ws; size_t z;
};
enum { I_X = 0, I_MEM, I_WMEMKV, I_WIN, I_GCQ, I_GCKV, I_GKIDX, I_BKIDX, I_WUQ, I_WUQI, I_WUKV, I_WUPA, I_WUPB, I_WUPC, I_WGATE, I_BGATE, I_WO, I_LN1G, I_LN1B,
       I_WGRP, I_BGRP, I_WRT, I_BRT, I_W1, I_W3, I_W2, I_LN2G, I_LN2B };
#define WSP(T_, off) ((T_*)(F.ws + (off)))
#ifndef DBG_TSUB
#define DBG_TSUB 0
#endif
#ifndef DBG_TBID
#define DBG_TBID 0
#endif
#define TSUB_START(id) do { if (DBG_TSUB == (id) && F.bid == DBG_TBID && F.wave == 0) { if (lane_id() == 0) F.MISC[22] = (unsigned)__builtin_amdgcn_s_memrealtime(); } } while (0)
#define TSUB_STOP(id) do { if (DBG_TSUB == (id) && F.bid == DBG_TBID && F.wave == 0) { if (lane_id() == 0) { const unsigned t_ = (unsigned)__builtin_amdgcn_s_memrealtime(); F.MISC[20] = F.MISC[20] + (t_ - F.MISC[22]); } } } while (0)

template <int NWD>
__device__ __forceinline__ void transpose_item(const float* src, int ldw, bf16* dst, int ldk, LAS float* scr, int lane) {
    constexpr int ST = NWD + 1, KPI = 64 / NWD;
    float tv[NWD];
#pragma unroll
    for (int i = 0; i < NWD; ++i) { const int kk = KPI * i + lane / NWD; tv[i] = src[(size_t)kk * ldw + (lane % NWD)]; }
#pragma unroll
    for (int i = 0; i < NWD; ++i) { const int kk = KPI * i + lane / NWD; scr[kk * ST + (lane % NWD)] = tv[i]; }
    LDS_WAIT(); asm volatile("" ::: "memory");
    const int c = lane & 7;
#pragma unroll
    for (int j = 0; j < NWD / 8; ++j) { const int n = (lane >> 3) + 8 * j; const LAS float* s = scr + (8 * c) * ST + n;
        v4u o; o.x = cvtpk(s[0 * ST], s[1 * ST]); o.y = cvtpk(s[2 * ST], s[3 * ST]); o.z = cvtpk(s[4 * ST], s[5 * ST]); o.w = cvtpk(s[6 * ST], s[7 * ST]);
        *(GAS v4u*)(dst + (size_t)n * ldk + 8 * c) = o; }
    LDS_WAIT(); asm volatile("" ::: "memory");
}
constexpr int CONV_TOTAL = 32 * 229 + 176 + 32 * 192 + 8 * 24 + 8 * 32 + 4 * 48 + 2 * 12 * 64 + 8 * 64 + 32 * 64 + 3 * 32 * 512 + 1536;
constexpr int CONV_E_LO = 32 * 229 + 176 + 32 * 192 + 8 * 24 + 8 * 32 + 4 * 48 + 2 * 12 * 64 + 8 * 64 + 32 * 64, CONV_E_N = 3 * 32 * 512;
constexpr int CONV_REST = CONV_TOTAL - CONV_E_N;
__device__ __forceinline__ void conv_items(Frame& F, const Args& a, int l, int it_begin, int it_stride, int it_end, int hole_lo) {
    LAS float* scr = (LAS float*)(F.lds + F.wave * 16384);
    const int lane = F.lane; const size_t wd = WD(l);
    bf16* WA = WSP(bf16, WS_WA + wd); bf16* WC1 = WSP(bf16, WS_WC1 + wd); bf16* WC2 = WSP(bf16, WS_WC2 + wd); bf16* WUP = WSP(bf16, WS_WUP + wd); bf16* WO = WSP(bf16, WS_WO + wd);
    bf16* W13 = WSP(bf16, WS_W13 + wd); bf16* W2T = WSP(bf16, WS_W2 + wd); float* WR = WSP(float, WS_WR + WDR(l));
    const float* w_in = (a.in[I_WIN] + F.z) + (size_t)l * 2048 * 3664; const float* w_gate = (a.in[I_WGATE] + F.z) + (size_t)l * 2048 * 6144;
    const float* w_uq = (a.in[I_WUQ] + F.z) + (size_t)l * 512 * 768; const float* w_uqi = (a.in[I_WUQI] + F.z) + (size_t)l * 512 * 1024; const float* w_ukv = (a.in[I_WUKV] + F.z) + (size_t)l * 256 * 1536;
    const float* w_upa = (a.in[I_WUPA] + F.z) + (size_t)l * 768 * 2048; const float* w_upb = (a.in[I_WUPB] + F.z) + (size_t)l * 768 * 2048; const float* w_upc = (a.in[I_WUPC] + F.z) + (size_t)l * 512 * 2048;
    const float* w_o = (a.in[I_WO] + F.z) + (size_t)l * 2048 * 2048;
    const float* w1 = (a.in[I_W1] + F.z) + (size_t)l * 32 * 2048 * 512; const float* w3 = (a.in[I_W3] + F.z) + (size_t)l * 32 * 2048 * 512; const float* w2 = (a.in[I_W2] + F.z) + (size_t)l * 32 * 512 * 2048;
    const float* w_grp = (a.in[I_WGRP] + F.z) + (size_t)l * 2048 * 4; const float* w_rt = (a.in[I_WRT] + F.z) + (size_t)l * 2048 * 32;
    constexpr int N_IN = 32 * 229, N_PAD = 176, N_GATE = 32 * 192, N_UQ = 8 * 24, N_UQI = 8 * 32, N_UKV = 4 * 48, N_UPA = 12 * 64, N_UPC = 8 * 64, N_O = 32 * 64, N_E = 32 * 512, N_R = 1536;
    constexpr int TOTAL = N_IN + N_PAD + N_GATE + N_UQ + N_UQI + N_UKV + 2 * N_UPA + N_UPC + N_O + 3 * N_E + N_R;
    static_assert(TOTAL == CONV_TOTAL, "conv item count");
    for (int it = it_begin; it < it_end; it += it_stride) {
        int r = it >= hole_lo ? it + CONV_E_N : it;
        const float* src = nullptr; bf16* dst = nullptr; int ldw = 0, ldk = 0, kind = 0;
        if (r < N_IN) { const int kb = r / 229, nb = r % 229, n0 = 16 * nb, k0 = 64 * kb, dr = n0 < 848 ? n0 : n0 + 176;
            src = w_in + (size_t)k0 * 3664 + n0; ldw = 3664; dst = WA + (size_t)dr * 2048 + k0; ldk = 2048; kind = 1; }
        else if ((r -= N_IN) < N_PAD) { kind = 2; }
        else if ((r -= N_PAD) < N_GATE) { const int kb = r / 192, nb = r % 192, n0 = 32 * nb, k0 = 64 * kb; src = w_gate + (size_t)k0 * 6144 + n0; ldw = 6144; dst = WA + (size_t)(3840 + n0) * 2048 + k0; ldk = 2048; }
        else if ((r -= N_GATE) < N_UQ) { const int kb = r / 24, nb = r % 24, n0 = 32 * nb, k0 = 64 * kb; src = w_uq + (size_t)k0 * 768 + n0; ldw = 768; dst = WC1 + (size_t)n0 * 512 + k0; ldk = 512; }
        else if ((r -= N_UQ) < N_UQI) { const int kb = r / 32, nb = r % 32, n0 = 32 * nb, k0 = 64 * kb; src = w_uqi + (size_t)k0 * 1024 + n0; ldw = 1024; dst = WC1 + (size_t)(768 + n0) * 512 + k0; ldk = 512; }
        else if ((r -= N_UQI) < N_UKV) { const int kb = r / 48, nb = r % 48, n0 = 32 * nb, k0 = 64 * kb; src = w_ukv + (size_t)k0 * 1536 + n0; ldw = 1536; dst = WC2 + (size_t)n0 * 256 + k0; ldk = 256; }
        else if ((r -= N_UKV) < N_UPA) { const int kb = r / 64, nb = r % 64, n0 = 32 * nb, k0 = 64 * kb; src = w_upa + (size_t)k0 * 2048 + n0; ldw = 2048; dst = WUP + (size_t)n0 * 2048 + k0; ldk = 2048; }
        else if ((r -= N_UPA) < N_UPA) { const int kb = r / 64, nb = r % 64, n0 = 32 * nb, k0 = 64 * kb; src = w_upb + (size_t)k0 * 2048 + n0; ldw = 2048; dst = WUP + (size_t)n0 * 2048 + 768 + k0; ldk = 2048; }
        else if ((r -= N_UPA) < N_UPC) { const int kb = r / 64, nb = r % 64, n0 = 32 * nb, k0 = 64 * kb; src = w_upc + (size_t)k0 * 2048 + n0; ldw = 2048; dst = WUP + (size_t)n0 * 2048 + 1536 + k0; ldk = 2048; }
        else if ((r -= N_UPC) < N_O) { const int kb = r / 64, nb = r % 64, n0 = 32 * nb, k0 = 64 * kb; src = w_o + (size_t)k0 * 2048 + n0; ldw = 2048; dst = WO + (size_t)n0 * 2048 + k0; ldk = 2048; }
        else if ((r -= N_O) < 2 * N_E) { const int which = r / N_E; r -= which * N_E; const int e = r / 512, q = r % 512, kb = q / 16, nb = q % 16, n0 = 32 * nb, k0 = 64 * kb;
            src = (which ? w3 : w1) + (size_t)e * 2048 * 512 + (size_t)k0 * 512 + n0; ldw = 512;
            const int dr = e * 1024 + (n0 >> 7) * 256 + (n0 & 127) + which * 128; dst = W13 + (size_t)dr * 2048 + k0; ldk = 2048; }
        else if ((r -= 2 * N_E) < N_E) { const int e = r / 512, q = r % 512, kb = q / 64, nb = q % 64, n0 = 32 * nb, k0 = 64 * kb;
            src = w2 + (size_t)e * 512 * 2048 + (size_t)k0 * 2048 + n0; ldw = 2048; dst = W2T + (size_t)(e * 2048 + n0) * 512 + k0; ldk = 512; }
        else { r -= N_E; kind = 3; }
        if (kind == 0) transpose_item<32>(src, ldw, dst, ldk, scr, lane);
        else if (kind == 1) transpose_item<16>(src, ldw, dst, ldk, scr, lane);
        else if (kind == 2) { GAS v4u* p = (GAS v4u*)(WA + (size_t)(848 + r) * 2048) + lane * 4; const v4u z = {0u, 0u, 0u, 0u}; p[0] = z; p[1] = z; p[2] = z; p[3] = z; }
        else { const int idx = r * 64 + lane, j = idx & 7, lm = (idx >> 3) & 63, sc = idx >> 9, c = sc % 3, S = sc / 3, k = 32 * S + 8 * (lm >> 4) + j, col = 16 * c + (lm & 15);
            const float wv_ = col < 32 ? w_rt[k * 32 + col] : (col < 36 ? w_grp[k * 4 + (col - 32)] : 0.f); const unsigned hb = f2bf(wv_); const unsigned lb = f2bf(wv_ - bf2f(hb));
            bf16* WRb = (bf16*)WR; WRb[((sc * 2 + 0) * 64 + lm) * 8 + j] = (bf16)hb; WRb[((sc * 2 + 1) * 64 + lm) * 8 + j] = (bf16)lb; }
    }
}
__device__ __forceinline__ void conv_layer(Frame& F, const Args& a, int l) { conv_items(F, a, l, F.bid * 8 + F.wave, F.G * 8, CONV_REST, CONV_E_LO); }
__device__ __forceinline__ void prologue(Frame& F, const Args& a) {
    LAS float* scr = (LAS float*)(F.lds + F.wave * 16384);
    const int gw = F.bid * 8 + F.wave, NGW = F.G * 8, lane = F.lane;
    bf16* HB = WSP(bf16, WS_HB); bf16* MEMB = WSP(bf16, WS_MEMB); bf16* WMEM = WSP(bf16, WS_WMEM);
    const float* x = (a.in[I_X] + F.z); const float* mem = (a.in[I_MEM] + F.z); const float* wm = (a.in[I_WMEMKV] + F.z);
    const long NX8 = (long)T * DM / 8, NM8 = 256L * DM / 8;
    for (long ib = (long)gw * 64 + lane; ib < NX8 + NM8; ib += 4L * NGW * 64) {
        f32x4 v0[4], v1[4];
#pragma unroll
        for (int u = 0; u < 4; ++u) { long i = ib + (long)u * NGW * 64; i = i < NX8 + NM8 ? i : ib; const bool inx = i < NX8; const long j = inx ? i : i - NX8; const float* s = (inx ? x : mem) + j * 8;
            v0[u] = *(const GAS f32x4*)s; v1[u] = *(const GAS f32x4*)(s + 4); }
#pragma unroll
        for (int u = 0; u < 4; ++u) { const long i = ib + (long)u * NGW * 64; if (i < NX8 + NM8) { const bool inx = i < NX8; const long j = inx ? i : i - NX8;
            v4u o; o.x = cvtpk(v0[u][0], v0[u][1]); o.y = cvtpk(v0[u][2], v0[u][3]); o.z = cvtpk(v1[u][0], v1[u][1]); o.w = cvtpk(v1[u][2], v1[u][3]);
            *(GAS v4u*)((inx ? HB : MEMB) + j * 8) = o; } }
    }
    for (int it = gw; it < 32 * 32; it += NGW) { const int kb = it / 32, nb = it % 32, n0 = 32 * nb, k0 = 64 * kb;
        transpose_item<32>(wm + (size_t)k0 * 1024 + n0, 1024, WMEM + (size_t)n0 * 2048 + k0, 2048, scr, lane); }
}

__device__ __forceinline__ void phase_norms(Frame& F, const Args& a, int l) {
    const int gw = F.bid * 8 + F.wave, NGW = F.G * 8, lane = F.lane;
    const bf16* PROJ = WSP(bf16, WS_PROJ); bf16* CQN = WSP(bf16, WS_CQN); bf16* CKVN = WSP(bf16, WS_CKVN); bf16* KIDX = WSP(bf16, WS_KIDX); float* WIDX = WSP(float, WS_WIDX); float* KMEAN = WSP(float, WS_KMEAN);
    const float* gcq = (a.in[I_GCQ] + F.z) + l * 512; const float* gckv = (a.in[I_GCKV] + F.z) + l * 256; const float* gk = (a.in[I_GKIDX] + F.z) + l * 64; const float* bk = (a.in[I_BKIDX] + F.z) + l * 64;
    { LAS float* red = (LAS float*)F.lds;
      for (int task = F.bid; task < 32 * 6; task += F.G) {
        const int n = task / 6, g = task % 6, rsub = lane >> 4, co = lane & 15;
        float s[8] = {0, 0, 0, 0, 0, 0, 0, 0};
#pragma unroll
        for (int i = 0; i < 8; ++i) { const v4u w = *(const GAS v4u*)(PROJ + (size_t)(n * 256 + F.wave * 32 + 4 * i + rsub) * NPROJ + PJ_KB + g * 128 + 8 * co);
            s[0] += bflo(w.x); s[1] += bfhi(w.x); s[2] += bflo(w.y); s[3] += bfhi(w.y); s[4] += bflo(w.z); s[5] += bfhi(w.z); s[6] += bflo(w.w); s[7] += bfhi(w.w); }
#pragma unroll
        for (int j = 0; j < 8; ++j) { s[j] += __shfl_xor(s[j], 16); s[j] += __shfl_xor(s[j], 32); }
        if (rsub == 0) {
#pragma unroll
            for (int j = 0; j < 8; ++j) red[F.wave * 128 + 8 * co + j] = s[j]; }
        __syncthreads();
        if (F.tid < 128) { float t = 0.f;
#pragma unroll
            for (int ww = 0; ww < 8; ++ww) t += red[ww * 128 + F.tid];
            KMEAN[(size_t)n * 768 + g * 128 + F.tid] = t * (1.f / 256.f); }
        __syncthreads();
      } }
    for (int tb = gw; tb < T; tb += 4 * NGW) {
        v4u wq[4]; v2u wk[4]; float vk[4], vw[4];
#pragma unroll
        for (int u = 0; u < 4; ++u) { const int t = tb + u * NGW < T ? tb + u * NGW : tb; const bf16* row = PROJ + (size_t)t * NPROJ;
            wq[u] = *(const GAS v4u*)(row + 8 * lane); wk[u] = *(const GAS v2u*)(row + 512 + 4 * lane); vk[u] = bf2f(row[768 + lane]); vw[u] = bf2f(row[832 + (lane & 15)]); }
#pragma unroll
        for (int u = 0; u < 4; ++u) { const int t = tb + u * NGW; if (t < T) {
          { const v4u w = wq[u]; float v[8] = {bflo(w.x), bfhi(w.x), bflo(w.y), bfhi(w.y), bflo(w.z), bfhi(w.z), bflo(w.w), bfhi(w.w)};
            float ss = 0.f;
#pragma unroll
            for (int j = 0; j < 8; ++j) ss += v[j] * v[j];
            const float rs = 1.0f / sqrtf(wave_sum(ss) * (1.f / 512.f) + LN_EPS);
            const f32x4 g0 = *(const GAS f32x4*)(gcq + 8 * lane), g1 = *(const GAS f32x4*)(gcq + 8 * lane + 4);
            v4u o; o.x = cvtpk(v[0] * rs * g0[0], v[1] * rs * g0[1]); o.y = cvtpk(v[2] * rs * g0[2], v[3] * rs * g0[3]); o.z = cvtpk(v[4] * rs * g1[0], v[5] * rs * g1[1]); o.w = cvtpk(v[6] * rs * g1[2], v[7] * rs * g1[3]);
            *(GAS v4u*)(CQN + (size_t)t * 512 + 8 * lane) = o; }
          { const v2u w = wk[u]; float v[4] = {bflo(w.x), bfhi(w.x), bflo(w.y), bfhi(w.y)};
            float ss = (v[0] * v[0] + v[1] * v[1]) + (v[2] * v[2] + v[3] * v[3]);
            const float rs = 1.0f / sqrtf(wave_sum(ss) * (1.f / 256.f) + LN_EPS);
            const f32x4 g0 = *(const GAS f32x4*)(gckv + 4 * lane);
            v2u o; o.x = cvtpk(v[0] * rs * g0[0], v[1] * rs * g0[1]); o.y = cvtpk(v[2] * rs * g0[2], v[3] * rs * g0[3]);
            *(GAS v2u*)(CKVN + (size_t)t * 256 + 4 * lane) = o; }
          { const float v = vk[u]; const float mu = wave_sum(v) * (1.f / 64.f); const float d = v - mu; const float var = wave_sum(d * d) * (1.f / 64.f);
            KIDX[(size_t)t * 64 + lane] = (bf16)f2bf(d * (1.0f / sqrtf(var + LN_EPS)) * gk[lane] + bk[lane]); }
          if (lane < 16) WIDX[(size_t)t * 16 + lane] = vw[u] * 0.25f; } }
    }
}

__device__ __forceinline__ void indexer_item(Frame& F, int item) {
    int tid = F.tid; asm volatile("" : "+v"(tid));
    const int lane = tid & 63, w = F.wave, hi = lane >> 5, kl = lane & 31;
    const bf16* QAI = WSP(bf16, WS_QAI); const bf16* KIDX = WSP(bf16, WS_KIDX); const float* WIDX = WSP(float, WS_WIDX); unsigned* MASKA = WSP(unsigned, WS_MASKA);
    const int t0 = item * 16, myq = t0 + 2 * w + hi;
    const GAS char* SCb = (const GAS char*)WSP(float, WS_SC); unsigned scoff; { const unsigned b_ = myq >> 6, r_ = myq & 63; scoff = (2048u * b_ * (b_ + 1u) + 64u * r_ * (b_ + 1u)) * 4u; }
    LAS unsigned char* reg = F.lds + (2 * w) * 8192;
    LAS unsigned char* myreg = reg + hi * 8192;
    LAS unsigned char* KST = F.lds + 131072;
    bf16x8 af[4];
    { const int rho = kl, qsel = (rho >> 2) & 1, head = (rho & 3) + 4 * (rho >> 3);
      const bf16* src = QAI + (size_t)(t0 + 2 * w + qsel) * NQAI + 768 + head * 64 + 8 * hi;
#pragma unroll
      for (int c = 0; c < 4; ++c) af[c] = *(const GAS bf16x8*)(src + 16 * c); }
    float wv[16];
    { const GAS f32x4* wp = (const GAS f32x4*)(WIDX + (size_t)myq * 16);
#pragma unroll
      for (int j = 0; j < 4; ++j) { const f32x4 v = wp[j]; wv[4 * j] = v[0]; wv[4 * j + 1] = v[1]; wv[4 * j + 2] = v[2]; wv[4 * j + 3] = v[3]; } }
    const int nch = (t0 + 16 + 63) >> 6;
    const int skey = tid >> 3, sch = tid & 7;
    const int sdst = skey * 128 + ((sch ^ ((skey >> 1) & 7)) << 4);
    int bstar = 0, nab = 0; bool allq = false;
#ifndef DBG_IDX_DUMMY
#define DBG_IDX_DUMMY 0
#endif
    {
        TSUB_START(1);
        { const v4u z = {0u, 0u, 0u, 0u};
#pragma unroll
          for (int i = 0; i < 16; ++i) *(LAS v4u*)(reg + (i * 64 + lane) * 16) = z; }
        const GAS char* kgb = (const GAS char*)KIDX; const unsigned kgo = (unsigned)(skey * 64 + sch * 8) * 2u;
#define KG(c) (*(const GAS v4u*)(kgb + (kgo + (unsigned)(c) * 8192u)))
        v4u R0 = {0u, 0u, 0u, 0u}, R1 = R0;
        { const v4u k0 = KG(0); R1 = KG(1 < nch ? 1 : nch - 1); R0 = KG(2 < nch ? 2 : nch - 1); *(LAS v4u*)(KST + sdst) = k0; }
        __syncthreads();
        int fo[4];
#pragma unroll
        for (int c = 0; c < 4; ++c) fo[c] = kl * 128 + (((2 * c + hi) ^ ((kl >> 1) & 7)) << 4);
        f32x16 AC[2][2];
#define IDX_POST(P, MM) do { \
            _Pragma("unroll") for (int tile = 0; tile < 2; ++tile) { float ps[4] = {0.f, 0.f, 0.f, 0.f}; \
                _Pragma("unroll") for (int r = 0; r < 16; ++r) { const float av = AC[P][tile][r]; const int xi = __float_as_int(av); const float rl = __int_as_float(xi > 0 ? xi : 0); \
                    ps[r & 3] = fmaf(rl, wv[r], ps[r & 3]); } \
                const float score = (ps[0] + ps[1]) + (ps[2] + ps[3]); \
                const int row = 32 * tile + kl; const int key = 64 * (MM) + row; const bool valid = key <= myq; \
                const unsigned bits = __float_as_uint(score); const unsigned u = bits ^ ((unsigned)((int)bits >> 31) | 0x80000000u); const int bin = (int)(u >> 20); \
                *(GAS float*)(SCb + (scoff + 4u * (unsigned)key)) = score; \
                if (valid) __hip_atomic_fetch_add((LAS unsigned*)(myreg + ((bin >> 1) << 2)), 1u << ((bin & 1) << 4), __ATOMIC_RELAXED, __HIP_MEMORY_SCOPE_WORKGROUP); \
            } } while (0)
#define IDX_STEP(J, RW) do { const int mm_ = m + (J); if (mm_ < nch) { \
            const LAS unsigned char* kb_ = KST + ((J) & 1) * 8192; bf16x8 FR[2][4]; \
            _Pragma("unroll") for (int tile = 0; tile < 2; ++tile) _Pragma("unroll") for (int c = 0; c < 4; ++c) FR[tile][c] = *(const LAS bf16x8*)(kb_ + fo[c] + tile * 4096); \
            asm volatile("s_waitcnt lgkmcnt(0)" ::: "memory"); SBAR(); \
            AC[(J) & 1][0] = __builtin_amdgcn_mfma_f32_32x32x16_bf16(af[0], FR[0][0], f32x16{}, 0, 0, 0); AC[(J) & 1][1] = __builtin_amdgcn_mfma_f32_32x32x16_bf16(af[0], FR[1][0], f32x16{}, 0, 0, 0); \
            _Pragma("unroll") for (int c = 1; c < 4; ++c) { AC[(J) & 1][0] = __builtin_amdgcn_mfma_f32_32x32x16_bf16(af[c], FR[0][c], AC[(J) & 1][0], 0, 0, 0); \
                AC[(J) & 1][1] = __builtin_amdgcn_mfma_f32_32x32x16_bf16(af[c], FR[1][c], AC[(J) & 1][1], 0, 0, 0); } \
            SBAR(); \
            if (mm_ >= 1) IDX_POST(((J) + 1) & 1, mm_ - 1); \
            if (mm_ + 1 < nch) *(LAS v4u*)(KST + (((J) + 1) & 1) * 8192 + sdst) = RW; \
            RW = KG(mm_ + 3 < nch ? mm_ + 3 : nch - 1); \
            __syncthreads(); } } while (0)
        for (int m = 0; m < nch; m += 2) { IDX_STEP(0, R1); IDX_STEP(1, R0); }
        if ((nch - 1) & 1) IDX_POST(1, nch - 1); else IDX_POST(0, nch - 1);
#undef IDX_POST
#undef IDX_STEP
#undef KG
        TSUB_STOP(1); TSUB_START(2);
        {
            int bsq[2], nbq[2]; bool alq[2];
#pragma unroll
            for (int q = 0; q < 2; ++q) {
                const LAS unsigned* hw = (const LAS unsigned*)(reg + q * 8192) + 32 * lane;
                unsigned wd[32]; unsigned s = 0;
#pragma unroll
                for (int i = 0; i < 8; ++i) { const v4u v = *(const LAS v4u*)(hw + 4 * i); wd[4 * i] = v.x; wd[4 * i + 1] = v.y; wd[4 * i + 2] = v.z; wd[4 * i + 3] = v.w; }
#pragma unroll
                for (int i = 0; i < 32; ++i) s += (wd[i] & 0xffffu) + (wd[i] >> 16);
                unsigned v = s;
#pragma unroll
                for (int off = 1; off < 64; off <<= 1) { const unsigned tt = __shfl_down(v, off); if (lane + off < 64) v += tt; }
                const unsigned sufx = v - s; const unsigned total = __builtin_amdgcn_readfirstlane(v);
                int nbel = 0; int fn = (int)sufx; int cum = (int)sufx;
#pragma unroll
                for (int i = 31; i >= 0; --i) {
                    cum += (int)(wd[i] >> 16);     { const int mk = (cum - 256) >> 31; nbel -= mk; const int cm = cum & mk; fn = cm > fn ? cm : fn; }
                    cum += (int)(wd[i] & 0xffffu); { const int mk = (cum - 256) >> 31; nbel -= mk; const int cm = cum & mk; fn = cm > fn ? cm : fn; }
                }
                const int fb = 64 * lane + 63 - nbel;
                const unsigned long long bm = __ballot(sufx < 256u && v >= 256u);
                const int lstar = bm ? (int)__builtin_ctzll(bm) : 0;
                bsq[q] = __builtin_amdgcn_readlane(fb, lstar); nbq[q] = __builtin_amdgcn_readlane(fn, lstar); alq[q] = total <= 256u;
            }
            bstar = hi ? bsq[1] : bsq[0]; nab = hi ? nbq[1] : nbq[0]; allq = hi ? alq[1] : alq[0];
        }
        TSUB_STOP(2); TSUB_START(3);
        { const v4u z = {0u, 0u, 0u, 0u};
#pragma unroll
          for (int i = 0; i < 16; ++i) *(LAS v4u*)(reg + (i * 64 + lane) * 16) = z; }
        asm volatile("s_waitcnt vmcnt(0)" ::: "memory");
        { const int ntile = 2 * nch;
          auto p1_load = [&](float (&sv)[16], int tb) {
#pragma unroll
              for (int j = 0; j < 16; ++j) { const int tt = tb + j < ntile ? tb + j : ntile - 1; sv[j] = __builtin_nontemporal_load((const GAS float*)(SCb + (scoff + 4u * (unsigned)(32 * tt + kl)))); } };
          auto p1_proc = [&](float (&sv)[16], int tb) {
#pragma unroll
              for (int j = 0; j < 16; ++j) if (tb + j < ntile) {
                  const int key = 32 * (tb + j) + kl; const bool valid = key <= myq; const float score = sv[j];
                  const unsigned bits = __float_as_uint(score); const unsigned u = bits ^ ((unsigned)((int)bits >> 31) | 0x80000000u); const int bin = (int)(u >> 20);
                  const bool above = valid && (allq || bin > bstar), cand = valid && !allq && bin == bstar;
                  const unsigned long long bal = __ballot(above);
                  if (kl == 0) *(LAS unsigned*)(myreg + 6144 + (tb + j) * 4) = hi ? (unsigned)(bal >> 32) : (unsigned)bal;
                  if (__any(cand)) { if (cand) { const unsigned slot = __hip_atomic_fetch_add((LAS unsigned*)(myreg + 7168), 1u, __ATOMIC_RELAXED, __HIP_MEMORY_SCOPE_WORKGROUP);
                      if (slot < 768u) { v2u e; e.x = ~(unsigned)key; e.y = u; *(LAS v2u*)(myreg + slot * 8) = e; } } }
              } };
          float sa[16], sb[16];
          p1_load(sa, 0);
          for (int tb = 0; tb < ntile; tb += 32) { p1_load(sb, tb + 16); p1_proc(sa, tb); p1_load(sa, tb + 32); p1_proc(sb, tb + 16); } }
        TSUB_STOP(3); TSUB_START(4);
        {
            if (kl == 0) *(LAS int*)(myreg + 7172) = allq ? 0 : 256 - nab;
            __syncthreads();
            int f = w;
#pragma nounroll
            for (int q = 0; q < 16; ++q) {
                LAS unsigned char* rq = F.lds + q * 8192;
                unsigned nc = *(LAS unsigned*)(rq + 7168); nc = nc > 768u ? 768u : nc; nc = __builtin_amdgcn_readfirstlane(nc);
                const int need = __builtin_amdgcn_readfirstlane(*(LAS int*)(rq + 7172));
                const int nck = need > 0 ? (int)((nc + 63u) >> 6) : 0;
                for (; f < nck; f += 8) { const unsigned i = (unsigned)f * 64u + lane; const bool act = i < nc;
                    unsigned long long me = 0ull; if (act) me = *(LAS unsigned long long*)(rq + i * 8);
                    int rank = 0;
                    unsigned j = 0;
                    for (; j + 4 <= nc; j += 4) { const unsigned long long o0 = *(LAS unsigned long long*)(rq + j * 8), o1 = *(LAS unsigned long long*)(rq + j * 8 + 8), o2 = *(LAS unsigned long long*)(rq + j * 8 + 16), o3 = *(LAS unsigned long long*)(rq + j * 8 + 24);
                        rank += (o0 > me ? 1 : 0) + (o1 > me ? 1 : 0) + (o2 > me ? 1 : 0) + (o3 > me ? 1 : 0); }
                    for (; j < nc; ++j) { const unsigned long long o = *(LAS unsigned long long*)(rq + j * 8); rank += o > me ? 1 : 0; }
                    const unsigned key = ~(unsigned)me;
                    if (act && rank < need) __hip_atomic_fetch_or((LAS unsigned*)(rq + 6144 + ((key >> 5) << 2)), 1u << (key & 31u), __ATOMIC_RELAXED, __HIP_MEMORY_SCOPE_WORKGROUP);
                }
                f -= nck;
            }
            __syncthreads();
#pragma unroll
            for (int q = 0; q < 2; ++q) {
                const v4u mrow = *(LAS v4u*)(reg + q * 8192 + 6144 + lane * 16);
                *(GAS v4u*)(MASKA + (size_t)(t0 + 2 * w + q) * 256 + 4 * lane) = mrow;
            }
        }
        TSUB_STOP(4);
    }
    __syncthreads();
}
__device__ __forceinline__ void phase_indexer(Frame& F) {
    for (int p = F.bid; p < 256; p += F.G) { indexer_item(F, 511 - p); indexer_item(F, p); }
}

__device__ __forceinline__ void phase_moba_gate(Frame& F) {
    const int lane = F.lane, tk = lane & 31, half = lane >> 5;
    const bf16* PROJ = WSP(bf16, WS_PROJ); const float* KMEAN = WSP(float, WS_KMEAN); unsigned* PICK = WSP(unsigned, WS_PICK); int* CNT2 = WSP(int, WS_CNT2);
    for (int item = F.wave * F.G + F.bid; item < 256 * 6; item += 8 * F.G) {
        const int grp = item / 6, h = item - grp * 6, t = grp * 32 + tk, c = grp >> 3;
        unsigned m0 = 0u, m1 = 0u, m2 = 0u;
        if (c > 0) {
            float qv[64];
            { const GAS v4u* qp = (const GAS v4u*)(PROJ + (size_t)t * NPROJ + PJ_QB + h * 128 + 64 * half);
#pragma unroll
              for (int i = 0; i < 8; ++i) { const v4u w = qp[i]; qv[8 * i] = bflo(w.x); qv[8 * i + 1] = bfhi(w.x); qv[8 * i + 2] = bflo(w.y); qv[8 * i + 3] = bfhi(w.y); qv[8 * i + 4] = bflo(w.z); qv[8 * i + 5] = bfhi(w.z); qv[8 * i + 6] = bflo(w.w); qv[8 * i + 7] = bfhi(w.w); } }
            float b0 = -__builtin_inff(), b1 = b0, b2 = b0;
            const float* kmh = KMEAN + h * 128 + 64 * half;
            f32x4 ka[16], kb[16];
#define GATE_LOAD(K_, n_) do { const GAS f32x4* kp_ = (const GAS f32x4*)(kmh + (size_t)((n_) < c ? (n_) : c - 1) * 768); _Pragma("unroll") for (int i = 0; i < 16; ++i) K_[i] = kp_[i]; } while (0)
#define GATE_SCORE(K_, n_) do { if ((n_) < c) { float g0 = 0.f, g1 = 0.f, g2 = 0.f, g3 = 0.f; \
                _Pragma("unroll") for (int i = 0; i < 16; ++i) { g0 = fmaf(qv[4 * i], K_[i][0], g0); g1 = fmaf(qv[4 * i + 1], K_[i][1], g1); g2 = fmaf(qv[4 * i + 2], K_[i][2], g2); g3 = fmaf(qv[4 * i + 3], K_[i][3], g3); } \
                float g = (g0 + g1) + (g2 + g3); g += __shfl_xor(g, 32); const unsigned bit = 1u << (n_); \
                if (g > b0) { b2 = b1; m2 = m1; b1 = b0; m1 = m0; b0 = g; m0 = bit; } else if (g > b1) { b2 = b1; m2 = m1; b1 = g; m1 = bit; } else if (g > b2) { b2 = g; m2 = bit; } } } while (0)
            GATE_LOAD(ka, 0);
            for (int n = 0; n < c; n += 2) { GATE_LOAD(kb, n + 1); GATE_SCORE(ka, n); GATE_LOAD(ka, n + 2); GATE_SCORE(kb, n + 1); }
#undef GATE_LOAD
#undef GATE_SCORE
        }
        const unsigned n0 = m0 ? (unsigned)__builtin_ctz(m0) : 255u, n1 = m1 ? (unsigned)__builtin_ctz(m1) : 255u, n2 = m2 ? (unsigned)__builtin_ctz(m2) : 255u;
        if (half == 0) PICK[(size_t)t * 6 + h] = n0 | (n1 << 8) | (n2 << 16);
        int cn = 0;
        for (int n = 0; n < c; ++n) { const unsigned long long b = __ballot(half == 0 && (n0 == (unsigned)n || n1 == (unsigned)n || n2 == (unsigned)n)); if (lane == n) cn = (int)__builtin_popcountll(b); }
        if (lane < 32) CNT2[(h * 256 + grp) * 32 + lane] = cn;
    }
}
__device__ __forceinline__ void phase_moba_lists(Frame& F) {
    const int lane = F.lane, tk = lane & 31, half = lane >> 5;
    const unsigned* PICK = WSP(unsigned, WS_PICK); const int* CNT2 = WSP(int, WS_CNT2); unsigned* LST = WSP(unsigned, WS_LST); int* LEN = WSP(int, WS_LEN);
    for (int item = F.wave * F.G + F.bid; item < 256 * 6; item += 8 * F.G) {
        const int grp = item / 6, h = item - grp * 6, t = grp * 32 + tk, c = grp >> 3;
        int before = 0, total = 0;
        { const int* cp = CNT2 + (h * 256 + 128 * half) * 32 + tk;
#pragma unroll 32
          for (int g = 0; g < 128; ++g) { const int v = cp[g * 32]; total += v; before += (128 * half + g < grp) ? v : 0; } }
        before += __shfl_xor(before, 32); total += __shfl_xor(total, 32);
        if (grp == 0 && lane < 32) LEN[h * 32 + lane] = total;
        if (c > 0) {
            const unsigned pk = PICK[(size_t)t * 6 + h]; const unsigned n0 = pk & 255u, n1 = (pk >> 8) & 255u, n2 = (pk >> 16) & 255u;
            int r0 = 0, r1 = 0, r2 = 0; const unsigned long long lt = (1ull << tk) - 1ull;
            for (int n = 0; n < c; ++n) { const unsigned long long b = __ballot(half == 0 && (n0 == (unsigned)n || n1 == (unsigned)n || n2 == (unsigned)n));
                const int rk = __builtin_amdgcn_readlane(before, n) + (int)__builtin_popcountll(b & lt);
                if (n0 == (unsigned)n) r0 = rk; if (n1 == (unsigned)n) r1 = rk; if (n2 == (unsigned)n) r2 = rk; }
            if (half == 0) { const int hb = h * LCAP;
                if (n0 < 32u) LST[hb + 256 * (31 * (int)n0 - (int)n0 * ((int)n0 - 1) / 2) + r0] = (unsigned)t | (1u << 16);
                if (n1 < 32u) LST[hb + 256 * (31 * (int)n1 - (int)n1 * ((int)n1 - 1) / 2) + r1] = (unsigned)t | (2u << 16);
                if (n2 < 32u) LST[hb + 256 * (31 * (int)n2 - (int)n2 * ((int)n2 - 1) / 2) + r2] = (unsigned)t | (3u << 16); }
        }
    }
}
__device__ __forceinline__ void phase_attn_merge(Frame& F) {
    const int gw = F.bid * 8 + F.wave, NGW = F.G * 8, lane = F.lane;
    const unsigned* PICK = WSP(unsigned, WS_PICK); const bf16* PO = WSP(bf16, WS_PO); const float* PML = WSP(float, WS_PML); const bf16* PO2 = WSP(bf16, WS_PO2); const float* PML2 = WSP(float, WS_PML2); bf16* OATT = WSP(bf16, WS_OATT);
    for (int tp = gw; tp < T / 2; tp += NGW) {
#pragma unroll 3
        for (int i = 0; i < 6; ++i) { const int p = lane + 64 * i, t = 2 * tp + p / 192, wi = p % 192, hx = wi >> 4, d8 = wi & 15; const bool dsa = hx < 6; const int h = dsa ? hx : hx - 6;
            unsigned pk = 0xffffffu; if (!dsa) pk = PICK[(size_t)t * 6 + h];
            const int ns = (t >> 11) + 1;
            const bool val[4] = {true, dsa ? 1 < ns : (pk & 255u) < 32u, dsa ? 2 < ns : ((pk >> 8) & 255u) < 32u, dsa ? 3 < ns : ((pk >> 16) & 255u) < 32u};
            const bf16* pob = dsa ? PO2 : PO; const float* pmb = dsa ? PML2 : PML;
            float m[4], lv[4]; v4u po[4];
#pragma unroll
            for (int sl = 0; sl < 4; ++sl) { const size_t r = (size_t)sl * T + t; const f32x2 ml = *(const GAS f32x2*)(pmb + (r * 6 + h) * 2); m[sl] = val[sl] ? ml.x : -3e38f; lv[sl] = val[sl] ? ml.y : 0.f;
                const v4u x = *(const GAS v4u*)(pob + r * 768 + h * 128 + 8 * d8); const v4u z = {0u, 0u, 0u, 0u}; po[sl] = val[sl] ? x : z; }
            const float M = fmaxf(fmaxf(m[0], m[1]), fmaxf(m[2], m[3]));
            float w[4], W = 0.f;
#pragma unroll
            for (int sl = 0; sl < 4; ++sl) { w[sl] = val[sl] ? __builtin_amdgcn_exp2f(m[sl] - M) * lv[sl] : 0.f; W += w[sl]; }
            const float inv = 1.f / W;
            float o[8] = {0, 0, 0, 0, 0, 0, 0, 0};
#pragma unroll
            for (int sl = 0; sl < 4; ++sl) { const float ws_ = w[sl] * inv;
                o[0] = fmaf(ws_, bflo(po[sl].x), o[0]); o[1] = fmaf(ws_, bfhi(po[sl].x), o[1]); o[2] = fmaf(ws_, bflo(po[sl].y), o[2]); o[3] = fmaf(ws_, bfhi(po[sl].y), o[3]);
                o[4] = fmaf(ws_, bflo(po[sl].z), o[4]); o[5] = fmaf(ws_, bfhi(po[sl].z), o[5]); o[6] = fmaf(ws_, bflo(po[sl].w), o[6]); o[7] = fmaf(ws_, bfhi(po[sl].w), o[7]); }
            v4u ob; ob.x = cvtpk(o[0], o[1]); ob.y = cvtpk(o[2], o[3]); ob.z = cvtpk(o[4], o[5]); ob.w = cvtpk(o[6], o[7]);
            *(GAS v4u*)(OATT + (size_t)t * 2048 + hx * 128 + 8 * d8) = ob; }
    }
}

constexpr int CONV_IPQ = 128, CONV_NQE = CONV_E_N / CONV_IPQ, CONV_NQR = (CONV_REST + CONV_IPQ - 1) / CONV_IPQ;
__device__ __forceinline__ void phase_attention(Frame& F, const Args& a, int l, int rep) {
    const GAS bf16* PROJ = (const GAS bf16*)WSP(bf16, WS_PROJ); const GAS bf16* QAI = (const GAS bf16*)WSP(bf16, WS_QAI); const GAS bf16* KVA = (const GAS bf16*)WSP(bf16, WS_KVA); const GAS bf16* MKV = (const GAS bf16*)WSP(bf16, WS_MKV);
    GAS bf16* OATT = (GAS bf16*)WSP(bf16, WS_OATT); const GAS unsigned* MASKA = (const GAS unsigned*)WSP(unsigned, WS_MASKA);
    GAS bf16* PO = (GAS bf16*)WSP(bf16, WS_PO); GAS float* PML = (GAS float*)WSP(float, WS_PML); const GAS unsigned* LST = (const GAS unsigned*)WSP(unsigned, WS_LST);
    LAS int* cum = (LAS int*)(F.lds + LDS_BYTES - 256 - 2048); LAS int* lenl = cum + 256;
    { const int* LEN = WSP(int, WS_LEN);
      if (F.wave == 0) { const int l3 = 3 * F.lane; const int e0 = LEN[l3], e1 = LEN[l3 + 1], e2 = LEN[l3 + 2]; const int v0 = (e0 + 255) >> 8, v1 = (e1 + 255) >> 8, v2 = (e2 + 255) >> 8;
          const int s_ = v0 + v1 + v2; int inc = s_;
#pragma unroll
          for (int o = 1; o < 64; o <<= 1) { const int u = __shfl_up(inc, o); if (F.lane >= o) inc += u; }
          const int exc = inc - s_; cum[l3] = exc; cum[l3 + 1] = exc + v0; cum[l3 + 2] = exc + v0 + v1; lenl[l3] = e0; lenl[l3 + 1] = e1; lenl[l3 + 2] = e2; if (F.lane == 63) cum[192] = inc; }
      __syncthreads(); }
    const int U = __builtin_amdgcn_readfirstlane(cum[192]);
    gu32* head = F.ctl + CW_AQ + 64 * l + 32 * rep;
    for (;;) {
        if (F.tid == 0) F.MISC[16] = __hip_atomic_fetch_add(head, 1u, RLX_AGENT);
        __syncthreads();
        const int i = __builtin_amdgcn_readfirstlane((int)F.MISC[16]);
        __syncthreads();
        const int nconv = CONV_NQE + ((l + 1 < NLAYER) ? CONV_NQR : 0), NS = 576, NX = NS + (nconv > 480 ? nconv - 480 : 0), NB = NX + 192, NC = NB + 384, ND = NC + U, NE = ND + 128;
        if (i >= NE) break;
        const int slot = i >> 1, sub = i & 1;
        const bool cvA = i < NS && sub, cvX = i >= NS && i < NX, cvC = i >= NB && i < NC && ((i - NB) & 1);
        if (cvA || cvX || cvC) { int q = cvA ? slot : (cvX ? 480 + (i - NS) : 288 + ((i - NB) >> 1)), lc = l, b_ = CONV_E_LO, e_ = CONV_E_LO + CONV_E_N, hole = 0x7fffffff;
            if (q >= nconv) continue;
            if (q >= CONV_NQE) { q -= CONV_NQE; lc = l + 1; b_ = 0; e_ = CONV_REST; hole = CONV_E_LO; }
            b_ += q * CONV_IPQ; e_ = b_ + CONV_IPQ < e_ ? b_ + CONV_IPQ : e_;
            { size_t z_ = 0; asm volatile("" : "+s"(z_)); F.z = z_; F.ws = a.ws + z_; int t_ = F.tid; asm volatile("" : "+v"(t_)); F.lane = t_ & 63; }
            TSUB_START(7); conv_items(F, a, lc, b_ + F.wave, 8, e_, hole); TSUB_STOP(7); continue; }
        int tl = F.tid; asm volatile("" : "+v"(tl));
        TSUB_START(6);
        if (i < NB) { int h, qb, seg, nt;
            if (i < NS) { h = slot % 6; const int f = slot / 6; nt = 32; if (f < 8) { qb = 8 + f; seg = 0; } else if (f < 24) { const int g = f - 8; qb = 16 + (g >> 1); seg = g & 1; } else { const int g = f - 24; qb = 24 + g / 3; seg = g - 3 * (g / 3); } }
            else { const int e6 = i - NX; h = e6 % 6; const int e = e6 / 6, r = 7 - (e >> 2); qb = r + 8 * (e & 3); seg = qb >> 3; nt = 4 * (r + 1); }
            const int qpos0 = qb * 256, kofs = seg * 2048; const float sl = exp2f(-8.f * (float)(2 * h + 1) / 12.f) * LOG2E;
            att::attn_unit<4>(QAI + (size_t)qpos0 * NQAI + h * 128, NQAI, KVA + (size_t)kofs * NKVA + h * 128, KVA + (size_t)kofs * NKVA + 768 + h * 128, NKVA, nullptr, 0, nt, qpos0, sl, MASKA, nullptr, (LAS char*)F.lds, tl,
                              256, (GAS bf16*)WSP(bf16, WS_PO2), (GAS float*)WSP(float, WS_PML2), h, kofs); }
        else if (i < NC) { const int m = (i - NB) >> 1, qb = 31 - m / 6, h = m % 6, qpos0 = qb * 256; const float sl = exp2f(-8.f * (float)(2 * h + 2) / 12.f) * LOG2E;
            att::attn_unit<2>(PROJ + (size_t)qpos0 * NPROJ + PJ_QB + h * 128, NPROJ, PROJ + (size_t)qpos0 * NPROJ + PJ_KB + h * 128, PROJ + (size_t)qpos0 * NPROJ + PJ_VB + h * 128, NPROJ, nullptr, 0, 4, qpos0, sl, nullptr, nullptr, (LAS char*)F.lds, tl, 256, PO, PML, h); }
        else if (i < ND) { const int u = i - NC; int lo = 0, hi_ = 192;
#pragma nounroll
            while (hi_ - lo > 1) { const int mid = (lo + hi_) >> 1; if (__builtin_amdgcn_readfirstlane(cum[mid]) <= u) lo = mid; else hi_ = mid; }
            const int h = lo >> 5, n = lo & 31, k = u - __builtin_amdgcn_readfirstlane(cum[lo]), len = __builtin_amdgcn_readfirstlane(lenl[lo]), kpos0 = n * 256;
            const int nv = len - 256 * k < 256 ? len - 256 * k : 256; const float sl = exp2f(-8.f * (float)(2 * h + 2) / 12.f) * LOG2E;
            att::attn_unit<3>(PROJ + PJ_QB + h * 128, NPROJ, PROJ + (size_t)kpos0 * NPROJ + PJ_KB + h * 128, PROJ + (size_t)kpos0 * NPROJ + PJ_VB + h * 128, NPROJ, nullptr, 0, 4, kpos0, sl, nullptr, LST + (h * LCAP + 256 * (31 * n - n * (n - 1) / 2) + 256 * k), (LAS char*)F.lds, tl, nv, PO, PML, h); }
        else { const int m = i - ND, h = m & 3, qpos0 = (m >> 2) * 256;
            att::attn_unit<0>(PROJ + (size_t)qpos0 * NPROJ + PJ_QC + h * 128, NPROJ, MKV + h * 128, MKV + 512 + h * 128, 1024, OATT + (size_t)qpos0 * 2048 + 1536 + h * 128, 2048, 4, qpos0, 0.f, nullptr, nullptr, (LAS char*)F.lds, tl); }
        TSUB_STOP(6);
    }
}

__device__ __forceinline__ void phase_ln1_router(Frame& F, const Args& a, int l, int rep) {
    const int lane = F.lane, w = F.wave, tid = F.tid;
    const bf16* PRE = WSP(bf16, WS_PRE); bf16* X1B = WSP(bf16, WS_X1B); const float* WR = WSP(float, WS_WR + WDR(l)); int* ROUTE = WSP(int, WS_ROUTE); int* CNT = WSP(int, WS_CNT);
    const float* g1 = (a.in[I_LN1G] + F.z) + l * 2048; const float* b1 = (a.in[I_LN1B] + F.z) + l * 2048; const float* bgrp = (a.in[I_BGRP] + F.z) + l * 4; const float* brt = (a.in[I_BRT] + F.z) + l * 32;
    constexpr int XS = 2052, NIT = T / 16;
    constexpr int XP = 4112;
    LAS unsigned char* xh = F.lds; LAS unsigned char* xl = F.lds + 16 * XP; LAS float* part = (LAS float*)(F.lds + 32 * XP); LAS float* bias = part + 8 * 16 * 48;
    const GAS bf16x8* WRB = (const GAS bf16x8*)WSP(bf16, WS_WR + WDR(l));
    if (tid < 36) bias[tid] = tid < 32 ? brt[tid] : bgrp[tid - 32];
    const int ar = lane & 15, kq = lane >> 4;
    v4u va[4], vb[4];
    int it = F.bid;
    if (it < NIT) { const GAS v4u* xr = (const GAS v4u*)(PRE + (size_t)(it * 16 + 2 * w) * 2048) + lane;
#pragma unroll
        for (int j = 0; j < 4; ++j) va[j] = xr[64 * j];
#pragma unroll
        for (int j = 0; j < 4; ++j) vb[j] = xr[256 + 64 * j]; }
    auto ln_row = [&](const v4u (&vw)[4], int rl, int t) {
        f32x4 v[8]; float s = 0.f;
#pragma unroll
        for (int j = 0; j < 4; ++j) { v[2 * j] = (f32x4){bflo(vw[j].x), bfhi(vw[j].x), bflo(vw[j].y), bfhi(vw[j].y)}; v[2 * j + 1] = (f32x4){bflo(vw[j].z), bfhi(vw[j].z), bflo(vw[j].w), bfhi(vw[j].w)}; }
#pragma unroll
        for (int j = 0; j < 8; ++j) s += (v[j].x + v[j].y) + (v[j].z + v[j].w);
        const float mean = wave_sum(s) * (1.f / 2048.f); float s2 = 0.f;
#pragma unroll
        for (int j = 0; j < 8; ++j) { v[j] = v[j] - mean; s2 += (v[j].x * v[j].x + v[j].y * v[j].y) + (v[j].z * v[j].z + v[j].w * v[j].w); }
        const float rstd = 1.f / sqrtf(wave_sum(s2) * (1.f / 2048.f) + LN_EPS);
#pragma unroll
        for (int j = 0; j < 4; ++j) { const int col = 8 * lane + 512 * j;
            const f32x4 ga = *(const GAS f32x4*)(g1 + col), gb = *(const GAS f32x4*)(g1 + col + 4), ba = *(const GAS f32x4*)(b1 + col), bb = *(const GAS f32x4*)(b1 + col + 4);
            const f32x4 o0 = v[2 * j] * rstd * ga + ba, o1 = v[2 * j + 1] * rstd * gb + bb;
            v4u ob; ob.x = cvtpk(o0[0], o0[1]); ob.y = cvtpk(o0[2], o0[3]); ob.z = cvtpk(o1[0], o1[1]); ob.w = cvtpk(o1[2], o1[3]); *(GAS v4u*)(X1B + (size_t)t * 2048 + col) = ob;
            { float lo[8];
#pragma unroll
              for (int q = 0; q < 4; ++q) { lo[q] = o0[q] - bf2f(f2bf(o0[q])); lo[4 + q] = o1[q] - bf2f(f2bf(o1[q])); }
              v4u oh; oh.x = pk2(o0[0], o0[1]); oh.y = pk2(o0[2], o0[3]); oh.z = pk2(o1[0], o1[1]); oh.w = pk2(o1[2], o1[3]);
              v4u ol; ol.x = pk2(lo[0], lo[1]); ol.y = pk2(lo[2], lo[3]); ol.z = pk2(lo[4], lo[5]); ol.w = pk2(lo[6], lo[7]);
              *(LAS v4u*)(xh + rl * XP + col * 2) = oh; *(LAS v4u*)(xl + rl * XP + col * 2) = ol; } }
    };
    for (; it < NIT; it += F.G) {
        const int t0 = it * 16;
        ln_row(va, 2 * w, t0 + 2 * w); ln_row(vb, 2 * w + 1, t0 + 2 * w + 1);
        __syncthreads();
        { const int nx = it + F.G;
          if (nx < NIT) { const GAS v4u* xr = (const GAS v4u*)(PRE + (size_t)(nx * 16 + 2 * w) * 2048) + lane;
#pragma unroll
            for (int j = 0; j < 4; ++j) va[j] = xr[64 * j];
#pragma unroll
            for (int j = 0; j < 4; ++j) vb[j] = xr[256 + 64 * j]; } }
        asm volatile("" ::: "memory");
        { f32x4 acc[3] = {{0, 0, 0, 0}, {0, 0, 0, 0}, {0, 0, 0, 0}};
#pragma unroll 4
          for (int s = 0; s < 8; ++s) { const int S = 8 * w + s;
              const bf16x8 ah = *(const LAS bf16x8*)(xh + ar * XP + (32 * S + 8 * kq) * 2), al = *(const LAS bf16x8*)(xl + ar * XP + (32 * S + 8 * kq) * 2);
              const GAS bf16x8* wr = WRB + (size_t)S * 384 + lane;
              bf16x8 bh[3], bl[3];
#pragma unroll
              for (int c = 0; c < 3; ++c) { bh[c] = wr[c * 128]; bl[c] = wr[c * 128 + 64]; }
#pragma unroll
              for (int c = 0; c < 3; ++c) { acc[c] = __builtin_amdgcn_mfma_f32_16x16x32_bf16(al, bh[c], acc[c], 0, 0, 0); acc[c] = __builtin_amdgcn_mfma_f32_16x16x32_bf16(ah, bl[c], acc[c], 0, 0, 0);
                  acc[c] = __builtin_amdgcn_mfma_f32_16x16x32_bf16(ah, bh[c], acc[c], 0, 0, 0); } }
#pragma unroll
          for (int c = 0; c < 3; ++c)
#pragma unroll
              for (int r = 0; r < 4; ++r) part[(w * 16 + 4 * kq + r) * 48 + 16 * c + ar] = acc[c][r]; }
        __syncthreads();
        if (w == 0) {
            const LAS float* Pp = part + ar * 48;
            float gl[4]; int gs = 0;
#pragma unroll
            for (int j = 0; j < 4; ++j) { float s = 0.f;
#pragma unroll
                for (int ww = 0; ww < 8; ++ww) s += Pp[ww * 768 + 32 + j];
                gl[j] = s + bias[32 + j]; }
#pragma unroll
            for (int j = 1; j < 4; ++j) if (gl[j] > gl[gs]) gs = j;
            float den = 0.f;
#pragma unroll
            for (int j = 0; j < 4; ++j) den += expf(gl[j] - gl[gs]);
            const float pg = 1.f / den;
            float el[8];
#pragma unroll
            for (int j = 0; j < 8; ++j) { float s = 0.f;
#pragma unroll
                for (int ww = 0; ww < 8; ++ww) s += Pp[ww * 768 + 8 * gs + j];
                el[j] = s + bias[8 * gs + j]; }
            int i0 = 0;
#pragma unroll
            for (int j = 1; j < 8; ++j) if (el[j] > el[i0]) i0 = j;
            int i1 = (i0 == 0) ? 1 : 0;
#pragma unroll
            for (int j = 0; j < 8; ++j) if (j != i0 && el[j] > el[i1]) i1 = j;
            const float e1 = expf(el[i1] - el[i0]); const float w0 = pg / (1.f + e1), w1 = pg * e1 / (1.f + e1);
            const int x0 = 8 * gs + i0, x1 = 8 * gs + i1, el_ = lane & 31;
            int lp0 = 0, lp1 = 0, cn = 0;
#pragma unroll
            for (int j = 0; j < 16; ++j) { const int y0 = __builtin_amdgcn_readlane(x0, j), y1 = __builtin_amdgcn_readlane(x1, j);
                const int m0 = (y0 == x0) | (y1 == x0), m1 = (y0 == x1) | (y1 == x1);
                lp0 += (j < ar) ? m0 : 0; lp1 += (j < ar) ? m1 : 0; cn += (y0 == el_) + (y1 == el_); }
            if (lane < 32) CNT[it * 32 + lane] = cn;
            if (lane < 16) { int* R = ROUTE + (size_t)(t0 + lane) * 8; R[0] = x0; R[1] = x1; R[2] = (int)__float_as_uint(w0); R[3] = (int)__float_as_uint(w1); R[4] = lp0; R[5] = lp1; }
        }
    }
}

__device__ __forceinline__ void phase_gather(Frame& F, int l) {
    const int lane = F.lane, tid = F.tid, w = F.wave;
    int* info = F.info + l * 256;
    const bf16* X1B = WSP(bf16, WS_X1B); bf16* XG = WSP(bf16, WS_XG); const int* ROUTE = WSP(int, WS_ROUTE); int* ROWMAP = WSP(int, WS_ROWMAP); float* ROWW = WSP(float, WS_ROWW); const int* CNT = WSP(int, WS_CNT);
    if (F.bid >= 32) return;
    LAS int* off = (LAS int*)F.lds;
    LAS int* TOT = off + 64;
    LAS int* CS = off + 128;
    LAS int* PT = off + 1024;
    { const int e = tid & 31, c = tid >> 5; int v[32]; int s = 0;
#pragma unroll
      for (int j = 0; j < 32; ++j) v[j] = CNT[(32 * c + j) * 32 + e];
#pragma unroll
      for (int j = 0; j < 32; ++j) s += v[j];
      CS[c * 32 + e] = s;
      __syncthreads();
      int base = 0, tot = 0;
#pragma unroll
      for (int c2 = 0; c2 < 16; ++c2) { const int x = CS[c2 * 32 + e]; base += c2 < c ? x : 0; tot += x; }
      if (c == 0) TOT[e] = tot;
      int p = base;
#pragma unroll
      for (int j = 0; j < 32; ++j) { PT[(32 * c + j) * 32 + e] = p; p += v[j]; } }
    __syncthreads();
    if (w == 0) { const int c = lane < 32 ? TOT[lane & 31] : 0; const int nt = (c + 255) >> 8; int inc = nt;
#pragma unroll
        for (int o = 1; o < 32; o <<= 1) { const int u = __shfl_up(inc, o); if (lane >= o) inc += u; }
        const int exc = inc - nt;
        if (lane < 32) off[lane] = exc << 8;
        if (lane == 31) off[32] = inc << 8;
        if (F.bid == 0) { if (lane < 32) {
#pragma nounroll
                for (int j = 0; j < nt; ++j) __hip_atomic_store(info + exc + j, lane, RLX_AGENT); }
            if (lane == 31) info[128] = inc; } }
    __syncthreads();
    for (int e = F.bid; e < 32; e += F.G) { const int c = TOT[e]; for (int r = off[e] + c + tid; r < off[e + 1]; r += 512) { ROWMAP[r] = -1; ROWW[r] = 0.f; } }
    const int gw = F.bid * 8 + F.wave, NGW = F.G * 8;
    for (int tb = gw * 64 + lane; tb < T; tb += (F.G < 32 ? F.G : 32) * 512) {
        const int t = tb; const int* R = ROUTE + (size_t)t * 8; const int e0 = R[0], e1 = R[1], p0 = R[4], p1 = R[5];
        const int d0 = off[e0] + PT[(t >> 4) * 32 + e0] + p0, d1 = off[e1] + PT[(t >> 4) * 32 + e1] + p1;
        ROWMAP[d0] = 2 * t; ROWMAP[d1] = 2 * t + 1; ROWW[d0] = __uint_as_float((unsigned)R[2]); ROWW[d1] = __uint_as_float((unsigned)R[3]);
    }
    __syncthreads();
}

__device__ __forceinline__ void phase_ln2(Frame& F, const Args& a, int l, float* xout) {
    const int gw = F.bid * 8 + F.wave, NGW = F.G * 8, lane = F.lane;
    const bf16* X1B = WSP(bf16, WS_X1B); const bf16* Y = WSP(bf16, WS_Y); bf16* HB = WSP(bf16, WS_HB);
    const float* g2 = (a.in[I_LN2G] + F.z) + l * 2048; const float* b2 = (a.in[I_LN2B] + F.z) + l * 2048;
    for (int tb = gw; tb < T; tb += 2 * NGW) {
        v4u xv[2][4], a0[2][4], a1[2][4];
#pragma unroll
        for (int u = 0; u < 2; ++u) { const int t = tb + u * NGW < T ? tb + u * NGW : tb;
            const GAS v4u* xr = (const GAS v4u*)(X1B + (size_t)t * 2048) + lane; const GAS v4u* y0 = (const GAS v4u*)(Y + (size_t)(2 * t) * 2048) + lane; const GAS v4u* y1 = (const GAS v4u*)(Y + (size_t)(2 * t + 1) * 2048) + lane;
#pragma unroll
            for (int j = 0; j < 4; ++j) { xv[u][j] = xr[64 * j]; a0[u][j] = y0[64 * j]; a1[u][j] = y1[64 * j]; } }
#pragma unroll
        for (int u = 0; u < 2; ++u) { const int t = tb + u * NGW; if (t < T) {
        f32x4 v[8]; float s = 0.f;
#pragma unroll
        for (int j = 0; j < 4; ++j) { const v4u x_ = xv[u][j], b0 = a0[u][j], b1 = a1[u][j];
            v[2 * j][0] = ALPHA * bflo(x_.x) + (bflo(b0.x) + bflo(b1.x)); v[2 * j][1] = ALPHA * bfhi(x_.x) + (bfhi(b0.x) + bfhi(b1.x)); v[2 * j][2] = ALPHA * bflo(x_.y) + (bflo(b0.y) + bflo(b1.y)); v[2 * j][3] = ALPHA * bfhi(x_.y) + (bfhi(b0.y) + bfhi(b1.y));
            v[2 * j + 1][0] = ALPHA * bflo(x_.z) + (bflo(b0.z) + bflo(b1.z)); v[2 * j + 1][1] = ALPHA * bfhi(x_.z) + (bfhi(b0.z) + bfhi(b1.z)); v[2 * j + 1][2] = ALPHA * bflo(x_.w) + (bflo(b0.w) + bflo(b1.w)); v[2 * j + 1][3] = ALPHA * bfhi(x_.w) + (bfhi(b0.w) + bfhi(b1.w)); }
#pragma unroll
        for (int j = 0; j < 8; ++j) s += (v[j].x + v[j].y) + (v[j].z + v[j].w);
        const float mean = wave_sum(s) * (1.f / 2048.f); float s2 = 0.f;
#pragma unroll
        for (int j = 0; j < 8; ++j) { v[j] = v[j] - mean; s2 += (v[j].x * v[j].x + v[j].y * v[j].y) + (v[j].z * v[j].z + v[j].w * v[j].w); }
        const float rstd = 1.f / sqrtf(wave_sum(s2) * (1.f / 2048.f) + LN_EPS);
#pragma unroll
        for (int j = 0; j < 4; ++j) { const int col = 8 * lane + 512 * j;
            const f32x4 ga = *(const GAS f32x4*)(g2 + col), gb = *(const GAS f32x4*)(g2 + col + 4), ba = *(const GAS f32x4*)(b2 + col), bb = *(const GAS f32x4*)(b2 + col + 4);
            const f32x4 o0 = v[2 * j] * rstd * ga + ba, o1 = v[2 * j + 1] * rstd * gb + bb;
            if (l + 1 == NLAYER) { *(GAS f32x4*)(xout + (size_t)t * 2048 + col) = o0; *(GAS f32x4*)(xout + (size_t)t * 2048 + col + 4) = o1; }
            else { v4u ob; ob.x = cvtpk(o0[0], o0[1]); ob.y = cvtpk(o0[2], o0[3]); ob.z = cvtpk(o1[0], o1[1]); ob.w = cvtpk(o1[2], o1[3]); *(GAS v4u*)(HB + (size_t)t * 2048 + col) = ob; } }
        } }
    }
}

#ifndef MK_PER_PHASE
#define MK_PER_PHASE 0
#endif
constexpr int NPHASE = 1 + 15 * NLAYER;
#ifndef PH_MASK
#define PH_MASK 0xFFFF
#endif
constexpr bool EN(int k) { return (PH_MASK >> k) & 1; }
#ifndef DBG_DOUBLE_MASK
#define DBG_DOUBLE_MASK 0
#endif
constexpr int REP(int k) { return ((DBG_DOUBLE_MASK >> k) & 1) ? 2 : 1; }
__global__ void __launch_bounds__(512, 2) fwd(Args a) {
    extern __shared__ __attribute__((aligned(16))) unsigned char lds_raw[];
    Frame F;
    F.lds = (LAS unsigned char*)lds_raw; F.MISC = (volatile LAS unsigned*)(F.lds + MISC_OFF);
    F.wave = __builtin_amdgcn_readfirstlane((int)threadIdx.x >> 6); F.lane = lane_id(); F.tid = F.wave * 64 + F.lane; F.G = gridDim.x; F.bid = blockIdx.x;
    F.z = 0; F.ws = a.ws; F.ctl = (gu32*)(F.ws + WS_CTL); F.info = (int*)(F.ws + WS_INFO);
    if (F.tid < 64) F.MISC[F.tid] = 0u;
    __syncthreads();
    XcdBarrier bar = xcd_barrier_post((unsigned*)(F.ctl + CW_BAR), F.MISC + 8, F.wave == 0 ? 1u : 0u);
    const int lo = a.ph_lo, hi = a.ph_hi;
#define ENTER() do { size_t z_ = 0; asm volatile("" : "+s"(z_)); F.z = z_; unsigned char* w_ = a.ws + z_; F.ws = w_; F.ctl = (gu32*)(w_ + WS_CTL); F.info = (int*)(w_ + WS_INFO); int wv_ = F.wave; asm volatile("" : "+s"(wv_)); int t_ = wv_ * 64 + lane_id(); asm volatile("" : "+v"(t_)); F.tid = t_; F.lane = t_ & 63; F.wave = wv_; } while (0)
#ifndef DBG_TIME_MASK
#define DBG_TIME_MASK 0
#endif
#ifndef DBG_TIME_LMASK
#define DBG_TIME_LMASK 3
#endif
#define TSTART(k) do { if (((DBG_TIME_MASK >> (k)) & 1) && ((DBG_TIME_LMASK >> l) & 1) && F.bid == 0 && F.wave == 0) { if (lane_id() == 0) { const unsigned long long t_ = __builtin_amdgcn_s_memrealtime(); F.MISC[22] = (unsigned)t_; } } } while (0)
#define TSTOP(k) do { if (((DBG_TIME_MASK >> (k)) & 1) && ((DBG_TIME_LMASK >> l) & 1) && F.bid == 0 && F.wave == 0) { if (lane_id() == 0) { const unsigned t_ = (unsigned)__builtin_amdgcn_s_memrealtime(); F.MISC[20] = F.MISC[20] + (t_ - F.MISC[22]); } } } while (0)
#define IN(k) (lo <= (k) && (k) < hi)
#define SEAM(k) do { if (lo <= (k) && (k) + 1 < hi) xcd_barrier(bar); } while (0)
    { const int l = 0; TSTART(0); if constexpr (EN(0)) if (IN(0)) for (int rep = 0; rep < REP(0); ++rep) { ENTER(); prologue(F, a); conv_layer(F, a, 0); } SEAM(0); TSTOP(0); }
#pragma unroll
    for (int l = 0; l < NLAYER; ++l) {
        const int pb = 1 + 15 * l;

        TSTART(1); if constexpr (EN(1)) if (IN(pb + 1)) for (int rep = 0; rep < REP(1); ++rep) { ENTER();
            pg8::Gemm g{WSP(bf16, WS_HB), WSP(bf16, WS_WA + WD(l)), T, NA, DM, DM}; pg8::StaticOrder S; S.init(T, NA, F.G, F.bid);
            pg8::EpiA E; E.proj = WSP(bf16, WS_PROJ); E.gate = WSP(bf16, WS_GATE); E.bgate = (a.in[I_BGATE] + F.z) + l * 6144; E.qs = SM_SCALE * LOG2E;
            pg8::gemm_phase<pg8::EpiA, pg8::StaticOrder, true, true>(F.lds, g, S, E, F.tid);
            if (l == 0) { pg8::Gemm g2{WSP(bf16, WS_MEMB), WSP(bf16, WS_WMEM), 256, 1024, DM, DM}; pg8::StaticOrder S2; S2.init(256, 1024, F.G, F.G - 1 - F.bid);
                pg8::EpiScale E2; E2.O = WSP(bf16, WS_MKV); E2.ldc = 1024; E2.pn_a = 0; E2.sa = 1.f; E2.sb = 1.f;
                int t2_ = F.tid; asm volatile("" : "+v"(t2_));
                pg8::gemm_phase<pg8::EpiScale, pg8::StaticOrder, true, true>(F.lds, g2, S2, E2, t2_); }
        } SEAM(pb + 1); TSTOP(1);
        TSTART(2); if constexpr (EN(2)) if (IN(pb + 2)) for (int rep = 0; rep < REP(2); ++rep) { ENTER(); phase_norms(F, a, l); } SEAM(pb + 2); TSTOP(2);
        TSTART(3); if constexpr (EN(3)) if (IN(pb + 3)) for (int rep = 0; rep < REP(3); ++rep) { ENTER();
            phase_moba_gate(F);
            { int t3_ = F.tid; asm volatile("" : "+v"(t3_)); F.tid = t3_; }
            { pg8::Gemm g{WSP(bf16, WS_CQN), WSP(bf16, WS_WC1 + WD(l)), T, NQAI, 512, 512}; pg8::StaticOrder S; S.init(T, NQAI, F.G, F.bid);
              pg8::EpiScale E; E.O = WSP(bf16, WS_QAI); E.ldc = NQAI; E.pn_a = 3; E.sa = SM_SCALE * LOG2E; E.sb = 0.125f;
              pg8::gemm_phase<pg8::EpiScale, pg8::StaticOrder, true, true>(F.lds, g, S, E, F.tid); }
            { pg8::Gemm g{WSP(bf16, WS_CKVN), WSP(bf16, WS_WC2 + WD(l)), T, NKVA, 256, 256}; pg8::StaticOrder S; S.init(T, NKVA, F.G, F.G - 1 - F.bid);
              pg8::EpiScale E; E.O = WSP(bf16, WS_KVA); E.ldc = NKVA; E.pn_a = 0; E.sa = 1.f; E.sb = 1.f;
              pg8::gemm_phase<pg8::EpiScale, pg8::StaticOrder, true, true>(F.lds, g, S, E, F.tid); }
        } SEAM(pb + 3); TSTOP(3);
        TSTART(4); if constexpr (EN(4)) if (IN(pb + 4)) for (int rep = 0; rep < REP(4); ++rep) { ENTER(); TSUB_START(5); phase_moba_lists(F); TSUB_STOP(5); TSUB_START(8); phase_indexer(F); TSUB_STOP(8); } SEAM(pb + 4); TSTOP(4);
        TSTART(5); if constexpr (EN(5)) if (IN(pb + 5)) for (int rep = 0; rep < REP(5); ++rep) { ENTER(); phase_attention(F, a, l, rep); } SEAM(pb + 5); TSTOP(5);
        TSTART(6); if constexpr (EN(6)) if (IN(pb + 6)) for (int rep = 0; rep < REP(6); ++rep) { ENTER(); phase_attn_merge(F); } SEAM(pb + 6); TSTOP(6);
        TSTART(7); if constexpr (EN(7)) if (IN(pb + 7)) for (int rep = 0; rep < REP(7); ++rep) { ENTER();
{ pg8::Gemm g{WSP(bf16, WS_OATT), WSP(bf16, WS_WUP + WD(l)), T, DM, DM, DM}; pg8::UpOrder S; S.so.init(T, DM, F.G, F.bid);
              pg8::EpiUpChain E; E.gate = WSP(bf16, WS_GATE); E.O = WSP(bf16, WS_MERGED);
              pg8::gemm_phase<pg8::EpiUpChain, pg8::UpOrder, true, true>(F.lds, g, S, E, F.tid); }
        } SEAM(pb + 7); TSTOP(7);
        TSTART(8); if constexpr (EN(8)) if (IN(pb + 8)) for (int rep = 0; rep < REP(8); ++rep) { ENTER();
            pg8::Gemm g{WSP(bf16, WS_MERGED), WSP(bf16, WS_WO + WD(l)), T, DM, DM, DM}; pg8::StaticOrder S; S.init(T, DM, F.G, F.bid);
            pg8::EpiPreB E; E.xb = WSP(bf16, WS_HB); E.pre = WSP(bf16, WS_PRE); E.alpha = ALPHA;
            pg8::gemm_phase<pg8::EpiPreB, pg8::StaticOrder, true, true>(F.lds, g, S, E, F.tid);
        } SEAM(pb + 8); TSTOP(8);
        TSTART(9); if constexpr (EN(9)) if (IN(pb + 9)) for (int rep = 0; rep < REP(9); ++rep) { ENTER(); phase_ln1_router(F, a, l, rep); } SEAM(pb + 9); TSTOP(9);
        TSTART(10); if constexpr (EN(10)) if (IN(pb + 10)) for (int rep = 0; rep < REP(10); ++rep) { ENTER(); phase_gather(F, l); } SEAM(pb + 10); TSTOP(10);
        TSTART(11); if constexpr (EN(11)) if (IN(pb + 11)) for (int rep = 0; rep < REP(11); ++rep) { ENTER();
            const int* info = F.info + l * 256; const int ntile = __builtin_amdgcn_readfirstlane(info[128]); const int n1 = ntile < 64 ? ntile : 64;
            pg8::Gemm g{WSP(bf16, WS_X1B), WSP(bf16, WS_W13 + WD(l)), MPAD, 32 * 1024, DM, DM};        pg8::MoeOrder S; S.tile_e = info; S.m_lo = 0; S.m_cnt = n1; S.nN = 4; S.G = F.G; S.c = F.bid;
            pg8::EpiMoeA E; E.hid = WSP(bf16, WS_HID); E.rowsrc = WSP(int, WS_ROWMAP);
            pg8::gemm_phase<pg8::EpiMoeA, pg8::MoeOrder, true, true>(F.lds, g, S, E, F.tid);
        } SEAM(pb + 11); TSTOP(11);
        TSTART(12); if constexpr (EN(12)) if (IN(pb + 12)) for (int rep = 0; rep < REP(12); ++rep) { ENTER();
            const int* info = F.info + l * 256; const int ntile = __builtin_amdgcn_readfirstlane(info[128]); const int n1 = ntile < 64 ? ntile : 64; int nA2 = (ntile - n1) * 4; nA2 = nA2 < F.G ? nA2 : F.G;
            { pg8::Gemm g{WSP(bf16, WS_X1B), WSP(bf16, WS_W13 + WD(l)), MPAD, 32 * 1024, DM, DM};        pg8::MoeOrder S; S.tile_e = info; S.m_lo = n1; S.m_cnt = ntile - n1; S.nN = 4; S.G = nA2; S.c = F.bid;
              pg8::EpiMoeA E; E.hid = WSP(bf16, WS_HID); E.rowsrc = WSP(int, WS_ROWMAP);
              pg8::gemm_phase<pg8::EpiMoeA, pg8::MoeOrder, true, true>(F.lds, g, S, E, F.tid); }
            { pg8::Gemm g{WSP(bf16, WS_HID), WSP(bf16, WS_W2 + WD(l)), MPAD, 32 * 2048, DEXP, DEXP}; pg8::MoeOrder S; S.tile_e = info; S.m_lo = 0; S.m_cnt = n1; S.nN = 8; S.G = F.G - nA2; S.c = F.bid - nA2;
              pg8::EpiMoeB E; E.Y = WSP(bf16, WS_Y); E.rowmap = WSP(int, WS_ROWMAP); E.roww = WSP(float, WS_ROWW);
              int t2_ = F.tid; asm volatile("" : "+v"(t2_));
              pg8::gemm_phase<pg8::EpiMoeB, pg8::MoeOrder, true, true>(F.lds, g, S, E, t2_); }
        } SEAM(pb + 12); TSTOP(12);
        TSTART(13); if constexpr (EN(13)) if (IN(pb + 13)) for (int rep = 0; rep < REP(13); ++rep) { ENTER();
            const int* info = F.info + l * 256; const int ntile = __builtin_amdgcn_readfirstlane(info[128]); const int n1 = ntile < 64 ? ntile : 64;
            pg8::Gemm g{WSP(bf16, WS_HID), WSP(bf16, WS_W2 + WD(l)), MPAD, 32 * 2048, DEXP, DEXP}; pg8::MoeOrder S; S.tile_e = info; S.m_lo = n1; S.m_cnt = ntile - n1; S.nN = 8; S.G = F.G; S.c = F.bid;
            pg8::EpiMoeB E; E.Y = WSP(bf16, WS_Y); E.rowmap = WSP(int, WS_ROWMAP); E.roww = WSP(float, WS_ROWW);
            pg8::gemm_phase<pg8::EpiMoeB, pg8::MoeOrder, true, true>(F.lds, g, S, E, F.tid);
        } SEAM(pb + 13); TSTOP(13);
        TSTART(14); if constexpr (EN(14)) if (IN(pb + 14)) for (int rep = 0; rep < REP(14); ++rep) { ENTER(); phase_ln2(F, a, l, (a.out + F.z)); } if (l + 1 < NLAYER) SEAM(pb + 14); TSTOP(14);
    }
#ifdef DBG_EXTRA_BARRIERS
    for (int i = 0; i < DBG_EXTRA_BARRIERS; ++i) xcd_barrier(bar);
#endif
    if ((DBG_TIME_MASK || DBG_TSUB) && F.bid == (DBG_TSUB ? DBG_TBID : 0) && F.wave == 0) { if (lane_id() == 0) { const unsigned long long t0_ = __builtin_amdgcn_s_memrealtime(); const unsigned w_ = F.MISC[20]; while (__builtin_amdgcn_s_memrealtime() - t0_ < (unsigned long long)w_) __builtin_amdgcn_s_sleep(8); } }
#undef IN
#undef SEAM
}


#ifdef DBG_STOP_PHASE
__global__ void dbg_dump(const unsigned char* ws, size_t off, int kind, long n, float* out, long nout) {
    for (long i = blockIdx.x * 256L + threadIdx.x; i < nout; i += gridDim.x * 256L) { const long j = i % n; float v;
        if (kind == 0) v = __builtin_bit_cast(float, (unsigned)((const unsigned short*)(ws + off))[j] << 16);
        else if (kind == 1) v = ((const float*)(ws + off))[j];
        else v = (float)(((const unsigned*)(ws + off))[j] & 0xffffu);
        out[i] = v; }
}
#endif
extern "C" void kernel_launch(void* const* d_in, const int* in_sizes, int n_in, void* d_out, int out_size, void* d_ws, size_t ws_size, hipStream_t stream) {
    static int grid = 0;
    if (grid == 0) {
        if (n_in != 28 || out_size != T * DM || ws_size < WS_END) { fprintf(stderr, "kernel_launch: unexpected shapes (n_in %d out %d ws %zu)\n", n_in, out_size, ws_size); grid = -1; return; }
        int dev = 0, cus = 0;
        if (hipGetDevice(&dev) != hipSuccess || hipDeviceGetAttribute(&cus, hipDeviceAttributeMultiprocessorCount, dev) != hipSuccess) { grid = -1; return; }
        if (hipFuncSetAttribute((const void*)fwd, hipFuncAttributeMaxDynamicSharedMemorySize, LDS_BYTES) != hipSuccess) { fprintf(stderr, "kernel_launch: hipFuncSetAttribute failed\n"); grid = -1; return; }
        int per_cu = 0;
        if (hipOccupancyMaxActiveBlocksPerMultiprocessor(&per_cu, (const void*)fwd, 512, LDS_BYTES) != hipSuccess || per_cu < 1) fprintf(stderr, "kernel_launch: occupancy query says %d\n", per_cu);
        (void)hipGetLastError();
        grid = cus;
    }
    if (grid < 0) return;
    if (hipMemsetAsync((char*)d_ws + WS_CTL, 0, CTL_ZERO_BYTES, stream) != hipSuccess) return;
    Args a{};
    for (int i = 0; i < 28; ++i) a.in[i] = (const float*)d_in[i];
    a.out = (float*)d_out; a.ws = (unsigned char*)d_ws;
#if defined(DBG_STOP_PHASE)
    for (int k = 0; k <= DBG_STOP_PHASE; ++k) { a.ph_lo = k; a.ph_hi = k + 1; hipLaunchKernelGGL(fwd, dim3(grid), dim3(512), LDS_BYTES, stream, a); }
    hipLaunchKernelGGL(dbg_dump, dim3(2048), dim3(256), 0, stream, (const unsigned char*)d_ws, (size_t)DBG_DUMP_OFF, DBG_DUMP_KIND, (long)DBG_DUMP_N, (float*)d_out, (long)out_size);
#elif MK_PER_PHASE
    for (int k = 0; k < NPHASE; ++k) { a.ph_lo = k; a.ph_hi = k + 1; hipLaunchKernelGGL(fwd, dim3(grid), dim3(512), LDS_BYTES, stream, a); }
#else
    a.ph_lo = 0; a.ph_hi = NPHASE;
    hipLaunchKernelGGL(fwd, dim3(grid), dim3(512), LDS_BYTES, stream, a);
#endif
    const hipError_t le = hipPeekAtLastError();
    if (le != hipSuccess) fprintf(stderr, "kernel_launch: launch failed: %s\n", hipGetErrorName(le));
}
```
